# Optimizing an MI355X kernel written in HIP

```python
import jax, jax.numpy as jnp
from jax import lax
import numpy as np

D_MODEL = 1024
BATCH = 32
SEQ = 2048
DEPTH = 1
DEC_BATCH = 2
DEC_SEQ = 16384
PAST_LEN = 128

POOL_GROUPS = 4
POOL_GROUP_DIM = 128
POOL_WIDTH = POOL_GROUPS * POOL_GROUP_DIM
POOL_WINDOWS = (2, 4, 8, 16)
HEAD_DIM = 64
N_HEADS = D_MODEL // HEAD_DIM
RWKV_WIDTH = N_HEADS * HEAD_DIM
DECAY_LORA = 64
AAA_LORA = 64
GATE_LORA = 128
D_FF = 4 * D_MODEL
N_BRANCHES = 2
RMS_EPS = 1e-6
GN_EPS = 64e-5
L2_EPS = 1e-12

COL_POOL = 0
COL_R = COL_POOL + POOL_WIDTH
COL_K = COL_R + RWKV_WIDTH
COL_V = COL_K + RWKV_WIDTH
COL_W = COL_V + RWKV_WIDTH
COL_A = COL_W + DECAY_LORA
COL_G = COL_A + AAA_LORA
COL_GATE = COL_G + GATE_LORA
IN_COLS = COL_GATE + N_BRANCHES * D_MODEL
SHIFT_WIDTH = COL_GATE - COL_R

kernel_name = "pool_rwkv7_bidir_hybrid_encoder"


def rms_norm(x, g):
    xf = x.astype(jnp.float32)
    y = xf * lax.rsqrt(jnp.mean(xf * xf, axis=-1, keepdims=True) + RMS_EPS)
    return (y * g.astype(jnp.float32)).astype(x.dtype)


def centred_shift_mix(z, mu_prev, mu_next):
    z_prev = jnp.pad(z, ((0, 0), (1, 0), (0, 0)))[:, :-1]
    z_next = jnp.pad(z, ((0, 0), (0, 1), (0, 0)))[:, 1:]
    return z + mu_prev * (z_prev - z) + mu_next * (z_next - z)


def multiscale_pool(u):
    B, S, _ = u.shape
    ug = u.reshape(B, S, POOL_GROUPS, POOL_GROUP_DIM).astype(jnp.float32)
    cs = jnp.concatenate([jnp.zeros((B, 1, POOL_GROUPS, POOL_GROUP_DIM), jnp.float32),
                          jnp.cumsum(ug, axis=1)], axis=1)
    t = np.arange(S)
    outs = []
    for gi, w in enumerate(POOL_WINDOWS):
        lo = np.maximum(t - w // 2, 0)
        hi = np.minimum(t + w // 2 - 1, S - 1)
        cnt = (hi - lo + 1).astype(np.float32)[None, :, None]
        csg = cs[:, :, gi]
        outs.append((csg[:, hi + 1] - csg[:, lo]) / cnt - ug[:, :, gi])
    return jnp.stack(outs, axis=2)


def wkv7_scan(r, k, v, w, kk, a, reverse):
    B, _, H, N = r.shape
    xs = tuple(jnp.moveaxis(t_, 1, 0) for t_ in (r, k, v, w, -kk, kk * a))

    def step(state, inp):
        r_t, k_t, v_t, w_t, a_t, b_t = inp
        sa = jnp.einsum('bhvk,bhk->bhv', state, a_t)
        state = (state * w_t[:, :, None, :] + sa[..., None] * b_t[:, :, None, :]
                 + v_t[..., None] * k_t[:, :, None, :])
        return state, jnp.einsum('bhvk,bhk->bhv', state, r_t)

    s0 = jnp.zeros((B, H, N, N), jnp.float32)
    _, ys = lax.scan(step, s0, xs, reverse=reverse)
    return jnp.moveaxis(ys, 0, 1)


def head_group_norm(y, w, b):
    mean = jnp.mean(y, axis=-1, keepdims=True)
    var = jnp.mean(jnp.square(y - mean), axis=-1, keepdims=True)
    return ((y - mean) * lax.rsqrt(var + GN_EPS) * w.reshape(N_HEADS, HEAD_DIM).astype(jnp.float32)
            + b.reshape(N_HEADS, HEAD_DIM).astype(jnp.float32))


def rwkv_branch(zr, zk, zv, zw, za, zg, k_k, k_a, r_k, w0_f, w_up_f, a0_f, a_up_f,
                w0_b, w_up_b, a0_b, a_up_b, g_up, ln_w, ln_b):
    B, S, _ = zr.shape
    heads = lambda t_: t_.astype(jnp.float32).reshape(B, S, N_HEADS, HEAD_DIM)
    r, k, v = heads(zr), heads(zk), heads(zv)
    kk = heads(zk * k_k)
    kk = kk / jnp.maximum(jnp.linalg.norm(kk, axis=-1, keepdims=True), L2_EPS)
    k_a_h = k_a.reshape(N_HEADS, HEAD_DIM).astype(jnp.float32)
    tw = jnp.tanh(zw)
    y_sum = jnp.zeros_like(r)
    k_sum = jnp.zeros_like(r)
    for w0, w_up, a0, a_up, rev in ((w0_f, w_up_f, a0_f, a_up_f, False),
                                    (w0_b, w_up_b, a0_b, a_up_b, True)):
        w_raw = (w0 + tw @ w_up).astype(jnp.float32)
        w = jnp.exp(-jnp.exp(-jax.nn.softplus(-w_raw) - 0.5))
        a = heads(jax.nn.sigmoid(a0 + za @ a_up))
        k_d = k * (1.0 + (a - 1.0) * k_a_h)
        y_sum = y_sum + wkv7_scan(r, k_d, v, heads(w), kk, a, rev)
        k_sum = k_sum + k_d
    y = head_group_norm(y_sum, ln_w, ln_b)
    y = y + jnp.sum(r * k_sum * r_k.astype(jnp.float32), axis=-1, keepdims=True) * v
    g = jax.nn.sigmoid(zg) @ g_up
    return (y.reshape(B, S, RWKV_WIDTH) * g.astype(jnp.float32)).astype(zr.dtype)


def encoder_layer(x, g_mix, w_in, b_gate, mu_prev, mu_next, pool_w, pool_scale, w_pool_br,
                  k_k, k_a, r_k, w0_f, w_up_f, a0_f, a_up_f, w0_b, w_up_b, a0_b, a_up_b,
                  g_up, ln_w, ln_b, w_rwkv_br, w_out, g_ffn, w_ff1, w_ff2):
    B, S, _ = x.shape
    xn = rms_norm(x, g_mix)
    z = xn @ w_in
    pooled = multiscale_pool(z[..., COL_POOL:COL_R])
    pooled = jnp.einsum('bsgc,gcd->bsgd', pooled, pool_w.astype(jnp.float32))
    pooled = (pooled.reshape(B, S, POOL_WIDTH) * pool_scale.astype(jnp.float32)).astype(x.dtype)
    pool_out = pooled @ w_pool_br
    zs = centred_shift_mix(z[..., COL_R:COL_GATE], mu_prev, mu_next)
    o = lambda c0, c1: zs[..., c0 - COL_R:c1 - COL_R]
    rw = rwkv_branch(o(COL_R, COL_K), o(COL_K, COL_V), o(COL_V, COL_W), o(COL_W, COL_A),
                     o(COL_A, COL_G), o(COL_G, COL_GATE), k_k, k_a, r_k, w0_f, w_up_f, a0_f, a_up_f,
                     w0_b, w_up_b, a0_b, a_up_b, g_up, ln_w, ln_b)
    rwkv_out = rw @ w_rwkv_br
    gates = jax.nn.sigmoid(z[..., COL_GATE:] + b_gate)
    merged = gates[..., :D_MODEL] * pool_out + gates[..., D_MODEL:] * rwkv_out
    x = x + merged @ w_out
    hn = rms_norm(x, g_ffn)
    return x + jnp.square(jax.nn.relu(hn @ w_ff1)) @ w_ff2


def setup_inputs(seed: int = 0) -> dict:
    key = jax.random.key(seed)
    ks = iter(jax.random.split(key, 40))
    nrm = lambda shape, scale: scale * jax.random.normal(next(ks), shape, jnp.float32)
    uni = lambda shape, lo, hi: jax.random.uniform(next(ks), shape, jnp.float32, lo, hi)
    L = DEPTH
    return {
        "x_prompt": nrm((BATCH, SEQ, D_MODEL), 1.0),
        "x_sample": nrm((DEC_BATCH, DEC_SEQ, D_MODEL), 1.0),
        "g_mix": 1.0 + nrm((L, D_MODEL), 0.05),
        "w_in": nrm((L, D_MODEL, IN_COLS), D_MODEL ** -0.5),
        "b_gate": nrm((L, N_BRANCHES * D_MODEL), 0.1),
        "mu_prev": uni((L, SHIFT_WIDTH), 0.1, 0.5),
        "mu_next": uni((L, SHIFT_WIDTH), 0.1, 0.5),
        "pool_w": nrm((L, POOL_GROUPS, POOL_GROUP_DIM, POOL_GROUP_DIM), POOL_GROUP_DIM ** -0.5),
        "pool_scale": 1.0 + nrm((L, POOL_WIDTH), 0.1),
        "w_pool_br": nrm((L, POOL_WIDTH, D_MODEL), POOL_WIDTH ** -0.5),
        "k_k": 0.85 + nrm((L, RWKV_WIDTH), 0.05),
        "k_a": 1.0 + nrm((L, RWKV_WIDTH), 0.05),
        "r_k": nrm((L, N_HEADS, HEAD_DIM), 0.1),
        "w0_f": uni((L, RWKV_WIDTH), -5.0, 1.0),
        "w_up_f": nrm((L, DECAY_LORA, RWKV_WIDTH), 0.5 * DECAY_LORA ** -0.5),
        "a0_f": nrm((L, RWKV_WIDTH), 0.5),
        "a_up_f": nrm((L, AAA_LORA, RWKV_WIDTH), 0.5 * AAA_LORA ** -0.5),
        "w0_b": uni((L, RWKV_WIDTH), -5.0, 1.0),
        "w_up_b": nrm((L, DECAY_LORA, RWKV_WIDTH), 0.5 * DECAY_LORA ** -0.5),
        "a0_b": nrm((L, RWKV_WIDTH), 0.5),
        "a_up_b": nrm((L, AAA_LORA, RWKV_WIDTH), 0.5 * AAA_LORA ** -0.5),
        "g_up": nrm((L, GATE_LORA, RWKV_WIDTH), GATE_LORA ** -0.5),
        "ln_w": 1.0 + nrm((L, RWKV_WIDTH), 0.05),
        "ln_b": nrm((L, RWKV_WIDTH), 0.02),
        "w_rwkv_br": nrm((L, RWKV_WIDTH, D_MODEL), RWKV_WIDTH ** -0.5),
        "w_out": nrm((L, D_MODEL, D_MODEL), D_MODEL ** -0.5),
        "g_ffn": 1.0 + nrm((L, D_MODEL), 0.05),
        "w_ff1": nrm((L, D_MODEL, D_FF), D_MODEL ** -0.5),
        "w_ff2": nrm((L, D_FF, D_MODEL), D_FF ** -0.5),
        "g_final": 1.0 + nrm((D_MODEL,), 0.05),
    }


def reference(x_prompt, x_sample, g_mix, w_in, b_gate, mu_prev, mu_next, pool_w, pool_scale,
              w_pool_br, k_k, k_a, r_k, w0_f, w_up_f, a0_f, a_up_f, w0_b, w_up_b, a0_b, a_up_b,
              g_up, ln_w, ln_b, w_rwkv_br, w_out, g_ffn, w_ff1, w_ff2, g_final):
    def trunk(x):
        for l in range(DEPTH):
            x = encoder_layer(x, g_mix[l], w_in[l], b_gate[l], mu_prev[l], mu_next[l], pool_w[l],
                              pool_scale[l], w_pool_br[l], k_k[l], k_a[l], r_k[l], w0_f[l], w_up_f[l],
                              a0_f[l], a_up_f[l], w0_b[l], w_up_b[l], a0_b[l], a_up_b[l], g_up[l],
                              ln_w[l], ln_b[l], w_rwkv_br[l], w_out[l], g_ffn[l], w_ff1[l], w_ff2[l])
        return rms_norm(x, g_final)

    y_prompt = trunk(x_prompt)
    y_sample = trunk(x_sample)
    return (y_prompt, y_sample)
```

```cpp
#include <hip/hip_runtime.h>
#include <hip/hip_cooperative_groups.h>
#include <cstdio>
namespace cg = cooperative_groups;

#define LAS __attribute__((address_space(3)))
typedef unsigned short bf16_t;
typedef short bf16x8 __attribute__((ext_vector_type(8)));
typedef float f32x4 __attribute__((ext_vector_type(4)));
typedef float f32x2 __attribute__((ext_vector_type(2)));
typedef unsigned u32x4 __attribute__((ext_vector_type(4)));
typedef unsigned u32x2 __attribute__((ext_vector_type(2)));

constexpr int T_TOK = 98304, DM = 1024, TP = 65536;
constexpr int ZLD = 3840;
constexpr int COL_R = 512, COL_K = 1536, COL_V = 2560, COL_W = 3584, COL_A = 3648, COL_G = 3712;
constexpr size_t MiB = 1ull << 20;
constexpr size_t OFF_WIN = 0, OFF_WEFF = 12 * MiB, OFF_WRBR = 13 * MiB, OFF_WOUT = 15 * MiB, OFF_WFF1 = 17 * MiB, OFF_WFF2 = 25 * MiB, OFF_WG = 33 * MiB;
constexpr size_t OFF_ROWSQ = 34 * MiB, OFF_ROWSQ2 = 34 * MiB + 512 * 1024, OFF_QUEUE = 35 * MiB, OFF_BONUS = 36 * MiB;
constexpr size_t OFF_R1 = 48 * MiB, OFF_Z = 240 * MiB;
constexpr size_t OFF_POOLED = OFF_R1, OFF_SG = OFF_R1 + 96 * MiB, OFF_XN2 = OFF_Z, OFF_GATES = OFF_Z + 192 * MiB, OFF_MERGED = OFF_Z + 576 * MiB;
constexpr size_t OFF_X1B = OFF_R1, OFF_X1 = OFF_Z, OFF_HLO = OFF_Z + 384 * MiB;
constexpr size_t U_BYTES = (size_t)T_TOK * 1024 * 2;
constexpr int N_ITEMS = 64 + 1024;

struct Params {
    const float *x_prompt, *x_sample, *g_mix, *w_in, *b_gate, *mu_prev, *mu_next, *pool_w, *pool_scale, *w_pool_br, *k_k, *k_a, *r_k,
        *w0_f, *w_up_f, *a0_f, *a_up_f, *w0_b, *w_up_b, *a0_b, *a_up_b, *g_up, *ln_w, *ln_b, *w_rwkv_br, *w_out, *g_ffn, *w_ff1, *w_ff2, *g_final;
    float* out; unsigned char* ws;
};

__device__ __forceinline__ float bf_lo(unsigned w) { return __uint_as_float(w << 16); }
__device__ __forceinline__ float bf_hi(unsigned w) { return __uint_as_float(w & 0xFFFF0000u); }
__device__ __forceinline__ unsigned pk_bf16(float lo, float hi) { unsigned r; asm("v_cvt_pk_bf16_f32 %0, %1, %2" : "=v"(r) : "v"(lo), "v"(hi)); return r; }
__device__ __forceinline__ float sigmoidf_(float x) { return 1.0f / (1.0f + __expf(-x)); }
template <int CTRL> __device__ __forceinline__ float dppf(float x) { return __int_as_float(__builtin_amdgcn_update_dpp(0, __float_as_int(x), CTRL, 0xF, 0xF, true)); }
__device__ __forceinline__ float red4(float x) { x += dppf<0xB1>(x); x += dppf<0x4E>(x); return x; }
__device__ __forceinline__ float red8(float x) { x = red4(x); x += dppf<0x141>(x); return x; }
__device__ __forceinline__ float red16(float x) { x = red8(x); x += dppf<0x140>(x); return x; }
__device__ __forceinline__ int opaque_tid() { int t = threadIdx.x; asm volatile("" : "+v"(t)); return t; }
__device__ __forceinline__ const float* xrow(const Params& p, int t) { return t < TP ? p.x_prompt + (size_t)t * DM : p.x_sample + (size_t)(t - TP) * DM; }
__device__ __forceinline__ void seq_of(int t, int& base, int& len) { if (t < TP) { base = t & ~2047; len = 2048; } else { base = TP + ((t - TP) & ~16383); len = 16384; } }

namespace pg8 {
constexpr int BM = 256, BK = 64, HALF = 128, HTB = HALF * BK * 2, STAGE_BYTES = 8 * HTB, NXCD = 8, WGM = 8;
__device__ __forceinline__ int lds_byte(int r, int c) { const int st = (r >> 4) * 2 + (c >> 5), rr = r & 15, cc = c & 31, ob = rr * 64 + cc * 2; return st * 1024 + (ob ^ (((ob >> 9) & 1) << 5)); }
__device__ __forceinline__ void stage_rc(int b, int& R, int& C) { const int st = b / 1024, sb = b % 1024, swz = sb ^ (((sb >> 9) & 1) << 5); R = (st >> 1) * 16 + swz / 64; C = (st & 1) * 32 + (swz % 64) / 2; }
__device__ __forceinline__ int perm32(int rho) { const int n = rho >> 4, i = rho & 15; return 8 * (i >> 2) + 4 * n + (i & 3); }
struct Unit { int pm, pn; };
struct Gemm { const bf16_t* A; const bf16_t* Bt; int M, N, K, lda, ldb; };
struct StaticOrder {
    int nM, nN, nwg, G, c;
    __device__ void init(int M, int N, int G_, int c_) { nM = M / BM; nN = N / BM; nwg = nM * nN; G = G_; c = c_; }
    __device__ bool next(int i, Unit& u) const {
        const long L = (long)i * G + c; if (L >= nwg) return false;
        int wgid = (int)L; { const int q = nwg / NXCD, r = nwg % NXCD, xcd = wgid % NXCD, off = wgid / NXCD; wgid = (xcd < r ? xcd * (q + 1) : r * (q + 1) + (xcd - r) * q) + off; }
        const int nig = WGM * nN, gid = wgid / nig, fm = gid * WGM, gsz = (nM - fm) < WGM ? (nM - fm) : WGM;
        u.pm = fm + ((wgid % nig) % gsz); u.pn = (wgid % nig) / gsz; return true;
    }
};

template <class Epi>
__device__ __forceinline__ void gemm_phase(LAS unsigned char* lds, const Gemm g, const StaticOrder& S, const Epi& E) {
    int tid = threadIdx.x; asm volatile("" : "+v"(tid));
    const int wid = __builtin_amdgcn_readfirstlane(tid >> 6), lane = tid & 63, wr = wid >> 2, wc = wid & 3, fr = lane & 15, fq = lane >> 4;
    const int K = g.K, nt = K / BK;
    unsigned voffA[2], voffB[2];
#pragma unroll
    for (int i = 0; i < 2; ++i) { int R, C; stage_rc(tid * 16 + i * 8192, R, C); const int Rb = (R & ~31) + perm32(R & 31);
        voffA[i] = (unsigned)(R * g.lda + C) * 2u; voffB[i] = (unsigned)(Rb * g.ldb + C) * 2u; }
    const size_t kstep = (size_t)(BK * 2);
    const size_t hstepA = (size_t)HALF * g.lda * 2, hstepB = (size_t)HALF * g.ldb * 2;
    const size_t tstepA = 2 * hstepA, tstepB = 2 * hstepB;
    const unsigned ldsw = (unsigned)wid * 1024u;
    const int aoff = lds_byte(wr * 64 + fr, fq * 8), boff = lds_byte(wc * 32 + fr, fq * 8);
#define PG8_SA(b, h) (((b) * 2 + (h)) * HTB)
#define PG8_SB(b, h) ((4 + (b) * 2 + (h)) * HTB)
#define PG8_STAGE(bufoff, gbase, voff) do { _Pragma("unroll") for (int _i = 0; _i < 2; ++_i) \
        __builtin_amdgcn_global_load_lds((const unsigned*)((const char*)(gbase) + (voff)[_i]), (LAS unsigned*)(lds + (bufoff) + ldsw + _i * 8192), 16, 0, 0); } while (0)
#define PG8_LDA(dst, b, h) do { _Pragma("unroll") for (int m = 0; m < 4; ++m) _Pragma("unroll") for (int k = 0; k < 2; ++k) dst[m][k] = *(const LAS bf16x8*)(lds + PG8_SA(b, h) + aoff + m * 2048 + k * 1024); } while (0)
#define PG8_LDB(dst, b, h) do { _Pragma("unroll") for (int n = 0; n < 2; ++n) _Pragma("unroll") for (int k = 0; k < 2; ++k) dst[n][k] = *(const LAS bf16x8*)(lds + PG8_SB(b, h) + boff + n * 2048 + k * 1024); } while (0)
#define PG8_MMA(ai, bj, At, Bt) do { __builtin_amdgcn_s_setprio(1); _Pragma("unroll") for (int m = 0; m < 4; ++m) _Pragma("unroll") for (int n = 0; n < 2; ++n) _Pragma("unroll") for (int k = 0; k < 2; ++k) \
        acc[ai][bj][m][n] = __builtin_amdgcn_mfma_f32_16x16x32_bf16(Bt[n][k], At[m][k], acc[ai][bj][m][n], 0, 0, 0); __builtin_amdgcn_s_setprio(0); } while (0)
#define PG8_WAIT_V(n) asm volatile("s_waitcnt vmcnt(" #n ")" ::: "memory")
#define PG8_WAIT_L(n) asm volatile("s_waitcnt lgkmcnt(" #n ")" ::: "memory")
#define PG8_BAR __builtin_amdgcn_s_barrier()
#define PG8_SCHED __builtin_amdgcn_sched_barrier(0)
    Unit cur, nxt; int ui = 0;
    if (!S.next(0, cur)) return;
    f32x4 acc[2][2][4][2];
#pragma unroll
    for (int a = 0; a < 2; ++a)
#pragma unroll
        for (int b = 0; b < 2; ++b)
#pragma unroll
            for (int m = 0; m < 4; ++m)
#pragma unroll
                for (int n = 0; n < 2; ++n) acc[a][b][m][n] = (f32x4){0.f, 0.f, 0.f, 0.f};
    bf16x8 At[4][2], B0[2][2], B1[2][2];
    const char* cA = (const char*)g.A + (size_t)cur.pm * tstepA; const char* cB = (const char*)g.Bt + (size_t)cur.pn * tstepB;
    PG8_STAGE(PG8_SB(0, 0), cB, voffB); PG8_STAGE(PG8_SA(0, 0), cA, voffA); PG8_STAGE(PG8_SB(0, 1), cB + hstepB, voffB); PG8_STAGE(PG8_SA(0, 1), cA + hstepA, voffA);
    if (wr == 1) PG8_BAR;
    PG8_WAIT_V(4); PG8_BAR;
    PG8_STAGE(PG8_SB(1, 0), cB + kstep, voffB); PG8_STAGE(PG8_SA(1, 0), cA + kstep, voffA); PG8_STAGE(PG8_SB(1, 1), cB + hstepB + kstep, voffB);
    PG8_WAIT_V(6); PG8_BAR;
    for (;;) {
        const bool has_next = S.next(ui + 1, nxt);
        const char* nA = has_next ? (const char*)g.A + (size_t)nxt.pm * tstepA : cA; const char* nB = has_next ? (const char*)g.Bt + (size_t)nxt.pn * tstepB : cB;
        for (int t = 0; t < nt; t += 2) {
            const bool last = (t == nt - 2);
            const char* a1 = cA + (size_t)(t + 1) * kstep;
            const char* a2 = last ? nA : cA + (size_t)(t + 2) * kstep; const char* b2 = last ? nB : cB + (size_t)(t + 2) * kstep;
            const char* a3 = a2 + kstep; const char* b3 = b2 + kstep;
            PG8_LDB(B0, 0, 0); PG8_SCHED; PG8_LDA(At, 0, 0); PG8_STAGE(PG8_SA(1, 1), a1 + hstepA, voffA);
            PG8_WAIT_L(8); PG8_BAR; PG8_WAIT_L(0); PG8_MMA(0, 0, At, B0); PG8_BAR; PG8_SCHED;
            PG8_LDB(B1, 0, 1); PG8_STAGE(PG8_SB(0, 0), b2, voffB);
            PG8_BAR; PG8_WAIT_L(0); PG8_MMA(0, 1, At, B1); PG8_BAR;
            PG8_LDA(At, 0, 1); PG8_STAGE(PG8_SA(0, 0), a2, voffA);
            PG8_BAR; PG8_WAIT_L(0); PG8_MMA(1, 0, At, B0); PG8_BAR; PG8_SCHED;
            PG8_STAGE(PG8_SB(0, 1), b2 + hstepB, voffB);
            PG8_WAIT_V(6); PG8_BAR; PG8_MMA(1, 1, At, B1); PG8_BAR;
            PG8_LDB(B0, 1, 0); PG8_SCHED; PG8_LDA(At, 1, 0); PG8_STAGE(PG8_SA(0, 1), a2 + hstepA, voffA);
            PG8_WAIT_L(8); PG8_BAR; PG8_WAIT_L(0); PG8_MMA(0, 0, At, B0); PG8_BAR; PG8_SCHED;
            PG8_LDB(B1, 1, 1); PG8_STAGE(PG8_SB(1, 0), b3, voffB);
            PG8_BAR; PG8_WAIT_L(0); PG8_MMA(0, 1, At, B1); PG8_BAR;
            PG8_LDA(At, 1, 1); PG8_STAGE(PG8_SA(1, 0), a3, voffA);
            PG8_BAR; PG8_WAIT_L(0); PG8_MMA(1, 0, At, B0); PG8_BAR; PG8_SCHED;
            PG8_STAGE(PG8_SB(1, 1), b3 + hstepB, voffB);
            PG8_WAIT_V(6); PG8_BAR; PG8_MMA(1, 1, At, B1); PG8_BAR;
        }
        E(acc, cur, wr, wc, fr, fq);
        if (!has_next) break;
#pragma unroll
        for (int a = 0; a < 2; ++a)
#pragma unroll
            for (int b = 0; b < 2; ++b)
#pragma unroll
                for (int m = 0; m < 4; ++m)
#pragma unroll
                    for (int n = 0; n < 2; ++n) acc[a][b][m][n] = (f32x4){0.f, 0.f, 0.f, 0.f};
        cur = nxt; cA = nA; cB = nB; ++ui;
    }
    PG8_WAIT_V(0);
    if (wr == 0) PG8_BAR;
    PG8_BAR;
#undef PG8_SA
#undef PG8_SB
#undef PG8_STAGE
#undef PG8_LDA
#undef PG8_LDB
#undef PG8_MMA
#undef PG8_WAIT_V
#undef PG8_WAIT_L
#undef PG8_BAR
#undef PG8_SCHED
}
}
using pg8::Unit;

#define EPI_LOOP_BEGIN const int row0 = u.pm * 256 + wr * 64 + fr, col0 = u.pn * 256 + wc * 32 + 8 * fq; \
    _Pragma("unroll") for (int ai = 0; ai < 2; ++ai) _Pragma("unroll") for (int m = 0; m < 4; ++m) { const int row = row0 + ai * 128 + m * 16;
#define EPI_BJ _Pragma("unroll") for (int bj = 0; bj < 2; ++bj) { const int col = col0 + bj * 128; const f32x4 v0 = acc[ai][bj][m][0], v1 = acc[ai][bj][m][1];
#define EPI_ACC const f32x4 (&acc)[2][2][4][2], const Unit& u, int wr, int wc, int fr, int fq

__device__ __forceinline__ u32x4 pack8(const f32x4 a, const f32x4 b) { u32x4 w; w.x = pk_bf16(a[0], a[1]); w.y = pk_bf16(a[2], a[3]); w.z = pk_bf16(b[0], b[1]); w.w = pk_bf16(b[2], b[3]); return w; }
__device__ __forceinline__ void unpack8(const u32x4 w, f32x4& a, f32x4& b) { a = (f32x4){bf_lo(w.x), bf_hi(w.x), bf_lo(w.y), bf_hi(w.y)}; b = (f32x4){bf_lo(w.z), bf_hi(w.z), bf_lo(w.w), bf_hi(w.w)}; }

struct EpiStore {
    bf16_t* O; int ldc;
    __device__ __forceinline__ void operator()(EPI_ACC) const { EPI_LOOP_BEGIN EPI_BJ *(u32x4*)(O + (size_t)row * ldc + col) = pack8(v0, v1); } } }
};
struct EpiMulInPlace {
    bf16_t* Y;
    __device__ __forceinline__ void operator()(EPI_ACC) const { EPI_LOOP_BEGIN EPI_BJ u32x4* ptr = (u32x4*)(Y + (size_t)row * 1024 + col); f32x4 a, b; unpack8(*ptr, a, b); *ptr = pack8(a * v0, b * v1); } } }
};
struct EpiGates {
    bf16_t* G; const float* bias;
    __device__ __forceinline__ void operator()(EPI_ACC) const { EPI_LOOP_BEGIN EPI_BJ
        const f32x4 b0 = *(const f32x4*)(bias + col), b1 = *(const f32x4*)(bias + col + 4); f32x4 a, b;
#pragma unroll
        for (int j = 0; j < 4; ++j) { a[j] = sigmoidf_(v0[j] + b0[j]); b[j] = sigmoidf_(v1[j] + b1[j]); }
        *(u32x4*)(G + (size_t)row * 2048 + col) = pack8(a, b); } } }
};
struct EpiPool {
    bf16_t* P; const bf16_t* G;
    __device__ __forceinline__ void operator()(EPI_ACC) const { EPI_LOOP_BEGIN EPI_BJ f32x4 a, b; unpack8(*(const u32x4*)(G + (size_t)row * 2048 + col), a, b);
        *(u32x4*)(P + (size_t)row * 1024 + col) = pack8(a * v0, b * v1); } } }
};
struct EpiMerge {
    bf16_t* P; const bf16_t* G;
    __device__ __forceinline__ void operator()(EPI_ACC) const { EPI_LOOP_BEGIN EPI_BJ f32x4 a, b, pa, pb; unpack8(*(const u32x4*)(G + (size_t)row * 2048 + 1024 + col), a, b);
        u32x4* ptr = (u32x4*)(P + (size_t)row * 1024 + col); unpack8(*ptr, pa, pb); *ptr = pack8(pa + a * v0, pb + b * v1); } } }
};
struct EpiOut {
    const float* xp; const float* xs; float* X1; bf16_t* X1B; float* rowsq;
    __device__ __forceinline__ void operator()(EPI_ACC) const { EPI_LOOP_BEGIN const float* xr = row < TP ? xp + (size_t)row * DM : xs + (size_t)(row - TP) * DM; float ss = 0.f; EPI_BJ
        f32x4 a = *(const f32x4*)(xr + col) + v0, b = *(const f32x4*)(xr + col + 4) + v1;
        *(f32x4*)(X1 + (size_t)row * 1024 + col) = a; *(f32x4*)(X1 + (size_t)row * 1024 + col + 4) = b; *(u32x4*)(X1B + (size_t)row * 1024 + col) = pack8(a, b);
#pragma unroll
        for (int j = 0; j < 4; ++j) ss += a[j] * a[j] + b[j] * b[j]; }
        ss += __shfl_xor(ss, 16); ss += __shfl_xor(ss, 32); if (fq == 0) atomicAdd(rowsq + row, ss); } }
};
struct EpiFF1 {
    bf16_t* Hlo; bf16_t* Hhi; const float* rowsq;
    __device__ __forceinline__ void operator()(EPI_ACC) const { bf16_t* H = u.pn < 8 ? Hlo : Hhi; const int cshift = u.pn < 8 ? 0 : 2048;
        EPI_LOOP_BEGIN const float rinv = rsqrtf(rowsq[row] * (1.0f / 1024.0f) + 1e-6f); EPI_BJ f32x4 a, b;
#pragma unroll
        for (int j = 0; j < 4; ++j) { float t0 = fmaxf(v0[j] * rinv, 0.f), t1 = fmaxf(v1[j] * rinv, 0.f); a[j] = t0 * t0; b[j] = t1 * t1; }
        *(u32x4*)(H + (size_t)row * 2048 + (col - cshift)) = pack8(a, b); } } }
};
struct EpiAddInPlace {
    float* X;
    __device__ __forceinline__ void operator()(EPI_ACC) const { EPI_LOOP_BEGIN EPI_BJ f32x4* ptr = (f32x4*)(X + (size_t)row * 1024 + col); ptr[0] = ptr[0] + v0; ptr[1] = ptr[1] + v1; } } }
};
struct EpiFinal {
    float* X; float* rowsq;
    __device__ __forceinline__ void operator()(EPI_ACC) const { EPI_LOOP_BEGIN float ss = 0.f; EPI_BJ f32x4* ptr = (f32x4*)(X + (size_t)row * 1024 + col); const f32x4 a = ptr[0] + v0, b = ptr[1] + v1; ptr[0] = a; ptr[1] = b;
#pragma unroll
        for (int j = 0; j < 4; ++j) ss += a[j] * a[j] + b[j] * b[j]; }
        ss += __shfl_xor(ss, 16); ss += __shfl_xor(ss, 32); if (fq == 0) atomicAdd(rowsq + row, ss); } }
};

template <class Epi>
__device__ __forceinline__ void run_gemm(unsigned char* shm, const bf16_t* A, int lda, const bf16_t* Bt, int ldb, int N, int K, const Epi& E) {
    pg8::Gemm g; g.A = A; g.Bt = Bt; g.M = T_TOK; g.N = N; g.K = K; g.lda = lda; g.ldb = ldb;
    pg8::StaticOrder S; S.init(T_TOK, N, (int)gridDim.x, (int)blockIdx.x);
    pg8::gemm_phase<Epi>((LAS unsigned char*)shm, g, S, E);
}

__device__ void transpose_cvt(unsigned char* shm, const float* src, int K, int N, bf16_t* dst, int ldd, const float* kscale) {
    float* tile = (float*)shm;
    const int tid = opaque_tid(), ntk = K / 64, ntn = N / 64;
    for (int t = blockIdx.x; t < ntk * ntn; t += gridDim.x) {
        const int tk = t / ntn, tn = t % ntn;
#pragma unroll
        for (int i = 0; i < 8; ++i) { const int kl = (tid >> 6) + 8 * i, nl = tid & 63; const int k = tk * 64 + kl;
            tile[kl * 65 + nl] = src[(size_t)k * N + tn * 64 + nl] * (kscale ? kscale[k] : 1.0f); }
        __syncthreads();
#pragma unroll
        for (int i = 0; i < 8; ++i) { const int nl = (tid >> 6) + 8 * i, kl = tid & 63;
            const unsigned w = pk_bf16(tile[kl * 65 + nl], 0.f); dst[(size_t)(tn * 64 + nl) * ldd + tk * 64 + kl] = (bf16_t)(w & 0xFFFFu); }
        __syncthreads();
    }
}

__device__ void rmsnorm_rows(const Params& p, const float* g, bf16_t* dst) {
    const int tidx = opaque_tid(); const int lane = tidx & 63, wave = (blockIdx.x * blockDim.x + tidx) >> 6, nw = (gridDim.x * blockDim.x) >> 6;
    f32x4 gv[4];
#pragma unroll
    for (int i = 0; i < 4; ++i) gv[i] = *(const f32x4*)(g + lane * 4 + 256 * i);
    for (int t = wave; t < T_TOK; t += nw) {
        const float* xr = xrow(p, t); f32x4 v[4]; float ss = 0.f;
#pragma unroll
        for (int i = 0; i < 4; ++i) { v[i] = *(const f32x4*)(xr + lane * 4 + 256 * i); ss += v[i][0] * v[i][0] + v[i][1] * v[i][1] + v[i][2] * v[i][2] + v[i][3] * v[i][3]; }
#pragma unroll
        for (int o = 1; o < 64; o <<= 1) ss += __shfl_xor(ss, o);
        const float rinv = rsqrtf(ss * (1.0f / 1024.0f) + 1e-6f);
#pragma unroll
        for (int i = 0; i < 4; ++i) { u32x2 w; w.x = pk_bf16(v[i][0] * rinv * gv[i][0], v[i][1] * rinv * gv[i][1]); w.y = pk_bf16(v[i][2] * rinv * gv[i][2], v[i][3] * rinv * gv[i][3]);
            *(u32x2*)(dst + (size_t)t * 1024 + lane * 4 + 256 * i) = w; }
    }
}

__device__ void prep_phase(const Params& p, unsigned char* shm) {
    unsigned char* ws = p.ws;
    const int gtid = blockIdx.x * blockDim.x + opaque_tid(), gn = gridDim.x * blockDim.x;
    for (int i = gtid; i < T_TOK; i += gn) { ((float*)(ws + OFF_ROWSQ))[i] = 0.f; ((float*)(ws + OFF_ROWSQ2))[i] = 0.f; }
    if (gtid < 64) ((unsigned*)(ws + OFF_QUEUE))[gtid] = 0u;
    transpose_cvt(shm, p.w_in, 1024, 5888, (bf16_t*)(ws + OFF_WIN), 1024, nullptr);
    transpose_cvt(shm, p.w_rwkv_br, 1024, 1024, (bf16_t*)(ws + OFF_WRBR), 1024, nullptr);
    transpose_cvt(shm, p.w_out, 1024, 1024, (bf16_t*)(ws + OFF_WOUT), 1024, nullptr);
    transpose_cvt(shm, p.w_ff1, 1024, 4096, (bf16_t*)(ws + OFF_WFF1), 1024, p.g_ffn);
    transpose_cvt(shm, p.w_ff2, 4096, 1024, (bf16_t*)(ws + OFF_WFF2), 4096, nullptr);
    transpose_cvt(shm, p.g_up, 128, 1024, (bf16_t*)(ws + OFF_WG), 256, nullptr);
    { bf16_t* wg = (bf16_t*)(ws + OFF_WG); for (int i = gtid; i < 1024 * 128; i += gn) wg[(size_t)(i >> 7) * 256 + 128 + (i & 127)] = 0; }
    { bf16_t* we = (bf16_t*)(ws + OFF_WEFF);
      for (int i = gtid; i < 512 * 1024; i += gn) { const int k = i >> 10, n = i & 1023, gI = k >> 7; const float* pw = p.pool_w + (size_t)k * 128; float acc = 0.f;
          for (int d = 0; d < 128; ++d) acc += pw[d] * p.pool_scale[gI * 128 + d] * p.w_pool_br[(size_t)(gI * 128 + d) * 1024 + n];
          we[(size_t)n * 512 + k] = (bf16_t)(pk_bf16(acc, 0.f) & 0xFFFFu); } }
    rmsnorm_rows(p, p.g_mix, (bf16_t*)(ws + OFF_R1));
}

__device__ void scan_phase(const Params& p, unsigned char* shm) {
    float* sW = (float*)shm; float* sAV = sW + 2048; float* sBV = sW + 4096; float* sKD = sW + 6144; float* sWR = sW + 8192; float* sR = sW + 10240; float* sV = sW + 12288; float* sY = sW + 14336;
    float* sBK = sW + 16384;
    bf16_t* sTW = (bf16_t*)(sW + 16384 + 64);
    bf16_t* sZA = sTW + 32 * 72;
    int* sItem = (int*)(sZA + 32 * 72);
    int tid = threadIdx.x; asm volatile("" : "+v"(tid));
    const int lane = tid & 63, wv = tid >> 6;
    const bf16_t* zall = (const bf16_t*)(p.ws + OFF_Z);
    unsigned* queue = (unsigned*)(p.ws + OFF_QUEUE);
    const int tokA = tid >> 4, q = tid & 15;
    const int rowS = wv * 8 + (lane >> 3), gS = lane & 7;
    for (;;) {
        if (tid == 0) *sItem = (int)atomicAdd(queue, 1u);
        __syncthreads();
        const int item = *sItem;
        __syncthreads();
        if (item >= N_ITEMS) break;
        int tbase, L, h, dir;
        if (item < 64) { tbase = TP + (item >> 5) * 16384; L = 16384; h = (item >> 1) & 15; dir = item & 1; }
        else { const int j = item - 64; tbase = (j >> 5) * 2048; L = 2048; h = (j >> 1) & 15; dir = j & 1; }
        const int NC = L / 32;
        bf16_t* ybuf = (bf16_t*)p.out + (dir ? (size_t)T_TOK * 1024 : 0);
        float* bonus = (float*)(p.ws + OFF_BONUS) + (dir ? (size_t)T_TOK * 16 : 0);
        const float* w_up = dir ? p.w_up_b : p.w_up_f; const float* a_up = dir ? p.a_up_b : p.a_up_f;
        const float* w0 = dir ? p.w0_b : p.w0_f; const float* a0 = dir ? p.a0_b : p.a0_f;
        const int mat = wv >> 2, cbk = wv & 3, colB = cbk * 16 + (lane & 15), quad = lane >> 4;
        bf16x8 bfrag[2];
        { const float* up = mat ? a_up : w_up;
#pragma unroll
          for (int kb = 0; kb < 2; ++kb) { float f[8];
#pragma unroll
              for (int j = 0; j < 8; ++j) f[j] = up[(size_t)(kb * 32 + quad * 8 + j) * 1024 + h * 64 + colB];
              u32x4 w; w.x = pk_bf16(f[0], f[1]); w.y = pk_bf16(f[2], f[3]); w.z = pk_bf16(f[4], f[5]); w.w = pk_bf16(f[6], f[7]); bfrag[kb] = __builtin_bit_cast(bf16x8, w); } }
        const float c0B = (mat ? a0 : w0)[h * 64 + colB];
        const float kaB = p.k_a[h * 64 + colB];
        const f32x4 rk4 = *(const f32x4*)(p.r_k + h * 64 + 4 * q);
        const f32x4 kk4c = *(const f32x4*)(p.k_k + h * 64 + 4 * q);
        f32x2 s[4];
#pragma unroll
        for (int j = 0; j < 4; ++j) s[j] = (f32x2){0.f, 0.f};
        for (int ci = 0; ci < NC; ++ci) {
            const int t0 = tbase + 32 * (dir ? NC - 1 - ci : ci);
            { const int t = t0 + tokA; const bool hasPrev = t > tbase, hasNext = t < tbase + L - 1;
              const bf16_t* zr = zall + (size_t)t * ZLD;
              float zs[5][4];
#pragma unroll
              for (int gi = 0; gi < 5; ++gi) {
                  const int col = (gi == 0 ? COL_R + h * 64 : gi == 1 ? COL_K + h * 64 : gi == 2 ? COL_V + h * 64 : gi == 3 ? COL_W : COL_A) + 4 * q;
                  const u32x2 zc = *(const u32x2*)(zr + col);
                  u32x2 zp = (u32x2){0u, 0u}, zn = (u32x2){0u, 0u};
                  if (hasPrev) zp = *(const u32x2*)(zr - ZLD + col);
                  if (hasNext) zn = *(const u32x2*)(zr + ZLD + col);
                  const f32x4 mp = *(const f32x4*)(p.mu_prev + col - COL_R), mn = *(const f32x4*)(p.mu_next + col - COL_R);
                  const float c[4] = {bf_lo(zc.x), bf_hi(zc.x), bf_lo(zc.y), bf_hi(zc.y)}, pv[4] = {bf_lo(zp.x), bf_hi(zp.x), bf_lo(zp.y), bf_hi(zp.y)}, nx[4] = {bf_lo(zn.x), bf_hi(zn.x), bf_lo(zn.y), bf_hi(zn.y)};
#pragma unroll
                  for (int j = 0; j < 4; ++j) zs[gi][j] = c[j] + mp[j] * (pv[j] - c[j]) + mn[j] * (nx[j] - c[j]);
              }
              *(f32x4*)(sR + tokA * 64 + 4 * q) = (f32x4){zs[0][0], zs[0][1], zs[0][2], zs[0][3]};
              *(f32x4*)(sKD + tokA * 64 + 4 * q) = (f32x4){zs[1][0], zs[1][1], zs[1][2], zs[1][3]};
              *(f32x4*)(sV + tokA * 64 + 4 * q) = (f32x4){zs[2][0], zs[2][1], zs[2][2], zs[2][3]};
              float kk[4], ss = 0.f;
#pragma unroll
              for (int j = 0; j < 4; ++j) { kk[j] = zs[1][j] * kk4c[j]; ss += kk[j] * kk[j]; }
              ss = red16(ss);
              const float inv = -1.0f / fmaxf(sqrtf(ss), 1e-12f);
              *(f32x4*)(sAV + tokA * 64 + 4 * q) = (f32x4){kk[0] * inv, kk[1] * inv, kk[2] * inv, kk[3] * inv};
              float tw[4];
#pragma unroll
              for (int j = 0; j < 4; ++j) tw[j] = 1.0f - 2.0f / (1.0f + __expf(2.0f * zs[3][j]));
              u32x2 w; w.x = pk_bf16(tw[0], tw[1]); w.y = pk_bf16(tw[2], tw[3]); *(u32x2*)(sTW + tokA * 72 + 4 * q) = w;
              w.x = pk_bf16(zs[4][0], zs[4][1]); w.y = pk_bf16(zs[4][2], zs[4][3]); *(u32x2*)(sZA + tokA * 72 + 4 * q) = w;
            }
            __syncthreads();
            { const bf16_t* sX = mat ? sZA : sTW;
#pragma unroll
              for (int rb = 0; rb < 2; ++rb) {
                  f32x4 acc = (f32x4){0.f, 0.f, 0.f, 0.f};
#pragma unroll
                  for (int kb = 0; kb < 2; ++kb) { const bf16x8 af = *(const bf16x8*)(sX + (rb * 16 + (lane & 15)) * 72 + kb * 32 + quad * 8);
                      acc = __builtin_amdgcn_mfma_f32_16x16x32_bf16(af, bfrag[kb], acc, 0, 0, 0); }
#pragma unroll
                  for (int j = 0; j < 4; ++j) { const int idx = (rb * 16 + quad * 4 + j) * 64 + colB; const float pre = c0B + acc[j];
                      if (mat == 0) { const float w = __expf(-0.6065306597f * sigmoidf_(pre)); sW[idx] = w; sWR[idx] = w * sR[idx]; }
                      else { const float a = sigmoidf_(pre); const float k = sKD[idx]; sKD[idx] = k * (1.0f + (a - 1.0f) * kaB); sBV[idx] = -sAV[idx] * a; } }
              } }
            __syncthreads();
            { const f32x4 r4 = *(const f32x4*)(sR + tokA * 64 + 4 * q), b4 = *(const f32x4*)(sBV + tokA * 64 + 4 * q), k4 = *(const f32x4*)(sKD + tokA * 64 + 4 * q);
              float br = 0.f, kr = 0.f, cb = 0.f;
#pragma unroll
              for (int j = 0; j < 4; ++j) { br += b4[j] * r4[j]; kr += k4[j] * r4[j]; cb += r4[j] * k4[j] * rk4[j]; }
              br = red16(br); kr = red16(kr); cb = red16(cb);
              if (q == 0) { sBK[tokA * 2] = br; sBK[tokA * 2 + 1] = kr; bonus[(size_t)(t0 + tokA) * 16 + h] = cb; } }
            __syncthreads();
#pragma unroll 4
            for (int i = 0; i < 32; ++i) {
                const int tk = dir ? 31 - i : i; const int o = tk * 64 + 4 * gS;
                const f32x4 wl = *(const f32x4*)(sW + o), wh = *(const f32x4*)(sW + o + 32);
                const f32x4 al = *(const f32x4*)(sAV + o), ah = *(const f32x4*)(sAV + o + 32);
                const f32x4 bl = *(const f32x4*)(sBV + o), bh = *(const f32x4*)(sBV + o + 32);
                const f32x4 kl = *(const f32x4*)(sKD + o), kh = *(const f32x4*)(sKD + o + 32);
                const f32x4 ql = *(const f32x4*)(sWR + o), qh = *(const f32x4*)(sWR + o + 32);
                const float v = sV[tk * 64 + rowS]; const f32x2 bk = *(const f32x2*)(sBK + tk * 2);
                f32x2 sa2 = s[0] * (f32x2){al[0], al[1]}; sa2 = __builtin_elementwise_fma(s[1], (f32x2){al[2], al[3]}, sa2);
                sa2 = __builtin_elementwise_fma(s[2], (f32x2){ah[0], ah[1]}, sa2); sa2 = __builtin_elementwise_fma(s[3], (f32x2){ah[2], ah[3]}, sa2);
                f32x2 yp2 = s[0] * (f32x2){ql[0], ql[1]}; yp2 = __builtin_elementwise_fma(s[1], (f32x2){ql[2], ql[3]}, yp2);
                yp2 = __builtin_elementwise_fma(s[2], (f32x2){qh[0], qh[1]}, yp2); yp2 = __builtin_elementwise_fma(s[3], (f32x2){qh[2], qh[3]}, yp2);
                const float sa = red8(sa2.x + sa2.y), yp = red8(yp2.x + yp2.y);
                const f32x2 vv = (f32x2){v, v}, sasa = (f32x2){sa, sa};
                s[0] = __builtin_elementwise_fma(s[0], (f32x2){wl[0], wl[1]}, __builtin_elementwise_fma(sasa, (f32x2){bl[0], bl[1]}, vv * (f32x2){kl[0], kl[1]}));
                s[1] = __builtin_elementwise_fma(s[1], (f32x2){wl[2], wl[3]}, __builtin_elementwise_fma(sasa, (f32x2){bl[2], bl[3]}, vv * (f32x2){kl[2], kl[3]}));
                s[2] = __builtin_elementwise_fma(s[2], (f32x2){wh[0], wh[1]}, __builtin_elementwise_fma(sasa, (f32x2){bh[0], bh[1]}, vv * (f32x2){kh[0], kh[1]}));
                s[3] = __builtin_elementwise_fma(s[3], (f32x2){wh[2], wh[3]}, __builtin_elementwise_fma(sasa, (f32x2){bh[2], bh[3]}, vv * (f32x2){kh[2], kh[3]}));
                const float y = yp + sa * bk.x + v * bk.y;
                if (gS == 0) sY[tk * 64 + rowS] = y;
            }
            __syncthreads();
            { const f32x4 y4 = *(const f32x4*)(sY + tokA * 64 + 4 * q); u32x2 w; w.x = pk_bf16(y4[0], y4[1]); w.y = pk_bf16(y4[2], y4[3]);
              *(u32x2*)(ybuf + (size_t)(t0 + tokA) * 1024 + h * 64 + 4 * q) = w; }
        }
    }
}

__device__ void mix_phase(const Params& p) {
    const int tidx = opaque_tid(); const int lane = tidx & 63, wave = (blockIdx.x * blockDim.x + tidx) >> 6, nw = (gridDim.x * blockDim.x) >> 6;
    const bf16_t* zall = (const bf16_t*)(p.ws + OFF_Z);
    bf16_t* yf = (bf16_t*)p.out; const bf16_t* yb = (const bf16_t*)p.out + (size_t)T_TOK * 1024;
    const float* bonus_f = (const float*)(p.ws + OFF_BONUS); const float* bonus_b = bonus_f + (size_t)T_TOK * 16;
    bf16_t* pooled = (bf16_t*)(p.ws + OFF_POOLED); bf16_t* sg = (bf16_t*)(p.ws + OFF_SG);
    const int hL = lane >> 2;
    for (int t = wave; t < T_TOK; t += nw) {
        int tbase, L; seq_of(t, tbase, L); const int pos = t - tbase; const bool hasPrev = pos > 0, hasNext = pos < L - 1;
        const bf16_t* zr = zall + (size_t)t * ZLD;
        { const int c0 = lane * 16; float y[16];
          { const u32x4 a0 = *(const u32x4*)(yf + (size_t)t * 1024 + c0), a1 = *(const u32x4*)(yf + (size_t)t * 1024 + c0 + 8);
            const u32x4 b0 = *(const u32x4*)(yb + (size_t)t * 1024 + c0), b1 = *(const u32x4*)(yb + (size_t)t * 1024 + c0 + 8);
            f32x4 fa, fb, ga, gb; unpack8(a0, fa, fb); unpack8(b0, ga, gb);
#pragma unroll
            for (int j = 0; j < 4; ++j) { y[j] = fa[j] + ga[j]; y[4 + j] = fb[j] + gb[j]; }
            unpack8(a1, fa, fb); unpack8(b1, ga, gb);
#pragma unroll
            for (int j = 0; j < 4; ++j) { y[8 + j] = fa[j] + ga[j]; y[12 + j] = fb[j] + gb[j]; } }
          float sm = 0.f;
#pragma unroll
          for (int j = 0; j < 16; ++j) sm += y[j];
          const float mean = red4(sm) * (1.0f / 64.0f); float vs = 0.f;
#pragma unroll
          for (int j = 0; j < 16; ++j) { const float d = y[j] - mean; vs += d * d; }
          const float rstd = rsqrtf(red4(vs) * (1.0f / 64.0f) + 64e-5f);
          const float bon = bonus_f[(size_t)t * 16 + hL] + bonus_b[(size_t)t * 16 + hL];
          float vv[16];
          { const bf16_t* zc = zr + COL_V + c0;
            u32x4 c_[2], p_[2], n_[2];
#pragma unroll
            for (int i = 0; i < 2; ++i) { c_[i] = *(const u32x4*)(zc + 8 * i); p_[i] = hasPrev ? *(const u32x4*)(zc - ZLD + 8 * i) : (u32x4){0u, 0u, 0u, 0u}; n_[i] = hasNext ? *(const u32x4*)(zc + ZLD + 8 * i) : (u32x4){0u, 0u, 0u, 0u}; }
#pragma unroll
            for (int i = 0; i < 2; ++i) { f32x4 ca, cb, pa, pb, na, nb; unpack8(c_[i], ca, cb); unpack8(p_[i], pa, pb); unpack8(n_[i], na, nb);
                const float* mp = p.mu_prev + (COL_V - COL_R) + c0 + 8 * i; const float* mn = p.mu_next + (COL_V - COL_R) + c0 + 8 * i;
                const f32x4 mp0 = *(const f32x4*)mp, mp1 = *(const f32x4*)(mp + 4), mn0 = *(const f32x4*)mn, mn1 = *(const f32x4*)(mn + 4);
#pragma unroll
                for (int j = 0; j < 4; ++j) { vv[8 * i + j] = ca[j] + mp0[j] * (pa[j] - ca[j]) + mn0[j] * (na[j] - ca[j]); vv[8 * i + 4 + j] = cb[j] + mp1[j] * (pb[j] - cb[j]) + mn1[j] * (nb[j] - cb[j]); } } }
          float o[16];
#pragma unroll
          for (int i = 0; i < 4; ++i) { const f32x4 lw = *(const f32x4*)(p.ln_w + c0 + 4 * i), lb = *(const f32x4*)(p.ln_b + c0 + 4 * i);
#pragma unroll
              for (int j = 0; j < 4; ++j) o[4 * i + j] = (y[4 * i + j] - mean) * rstd * lw[j] + lb[j] + bon * vv[4 * i + j]; }
          u32x4 w0, w1; w0.x = pk_bf16(o[0], o[1]); w0.y = pk_bf16(o[2], o[3]); w0.z = pk_bf16(o[4], o[5]); w0.w = pk_bf16(o[6], o[7]);
          w1.x = pk_bf16(o[8], o[9]); w1.y = pk_bf16(o[10], o[11]); w1.z = pk_bf16(o[12], o[13]); w1.w = pk_bf16(o[14], o[15]);
          *(u32x4*)(yf + (size_t)t * 1024 + c0) = w0; *(u32x4*)(yf + (size_t)t * 1024 + c0 + 8) = w1; }
        { const int c = 2 * lane; const bf16_t* zc = zr + COL_G + c; const unsigned wc_ = *(const unsigned*)zc; const unsigned wp = hasPrev ? *(const unsigned*)(zc - ZLD) : 0u, wn = hasNext ? *(const unsigned*)(zc + ZLD) : 0u;
          const float mp0 = p.mu_prev[COL_G - COL_R + c], mp1 = p.mu_prev[COL_G - COL_R + c + 1], mn0 = p.mu_next[COL_G - COL_R + c], mn1 = p.mu_next[COL_G - COL_R + c + 1];
          const float c0v = bf_lo(wc_), c1v = bf_hi(wc_);
          const float z0 = c0v + mp0 * (bf_lo(wp) - c0v) + mn0 * (bf_lo(wn) - c0v), z1 = c1v + mp1 * (bf_hi(wp) - c1v) + mn1 * (bf_hi(wn) - c1v);
          *(unsigned*)(sg + (size_t)t * 256 + c) = pk_bf16(sigmoidf_(z0), sigmoidf_(z1)); *(unsigned*)(sg + (size_t)t * 256 + 128 + c) = 0u; }
        { const int c = lane * 8, gi = lane >> 4, w = 2 << gi; const int lo = max(pos - (w >> 1), 0), hi = min(pos + (w >> 1) - 1, L - 1);
          float sum[8];
#pragma unroll
          for (int j = 0; j < 8; ++j) sum[j] = 0.f;
          for (int r = lo; r <= hi; ++r) { f32x4 a, b; unpack8(*(const u32x4*)(zall + (size_t)(tbase + r) * ZLD + c), a, b);
#pragma unroll
              for (int j = 0; j < 4; ++j) { sum[j] += a[j]; sum[4 + j] += b[j]; } }
          const float icnt = 1.0f / (float)(hi - lo + 1); f32x4 a, b; unpack8(*(const u32x4*)(zr + c), a, b); f32x4 oa, ob;
#pragma unroll
          for (int j = 0; j < 4; ++j) { oa[j] = sum[j] * icnt - a[j]; ob[j] = sum[4 + j] * icnt - b[j]; }
          *(u32x4*)(pooled + (size_t)t * 512 + c) = pack8(oa, ob); }
    }
}

__device__ void final_phase(const Params& p) {
    const int tidx = opaque_tid(); const int lane = tidx & 63, wave = (blockIdx.x * blockDim.x + tidx) >> 6, nw = (gridDim.x * blockDim.x) >> 6;
    const float* x2 = (const float*)(p.ws + OFF_X1); const float* rowsq2 = (const float*)(p.ws + OFF_ROWSQ2);
    f32x4 gv[4];
#pragma unroll
    for (int i = 0; i < 4; ++i) gv[i] = *(const f32x4*)(p.g_final + lane * 4 + 256 * i);
    for (int t = wave; t < T_TOK; t += nw) {
        const float rinv = rsqrtf(rowsq2[t] * (1.0f / 1024.0f) + 1e-6f);
#pragma unroll
        for (int i = 0; i < 4; ++i) { const f32x4 v = *(const f32x4*)(x2 + (size_t)t * 1024 + lane * 4 + 256 * i); *(f32x4*)(p.out + (size_t)t * 1024 + lane * 4 + 256 * i) = v * rinv * gv[i]; }
    }
}

__global__ void __launch_bounds__(512, 2) fwd_megakernel(Params p) {
    extern __shared__ __attribute__((aligned(16))) unsigned char shm[];
    cg::grid_group grid = cg::this_grid();
    unsigned char* ws = p.ws;
    prep_phase(p, shm);
    grid.sync();
    { EpiStore E; E.O = (bf16_t*)(ws + OFF_Z); E.ldc = ZLD; run_gemm(shm, (const bf16_t*)(ws + OFF_R1), 1024, (const bf16_t*)(ws + OFF_WIN), 1024, 3840, 1024, E); }
    grid.sync();
    scan_phase(p, shm);
    grid.sync();
    mix_phase(p);
    grid.sync();
    rmsnorm_rows(p, p.g_mix, (bf16_t*)(ws + OFF_XN2));
    { EpiMulInPlace E; E.Y = (bf16_t*)p.out; run_gemm(shm, (const bf16_t*)(ws + OFF_SG), 256, (const bf16_t*)(ws + OFF_WG), 256, 1024, 256, E); }
    grid.sync();
    { EpiGates E; E.G = (bf16_t*)(ws + OFF_GATES); E.bias = p.b_gate; run_gemm(shm, (const bf16_t*)(ws + OFF_XN2), 1024, (const bf16_t*)(ws + OFF_WIN) + (size_t)3840 * 1024, 1024, 2048, 1024, E); }
    grid.sync();
    { EpiPool E; E.P = (bf16_t*)(ws + OFF_MERGED); E.G = (const bf16_t*)(ws + OFF_GATES); run_gemm(shm, (const bf16_t*)(ws + OFF_POOLED), 512, (const bf16_t*)(ws + OFF_WEFF), 512, 1024, 512, E); }
    { EpiMerge E; E.P = (bf16_t*)(ws + OFF_MERGED); E.G = (const bf16_t*)(ws + OFF_GATES); run_gemm(shm, (const bf16_t*)p.out, 1024, (const bf16_t*)(ws + OFF_WRBR), 1024, 1024, 1024, E); }
    grid.sync();
    { EpiOut E; E.xp = p.x_prompt; E.xs = p.x_sample; E.X1 = (float*)(ws + OFF_X1); E.X1B = (bf16_t*)(ws + OFF_X1B); E.rowsq = (float*)(ws + OFF_ROWSQ); run_gemm(shm, (const bf16_t*)(ws + OFF_MERGED), 1024, (const bf16_t*)(ws + OFF_WOUT), 1024, 1024, 1024, E); }
    grid.sync();
    { EpiFF1 E; E.Hlo = (bf16_t*)(ws + OFF_HLO); E.Hhi = (bf16_t*)p.out; E.rowsq = (const float*)(ws + OFF_ROWSQ); run_gemm(shm, (const bf16_t*)(ws + OFF_X1B), 1024, (const bf16_t*)(ws + OFF_WFF1), 1024, 4096, 1024, E); }
    grid.sync();
    { EpiAddInPlace E; E.X = (float*)(ws + OFF_X1); run_gemm(shm, (const bf16_t*)(ws + OFF_HLO), 2048, (const bf16_t*)(ws + OFF_WFF2), 4096, 1024, 2048, E); }
    { EpiFinal E; E.X = (float*)(ws + OFF_X1); E.rowsq = (float*)(ws + OFF_ROWSQ2); run_gemm(shm, (const bf16_t*)p.out, 2048, (const bf16_t*)(ws + OFF_WFF2) + 2048, 4096, 1024, 2048, E); }
    grid.sync();
    final_phase(p);
}

extern "C" void kernel_launch(void* const* d_in, const int* in_sizes, int n_in, void* d_out, int out_size, void* d_ws, size_t ws_size, hipStream_t stream) {
    constexpr size_t kDynLds = 131072;
    static int grid_blocks = 0;
    if (!grid_blocks) {
        hipFuncSetAttribute((const void*)fwd_megakernel, hipFuncAttributeMaxDynamicSharedMemorySize, (int)kDynLds);
        int dev = 0, cus = 0, per_cu = 0;
        hipGetDevice(&dev);
        hipDeviceGetAttribute(&cus, hipDeviceAttributeMultiprocessorCount, dev);
        hipOccupancyMaxActiveBlocksPerMultiprocessor(&per_cu, fwd_megakernel, 512, kDynLds);
        if (per_cu < 1) per_cu = 1;
        grid_blocks = cus;
    }
    Params p{};
    const float** pf = (const float**)&p;
    for (int i = 0; i < 30; ++i) pf[i] = (const float*)d_in[i];
    p.out = (float*)d_out; p.ws = (unsigned char*)d_ws;
    void* args[] = {&p};
    hipError_t e = hipLaunchCooperativeKernel((const void*)fwd_megakernel, dim3(grid_blocks), dim3(512), args, kDynLds, stream);
    if (e != hipSuccess) fprintf(stderr, "cooperative launch failed: %s (grid %d)\n", hipGetErrorString(e), grid_blocks);
}
```

```cpp
#include <hip/hip_runtime.h>
#include <hip/hip_cooperative_groups.h>
#include <cstdio>
namespace cg = cooperative_groups;

#define LAS __attribute__((address_space(3)))
typedef unsigned short bf16_t;
typedef short bf16x8 __attribute__((ext_vector_type(8)));
typedef float f32x4 __attribute__((ext_vector_type(4)));
typedef float f32x2 __attribute__((ext_vector_type(2)));
typedef unsigned u32x4 __attribute__((ext_vector_type(4)));
typedef unsigned u32x2 __attribute__((ext_vector_type(2)));

constexpr int T_TOK = 98304, DM = 1024, TP = 65536;
constexpr int ZLD = 3840;
constexpr int COL_R = 512, COL_K = 1536, COL_V = 2560, COL_W = 3584, COL_A = 3648, COL_G = 3712;
constexpr size_t MiB = 1ull << 20;
constexpr size_t OFF_WIN = 0, OFF_WEFF = 12 * MiB, OFF_WRBR = 13 * MiB, OFF_WOUT = 15 * MiB, OFF_WFF1 = 17 * MiB, OFF_WFF2 = 25 * MiB, OFF_WG = 33 * MiB;
constexpr size_t OFF_ROWSQ = 34 * MiB, OFF_ROWSQ2 = 34 * MiB + 512 * 1024, OFF_QUEUE = 35 * MiB, OFF_BONUS = 36 * MiB;
constexpr size_t OFF_R1 = 48 * MiB, OFF_Z = 240 * MiB;
constexpr size_t OFF_POOLED = OFF_R1, OFF_SG = OFF_R1 + 96 * MiB, OFF_XN2 = OFF_Z, OFF_GATES = OFF_Z + 192 * MiB, OFF_MERGED = OFF_Z + 576 * MiB;
constexpr size_t OFF_X1B = OFF_R1, OFF_X1 = OFF_Z, OFF_HLO = OFF_Z + 384 * MiB;
constexpr size_t U_BYTES = (size_t)T_TOK * 1024 * 2;

struct Params {
    const float *x_prompt, *x_sample, *g_mix, *w_in, *b_gate, *mu_prev, *mu_next, *pool_w, *pool_scale, *w_pool_br, *k_k, *k_a, *r_k,
        *w0_f, *w_up_f, *a0_f, *a_up_f, *w0_b, *w_up_b, *a0_b, *a_up_b, *g_up, *ln_w, *ln_b, *w_rwkv_br, *w_out, *g_ffn, *w_ff1, *w_ff2, *g_final;
    float* out; unsigned char* ws;
};

__device__ __forceinline__ float bf_lo(unsigned w) { return __uint_as_float(w << 16); }
__device__ __forceinline__ float bf_hi(unsigned w) { return __uint_as_float(w & 0xFFFF0000u); }
__device__ __forceinline__ unsigned pk_bf16(float lo, float hi) { unsigned r; asm("v_cvt_pk_bf16_f32 %0, %1, %2" : "=v"(r) : "v"(lo), "v"(hi)); return r; }
__device__ __forceinline__ float sigmoidf_(float x) { return 1.0f / (1.0f + __expf(-x)); }
template <int CTRL> __device__ __forceinline__ float dppf(float x) { return __int_as_float(__builtin_amdgcn_update_dpp(0, __float_as_int(x), CTRL, 0xF, 0xF, true)); }
__device__ __forceinline__ float red4(float x) { x += dppf<0xB1>(x); x += dppf<0x4E>(x); return x; }
__device__ __forceinline__ float red8(float x) { x = red4(x); x += dppf<0x141>(x); return x; }
__device__ __forceinline__ float red16(float x) { x = red8(x); x += dppf<0x140>(x); return x; }
__device__ __forceinline__ int opaque_tid() { int t = threadIdx.x; asm volatile("" : "+v"(t)); return t; }
__device__ __forceinline__ const float* xrow(const Params& p, int t) { return t < TP ? p.x_prompt + (size_t)t * DM : p.x_sample + (size_t)(t - TP) * DM; }
__device__ __forceinline__ void seq_of(int t, int& base, int& len) { if (t < TP) { base = t & ~2047; len = 2048; } else { base = TP + ((t - TP) & ~16383); len = 16384; } }

namespace pg8 {
constexpr int BM = 256, BK = 64, HALF = 128, HTB = HALF * BK * 2, STAGE_BYTES = 8 * HTB, NXCD = 8, WGM = 8;
__device__ __forceinline__ int lds_byte(int r, int c) { const int st = (r >> 4) * 2 + (c >> 5), rr = r & 15, cc = c & 31, ob = rr * 64 + cc * 2; return st * 1024 + (ob ^ (((ob >> 9) & 1) << 5)); }
__device__ __forceinline__ void stage_rc(int b, int& R, int& C) { const int st = b / 1024, sb = b % 1024, swz = sb ^ (((sb >> 9) & 1) << 5); R = (st >> 1) * 16 + swz / 64; C = (st & 1) * 32 + (swz % 64) / 2; }
__device__ __forceinline__ int perm32(int rho) { const int n = rho >> 4, i = rho & 15; return 8 * (i >> 2) + 4 * n + (i & 3); }
struct Unit { int pm, pn; };
struct Gemm { const bf16_t* A; const bf16_t* Bt; int M, N, K, lda, ldb; };
struct StaticOrder {
    int nM, nN, nwg, G, c;
    __device__ void init(int M, int N, int G_, int c_) { nM = M / BM; nN = N / BM; nwg = nM * nN; G = G_; c = c_; }
    __device__ bool next(int i, Unit& u) const {
        const long L = (long)i * G + c; if (L >= nwg) return false;
        int wgid = (int)L; { const int q = nwg / NXCD, r = nwg % NXCD, xcd = wgid % NXCD, off = wgid / NXCD; wgid = (xcd < r ? xcd * (q + 1) : r * (q + 1) + (xcd - r) * q) + off; }
        const int nig = WGM * nN, gid = wgid / nig, fm = gid * WGM, gsz = (nM - fm) < WGM ? (nM - fm) : WGM;
        u.pm = fm + ((wgid % nig) % gsz); u.pn = (wgid % nig) / gsz; return true;
    }
};

template <class Epi>
__device__ __forceinline__ void gemm_phase(LAS unsigned char* lds, const Gemm g, const StaticOrder& S, const Epi& E) {
    int tid = threadIdx.x; asm volatile("" : "+v"(tid));
    const int wid = __builtin_amdgcn_readfirstlane(tid >> 6), lane = tid & 63, wr = wid >> 2, wc = wid & 3, fr = lane & 15, fq = lane >> 4;
    const int K = g.K, nt = K / BK;
    unsigned voffA[2], voffB[2];
#pragma unroll
    for (int i = 0; i < 2; ++i) { int R, C; stage_rc(tid * 16 + i * 8192, R, C); const int Rb = (R & ~31) + perm32(R & 31);
        voffA[i] = (unsigned)(R * g.lda + C) * 2u; voffB[i] = (unsigned)(Rb * g.ldb + C) * 2u; }
    const size_t kstep = (size_t)(BK * 2);
    const size_t hstepA = (size_t)HALF * g.lda * 2, hstepB = (size_t)HALF * g.ldb * 2;
    const size_t tstepA = 2 * hstepA, tstepB = 2 * hstepB;
    const unsigned ldsw = (unsigned)wid * 1024u;
    const int aoff = lds_byte(wr * 64 + fr, fq * 8), boff = lds_byte(wc * 32 + fr, fq * 8);
#define PG8_SA(b, h) (((b) * 2 + (h)) * HTB)
#define PG8_SB(b, h) ((4 + (b) * 2 + (h)) * HTB)
#define PG8_STAGE(bufoff, gbase, voff) do { _Pragma("unroll") for (int _i = 0; _i < 2; ++_i) \
        __builtin_amdgcn_global_load_lds((const unsigned*)((const char*)(gbase) + (voff)[_i]), (LAS unsigned*)(lds + (bufoff) + ldsw + _i * 8192), 16, 0, 0); } while (0)
#define PG8_LDA(dst, b, h) do { _Pragma("unroll") for (int m = 0; m < 4; ++m) _Pragma("unroll") for (int k = 0; k < 2; ++k) dst[m][k] = *(const LAS bf16x8*)(lds + PG8_SA(b, h) + aoff + m * 2048 + k * 1024); } while (0)
#define PG8_LDB(dst, b, h) do { _Pragma("unroll") for (int n = 0; n < 2; ++n) _Pragma("unroll") for (int k = 0; k < 2; ++k) dst[n][k] = *(const LAS bf16x8*)(lds + PG8_SB(b, h) + boff + n * 2048 + k * 1024); } while (0)
#define PG8_MMA(ai, bj, At, Bt) do { __builtin_amdgcn_s_setprio(1); _Pragma("unroll") for (int m = 0; m < 4; ++m) _Pragma("unroll") for (int n = 0; n < 2; ++n) _Pragma("unroll") for (int k = 0; k < 2; ++k) \
        acc[ai][bj][m][n] = __builtin_amdgcn_mfma_f32_16x16x32_bf16(Bt[n][k], At[m][k], acc[ai][bj][m][n], 0, 0, 0); __builtin_amdgcn_s_setprio(0); } while (0)
#define PG8_WAIT_V(n) asm volatile("s_waitcnt vmcnt(" #n ")" ::: "memory")
#define PG8_WAIT_L(n) asm volatile("s_waitcnt lgkmcnt(" #n ")" ::: "memory")
#define PG8_BAR __builtin_amdgcn_s_barrier()
#define PG8_SCHED __builtin_amdgcn_sched_barrier(0)
    Unit cur, nxt; int ui = 0;
    if (!S.next(0, cur)) return;
    f32x4 acc[2][2][4][2];
#pragma unroll
    for (int a = 0; a < 2; ++a)
#pragma unroll
        for (int b = 0; b < 2; ++b)
#pragma unroll
            for (int m = 0; m < 4; ++m)
#pragma unroll
                for (int n = 0; n < 2; ++n) acc[a][b][m][n] = (f32x4){0.f, 0.f, 0.f, 0.f};
    bf16x8 At[4][2], B0[2][2], B1[2][2];
    const char* cA = (const char*)g.A + (size_t)cur.pm * tstepA; const char* cB = (const char*)g.Bt + (size_t)cur.pn * tstepB;
    PG8_STAGE(PG8_SB(0, 0), cB, voffB); PG8_STAGE(PG8_SA(0, 0), cA, voffA); PG8_STAGE(PG8_SB(0, 1), cB + hstepB, voffB); PG8_STAGE(PG8_SA(0, 1), cA + hstepA, voffA);
    if (wr == 1) PG8_BAR;
    PG8_WAIT_V(4); PG8_BAR;
    PG8_STAGE(PG8_SB(1, 0), cB + kstep, voffB); PG8_STAGE(PG8_SA(1, 0), cA + kstep, voffA); PG8_STAGE(PG8_SB(1, 1), cB + hstepB + kstep, voffB);
    PG8_WAIT_V(6); PG8_BAR;
    for (;;) {
        const bool has_next = S.next(ui + 1, nxt);
        const char* nA = has_next ? (const char*)g.A + (size_t)nxt.pm * tstepA : cA; const char* nB = has_next ? (const char*)g.Bt + (size_t)nxt.pn * tstepB : cB;
        for (int t = 0; t < nt; t += 2) {
            const bool last = (t == nt - 2);
            const char* a1 = cA + (size_t)(t + 1) * kstep;
            const char* a2 = last ? nA : cA + (size_t)(t + 2) * kstep; const char* b2 = last ? nB : cB + (size_t)(t + 2) * kstep;
            const char* a3 = a2 + kstep; const char* b3 = b2 + kstep;
            PG8_LDB(B0, 0, 0); PG8_SCHED; PG8_LDA(At, 0, 0); PG8_STAGE(PG8_SA(1, 1), a1 + hstepA, voffA);
            PG8_WAIT_L(8); PG8_BAR; PG8_WAIT_L(0); PG8_MMA(0, 0, At, B0); PG8_BAR; PG8_SCHED;
            PG8_LDB(B1, 0, 1); PG8_STAGE(PG8_SB(0, 0), b2, voffB);
            PG8_BAR; PG8_WAIT_L(0); PG8_MMA(0, 1, At, B1); PG8_BAR;
            PG8_LDA(At, 0, 1); PG8_STAGE(PG8_SA(0, 0), a2, voffA);
            PG8_BAR; PG8_WAIT_L(0); PG8_MMA(1, 0, At, B0); PG8_BAR; PG8_SCHED;
            PG8_STAGE(PG8_SB(0, 1), b2 + hstepB, voffB);
            PG8_WAIT_V(6); PG8_BAR; PG8_MMA(1, 1, At, B1); PG8_BAR;
            PG8_LDB(B0, 1, 0); PG8_SCHED; PG8_LDA(At, 1, 0); PG8_STAGE(PG8_SA(0, 1), a2 + hstepA, voffA);
            PG8_WAIT_L(8); PG8_BAR; PG8_WAIT_L(0); PG8_MMA(0, 0, At, B0); PG8_BAR; PG8_SCHED;
            PG8_LDB(B1, 1, 1); PG8_STAGE(PG8_SB(1, 0), b3, voffB);
            PG8_BAR; PG8_WAIT_L(0); PG8_MMA(0, 1, At, B1); PG8_BAR;
            PG8_LDA(At, 1, 1); PG8_STAGE(PG8_SA(1, 0), a3, voffA);
            PG8_BAR; PG8_WAIT_L(0); PG8_MMA(1, 0, At, B0); PG8_BAR; PG8_SCHED;
            PG8_STAGE(PG8_SB(1, 1), b3 + hstepB, voffB);
            PG8_WAIT_V(6); PG8_BAR; PG8_MMA(1, 1, At, B1); PG8_BAR;
        }
        E(acc, cur, wr, wc, fr, fq);
        if (!has_next) break;
#pragma unroll
        for (int a = 0; a < 2; ++a)
#pragma unroll
            for (int b = 0; b < 2; ++b)
#pragma unroll
                for (int m = 0; m < 4; ++m)
#pragma unroll
                    for (int n = 0; n < 2; ++n) acc[a][b][m][n] = (f32x4){0.f, 0.f, 0.f, 0.f};
        cur = nxt; cA = nA; cB = nB; ++ui;
    }
    PG8_WAIT_V(0);
    if (wr == 0) PG8_BAR;
    PG8_BAR;
#undef PG8_SA
#undef PG8_SB
#undef PG8_STAGE
#undef PG8_LDA
#undef PG8_LDB
#undef PG8_MMA
#undef PG8_WAIT_V
#undef PG8_WAIT_L
#undef PG8_BAR
#undef PG8_SCHED
}
}
using pg8::Unit;

#define EPI_LOOP_BEGIN const int row0 = u.pm * 256 + wr * 64 + fr, col0 = u.pn * 256 + wc * 32 + 8 * fq; \
    _Pragma("unroll") for (int ai = 0; ai < 2; ++ai) _Pragma("unroll") for (int m = 0; m < 4; ++m) { const int row = row0 + ai * 128 + m * 16;
#define EPI_BJ _Pragma("unroll") for (int bj = 0; bj < 2; ++bj) { const int col = col0 + bj * 128; const f32x4 v0 = acc[ai][bj][m][0], v1 = acc[ai][bj][m][1];
#define EPI_ACC const f32x4 (&acc)[2][2][4][2], const Unit& u, int wr, int wc, int fr, int fq

__device__ __forceinline__ u32x4 pack8(const f32x4 a, const f32x4 b) { u32x4 w; w.x = pk_bf16(a[0], a[1]); w.y = pk_bf16(a[2], a[3]); w.z = pk_bf16(b[0], b[1]); w.w = pk_bf16(b[2], b[3]); return w; }
__device__ __forceinline__ void unpack8(const u32x4 w, f32x4& a, f32x4& b) { a = (f32x4){bf_lo(w.x), bf_hi(w.x), bf_lo(w.y), bf_hi(w.y)}; b = (f32x4){bf_lo(w.z), bf_hi(w.z), bf_lo(w.w), bf_hi(w.w)}; }

struct EpiStore {
    bf16_t* O; int ldc;
    __device__ __forceinline__ void operator()(EPI_ACC) const { EPI_LOOP_BEGIN EPI_BJ *(u32x4*)(O + (size_t)row * ldc + col) = pack8(v0, v1); } } }
};
struct EpiMulInPlace {
    bf16_t* Y;
    __device__ __forceinline__ void operator()(EPI_ACC) const { EPI_LOOP_BEGIN EPI_BJ u32x4* ptr = (u32x4*)(Y + (size_t)row * 1024 + col); f32x4 a, b; unpack8(*ptr, a, b); *ptr = pack8(a * v0, b * v1); } } }
};
struct EpiGates {
    bf16_t* G; const float* bias;
    __device__ __forceinline__ void operator()(EPI_ACC) const { EPI_LOOP_BEGIN EPI_BJ
        const f32x4 b0 = *(const f32x4*)(bias + col), b1 = *(const f32x4*)(bias + col + 4); f32x4 a, b;
#pragma unroll
        for (int j = 0; j < 4; ++j) { a[j] = sigmoidf_(v0[j] + b0[j]); b[j] = sigmoidf_(v1[j] + b1[j]); }
        *(u32x4*)(G + (size_t)row * 2048 + col) = pack8(a, b); } } }
};
struct EpiPool {
    bf16_t* P; const bf16_t* G;
    __device__ __forceinline__ void operator()(EPI_ACC) const { EPI_LOOP_BEGIN EPI_BJ f32x4 a, b; unpack8(*(const u32x4*)(G + (size_t)row * 2048 + col), a, b);
        *(u32x4*)(P + (size_t)row * 1024 + col) = pack8(a * v0, b * v1); } } }
};
struct EpiMerge {
    bf16_t* P; const bf16_t* G;
    __device__ __forceinline__ void operator()(EPI_ACC) const { EPI_LOOP_BEGIN EPI_BJ f32x4 a, b, pa, pb; unpack8(*(const u32x4*)(G + (size_t)row * 2048 + 1024 + col), a, b);
        u32x4* ptr = (u32x4*)(P + (size_t)row * 1024 + col); unpack8(*ptr, pa, pb); *ptr = pack8(pa + a * v0, pb + b * v1); } } }
};
struct EpiOut {
    const float* xp; const float* xs; float* X1; bf16_t* X1B; float* rowsq;
    __device__ __forceinline__ void operator()(EPI_ACC) const { EPI_LOOP_BEGIN const float* xr = row < TP ? xp + (size_t)row * DM : xs + (size_t)(row - TP) * DM; float ss = 0.f; EPI_BJ
        f32x4 a = *(const f32x4*)(xr + col) + v0, b = *(const f32x4*)(xr + col + 4) + v1;
        *(f32x4*)(X1 + (size_t)row * 1024 + col) = a; *(f32x4*)(X1 + (size_t)row * 1024 + col + 4) = b; *(u32x4*)(X1B + (size_t)row * 1024 + col) = pack8(a, b);
#pragma unroll
        for (int j = 0; j < 4; ++j) ss += a[j] * a[j] + b[j] * b[j]; }
        ss += __shfl_xor(ss, 16); ss += __shfl_xor(ss, 32); if (fq == 0) atomicAdd(rowsq + row, ss); } }
};
struct EpiFF1 {
    bf16_t* Hlo; bf16_t* Hhi; const float* rowsq;
    __device__ __forceinline__ void operator()(EPI_ACC) const { bf16_t* H = u.pn < 8 ? Hlo : Hhi; const int cshift = u.pn < 8 ? 0 : 2048;
        EPI_LOOP_BEGIN const float rinv = rsqrtf(rowsq[row] * (1.0f / 1024.0f) + 1e-6f); EPI_BJ f32x4 a, b;
#pragma unroll
        for (int j = 0; j < 4; ++j) { float t0 = fmaxf(v0[j] * rinv, 0.f), t1 = fmaxf(v1[j] * rinv, 0.f); a[j] = t0 * t0; b[j] = t1 * t1; }
        *(u32x4*)(H + (size_t)row * 2048 + (col - cshift)) = pack8(a, b); } } }
};
struct EpiAddInPlace {
    float* X;
    __device__ __forceinline__ void operator()(EPI_ACC) const { EPI_LOOP_BEGIN EPI_BJ f32x4* ptr = (f32x4*)(X + (size_t)row * 1024 + col); ptr[0] = ptr[0] + v0; ptr[1] = ptr[1] + v1; } } }
};
struct EpiFinal {
    float* X; float* rowsq;
    __device__ __forceinline__ void operator()(EPI_ACC) const { EPI_LOOP_BEGIN float ss = 0.f; EPI_BJ f32x4* ptr = (f32x4*)(X + (size_t)row * 1024 + col); const f32x4 a = ptr[0] + v0, b = ptr[1] + v1; ptr[0] = a; ptr[1] = b;
#pragma unroll
        for (int j = 0; j < 4; ++j) ss += a[j] * a[j] + b[j] * b[j]; }
        ss += __shfl_xor(ss, 16); ss += __shfl_xor(ss, 32); if (fq == 0) atomicAdd(rowsq + row, ss); } }
};

template <class Epi>
__device__ __forceinline__ void run_gemm(unsigned char* shm, const bf16_t* A, int lda, const bf16_t* Bt, int ldb, int N, int K, const Epi& E) {
    pg8::Gemm g; g.A = A; g.Bt = Bt; g.M = T_TOK; g.N = N; g.K = K; g.lda = lda; g.ldb = ldb;
    pg8::StaticOrder S; S.init(T_TOK, N, (int)gridDim.x, (int)blockIdx.x);
    pg8::gemm_phase<Epi>((LAS unsigned char*)shm, g, S, E);
}

__device__ void transpose_cvt(unsigned char* shm, const float* src, int K, int N, bf16_t* dst, int ldd, const float* kscale) {
    float* tile = (float*)shm;
    const int tid = opaque_tid(), ntk = K / 64, ntn = N / 64;
    for (int t = blockIdx.x; t < ntk * ntn; t += gridDim.x) {
        const int tk = t / ntn, tn = t % ntn;
#pragma unroll
        for (int i = 0; i < 8; ++i) { const int kl = (tid >> 6) + 8 * i, nl = tid & 63; const int k = tk * 64 + kl;
            tile[kl * 65 + nl] = src[(size_t)k * N + tn * 64 + nl] * (kscale ? kscale[k] : 1.0f); }
        __syncthreads();
#pragma unroll
        for (int i = 0; i < 8; ++i) { const int nl = (tid >> 6) + 8 * i, kl = tid & 63;
            const unsigned w = pk_bf16(tile[kl * 65 + nl], 0.f); dst[(size_t)(tn * 64 + nl) * ldd + tk * 64 + kl] = (bf16_t)(w & 0xFFFFu); }
        __syncthreads();
    }
}

__device__ void rmsnorm_rows(const Params& p, const float* g, bf16_t* dst) {
    const int tidx = opaque_tid(); const int lane = tidx & 63, wave = (blockIdx.x * blockDim.x + tidx) >> 6, nw = (gridDim.x * blockDim.x) >> 6;
    f32x4 gv[4];
#pragma unroll
    for (int i = 0; i < 4; ++i) gv[i] = *(const f32x4*)(g + lane * 4 + 256 * i);
    for (int t = wave; t < T_TOK; t += nw) {
        const float* xr = xrow(p, t); f32x4 v[4]; float ss = 0.f;
#pragma unroll
        for (int i = 0; i < 4; ++i) { v[i] = *(const f32x4*)(xr + lane * 4 + 256 * i); ss += v[i][0] * v[i][0] + v[i][1] * v[i][1] + v[i][2] * v[i][2] + v[i][3] * v[i][3]; }
#pragma unroll
        for (int o = 1; o < 64; o <<= 1) ss += __shfl_xor(ss, o);
        const float rinv = rsqrtf(ss * (1.0f / 1024.0f) + 1e-6f);
#pragma unroll
        for (int i = 0; i < 4; ++i) { u32x2 w; w.x = pk_bf16(v[i][0] * rinv * gv[i][0], v[i][1] * rinv * gv[i][1]); w.y = pk_bf16(v[i][2] * rinv * gv[i][2], v[i][3] * rinv * gv[i][3]);
            *(u32x2*)(dst + (size_t)t * 1024 + lane * 4 + 256 * i) = w; }
    }
}

__device__ void prep_phase(const Params& p, unsigned char* shm) {
    unsigned char* ws = p.ws;
    const int gtid = blockIdx.x * blockDim.x + opaque_tid(), gn = gridDim.x * blockDim.x;
    for (int i = gtid; i < T_TOK; i += gn) { ((float*)(ws + OFF_ROWSQ))[i] = 0.f; ((float*)(ws + OFF_ROWSQ2))[i] = 0.f; }
    if (gtid < 64) ((unsigned*)(ws + OFF_QUEUE))[gtid] = 0u;
    transpose_cvt(shm, p.w_in, 1024, 5888, (bf16_t*)(ws + OFF_WIN), 1024, nullptr);
    transpose_cvt(shm, p.w_rwkv_br, 1024, 1024, (bf16_t*)(ws + OFF_WRBR), 1024, nullptr);
    transpose_cvt(shm, p.w_out, 1024, 1024, (bf16_t*)(ws + OFF_WOUT), 1024, nullptr);
    transpose_cvt(shm, p.w_ff1, 1024, 4096, (bf16_t*)(ws + OFF_WFF1), 1024, p.g_ffn);
    transpose_cvt(shm, p.w_ff2, 4096, 1024, (bf16_t*)(ws + OFF_WFF2), 4096, nullptr);
    transpose_cvt(shm, p.g_up, 128, 1024, (bf16_t*)(ws + OFF_WG), 256, nullptr);
    { bf16_t* wg = (bf16_t*)(ws + OFF_WG); for (int i = gtid; i < 1024 * 128; i += gn) wg[(size_t)(i >> 7) * 256 + 128 + (i & 127)] = 0; }
    { bf16_t* we = (bf16_t*)(ws + OFF_WEFF);
      for (int i = gtid; i < 512 * 1024; i += gn) { const int k = i >> 10, n = i & 1023, gI = k >> 7; const float* pw = p.pool_w + (size_t)k * 128; float acc = 0.f;
          for (int d = 0; d < 128; ++d) acc += pw[d] * p.pool_scale[gI * 128 + d] * p.w_pool_br[(size_t)(gI * 128 + d) * 1024 + n];
          we[(size_t)n * 512 + k] = (bf16_t)(pk_bf16(acc, 0.f) & 0xFFFFu); } }
    rmsnorm_rows(p, p.g_mix, (bf16_t*)(ws + OFF_R1));
}

#define LDS_BAR() do { asm volatile("s_waitcnt lgkmcnt(0)" ::: "memory"); __builtin_amdgcn_s_barrier(); asm volatile("" ::: "memory"); } while (0)
constexpr int N_SAMPLE_ITEMS = 128, N_ITEMS = N_SAMPLE_ITEMS + 1024;

template <int LPR>
__device__ __forceinline__ void scan_item(const Params& p, unsigned char* shm, const int tid, const int tbase, const int L, const int h, const int dir, const int half) {
    constexpr int EC = 64 / LPR, RPW = 64 / LPR, NS = EC / 2;
    float* sW = (float*)shm; float* sAV = sW + 2048; float* sBV = sW + 4096; float* sKD = sW + 6144; float* sWR = sW + 8192; float* sR = sW + 10240; float* sV = sW + 12288; float* sY = sW + 14336;
    float* sBK = sW + 16384;
    bf16_t* sTW = (bf16_t*)(sW + 16384 + 64);
    bf16_t* sZA = sTW + 32 * 72;
    const int lane = tid & 63, wv = tid >> 6;
    const bf16_t* zall = (const bf16_t*)(p.ws + OFF_Z);
    const int tokA = tid >> 4, q = tid & 15;
    const int rowS = (LPR == 16 ? half * 32 : 0) + wv * RPW + lane / LPR, gS = lane % LPR;
    const int NC = L / 32;
    bf16_t* ybuf = (bf16_t*)p.out + (dir ? (size_t)T_TOK * 1024 : 0);
    float* bonus = (float*)(p.ws + OFF_BONUS) + (dir ? (size_t)T_TOK * 16 : 0);
    const float* w_up = dir ? p.w_up_b : p.w_up_f; const float* a_up = dir ? p.a_up_b : p.a_up_f;
    const float* w0 = dir ? p.w0_b : p.w0_f; const float* a0 = dir ? p.a0_b : p.a0_f;
    const int mat = wv >> 2, cbk = wv & 3, colB = cbk * 16 + (lane & 15), quad = lane >> 4;
    bf16x8 bfrag[2];
    { const float* up = mat ? a_up : w_up;
#pragma unroll
      for (int kb = 0; kb < 2; ++kb) { float f[8];
#pragma unroll
          for (int j = 0; j < 8; ++j) f[j] = up[(size_t)(kb * 32 + quad * 8 + j) * 1024 + h * 64 + colB];
          u32x4 w; w.x = pk_bf16(f[0], f[1]); w.y = pk_bf16(f[2], f[3]); w.z = pk_bf16(f[4], f[5]); w.w = pk_bf16(f[6], f[7]); bfrag[kb] = __builtin_bit_cast(bf16x8, w); } }
    const float c0B = (mat ? a0 : w0)[h * 64 + colB];
    const float kaB = p.k_a[h * 64 + colB];
    const f32x4 rk4 = *(const f32x4*)(p.r_k + h * 64 + 4 * q);
    const f32x4 kk4c = *(const f32x4*)(p.k_k + h * 64 + 4 * q);
    f32x4 mpv[5], mnv[5]; int colz[5];
#pragma unroll
    for (int gi = 0; gi < 5; ++gi) { colz[gi] = (gi == 0 ? COL_R + h * 64 : gi == 1 ? COL_K + h * 64 : gi == 2 ? COL_V + h * 64 : gi == 3 ? COL_W : COL_A) + 4 * q;
        mpv[gi] = *(const f32x4*)(p.mu_prev + colz[gi] - COL_R); mnv[gi] = *(const f32x4*)(p.mu_next + colz[gi] - COL_R); }
    f32x2 s[NS];
#pragma unroll
    for (int j = 0; j < NS; ++j) s[j] = (f32x2){0.f, 0.f};
    u32x2 zc[5], zp[5], zn[5];
    auto load_chunk = [&](int ci) {
        const int t = tbase + 32 * (dir ? NC - 1 - ci : ci) + tokA; const bool hasPrev = t > tbase, hasNext = t < tbase + L - 1;
        const bf16_t* zr = zall + (size_t)t * ZLD;
#pragma unroll
        for (int gi = 0; gi < 5; ++gi) { zc[gi] = *(const u32x2*)(zr + colz[gi]); zp[gi] = (u32x2){0u, 0u}; zn[gi] = (u32x2){0u, 0u};
            if (hasPrev) zp[gi] = *(const u32x2*)(zr - ZLD + colz[gi]);
            if (hasNext) zn[gi] = *(const u32x2*)(zr + ZLD + colz[gi]); }
    };
    load_chunk(0);
    for (int ci = 0; ci < NC; ++ci) {
        const int t0 = tbase + 32 * (dir ? NC - 1 - ci : ci);
        { float zs[5][4];
#pragma unroll
          for (int gi = 0; gi < 5; ++gi) {
              const float c[4] = {bf_lo(zc[gi].x), bf_hi(zc[gi].x), bf_lo(zc[gi].y), bf_hi(zc[gi].y)}, pv[4] = {bf_lo(zp[gi].x), bf_hi(zp[gi].x), bf_lo(zp[gi].y), bf_hi(zp[gi].y)}, nx[4] = {bf_lo(zn[gi].x), bf_hi(zn[gi].x), bf_lo(zn[gi].y), bf_hi(zn[gi].y)};
#pragma unroll
              for (int j = 0; j < 4; ++j) zs[gi][j] = c[j] + mpv[gi][j] * (pv[j] - c[j]) + mnv[gi][j] * (nx[j] - c[j]);
          }
          if (ci + 1 < NC) load_chunk(ci + 1);
          *(f32x4*)(sR + tokA * 64 + 4 * q) = (f32x4){zs[0][0], zs[0][1], zs[0][2], zs[0][3]};
          *(f32x4*)(sKD + tokA * 64 + 4 * q) = (f32x4){zs[1][0], zs[1][1], zs[1][2], zs[1][3]};
          *(f32x4*)(sV + tokA * 64 + 4 * q) = (f32x4){zs[2][0], zs[2][1], zs[2][2], zs[2][3]};
          float kk[4], ss = 0.f;
#pragma unroll
          for (int j = 0; j < 4; ++j) { kk[j] = zs[1][j] * kk4c[j]; ss += kk[j] * kk[j]; }
          ss = red16(ss);
          const float inv = -1.0f / fmaxf(sqrtf(ss), 1e-12f);
          *(f32x4*)(sAV + tokA * 64 + 4 * q) = (f32x4){kk[0] * inv, kk[1] * inv, kk[2] * inv, kk[3] * inv};
          float tw[4];
#pragma unroll
          for (int j = 0; j < 4; ++j) tw[j] = 1.0f - 2.0f / (1.0f + __expf(2.0f * zs[3][j]));
          u32x2 w; w.x = pk_bf16(tw[0], tw[1]); w.y = pk_bf16(tw[2], tw[3]); *(u32x2*)(sTW + tokA * 72 + 4 * q) = w;
          w.x = pk_bf16(zs[4][0], zs[4][1]); w.y = pk_bf16(zs[4][2], zs[4][3]); *(u32x2*)(sZA + tokA * 72 + 4 * q) = w;
        }
        LDS_BAR();
        { const bf16_t* sX = mat ? sZA : sTW;
#pragma unroll
          for (int rb = 0; rb < 2; ++rb) {
              f32x4 acc = (f32x4){0.f, 0.f, 0.f, 0.f};
#pragma unroll
              for (int kb = 0; kb < 2; ++kb) { const bf16x8 af = *(const bf16x8*)(sX + (rb * 16 + (lane & 15)) * 72 + kb * 32 + quad * 8);
                  acc = __builtin_amdgcn_mfma_f32_16x16x32_bf16(af, bfrag[kb], acc, 0, 0, 0); }
#pragma unroll
              for (int j = 0; j < 4; ++j) { const int idx = (rb * 16 + quad * 4 + j) * 64 + colB; const float pre = c0B + acc[j];
                  if (mat == 0) { const float w = __expf(-0.6065306597f * sigmoidf_(pre)); sW[idx] = w; sWR[idx] = w * sR[idx]; }
                  else { const float a = sigmoidf_(pre); const float k = sKD[idx]; sKD[idx] = k * (1.0f + (a - 1.0f) * kaB); sBV[idx] = -sAV[idx] * a; } }
          } }
        LDS_BAR();
        { const f32x4 r4 = *(const f32x4*)(sR + tokA * 64 + 4 * q), b4 = *(const f32x4*)(sBV + tokA * 64 + 4 * q), k4 = *(const f32x4*)(sKD + tokA * 64 + 4 * q);
          float br = 0.f, kr = 0.f, cb = 0.f;
#pragma unroll
          for (int j = 0; j < 4; ++j) { br += b4[j] * r4[j]; kr += k4[j] * r4[j]; cb += r4[j] * k4[j] * rk4[j]; }
          br = red16(br); kr = red16(kr); cb = red16(cb);
          if (q == 0) { sBK[tokA * 2] = br; sBK[tokA * 2 + 1] = kr; if (half == 0) bonus[(size_t)(t0 + tokA) * 16 + h] = cb; } }
        LDS_BAR();
#pragma unroll 4
        for (int i = 0; i < 32; ++i) {
            const int tk = dir ? 31 - i : i; const int o = tk * 64 + 4 * gS;
            const float v = sV[tk * 64 + rowS]; const f32x2 bk = *(const f32x2*)(sBK + tk * 2);
            float y;
            if constexpr (LPR == 8) {
                const f32x4 wl = *(const f32x4*)(sW + o), wh = *(const f32x4*)(sW + o + 32);
                const f32x4 al = *(const f32x4*)(sAV + o), ah = *(const f32x4*)(sAV + o + 32);
                const f32x4 bl = *(const f32x4*)(sBV + o), bh = *(const f32x4*)(sBV + o + 32);
                const f32x4 kl = *(const f32x4*)(sKD + o), kh = *(const f32x4*)(sKD + o + 32);
                const f32x4 ql = *(const f32x4*)(sWR + o), qh = *(const f32x4*)(sWR + o + 32);
                f32x2 sa2 = s[0] * (f32x2){al[0], al[1]}; sa2 = __builtin_elementwise_fma(s[1], (f32x2){al[2], al[3]}, sa2);
                sa2 = __builtin_elementwise_fma(s[2], (f32x2){ah[0], ah[1]}, sa2); sa2 = __builtin_elementwise_fma(s[3], (f32x2){ah[2], ah[3]}, sa2);
                f32x2 yp2 = s[0] * (f32x2){ql[0], ql[1]}; yp2 = __builtin_elementwise_fma(s[1], (f32x2){ql[2], ql[3]}, yp2);
                yp2 = __builtin_elementwise_fma(s[2], (f32x2){qh[0], qh[1]}, yp2); yp2 = __builtin_elementwise_fma(s[3], (f32x2){qh[2], qh[3]}, yp2);
                const float sa = red8(sa2.x + sa2.y), yp = red8(yp2.x + yp2.y);
                const f32x2 vv = (f32x2){v, v}, sasa = (f32x2){sa, sa};
                s[0] = __builtin_elementwise_fma(s[0], (f32x2){wl[0], wl[1]}, __builtin_elementwise_fma(sasa, (f32x2){bl[0], bl[1]}, vv * (f32x2){kl[0], kl[1]}));
                s[1] = __builtin_elementwise_fma(s[1], (f32x2){wl[2], wl[3]}, __builtin_elementwise_fma(sasa, (f32x2){bl[2], bl[3]}, vv * (f32x2){kl[2], kl[3]}));
                s[2] = __builtin_elementwise_fma(s[2], (f32x2){wh[0], wh[1]}, __builtin_elementwise_fma(sasa, (f32x2){bh[0], bh[1]}, vv * (f32x2){kh[0], kh[1]}));
                s[3] = __builtin_elementwise_fma(s[3], (f32x2){wh[2], wh[3]}, __builtin_elementwise_fma(sasa, (f32x2){bh[2], bh[3]}, vv * (f32x2){kh[2], kh[3]}));
                y = yp + sa * bk.x + v * bk.y;
            } else {
                const f32x4 wl = *(const f32x4*)(sW + o), al = *(const f32x4*)(sAV + o), bl = *(const f32x4*)(sBV + o), kl = *(const f32x4*)(sKD + o), ql = *(const f32x4*)(sWR + o);
                f32x2 sa2 = s[0] * (f32x2){al[0], al[1]}; sa2 = __builtin_elementwise_fma(s[1], (f32x2){al[2], al[3]}, sa2);
                f32x2 yp2 = s[0] * (f32x2){ql[0], ql[1]}; yp2 = __builtin_elementwise_fma(s[1], (f32x2){ql[2], ql[3]}, yp2);
                const float sa = red16(sa2.x + sa2.y), yp = red16(yp2.x + yp2.y);
                const f32x2 vv = (f32x2){v, v}, sasa = (f32x2){sa, sa};
                s[0] = __builtin_elementwise_fma(s[0], (f32x2){wl[0], wl[1]}, __builtin_elementwise_fma(sasa, (f32x2){bl[0], bl[1]}, vv * (f32x2){kl[0], kl[1]}));
                s[1] = __builtin_elementwise_fma(s[1], (f32x2){wl[2], wl[3]}, __builtin_elementwise_fma(sasa, (f32x2){bl[2], bl[3]}, vv * (f32x2){kl[2], kl[3]}));
                y = yp + sa * bk.x + v * bk.y;
            }
            if (gS == 0) sY[tk * 64 + rowS] = y;
        }
        LDS_BAR();
        if (LPR == 8 || (q >> 3) == half) { const f32x4 y4 = *(const f32x4*)(sY + tokA * 64 + 4 * q); u32x2 w; w.x = pk_bf16(y4[0], y4[1]); w.y = pk_bf16(y4[2], y4[3]);
          *(u32x2*)(ybuf + (size_t)(t0 + tokA) * 1024 + h * 64 + 4 * q) = w; }
    }
}

__device__ void scan_phase(const Params& p, unsigned char* shm) {
    int* sItem = (int*)(shm + 80 * 1024);
    const int tid = opaque_tid();
    unsigned* queue = (unsigned*)(p.ws + OFF_QUEUE);
    for (;;) {
        if (tid == 0) *sItem = (int)atomicAdd(queue, 1u);
        __syncthreads();
        const int item = *sItem;
        __syncthreads();
        if (item >= N_ITEMS) break;
        if (item < N_SAMPLE_ITEMS) {
            const int half = item & 1, j = item >> 1;
            scan_item<16>(p, shm, tid, TP + (j >> 5) * 16384, 16384, (j >> 1) & 15, j & 1, half);
        } else { const int j = item - N_SAMPLE_ITEMS;
            scan_item<8>(p, shm, tid, (j >> 5) * 2048, 2048, (j >> 1) & 15, j & 1, 0); }
        __syncthreads();
    }
}

__device__ void mix_phase(const Params& p) {
    const int tidx = opaque_tid(); const int lane = tidx & 63, wave = (blockIdx.x * blockDim.x + tidx) >> 6, nw = (gridDim.x * blockDim.x) >> 6;
    const bf16_t* zall = (const bf16_t*)(p.ws + OFF_Z);
    bf16_t* yf = (bf16_t*)p.out; const bf16_t* yb = (const bf16_t*)p.out + (size_t)T_TOK * 1024;
    const float* bonus_f = (const float*)(p.ws + OFF_BONUS); const float* bonus_b = bonus_f + (size_t)T_TOK * 16;
    bf16_t* pooled = (bf16_t*)(p.ws + OFF_POOLED); bf16_t* sg = (bf16_t*)(p.ws + OFF_SG);
    const int hL = lane >> 2;
    for (int t = wave; t < T_TOK; t += nw) {
        int tbase, L; seq_of(t, tbase, L); const int pos = t - tbase; const bool hasPrev = pos > 0, hasNext = pos < L - 1;
        const bf16_t* zr = zall + (size_t)t * ZLD;
        { const int c0 = lane * 16; float y[16];
          { const u32x4 a0 = *(const u32x4*)(yf + (size_t)t * 1024 + c0), a1 = *(const u32x4*)(yf + (size_t)t * 1024 + c0 + 8);
            const u32x4 b0 = *(const u32x4*)(yb + (size_t)t * 1024 + c0), b1 = *(const u32x4*)(yb + (size_t)t * 1024 + c0 + 8);
            f32x4 fa, fb, ga, gb; unpack8(a0, fa, fb); unpack8(b0, ga, gb);
#pragma unroll
            for (int j = 0; j < 4; ++j) { y[j] = fa[j] + ga[j]; y[4 + j] = fb[j] + gb[j]; }
            unpack8(a1, fa, fb); unpack8(b1, ga, gb);
#pragma unroll
            for (int j = 0; j < 4; ++j) { y[8 + j] = fa[j] + ga[j]; y[12 + j] = fb[j] + gb[j]; } }
          float sm = 0.f;
#pragma unroll
          for (int j = 0; j < 16; ++j) sm += y[j];
          const float mean = red4(sm) * (1.0f / 64.0f); float vs = 0.f;
#pragma unroll
          for (int j = 0; j < 16; ++j) { const float d = y[j] - mean; vs += d * d; }
          const float rstd = rsqrtf(red4(vs) * (1.0f / 64.0f) + 64e-5f);
          const float bon = bonus_f[(size_t)t * 16 + hL] + bonus_b[(size_t)t * 16 + hL];
          float vv[16];
          { const bf16_t* zc = zr + COL_V + c0;
            u32x4 c_[2], p_[2], n_[2];
#pragma unroll
            for (int i = 0; i < 2; ++i) { c_[i] = *(const u32x4*)(zc + 8 * i); p_[i] = hasPrev ? *(const u32x4*)(zc - ZLD + 8 * i) : (u32x4){0u, 0u, 0u, 0u}; n_[i] = hasNext ? *(const u32x4*)(zc + ZLD + 8 * i) : (u32x4){0u, 0u, 0u, 0u}; }
#pragma unroll
            for (int i = 0; i < 2; ++i) { f32x4 ca, cb, pa, pb, na, nb; unpack8(c_[i], ca, cb); unpack8(p_[i], pa, pb); unpack8(n_[i], na, nb);
                const float* mp = p.mu_prev + (COL_V - COL_R) + c0 + 8 * i; const float* mn = p.mu_next + (COL_V - COL_R) + c0 + 8 * i;
                const f32x4 mp0 = *(const f32x4*)mp, mp1 = *(const f32x4*)(mp + 4), mn0 = *(const f32x4*)mn, mn1 = *(const f32x4*)(mn + 4);
#pragma unroll
                for (int j = 0; j < 4; ++j) { vv[8 * i + j] = ca[j] + mp0[j] * (pa[j] - ca[j]) + mn0[j] * (na[j] - ca[j]); vv[8 * i + 4 + j] = cb[j] + mp1[j] * (pb[j] - cb[j]) + mn1[j] * (nb[j] - cb[j]); } } }
          float o[16];
#pragma unroll
          for (int i = 0; i < 4; ++i) { const f32x4 lw = *(const f32x4*)(p.ln_w + c0 + 4 * i), lb = *(const f32x4*)(p.ln_b + c0 + 4 * i);
#pragma unroll
              for (int j = 0; j < 4; ++j) o[4 * i + j] = (y[4 * i + j] - mean) * rstd * lw[j] + lb[j] + bon * vv[4 * i + j]; }
          u32x4 w0, w1; w0.x = pk_bf16(o[0], o[1]); w0.y = pk_bf16(o[2], o[3]); w0.z = pk_bf16(o[4], o[5]); w0.w = pk_bf16(o[6], o[7]);
          w1.x = pk_bf16(o[8], o[9]); w1.y = pk_bf16(o[10], o[11]); w1.z = pk_bf16(o[12], o[13]); w1.w = pk_bf16(o[14], o[15]);
          *(u32x4*)(yf + (size_t)t * 1024 + c0) = w0; *(u32x4*)(yf + (size_t)t * 1024 + c0 + 8) = w1; }
        { const int c = 2 * lane; const bf16_t* zc = zr + COL_G + c; const unsigned wc_ = *(const unsigned*)zc; const unsigned wp = hasPrev ? *(const unsigned*)(zc - ZLD) : 0u, wn = hasNext ? *(const unsigned*)(zc + ZLD) : 0u;
          const float mp0 = p.mu_prev[COL_G - COL_R + c], mp1 = p.mu_prev[COL_G - COL_R + c + 1], mn0 = p.mu_next[COL_G - COL_R + c], mn1 = p.mu_next[COL_G - COL_R + c + 1];
          const float c0v = bf_lo(wc_), c1v = bf_hi(wc_);
          const float z0 = c0v + mp0 * (bf_lo(wp) - c0v) + mn0 * (bf_lo(wn) - c0v), z1 = c1v + mp1 * (bf_hi(wp) - c1v) + mn1 * (bf_hi(wn) - c1v);
          *(unsigned*)(sg + (size_t)t * 256 + c) = pk_bf16(sigmoidf_(z0), sigmoidf_(z1)); *(unsigned*)(sg + (size_t)t * 256 + 128 + c) = 0u; }
        { const int c = lane * 8, gi = lane >> 4, w = 2 << gi; const int lo = max(pos - (w >> 1), 0), hi = min(pos + (w >> 1) - 1, L - 1);
          float sum[8];
#pragma unroll
          for (int j = 0; j < 8; ++j) sum[j] = 0.f;
          for (int r = lo; r <= hi; ++r) { f32x4 a, b; unpack8(*(const u32x4*)(zall + (size_t)(tbase + r) * ZLD + c), a, b);
#pragma unroll
              for (int j = 0; j < 4; ++j) { sum[j] += a[j]; sum[4 + j] += b[j]; } }
          const float icnt = 1.0f / (float)(hi - lo + 1); f32x4 a, b; unpack8(*(const u32x4*)(zr + c), a, b); f32x4 oa, ob;
#pragma unroll
          for (int j = 0; j < 4; ++j) { oa[j] = sum[j] * icnt - a[j]; ob[j] = sum[4 + j] * icnt - b[j]; }
          *(u32x4*)(pooled + (size_t)t * 512 + c) = pack8(oa, ob); }
    }
}

__device__ void final_phase(const Params& p) {
    const int tidx = opaque_tid(); const int lane = tidx & 63, wave = (blockIdx.x * blockDim.x + tidx) >> 6, nw = (gridDim.x * blockDim.x) >> 6;
    const float* x2 = (const float*)(p.ws + OFF_X1); const float* rowsq2 = (const float*)(p.ws + OFF_ROWSQ2);
    f32x4 gv[4];
#pragma unroll
    for (int i = 0; i < 4; ++i) gv[i] = *(const f32x4*)(p.g_final + lane * 4 + 256 * i);
    for (int t = wave; t < T_TOK; t += nw) {
        const float rinv = rsqrtf(rowsq2[t] * (1.0f / 1024.0f) + 1e-6f);
#pragma unroll
        for (int i = 0; i < 4; ++i) { const f32x4 v = *(const f32x4*)(x2 + (size_t)t * 1024 + lane * 4 + 256 * i); *(f32x4*)(p.out + (size_t)t * 1024 + lane * 4 + 256 * i) = v * rinv * gv[i]; }
    }
}

__global__ void __launch_bounds__(512, 2) fwd_megakernel(Params p) {
    extern __shared__ __attribute__((aligned(16))) unsigned char shm[];
    cg::grid_group grid = cg::this_grid();
    unsigned char* ws = p.ws;
    prep_phase(p, shm);
    grid.sync();
    { EpiStore E; E.O = (bf16_t*)(ws + OFF_Z); E.ldc = ZLD; run_gemm(shm, (const bf16_t*)(ws + OFF_R1), 1024, (const bf16_t*)(ws + OFF_WIN), 1024, 3840, 1024, E); }
    grid.sync();
    scan_phase(p, shm);
    grid.sync();
    mix_phase(p);
    grid.sync();
    rmsnorm_rows(p, p.g_mix, (bf16_t*)(ws + OFF_XN2));
    { EpiMulInPlace E; E.Y = (bf16_t*)p.out; run_gemm(shm, (const bf16_t*)(ws + OFF_SG), 256, (const bf16_t*)(ws + OFF_WG), 256, 1024, 256, E); }
    grid.sync();
    { EpiGates E; E.G = (bf16_t*)(ws + OFF_GATES); E.bias = p.b_gate; run_gemm(shm, (const bf16_t*)(ws + OFF_XN2), 1024, (const bf16_t*)(ws + OFF_WIN) + (size_t)3840 * 1024, 1024, 2048, 1024, E); }
    grid.sync();
    { EpiPool E; E.P = (bf16_t*)(ws + OFF_MERGED); E.G = (const bf16_t*)(ws + OFF_GATES); run_gemm(shm, (const bf16_t*)(ws + OFF_POOLED), 512, (const bf16_t*)(ws + OFF_WEFF), 512, 1024, 512, E); }
    { EpiMerge E; E.P = (bf16_t*)(ws + OFF_MERGED); E.G = (const bf16_t*)(ws + OFF_GATES); run_gemm(shm, (const bf16_t*)p.out, 1024, (const bf16_t*)(ws + OFF_WRBR), 1024, 1024, 1024, E); }
    grid.sync();
    { EpiOut E; E.xp = p.x_prompt; E.xs = p.x_sample; E.X1 = (float*)(ws + OFF_X1); E.X1B = (bf16_t*)(ws + OFF_X1B); E.rowsq = (float*)(ws + OFF_ROWSQ); run_gemm(shm, (const bf16_t*)(ws + OFF_MERGED), 1024, (const bf16_t*)(ws + OFF_WOUT), 1024, 1024, 1024, E); }
    grid.sync();
    { EpiFF1 E; E.Hlo = (bf16_t*)(ws + OFF_HLO); E.Hhi = (bf16_t*)p.out; E.rowsq = (const float*)(ws + OFF_ROWSQ); run_gemm(shm, (const bf16_t*)(ws + OFF_X1B), 1024, (const bf16_t*)(ws + OFF_WFF1), 1024, 4096, 1024, E); }
    grid.sync();
    { EpiAddInPlace E; E.X = (float*)(ws + OFF_X1); run_gemm(shm, (const bf16_t*)(ws + OFF_HLO), 2048, (const bf16_t*)(ws + OFF_WFF2), 4096, 1024, 2048, E); }
    { EpiFinal E; E.X = (float*)(ws + OFF_X1); E.rowsq = (float*)(ws + OFF_ROWSQ2); run_gemm(shm, (const bf16_t*)p.out, 2048, (const bf16_t*)(ws + OFF_WFF2) + 2048, 4096, 1024, 2048, E); }
    grid.sync();
    final_phase(p);
}

extern "C" void kernel_launch(void* const* d_in, const int* in_sizes, int n_in, void* d_out, int out_size, void* d_ws, size_t ws_size, hipStream_t stream) {
    constexpr size_t kDynLds = 131072;
    static int grid_blocks = 0;
    if (!grid_blocks) {
        hipFuncSetAttribute((const void*)fwd_megakernel, hipFuncAttributeMaxDynamicSharedMemorySize, (int)kDynLds);
        int dev = 0, cus = 0, per_cu = 0;
        hipGetDevice(&dev);
        hipDeviceGetAttribute(&cus, hipDeviceAttributeMultiprocessorCount, dev);
        hipOccupancyMaxActiveBlocksPerMultiprocessor(&per_cu, fwd_megakernel, 512, kDynLds);
        if (per_cu < 1) per_cu = 1;
        grid_blocks = cus;
    }
    Params p{};
    const float** pf = (const float**)&p;
    for (int i = 0; i < 30; ++i) pf[i] = (const float*)d_in[i];
    p.out = (float*)d_out; p.ws = (unsigned char*)d_ws;
    void* args[] = {&p};
    hipError_t e = hipLaunchCooperativeKernel((const void*)fwd_megakernel, dim3(grid_blocks), dim3(512), args, kDynLds, stream);
    if (e != hipSuccess) fprintf(stderr, "cooperative launch failed: %s (grid %d)\n", hipGetErrorString(e), grid_blocks);
}
```

```cpp
#include <hip/hip_runtime.h>
#include <hip/hip_cooperative_groups.h>
#include <cstdio>
namespace cg = cooperative_groups;

#define LAS __attribute__((address_space(3)))
typedef unsigned short bf16_t;
typedef short bf16x8 __attribute__((ext_vector_type(8)));
typedef float f32x4 __attribute__((ext_vector_type(4)));
typedef float f32x2 __attribute__((ext_vector_type(2)));
typedef unsigned u32x4 __attribute__((ext_vector_type(4)));
typedef unsigned u32x2 __attribute__((ext_vector_type(2)));

constexpr int T_TOK = 98304, DM = 1024, TP = 65536;
constexpr int ZLD = 3840;
constexpr int COL_R = 512, COL_K = 1536, COL_V = 2560, COL_W = 3584, COL_A = 3648, COL_G = 3712;
constexpr size_t MiB = 1ull << 20;
constexpr size_t OFF_WIN = 0, OFF_WEFF = 12 * MiB, OFF_WRBR = 13 * MiB, OFF_WOUT = 15 * MiB, OFF_WFF1 = 17 * MiB, OFF_WFF2 = 25 * MiB, OFF_WG = 33 * MiB;
constexpr size_t OFF_ROWSQ = 34 * MiB, OFF_ROWSQ2 = 34 * MiB + 512 * 1024, OFF_QUEUE = 35 * MiB, OFF_BONUS = 36 * MiB;
constexpr size_t OFF_R1 = 48 * MiB, OFF_Z = 240 * MiB;
constexpr size_t OFF_POOLED = OFF_R1, OFF_SG = OFF_R1 + 96 * MiB, OFF_XN2 = OFF_Z, OFF_GATES = OFF_Z + 192 * MiB, OFF_MERGED = OFF_Z + 576 * MiB;
constexpr size_t OFF_X1B = OFF_R1, OFF_X1 = OFF_Z, OFF_HLO = OFF_Z + 384 * MiB;
constexpr size_t U_BYTES = (size_t)T_TOK * 1024 * 2;

struct Params {
    const float *x_prompt, *x_sample, *g_mix, *w_in, *b_gate, *mu_prev, *mu_next, *pool_w, *pool_scale, *w_pool_br, *k_k, *k_a, *r_k,
        *w0_f, *w_up_f, *a0_f, *a_up_f, *w0_b, *w_up_b, *a0_b, *a_up_b, *g_up, *ln_w, *ln_b, *w_rwkv_br, *w_out, *g_ffn, *w_ff1, *w_ff2, *g_final;
    float* out; unsigned char* ws;
};

__device__ __forceinline__ float bf_lo(unsigned w) { return __uint_as_float(w << 16); }
__device__ __forceinline__ float bf_hi(unsigned w) { return __uint_as_float(w & 0xFFFF0000u); }
__device__ __forceinline__ unsigned pk_bf16(float lo, float hi) { unsigned r; asm("v_cvt_pk_bf16_f32 %0, %1, %2" : "=v"(r) : "v"(lo), "v"(hi)); return r; }
__device__ __forceinline__ float sigmoidf_(float x) { return 1.0f / (1.0f + __expf(-x)); }
template <int CTRL> __device__ __forceinline__ float dppf(float x) { return __int_as_float(__builtin_amdgcn_update_dpp(0, __float_as_int(x), CTRL, 0xF, 0xF, true)); }
__device__ __forceinline__ float red4(float x) { x += dppf<0xB1>(x); x += dppf<0x4E>(x); return x; }
__device__ __forceinline__ float red8(float x) { x = red4(x); x += dppf<0x141>(x); return x; }
__device__ __forceinline__ float red16(float x) { x = red8(x); x += dppf<0x140>(x); return x; }
__device__ __forceinline__ int opaque_tid() { int t = threadIdx.x; asm volatile("" : "+v"(t)); return t; }
__device__ __forceinline__ const float* xrow(const Params& p, int t) { return t < TP ? p.x_prompt + (size_t)t * DM : p.x_sample + (size_t)(t - TP) * DM; }
__device__ __forceinline__ void seq_of(int t, int& base, int& len) { if (t < TP) { base = t & ~2047; len = 2048; } else { base = TP + ((t - TP) & ~16383); len = 16384; } }

namespace pg8 {
constexpr int BM = 256, BK = 64, HALF = 128, HTB = HALF * BK * 2, STAGE_BYTES = 8 * HTB, NXCD = 8, WGM = 8;
__device__ __forceinline__ int lds_byte(int r, int c) { const int st = (r >> 4) * 2 + (c >> 5), rr = r & 15, cc = c & 31, ob = rr * 64 + cc * 2; return st * 1024 + (ob ^ (((ob >> 9) & 1) << 5)); }
__device__ __forceinline__ void stage_rc(int b, int& R, int& C) { const int st = b / 1024, sb = b % 1024, swz = sb ^ (((sb >> 9) & 1) << 5); R = (st >> 1) * 16 + swz / 64; C = (st & 1) * 32 + (swz % 64) / 2; }
__device__ __forceinline__ int perm32(int rho) { const int n = rho >> 4, i = rho & 15; return 8 * (i >> 2) + 4 * n + (i & 3); }
struct Unit { int pm, pn; };
struct Gemm { const bf16_t* A; const bf16_t* Bt; int M, N, K, lda, ldb; };
struct StaticOrder {
    int nM, nN, nwg, G, c;
    __device__ void init(int M, int N, int G_, int c_) { nM = M / BM; nN = N / BM; nwg = nM * nN; G = G_; c = c_; }
    __device__ bool next(int i, Unit& u) const {
        const long L = (long)i * G + c; if (L >= nwg) return false;
        int wgid = (int)L; { const int q = nwg / NXCD, r = nwg % NXCD, xcd = wgid % NXCD, off = wgid / NXCD; wgid = (xcd < r ? xcd * (q + 1) : r * (q + 1) + (xcd - r) * q) + off; }
        const int nig = WGM * nN, gid = wgid / nig, fm = gid * WGM, gsz = (nM - fm) < WGM ? (nM - fm) : WGM;
        u.pm = fm + ((wgid % nig) % gsz); u.pn = (wgid % nig) / gsz; return true;
    }
};

template <class Epi>
__device__ __forceinline__ void gemm_phase(LAS unsigned char* lds, const Gemm g, const StaticOrder& S, const Epi& E) {
    const int tid = opaque_tid();
    const int wid = __builtin_amdgcn_readfirstlane(tid >> 6), lane = tid & 63, wr = wid >> 2, wc = wid & 3, fr = lane & 15, fq = lane >> 4;
    const int K = g.K, nt = K / BK;
    unsigned voffA[2], voffB[2];
#pragma unroll
    for (int i = 0; i < 2; ++i) { int R, C; stage_rc(tid * 16 + i * 8192, R, C); const int Rb = (R & ~31) + perm32(R & 31);
        voffA[i] = (unsigned)(R * g.lda + C) * 2u; voffB[i] = (unsigned)(Rb * g.ldb + C) * 2u; }
    const size_t kstep = (size_t)(BK * 2);
    const size_t hstepA = (size_t)HALF * g.lda * 2, hstepB = (size_t)HALF * g.ldb * 2;
    const size_t tstepA = 2 * hstepA, tstepB = 2 * hstepB;
    const unsigned ldsw = (unsigned)wid * 1024u;
    const int aoff = lds_byte(wr * 64 + fr, fq * 8), boff = lds_byte(wc * 32 + fr, fq * 8);
#define PG8_SA(b, h) (((b) * 2 + (h)) * HTB)
#define PG8_SB(b, h) ((4 + (b) * 2 + (h)) * HTB)
#define PG8_STAGE(bufoff, gbase, voff) do { _Pragma("unroll") for (int _i = 0; _i < 2; ++_i) \
        __builtin_amdgcn_global_load_lds((const unsigned*)((const char*)(gbase) + (voff)[_i]), (LAS unsigned*)(lds + (bufoff) + ldsw + _i * 8192), 16, 0, 0); } while (0)
#define PG8_LDA(dst, b, h) do { _Pragma("unroll") for (int m = 0; m < 4; ++m) _Pragma("unroll") for (int k = 0; k < 2; ++k) dst[m][k] = *(const LAS bf16x8*)(lds + PG8_SA(b, h) + aoff + m * 2048 + k * 1024); } while (0)
#define PG8_LDB(dst, b, h) do { _Pragma("unroll") for (int n = 0; n < 2; ++n) _Pragma("unroll") for (int k = 0; k < 2; ++k) dst[n][k] = *(const LAS bf16x8*)(lds + PG8_SB(b, h) + boff + n * 2048 + k * 1024); } while (0)
#define PG8_MMA(ai, bj, At, Bt) do { __builtin_amdgcn_s_setprio(1); _Pragma("unroll") for (int m = 0; m < 4; ++m) _Pragma("unroll") for (int n = 0; n < 2; ++n) _Pragma("unroll") for (int k = 0; k < 2; ++k) \
        acc[ai][bj][m][n] = __builtin_amdgcn_mfma_f32_16x16x32_bf16(Bt[n][k], At[m][k], acc[ai][bj][m][n], 0, 0, 0); __builtin_amdgcn_s_setprio(0); } while (0)
#define PG8_WAIT_V(n) asm volatile("s_waitcnt vmcnt(" #n ")" ::: "memory")
#define PG8_WAIT_L(n) asm volatile("s_waitcnt lgkmcnt(" #n ")" ::: "memory")
#define PG8_BAR __builtin_amdgcn_s_barrier()
#define PG8_SCHED __builtin_amdgcn_sched_barrier(0)
    Unit cur, nxt; int ui = 0;
    if (!S.next(0, cur)) return;
    f32x4 acc[2][2][4][2];
#pragma unroll
    for (int a = 0; a < 2; ++a)
#pragma unroll
        for (int b = 0; b < 2; ++b)
#pragma unroll
            for (int m = 0; m < 4; ++m)
#pragma unroll
                for (int n = 0; n < 2; ++n) acc[a][b][m][n] = (f32x4){0.f, 0.f, 0.f, 0.f};
    bf16x8 At[4][2], B0[2][2], B1[2][2];
    const char* cA = (const char*)g.A + (size_t)cur.pm * tstepA; const char* cB = (const char*)g.Bt + (size_t)cur.pn * tstepB;
    PG8_STAGE(PG8_SB(0, 0), cB, voffB); PG8_STAGE(PG8_SA(0, 0), cA, voffA); PG8_STAGE(PG8_SB(0, 1), cB + hstepB, voffB); PG8_STAGE(PG8_SA(0, 1), cA + hstepA, voffA);
    if (wr == 1) PG8_BAR;
    PG8_WAIT_V(4); PG8_BAR;
    PG8_STAGE(PG8_SB(1, 0), cB + kstep, voffB); PG8_STAGE(PG8_SA(1, 0), cA + kstep, voffA); PG8_STAGE(PG8_SB(1, 1), cB + hstepB + kstep, voffB);
    PG8_WAIT_V(6); PG8_BAR;
    for (;;) {
        const bool has_next = S.next(ui + 1, nxt);
        const char* nA = has_next ? (const char*)g.A + (size_t)nxt.pm * tstepA : cA; const char* nB = has_next ? (const char*)g.Bt + (size_t)nxt.pn * tstepB : cB;
#pragma unroll 1
        for (int t = 0; t < nt; t += 2) {
            const bool last = (t == nt - 2);
            const char* a1 = cA + (size_t)(t + 1) * kstep;
            const char* a2 = last ? nA : cA + (size_t)(t + 2) * kstep; const char* b2 = last ? nB : cB + (size_t)(t + 2) * kstep;
            const char* a3 = a2 + kstep; const char* b3 = b2 + kstep;
            PG8_LDB(B0, 0, 0); PG8_SCHED; PG8_LDA(At, 0, 0); PG8_STAGE(PG8_SA(1, 1), a1 + hstepA, voffA);
            PG8_WAIT_L(8); PG8_BAR; PG8_WAIT_L(0); PG8_MMA(0, 0, At, B0); PG8_BAR; PG8_SCHED;
            PG8_LDB(B1, 0, 1); PG8_STAGE(PG8_SB(0, 0), b2, voffB);
            PG8_BAR; PG8_WAIT_L(0); PG8_MMA(0, 1, At, B1); PG8_BAR;
            PG8_LDA(At, 0, 1); PG8_STAGE(PG8_SA(0, 0), a2, voffA);
            PG8_BAR; PG8_WAIT_L(0); PG8_MMA(1, 0, At, B0); PG8_BAR; PG8_SCHED;
            PG8_STAGE(PG8_SB(0, 1), b2 + hstepB, voffB);
            PG8_WAIT_V(6); PG8_BAR; PG8_MMA(1, 1, At, B1); PG8_BAR;
            PG8_LDB(B0, 1, 0); PG8_SCHED; PG8_LDA(At, 1, 0); PG8_STAGE(PG8_SA(0, 1), a2 + hstepA, voffA);
            PG8_WAIT_L(8); PG8_BAR; PG8_WAIT_L(0); PG8_MMA(0, 0, At, B0); PG8_BAR; PG8_SCHED;
            PG8_LDB(B1, 1, 1); PG8_STAGE(PG8_SB(1, 0), b3, voffB);
            PG8_BAR; PG8_WAIT_L(0); PG8_MMA(0, 1, At, B1); PG8_BAR;
            PG8_LDA(At, 1, 1); PG8_STAGE(PG8_SA(1, 0), a3, voffA);
            PG8_BAR; PG8_WAIT_L(0); PG8_MMA(1, 0, At, B0); PG8_BAR; PG8_SCHED;
            PG8_STAGE(PG8_SB(1, 1), b3 + hstepB, voffB);
            PG8_WAIT_V(6); PG8_BAR; PG8_MMA(1, 1, At, B1); PG8_BAR;
        }
        E(acc, cur, wr, wc, fr, fq);
        if (!has_next) break;
#pragma unroll
        for (int a = 0; a < 2; ++a)
#pragma unroll
            for (int b = 0; b < 2; ++b)
#pragma unroll
                for (int m = 0; m < 4; ++m)
#pragma unroll
                    for (int n = 0; n < 2; ++n) acc[a][b][m][n] = (f32x4){0.f, 0.f, 0.f, 0.f};
        cur = nxt; cA = nA; cB = nB; ++ui;
    }
    PG8_WAIT_V(0);
    if (wr == 0) PG8_BAR;
    PG8_BAR;
#undef PG8_SA
#undef PG8_SB
#undef PG8_STAGE
#undef PG8_LDA
#undef PG8_LDB
#undef PG8_MMA
#undef PG8_WAIT_V
#undef PG8_WAIT_L
#undef PG8_BAR
#undef PG8_SCHED
}
}
using pg8::Unit;

#define EPI_LOOP_BEGIN const int row0 = u.pm * 256 + wr * 64 + fr, col0 = u.pn * 256 + wc * 32 + 8 * fq; \
    _Pragma("unroll") for (int ai = 0; ai < 2; ++ai) _Pragma("unroll") for (int m = 0; m < 4; ++m) { const int row = row0 + ai * 128 + m * 16;
#define EPI_BJ _Pragma("unroll") for (int bj = 0; bj < 2; ++bj) { const int col = col0 + bj * 128; const f32x4 v0 = acc[ai][bj][m][0], v1 = acc[ai][bj][m][1];
#define EPI_ACC const f32x4 (&acc)[2][2][4][2], const Unit& u, int wr, int wc, int fr, int fq

__device__ __forceinline__ u32x4 pack8(const f32x4 a, const f32x4 b) { u32x4 w; w.x = pk_bf16(a[0], a[1]); w.y = pk_bf16(a[2], a[3]); w.z = pk_bf16(b[0], b[1]); w.w = pk_bf16(b[2], b[3]); return w; }
__device__ __forceinline__ void unpack8(const u32x4 w, f32x4& a, f32x4& b) { a = (f32x4){bf_lo(w.x), bf_hi(w.x), bf_lo(w.y), bf_hi(w.y)}; b = (f32x4){bf_lo(w.z), bf_hi(w.z), bf_lo(w.w), bf_hi(w.w)}; }

struct EpiStore {
    bf16_t* O; int ldc;
    __device__ __forceinline__ void operator()(EPI_ACC) const { EPI_LOOP_BEGIN EPI_BJ *(u32x4*)(O + (size_t)row * ldc + col) = pack8(v0, v1); } } }
};
struct EpiMulInPlace {
    bf16_t* Y;
    __device__ __forceinline__ void operator()(EPI_ACC) const { EPI_LOOP_BEGIN if ((m & 1) == 0) __builtin_amdgcn_sched_barrier(0);
        EPI_BJ u32x4* ptr = (u32x4*)(Y + (size_t)row * 1024 + col); f32x4 a, b; unpack8(*ptr, a, b); *ptr = pack8(a * v0, b * v1); } } }
};
struct EpiGates {
    bf16_t* G; const float* bias;
    __device__ __forceinline__ void operator()(EPI_ACC) const { EPI_LOOP_BEGIN EPI_BJ
        const f32x4 b0 = *(const f32x4*)(bias + col), b1 = *(const f32x4*)(bias + col + 4); f32x4 a, b;
#pragma unroll
        for (int j = 0; j < 4; ++j) { a[j] = sigmoidf_(v0[j] + b0[j]); b[j] = sigmoidf_(v1[j] + b1[j]); }
        *(u32x4*)(G + (size_t)row * 2048 + col) = pack8(a, b); } } }
};
struct EpiPool {
    bf16_t* P; const bf16_t* G;
    __device__ __forceinline__ void operator()(EPI_ACC) const { EPI_LOOP_BEGIN EPI_BJ f32x4 a, b; unpack8(*(const u32x4*)(G + (size_t)row * 2048 + col), a, b);
        *(u32x4*)(P + (size_t)row * 1024 + col) = pack8(a * v0, b * v1); } } }
};
struct EpiMerge {
    bf16_t* P; const bf16_t* G;
    __device__ __forceinline__ void operator()(EPI_ACC) const { EPI_LOOP_BEGIN EPI_BJ f32x4 a, b, pa, pb; unpack8(*(const u32x4*)(G + (size_t)row * 2048 + 1024 + col), a, b);
        u32x4* ptr = (u32x4*)(P + (size_t)row * 1024 + col); unpack8(*ptr, pa, pb); *ptr = pack8(pa + a * v0, pb + b * v1); } } }
};
struct EpiOut {
    const float* xp; const float* xs; float* X1; bf16_t* X1B; float* rowsq;
    __device__ __forceinline__ void operator()(EPI_ACC) const { EPI_LOOP_BEGIN const float* xr = row < TP ? xp + (size_t)row * DM : xs + (size_t)(row - TP) * DM; float ss = 0.f; EPI_BJ
        f32x4 a = *(const f32x4*)(xr + col) + v0, b = *(const f32x4*)(xr + col + 4) + v1;
        *(f32x4*)(X1 + (size_t)row * 1024 + col) = a; *(f32x4*)(X1 + (size_t)row * 1024 + col + 4) = b; *(u32x4*)(X1B + (size_t)row * 1024 + col) = pack8(a, b);
#pragma unroll
        for (int j = 0; j < 4; ++j) ss += a[j] * a[j] + b[j] * b[j]; }
        ss += __shfl_xor(ss, 16); ss += __shfl_xor(ss, 32); if (fq == 0) atomicAdd(rowsq + row, ss); } }
};
struct EpiFF1 {
    bf16_t* Hlo; bf16_t* Hhi; const float* rowsq;
    __device__ __forceinline__ void operator()(EPI_ACC) const { bf16_t* H = u.pn < 8 ? Hlo : Hhi; const int cshift = u.pn < 8 ? 0 : 2048;
        EPI_LOOP_BEGIN const float rinv = rsqrtf(rowsq[row] * (1.0f / 1024.0f) + 1e-6f); EPI_BJ f32x4 a, b;
#pragma unroll
        for (int j = 0; j < 4; ++j) { float t0 = fmaxf(v0[j] * rinv, 0.f), t1 = fmaxf(v1[j] * rinv, 0.f); a[j] = t0 * t0; b[j] = t1 * t1; }
        *(u32x4*)(H + (size_t)row * 2048 + (col - cshift)) = pack8(a, b); } } }
};
struct EpiAddInPlace {
    float* X;
    __device__ __forceinline__ void operator()(EPI_ACC) const { EPI_LOOP_BEGIN EPI_BJ f32x4* ptr = (f32x4*)(X + (size_t)row * 1024 + col); ptr[0] = ptr[0] + v0; ptr[1] = ptr[1] + v1; } } }
};
struct EpiFinal {
    float* X; float* rowsq;
    __device__ __forceinline__ void operator()(EPI_ACC) const { EPI_LOOP_BEGIN float ss = 0.f; EPI_BJ f32x4* ptr = (f32x4*)(X + (size_t)row * 1024 + col); const f32x4 a = ptr[0] + v0, b = ptr[1] + v1; ptr[0] = a; ptr[1] = b;
#pragma unroll
        for (int j = 0; j < 4; ++j) ss += a[j] * a[j] + b[j] * b[j]; }
        ss += __shfl_xor(ss, 16); ss += __shfl_xor(ss, 32); if (fq == 0) atomicAdd(rowsq + row, ss); } }
};

template <class Epi>
__device__ __forceinline__ void run_gemm(unsigned char* shm, const bf16_t* A, int lda, const bf16_t* Bt, int ldb, int N, int K, const Epi& E) {
    pg8::Gemm g; g.A = A; g.Bt = Bt; g.M = T_TOK; g.N = N; g.K = K; g.lda = lda; g.ldb = ldb;
    pg8::StaticOrder S; S.init(T_TOK, N, (int)gridDim.x, (int)blockIdx.x);
    pg8::gemm_phase<Epi>((LAS unsigned char*)shm, g, S, E);
}

__device__ void transpose_cvt(unsigned char* shm, const float* src, int K, int N, bf16_t* dst, int ldd, const float* kscale) {
    float* tile = (float*)shm;
    const int tid = opaque_tid(), ntk = K / 64, ntn = N / 64;
    for (int t = blockIdx.x; t < ntk * ntn; t += gridDim.x) {
        const int tk = t / ntn, tn = t % ntn;
#pragma unroll
        for (int i = 0; i < 8; ++i) { const int kl = (tid >> 6) + 8 * i, nl = tid & 63; const int k = tk * 64 + kl;
            tile[kl * 65 + nl] = src[(size_t)k * N + tn * 64 + nl] * (kscale ? kscale[k] : 1.0f); }
        __syncthreads();
#pragma unroll
        for (int i = 0; i < 8; ++i) { const int nl = (tid >> 6) + 8 * i, kl = tid & 63;
            const unsigned w = pk_bf16(tile[kl * 65 + nl], 0.f); dst[(size_t)(tn * 64 + nl) * ldd + tk * 64 + kl] = (bf16_t)(w & 0xFFFFu); }
        __syncthreads();
    }
}

__device__ void rmsnorm_rows(const Params& p, const float* g, bf16_t* dst) {
    const int tidx = opaque_tid(); const int lane = tidx & 63, wave = (blockIdx.x * 512 + tidx) >> 6, nw = (gridDim.x * 512) >> 6;
    f32x4 gv[4];
#pragma unroll
    for (int i = 0; i < 4; ++i) gv[i] = *(const f32x4*)(g + lane * 4 + 256 * i);
    for (int t = wave; t < T_TOK; t += nw) {
        const float* xr = xrow(p, t); f32x4 v[4]; float ss = 0.f;
#pragma unroll
        for (int i = 0; i < 4; ++i) { v[i] = *(const f32x4*)(xr + lane * 4 + 256 * i); ss += v[i][0] * v[i][0] + v[i][1] * v[i][1] + v[i][2] * v[i][2] + v[i][3] * v[i][3]; }
#pragma unroll
        for (int o = 1; o < 64; o <<= 1) ss += __shfl_xor(ss, o);
        const float rinv = rsqrtf(ss * (1.0f / 1024.0f) + 1e-6f);
#pragma unroll
        for (int i = 0; i < 4; ++i) { u32x2 w; w.x = pk_bf16(v[i][0] * rinv * gv[i][0], v[i][1] * rinv * gv[i][1]); w.y = pk_bf16(v[i][2] * rinv * gv[i][2], v[i][3] * rinv * gv[i][3]);
            *(u32x2*)(dst + (size_t)t * 1024 + lane * 4 + 256 * i) = w; }
    }
}

__device__ void prep_phase(const Params& p, unsigned char* shm) {
    unsigned char* ws = p.ws;
    const int gtid = blockIdx.x * 512 + opaque_tid(), gn = gridDim.x * 512;
    for (int i = gtid; i < T_TOK; i += gn) { ((float*)(ws + OFF_ROWSQ))[i] = 0.f; ((float*)(ws + OFF_ROWSQ2))[i] = 0.f; }
    if (gtid < 64) ((unsigned*)(ws + OFF_QUEUE))[gtid] = 0u;
    transpose_cvt(shm, p.w_in, 1024, 5888, (bf16_t*)(ws + OFF_WIN), 1024, nullptr);
    transpose_cvt(shm, p.w_rwkv_br, 1024, 1024, (bf16_t*)(ws + OFF_WRBR), 1024, nullptr);
    transpose_cvt(shm, p.w_out, 1024, 1024, (bf16_t*)(ws + OFF_WOUT), 1024, nullptr);
    transpose_cvt(shm, p.w_ff1, 1024, 4096, (bf16_t*)(ws + OFF_WFF1), 1024, p.g_ffn);
    transpose_cvt(shm, p.w_ff2, 4096, 1024, (bf16_t*)(ws + OFF_WFF2), 4096, nullptr);
    transpose_cvt(shm, p.g_up, 128, 1024, (bf16_t*)(ws + OFF_WG), 256, nullptr);
    { bf16_t* wg = (bf16_t*)(ws + OFF_WG); for (int i = gtid; i < 1024 * 128; i += gn) wg[(size_t)(i >> 7) * 256 + 128 + (i & 127)] = 0; }
    { bf16_t* we = (bf16_t*)(ws + OFF_WEFF);
      for (int i = gtid; i < 512 * 1024; i += gn) { const int k = i >> 10, n = i & 1023, gI = k >> 7; const float* pw = p.pool_w + (size_t)k * 128; float acc = 0.f;
          for (int d = 0; d < 128; ++d) acc += pw[d] * p.pool_scale[gI * 128 + d] * p.w_pool_br[(size_t)(gI * 128 + d) * 1024 + n];
          we[(size_t)n * 512 + k] = (bf16_t)(pk_bf16(acc, 0.f) & 0xFFFFu); } }
    rmsnorm_rows(p, p.g_mix, (bf16_t*)(ws + OFF_R1));
}

#define LDS_BAR() do { asm volatile("s_waitcnt lgkmcnt(0)" ::: "memory"); __builtin_amdgcn_s_barrier(); asm volatile("" ::: "memory"); } while (0)
constexpr int N_SAMPLE_ITEMS = 128, N_ITEMS = N_SAMPLE_ITEMS + 1024;

template <int LPR, int DIR>
__device__ __forceinline__ void scan_item(const Params& p, unsigned char* shm, const int tid, const int tbase, const int L, const int h, const int half) {
    constexpr int dir = DIR;
    constexpr int EC = 64 / LPR, RPW = 64 / LPR, NS = EC / 2;
    float* sW = (float*)shm; float* sAV = sW + 2048; float* sBV = sW + 4096; float* sKD = sW + 6144; float* sWR = sW + 8192; float* sR = sW + 10240; float* sV = sW + 12288; float* sY = sW + 14336;
    float* sBK = sW + 16384;
    bf16_t* sTW = (bf16_t*)(sW + 16384 + 64);
    bf16_t* sZA = sTW + 32 * 72;
    const int lane = tid & 63, wv = tid >> 6;
    const bf16_t* zall = (const bf16_t*)(p.ws + OFF_Z);
    const int tokA = tid >> 4, q = tid & 15;
    const int rowS = (LPR == 16 ? half * 32 : 0) + wv * RPW + lane / LPR, gS = lane % LPR;
    const int NC = L / 32;
    bf16_t* ybuf = (bf16_t*)p.out + (dir ? (size_t)T_TOK * 1024 : 0);
    float* bonus = (float*)(p.ws + OFF_BONUS) + (dir ? (size_t)T_TOK * 16 : 0);
    const float* w_up = dir ? p.w_up_b : p.w_up_f; const float* a_up = dir ? p.a_up_b : p.a_up_f;
    const float* w0 = dir ? p.w0_b : p.w0_f; const float* a0 = dir ? p.a0_b : p.a0_f;
    const int mat = wv >> 2, cbk = wv & 3, colB = cbk * 16 + (lane & 15), quad = lane >> 4;
    u32x4* sBF = (u32x4*)(shm + 84 * 1024);
    { const float* up = mat ? a_up : w_up;
#pragma unroll
      for (int kb = 0; kb < 2; ++kb) { float f[8];
#pragma unroll
          for (int j = 0; j < 8; ++j) f[j] = up[(size_t)(kb * 32 + quad * 8 + j) * 1024 + h * 64 + colB];
          u32x4 w; w.x = pk_bf16(f[0], f[1]); w.y = pk_bf16(f[2], f[3]); w.z = pk_bf16(f[4], f[5]); w.w = pk_bf16(f[6], f[7]); sBF[kb * 512 + tid] = w; } }
    const float c0B = (mat ? a0 : w0)[h * 64 + colB];
    const float kaB = p.k_a[h * 64 + colB];
    int colz[5];
    float* sMU = (float*)(shm + 76 * 1024);
#pragma unroll
    for (int gi = 0; gi < 5; ++gi) colz[gi] = (gi == 0 ? COL_R + h * 64 : gi == 1 ? COL_K + h * 64 : gi == 2 ? COL_V + h * 64 : gi == 3 ? COL_W : COL_A) + 4 * q;
    if (tid < 320) { const int gi = tid >> 6, c = tid & 63; const int col = (gi == 0 ? COL_R + h * 64 : gi == 1 ? COL_K + h * 64 : gi == 2 ? COL_V + h * 64 : gi == 3 ? COL_W : COL_A) + c - COL_R;
        sMU[gi * 64 + c] = p.mu_prev[col]; sMU[320 + gi * 64 + c] = p.mu_next[col]; }
    else if (tid < 384) sMU[640 + (tid - 320)] = p.k_k[h * 64 + (tid - 320)];
    else if (tid < 448) sMU[704 + (tid - 384)] = p.r_k[h * 64 + (tid - 384)];
    __syncthreads();
    f32x2 s[NS];
#pragma unroll
    for (int j = 0; j < NS; ++j) s[j] = (f32x2){0.f, 0.f};
    u32x2 zc[5], zp[5], zn[5];
    auto load_chunk = [&](int ci) {
        const int t = tbase + 32 * (dir ? NC - 1 - ci : ci) + tokA; const bool hasPrev = t > tbase, hasNext = t < tbase + L - 1;
        const bf16_t* zr = zall + (size_t)t * ZLD;
#pragma unroll
        for (int gi = 0; gi < 5; ++gi) { zc[gi] = *(const u32x2*)(zr + colz[gi]); zp[gi] = (u32x2){0u, 0u}; zn[gi] = (u32x2){0u, 0u};
            if (hasPrev) zp[gi] = *(const u32x2*)(zr - ZLD + colz[gi]);
            if (hasNext) zn[gi] = *(const u32x2*)(zr + ZLD + colz[gi]); }
    };
    load_chunk(0);
    for (int ci = 0; ci < NC; ++ci) {
        const int t0 = tbase + 32 * (dir ? NC - 1 - ci : ci);
        { float zs[5][4];
#pragma unroll
          for (int gi = 0; gi < 5; ++gi) {
              const float c[4] = {bf_lo(zc[gi].x), bf_hi(zc[gi].x), bf_lo(zc[gi].y), bf_hi(zc[gi].y)}, pv[4] = {bf_lo(zp[gi].x), bf_hi(zp[gi].x), bf_lo(zp[gi].y), bf_hi(zp[gi].y)}, nx[4] = {bf_lo(zn[gi].x), bf_hi(zn[gi].x), bf_lo(zn[gi].y), bf_hi(zn[gi].y)};
              const f32x4 mp = *(const f32x4*)(sMU + gi * 64 + 4 * q), mn = *(const f32x4*)(sMU + 320 + gi * 64 + 4 * q);
#pragma unroll
              for (int j = 0; j < 4; ++j) zs[gi][j] = c[j] + mp[j] * (pv[j] - c[j]) + mn[j] * (nx[j] - c[j]);
          }
          if (ci + 1 < NC) load_chunk(ci + 1);
          *(f32x4*)(sR + tokA * 64 + 4 * q) = (f32x4){zs[0][0], zs[0][1], zs[0][2], zs[0][3]};
          *(f32x4*)(sKD + tokA * 64 + 4 * q) = (f32x4){zs[1][0], zs[1][1], zs[1][2], zs[1][3]};
          *(f32x4*)(sV + tokA * 64 + 4 * q) = (f32x4){zs[2][0], zs[2][1], zs[2][2], zs[2][3]};
          float kk[4], ss = 0.f; const f32x4 kk4c = *(const f32x4*)(sMU + 640 + 4 * q);
#pragma unroll
          for (int j = 0; j < 4; ++j) { kk[j] = zs[1][j] * kk4c[j]; ss += kk[j] * kk[j]; }
          ss = red16(ss);
          const float inv = -1.0f / fmaxf(sqrtf(ss), 1e-12f);
          *(f32x4*)(sAV + tokA * 64 + 4 * q) = (f32x4){kk[0] * inv, kk[1] * inv, kk[2] * inv, kk[3] * inv};
          float tw[4];
#pragma unroll
          for (int j = 0; j < 4; ++j) tw[j] = 1.0f - 2.0f / (1.0f + __expf(2.0f * zs[3][j]));
          u32x2 w; w.x = pk_bf16(tw[0], tw[1]); w.y = pk_bf16(tw[2], tw[3]); *(u32x2*)(sTW + tokA * 72 + 4 * q) = w;
          w.x = pk_bf16(zs[4][0], zs[4][1]); w.y = pk_bf16(zs[4][2], zs[4][3]); *(u32x2*)(sZA + tokA * 72 + 4 * q) = w;
        }
        LDS_BAR();
        { const bf16_t* sX = mat ? sZA : sTW;
#pragma unroll
          for (int rb = 0; rb < 2; ++rb) {
              f32x4 acc = (f32x4){0.f, 0.f, 0.f, 0.f};
#pragma unroll
              for (int kb = 0; kb < 2; ++kb) { const bf16x8 af = *(const bf16x8*)(sX + (rb * 16 + (lane & 15)) * 72 + kb * 32 + quad * 8);
                  acc = __builtin_amdgcn_mfma_f32_16x16x32_bf16(af, __builtin_bit_cast(bf16x8, sBF[kb * 512 + tid]), acc, 0, 0, 0); }
#pragma unroll
              for (int j = 0; j < 4; ++j) { const int idx = (rb * 16 + quad * 4 + j) * 64 + colB; const float pre = c0B + acc[j];
                  if (mat == 0) { const float w = __expf(-0.6065306597f * sigmoidf_(pre)); sW[idx] = w; sWR[idx] = w * sR[idx]; }
                  else { const float a = sigmoidf_(pre); const float k = sKD[idx]; sKD[idx] = k * (1.0f + (a - 1.0f) * kaB); sBV[idx] = -sAV[idx] * a; } }
          } }
        LDS_BAR();
        { const f32x4 r4 = *(const f32x4*)(sR + tokA * 64 + 4 * q), b4 = *(const f32x4*)(sBV + tokA * 64 + 4 * q), k4 = *(const f32x4*)(sKD + tokA * 64 + 4 * q);
          float br = 0.f, kr = 0.f, cb = 0.f; const f32x4 rk4 = *(const f32x4*)(sMU + 704 + 4 * q);
#pragma unroll
          for (int j = 0; j < 4; ++j) { br += b4[j] * r4[j]; kr += k4[j] * r4[j]; cb += r4[j] * k4[j] * rk4[j]; }
          br = red16(br); kr = red16(kr); cb = red16(cb);
          if (q == 0) { sBK[tokA * 2] = br; sBK[tokA * 2 + 1] = kr; if (half == 0) bonus[(size_t)(t0 + tokA) * 16 + h] = cb; } }
        LDS_BAR();
        {
            constexpr int NV = EC / 4;
            struct Ops { f32x4 w[NV], a[NV], b[NV], k[NV], q[NV]; float v; f32x2 bk; };
            auto ld = [&](Ops& o, int i) { const int tk = DIR ? 31 - i : i; const int off = tk * 64 + 4 * gS;
#pragma unroll
                for (int c = 0; c < NV; ++c) { o.w[c] = *(const f32x4*)(sW + off + 32 * c); o.a[c] = *(const f32x4*)(sAV + off + 32 * c); o.b[c] = *(const f32x4*)(sBV + off + 32 * c);
                    o.k[c] = *(const f32x4*)(sKD + off + 32 * c); o.q[c] = *(const f32x4*)(sWR + off + 32 * c); }
                o.v = sV[tk * 64 + rowS]; o.bk = *(const f32x2*)(sBK + tk * 2); };
            auto step = [&](const Ops& cur, int i) {
                f32x2 sa2 = (f32x2){0.f, 0.f}, yp2 = (f32x2){0.f, 0.f};
#pragma unroll
                for (int c = 0; c < NV; ++c) {
                    sa2 = __builtin_elementwise_fma(s[2 * c], (f32x2){cur.a[c][0], cur.a[c][1]}, sa2); sa2 = __builtin_elementwise_fma(s[2 * c + 1], (f32x2){cur.a[c][2], cur.a[c][3]}, sa2);
                    yp2 = __builtin_elementwise_fma(s[2 * c], (f32x2){cur.q[c][0], cur.q[c][1]}, yp2); yp2 = __builtin_elementwise_fma(s[2 * c + 1], (f32x2){cur.q[c][2], cur.q[c][3]}, yp2); }
                float sa = sa2.x + sa2.y, yp = yp2.x + yp2.y;
                if constexpr (LPR == 8) { sa = red8(sa); yp = red8(yp); } else { sa = red16(sa); yp = red16(yp); }
                const f32x2 vv = (f32x2){cur.v, cur.v}, sasa = (f32x2){sa, sa};
#pragma unroll
                for (int c = 0; c < NV; ++c) {
                    s[2 * c] = __builtin_elementwise_fma(s[2 * c], (f32x2){cur.w[c][0], cur.w[c][1]}, __builtin_elementwise_fma(sasa, (f32x2){cur.b[c][0], cur.b[c][1]}, vv * (f32x2){cur.k[c][0], cur.k[c][1]}));
                    s[2 * c + 1] = __builtin_elementwise_fma(s[2 * c + 1], (f32x2){cur.w[c][2], cur.w[c][3]}, __builtin_elementwise_fma(sasa, (f32x2){cur.b[c][2], cur.b[c][3]}, vv * (f32x2){cur.k[c][2], cur.k[c][3]})); }
                const float y = yp + sa * cur.bk.x + cur.v * cur.bk.y;
                if (gS == 0) sY[(DIR ? 31 - i : i) * 64 + rowS] = y;
            };
            Ops o0, o1; ld(o0, 0);
#pragma unroll 1
            for (int i = 0; i < 32; i += 2) {
                ld(o1, i + 1);
                step(o0, i);
                ld(o0, min(i + 2, 31));
                step(o1, i + 1);
            }
        }
        LDS_BAR();
        if (LPR == 8 || (q >> 3) == half) { const f32x4 y4 = *(const f32x4*)(sY + tokA * 64 + 4 * q); u32x2 w; w.x = pk_bf16(y4[0], y4[1]); w.y = pk_bf16(y4[2], y4[3]);
          *(u32x2*)(ybuf + (size_t)(t0 + tokA) * 1024 + h * 64 + 4 * q) = w; }
    }
}

__device__ void scan_phase(const Params& p, unsigned char* shm) {
    int* sItem = (int*)(shm + 80 * 1024);
    const int tid = opaque_tid();
    unsigned* queue = (unsigned*)(p.ws + OFF_QUEUE);
    for (;;) {
        if (tid == 0) *sItem = (int)atomicAdd(queue, 1u);
        __syncthreads();
        const int item = *sItem;
        __syncthreads();
        if (item >= N_ITEMS) break;
        if (item < N_SAMPLE_ITEMS) {
            const int half = item & 1, j = item >> 1;
            if (j & 1) scan_item<16, 1>(p, shm, tid, TP + (j >> 5) * 16384, 16384, (j >> 1) & 15, half); else scan_item<16, 0>(p, shm, tid, TP + (j >> 5) * 16384, 16384, (j >> 1) & 15, half);
        } else { const int j = item - N_SAMPLE_ITEMS;
            if (j & 1) scan_item<8, 1>(p, shm, tid, (j >> 5) * 2048, 2048, (j >> 1) & 15, 0); else scan_item<8, 0>(p, shm, tid, (j >> 5) * 2048, 2048, (j >> 1) & 15, 0); }
        __syncthreads();
    }
}

__device__ void mix_phase(const Params& p) {
    const int tidx = opaque_tid(); const int lane = tidx & 63, wave = (blockIdx.x * 512 + tidx) >> 6, nw = (gridDim.x * 512) >> 6;
    const bf16_t* zall = (const bf16_t*)(p.ws + OFF_Z);
    bf16_t* yf = (bf16_t*)p.out; const bf16_t* yb = (const bf16_t*)p.out + (size_t)T_TOK * 1024;
    const float* bonus_f = (const float*)(p.ws + OFF_BONUS); const float* bonus_b = bonus_f + (size_t)T_TOK * 16;
    bf16_t* pooled = (bf16_t*)(p.ws + OFF_POOLED); bf16_t* sg = (bf16_t*)(p.ws + OFF_SG);
    const int hL = lane >> 2;
    for (int t = wave; t < T_TOK; t += nw) {
        int tbase, L; seq_of(t, tbase, L); const int pos = t - tbase; const bool hasPrev = pos > 0, hasNext = pos < L - 1;
        const bf16_t* zr = zall + (size_t)t * ZLD;
        { const int c0 = lane * 16; float y[16];
          { const u32x4 a0 = *(const u32x4*)(yf + (size_t)t * 1024 + c0), a1 = *(const u32x4*)(yf + (size_t)t * 1024 + c0 + 8);
            const u32x4 b0 = *(const u32x4*)(yb + (size_t)t * 1024 + c0), b1 = *(const u32x4*)(yb + (size_t)t * 1024 + c0 + 8);
            f32x4 fa, fb, ga, gb; unpack8(a0, fa, fb); unpack8(b0, ga, gb);
#pragma unroll
            for (int j = 0; j < 4; ++j) { y[j] = fa[j] + ga[j]; y[4 + j] = fb[j] + gb[j]; }
            unpack8(a1, fa, fb); unpack8(b1, ga, gb);
#pragma unroll
            for (int j = 0; j < 4; ++j) { y[8 + j] = fa[j] + ga[j]; y[12 + j] = fb[j] + gb[j]; } }
          float sm = 0.f;
#pragma unroll
          for (int j = 0; j < 16; ++j) sm += y[j];
          const float mean = red4(sm) * (1.0f / 64.0f); float vs = 0.f;
#pragma unroll
          for (int j = 0; j < 16; ++j) { const float d = y[j] - mean; vs += d * d; }
          const float rstd = rsqrtf(red4(vs) * (1.0f / 64.0f) + 64e-5f);
          const float bon = bonus_f[(size_t)t * 16 + hL] + bonus_b[(size_t)t * 16 + hL];
          float vv[16];
          { const bf16_t* zc = zr + COL_V + c0;
            u32x4 c_[2], p_[2], n_[2];
#pragma unroll
            for (int i = 0; i < 2; ++i) { c_[i] = *(const u32x4*)(zc + 8 * i); p_[i] = hasPrev ? *(const u32x4*)(zc - ZLD + 8 * i) : (u32x4){0u, 0u, 0u, 0u}; n_[i] = hasNext ? *(const u32x4*)(zc + ZLD + 8 * i) : (u32x4){0u, 0u, 0u, 0u}; }
#pragma unroll
            for (int i = 0; i < 2; ++i) { f32x4 ca, cb, pa, pb, na, nb; unpack8(c_[i], ca, cb); unpack8(p_[i], pa, pb); unpack8(n_[i], na, nb);
                const float* mp = p.mu_prev + (COL_V - COL_R) + c0 + 8 * i; const float* mn = p.mu_next + (COL_V - COL_R) + c0 + 8 * i;
                const f32x4 mp0 = *(const f32x4*)mp, mp1 = *(const f32x4*)(mp + 4), mn0 = *(const f32x4*)mn, mn1 = *(const f32x4*)(mn + 4);
#pragma unroll
                for (int j = 0; j < 4; ++j) { vv[8 * i + j] = ca[j] + mp0[j] * (pa[j] - ca[j]) + mn0[j] * (na[j] - ca[j]); vv[8 * i + 4 + j] = cb[j] + mp1[j] * (pb[j] - cb[j]) + mn1[j] * (nb[j] - cb[j]); } } }
          float o[16];
#pragma unroll
          for (int i = 0; i < 4; ++i) { const f32x4 lw = *(const f32x4*)(p.ln_w + c0 + 4 * i), lb = *(const f32x4*)(p.ln_b + c0 + 4 * i);
#pragma unroll
              for (int j = 0; j < 4; ++j) o[4 * i + j] = (y[4 * i + j] - mean) * rstd * lw[j] + lb[j] + bon * vv[4 * i + j]; }
          u32x4 w0, w1; w0.x = pk_bf16(o[0], o[1]); w0.y = pk_bf16(o[2], o[3]); w0.z = pk_bf16(o[4], o[5]); w0.w = pk_bf16(o[6], o[7]);
          w1.x = pk_bf16(o[8], o[9]); w1.y = pk_bf16(o[10], o[11]); w1.z = pk_bf16(o[12], o[13]); w1.w = pk_bf16(o[14], o[15]);
          *(u32x4*)(yf + (size_t)t * 1024 + c0) = w0; *(u32x4*)(yf + (size_t)t * 1024 + c0 + 8) = w1; }
        { const int c = 2 * lane; const bf16_t* zc = zr + COL_G + c; const unsigned wc_ = *(const unsigned*)zc; const unsigned wp = hasPrev ? *(const unsigned*)(zc - ZLD) : 0u, wn = hasNext ? *(const unsigned*)(zc + ZLD) : 0u;
          const float mp0 = p.mu_prev[COL_G - COL_R + c], mp1 = p.mu_prev[COL_G - COL_R + c + 1], mn0 = p.mu_next[COL_G - COL_R + c], mn1 = p.mu_next[COL_G - COL_R + c + 1];
          const float c0v = bf_lo(wc_), c1v = bf_hi(wc_);
          const float z0 = c0v + mp0 * (bf_lo(wp) - c0v) + mn0 * (bf_lo(wn) - c0v), z1 = c1v + mp1 * (bf_hi(wp) - c1v) + mn1 * (bf_hi(wn) - c1v);
          *(unsigned*)(sg + (size_t)t * 256 + c) = pk_bf16(sigmoidf_(z0), sigmoidf_(z1)); *(unsigned*)(sg + (size_t)t * 256 + 128 + c) = 0u; }
        { const int c = lane * 8, gi = lane >> 4, w = 2 << gi; const int lo = max(pos - (w >> 1), 0), hi = min(pos + (w >> 1) - 1, L - 1);
          float sum[8];
#pragma unroll
          for (int j = 0; j < 8; ++j) sum[j] = 0.f;
          for (int r = lo; r <= hi; ++r) { f32x4 a, b; unpack8(*(const u32x4*)(zall + (size_t)(tbase + r) * ZLD + c), a, b);
#pragma unroll
              for (int j = 0; j < 4; ++j) { sum[j] += a[j]; sum[4 + j] += b[j]; } }
          const float icnt = 1.0f / (float)(hi - lo + 1); f32x4 a, b; unpack8(*(const u32x4*)(zr + c), a, b); f32x4 oa, ob;
#pragma unroll
          for (int j = 0; j < 4; ++j) { oa[j] = sum[j] * icnt - a[j]; ob[j] = sum[4 + j] * icnt - b[j]; }
          *(u32x4*)(pooled + (size_t)t * 512 + c) = pack8(oa, ob); }
    }
}

__device__ void final_phase(const Params& p) {
    const int tidx = opaque_tid(); const int lane = tidx & 63, wave = (blockIdx.x * 512 + tidx) >> 6, nw = (gridDim.x * 512) >> 6;
    const float* x2 = (const float*)(p.ws + OFF_X1); const float* rowsq2 = (const float*)(p.ws + OFF_ROWSQ2);
    f32x4 gv[4];
#pragma unroll
    for (int i = 0; i < 4; ++i) gv[i] = *(const f32x4*)(p.g_final + lane * 4 + 256 * i);
    for (int t = wave; t < T_TOK; t += nw) {
        const float rinv = rsqrtf(rowsq2[t] * (1.0f / 1024.0f) + 1e-6f);
#pragma unroll
        for (int i = 0; i < 4; ++i) { const f32x4 v = *(const f32x4*)(x2 + (size_t)t * 1024 + lane * 4 + 256 * i); *(f32x4*)(p.out + (size_t)t * 1024 + lane * 4 + 256 * i) = v * rinv * gv[i]; }
    }
}

__global__ void __launch_bounds__(512, 2) fwd_megakernel(Params p) {
    extern __shared__ __attribute__((aligned(16))) unsigned char shm[];
    unsigned char* ws = p.ws;
    prep_phase(p, shm);
    cg::this_grid().sync();
    { EpiStore E; E.O = (bf16_t*)(ws + OFF_Z); E.ldc = ZLD; run_gemm(shm, (const bf16_t*)(ws + OFF_R1), 1024, (const bf16_t*)(ws + OFF_WIN), 1024, 3840, 1024, E); }
    cg::this_grid().sync();
    scan_phase(p, shm);
    cg::this_grid().sync();
    mix_phase(p);
    cg::this_grid().sync();
    rmsnorm_rows(p, p.g_mix, (bf16_t*)(ws + OFF_XN2));
    { EpiMulInPlace E; E.Y = (bf16_t*)p.out; run_gemm(shm, (const bf16_t*)(ws + OFF_SG), 256, (const bf16_t*)(ws + OFF_WG), 256, 1024, 256, E); }
    cg::this_grid().sync();
    { EpiGates E; E.G = (bf16_t*)(ws + OFF_GATES); E.bias = p.b_gate; run_gemm(shm, (const bf16_t*)(ws + OFF_XN2), 1024, (const bf16_t*)(ws + OFF_WIN) + (size_t)3840 * 1024, 1024, 2048, 1024, E); }
    cg::this_grid().sync();
    { EpiPool E; E.P = (bf16_t*)(ws + OFF_MERGED); E.G = (const bf16_t*)(ws + OFF_GATES); run_gemm(shm, (const bf16_t*)(ws + OFF_POOLED), 512, (const bf16_t*)(ws + OFF_WEFF), 512, 1024, 512, E); }
    { EpiMerge E; E.P = (bf16_t*)(ws + OFF_MERGED); E.G = (const bf16_t*)(ws + OFF_GATES); run_gemm(shm, (const bf16_t*)p.out, 1024, (const bf16_t*)(ws + OFF_WRBR), 1024, 1024, 1024, E); }
    cg::this_grid().sync();
    { EpiOut E; E.xp = p.x_prompt; E.xs = p.x_sample; E.X1 = (float*)(ws + OFF_X1); E.X1B = (bf16_t*)(ws + OFF_X1B); E.rowsq = (float*)(ws + OFF_ROWSQ); run_gemm(shm, (const bf16_t*)(ws + OFF_MERGED), 1024, (const bf16_t*)(ws + OFF_WOUT), 1024, 1024, 1024, E); }
    cg::this_grid().sync();
    { EpiFF1 E; E.Hlo = (bf16_t*)(ws + OFF_HLO); E.Hhi = (bf16_t*)p.out; E.rowsq = (const float*)(ws + OFF_ROWSQ); run_gemm(shm, (const bf16_t*)(ws + OFF_X1B), 1024, (const bf16_t*)(ws + OFF_WFF1), 1024, 4096, 1024, E); }
    cg::this_grid().sync();
    { EpiAddInPlace E; E.X = (float*)(ws + OFF_X1); run_gemm(shm, (const bf16_t*)(ws + OFF_HLO), 2048, (const bf16_t*)(ws + OFF_WFF2), 4096, 1024, 2048, E); }
    { EpiFinal E; E.X = (float*)(ws + OFF_X1); E.rowsq = (float*)(ws + OFF_ROWSQ2); run_gemm(shm, (const bf16_t*)p.out, 2048, (const bf16_t*)(ws + OFF_WFF2) + 2048, 4096, 1024, 2048, E); }
    cg::this_grid().sync();
    final_phase(p);
}

extern "C" void kernel_launch(void* const* d_in, const int* in_sizes, int n_in, void* d_out, int out_size, void* d_ws, size_t ws_size, hipStream_t stream) {
    constexpr size_t kDynLds = 131072;
    static int grid_blocks = 0;
    if (!grid_blocks) {
        hipFuncSetAttribute((const void*)fwd_megakernel, hipFuncAttributeMaxDynamicSharedMemorySize, (int)kDynLds);
        int dev = 0, cus = 0, per_cu = 0;
        hipGetDevice(&dev);
        hipDeviceGetAttribute(&cus, hipDeviceAttributeMultiprocessorCount, dev);
        hipOccupancyMaxActiveBlocksPerMultiprocessor(&per_cu, fwd_megakernel, 512, kDynLds);
        if (per_cu < 1) per_cu = 1;
        grid_blocks = cus;
    }
    Params p{};
    const float** pf = (const float**)&p;
    for (int i = 0; i < 30; ++i) pf[i] = (const float*)d_in[i];
    p.out = (float*)d_out; p.ws = (unsigned char*)d_ws;
    void* args[] = {&p};
    hipError_t e = hipLaunchCooperativeKernel((const void*)fwd_megakernel, dim3(grid_blocks), dim3(512), args, kDynLds, stream);
    if (e != hipSuccess) fprintf(stderr, "cooperative launch failed: %s (grid %d)\n", hipGetErrorString(e), grid_blocks);
}
```

```cpp
#include <hip/hip_runtime.h>
#include <hip/hip_cooperative_groups.h>
#include <cstdio>
namespace cg = cooperative_groups;

#define LAS __attribute__((address_space(3)))
typedef unsigned short bf16_t;
typedef short bf16x8 __attribute__((ext_vector_type(8)));
typedef float f32x4 __attribute__((ext_vector_type(4)));
typedef float f32x2 __attribute__((ext_vector_type(2)));
typedef unsigned u32x4 __attribute__((ext_vector_type(4)));
typedef unsigned u32x2 __attribute__((ext_vector_type(2)));

constexpr int T_TOK = 98304, DM = 1024, TP = 65536;
constexpr int ZLD = 3840;
constexpr int COL_R = 512, COL_K = 1536, COL_V = 2560, COL_W = 3584, COL_A = 3648, COL_G = 3712;
constexpr size_t MiB = 1ull << 20;
constexpr size_t OFF_WIN = 0, OFF_WEFF = 12 * MiB, OFF_WRBR = 13 * MiB, OFF_WOUT = 15 * MiB, OFF_WFF1 = 17 * MiB, OFF_WFF2 = 25 * MiB, OFF_WG = 33 * MiB;
constexpr size_t OFF_ROWSQ = 34 * MiB, OFF_ROWSQ2 = 34 * MiB + 512 * 1024, OFF_QUEUE = 35 * MiB, OFF_BONUS = 36 * MiB;
constexpr size_t OFF_R1 = 48 * MiB, OFF_Z = 240 * MiB;
constexpr size_t OFF_POOLED = OFF_R1, OFF_SG = OFF_R1 + 96 * MiB, OFF_XN2 = OFF_Z, OFF_GATES = OFF_Z + 192 * MiB, OFF_MERGED = OFF_Z + 576 * MiB;
constexpr size_t OFF_X1B = OFF_R1, OFF_X1 = OFF_Z, OFF_HLO = OFF_Z + 384 * MiB;
constexpr size_t U_BYTES = (size_t)T_TOK * 1024 * 2;

struct Params {
    const float *x_prompt, *x_sample, *g_mix, *w_in, *b_gate, *mu_prev, *mu_next, *pool_w, *pool_scale, *w_pool_br, *k_k, *k_a, *r_k,
        *w0_f, *w_up_f, *a0_f, *a_up_f, *w0_b, *w_up_b, *a0_b, *a_up_b, *g_up, *ln_w, *ln_b, *w_rwkv_br, *w_out, *g_ffn, *w_ff1, *w_ff2, *g_final;
    float* out; unsigned char* ws;
};

__device__ __forceinline__ float bf_lo(unsigned w) { return __uint_as_float(w << 16); }
__device__ __forceinline__ float bf_hi(unsigned w) { return __uint_as_float(w & 0xFFFF0000u); }
typedef __bf16 bf16x2_t __attribute__((ext_vector_type(2)));
__device__ __forceinline__ unsigned pk_bf16(float lo, float hi) { f32x2 v = {lo, hi}; bf16x2_t b = __builtin_convertvector(v, bf16x2_t); return __builtin_bit_cast(unsigned, b); }
__device__ __forceinline__ float sigmoidf_(float x) { return __builtin_amdgcn_rcpf(1.0f + __expf(-x)); }
template <int CTRL> __device__ __forceinline__ float dppf(float x) { return __int_as_float(__builtin_amdgcn_update_dpp(0, __float_as_int(x), CTRL, 0xF, 0xF, true)); }
__device__ __forceinline__ float red4(float x) { x += dppf<0xB1>(x); x += dppf<0x4E>(x); return x; }
__device__ __forceinline__ float red8(float x) { x = red4(x); x += dppf<0x141>(x); return x; }
__device__ __forceinline__ float red16(float x) { x = red8(x); x += dppf<0x140>(x); return x; }
__device__ __forceinline__ int opaque_tid() { int t = threadIdx.x; asm volatile("" : "+v"(t)); return t; }
__device__ __forceinline__ const float* xrow(const Params& p, int t) { return t < TP ? p.x_prompt + (size_t)t * DM : p.x_sample + (size_t)(t - TP) * DM; }
__device__ __forceinline__ void seq_of(int t, int& base, int& len) { if (t < TP) { base = t & ~2047; len = 2048; } else { base = TP + ((t - TP) & ~16383); len = 16384; } }

namespace pg8 {
constexpr int BM = 256, BK = 64, HALF = 128, HTB = HALF * BK * 2, STAGE_BYTES = 8 * HTB, NXCD = 8, WGM = 8;
__device__ __forceinline__ int lds_byte(int r, int c) { const int st = (r >> 4) * 2 + (c >> 5), rr = r & 15, cc = c & 31, ob = rr * 64 + cc * 2; return st * 1024 + (ob ^ (((ob >> 9) & 1) << 5)); }
__device__ __forceinline__ void stage_rc(int b, int& R, int& C) { const int st = b / 1024, sb = b % 1024, swz = sb ^ (((sb >> 9) & 1) << 5); R = (st >> 1) * 16 + swz / 64; C = (st & 1) * 32 + (swz % 64) / 2; }
__device__ __forceinline__ int perm32(int rho) { const int n = rho >> 4, i = rho & 15; return 8 * (i >> 2) + 4 * n + (i & 3); }
struct Unit { int pm, pn; };
struct Gemm { const bf16_t* A; const bf16_t* Bt; int M, N, K, lda, ldb; const bf16_t* A2; int ks; };
struct StaticOrder {
    int nM, nN, nwg, G, c;
    __device__ void init(int M, int N, int G_, int c_) { nM = M / BM; nN = N / BM; nwg = nM * nN; G = G_; c = c_; }
    __device__ bool next(int i, Unit& u) const {
        const long L = (long)i * G + c; if (L >= nwg) return false;
        int wgid = (int)L; { const int q = nwg / NXCD, r = nwg % NXCD, xcd = wgid % NXCD, off = wgid / NXCD; wgid = (xcd < r ? xcd * (q + 1) : r * (q + 1) + (xcd - r) * q) + off; }
        const int nig = WGM * nN, gid = wgid / nig, fm = gid * WGM, gsz = (nM - fm) < WGM ? (nM - fm) : WGM;
        u.pm = fm + ((wgid % nig) % gsz); u.pn = (wgid % nig) / gsz; return true;
    }
};

template <class Epi>
__device__ __forceinline__ void gemm_phase(LAS unsigned char* lds, const Gemm g, const StaticOrder& S, const Epi& E) {
    const int tid = opaque_tid();
    const int wid = __builtin_amdgcn_readfirstlane(tid >> 6), lane = tid & 63, wr = wid >> 2, wc = wid & 3, fr = lane & 15, fq = lane >> 4;
    const int K = g.K, nt = K / BK;
    unsigned voffA[2], voffB[2];
#pragma unroll
    for (int i = 0; i < 2; ++i) { int R, C; stage_rc(tid * 16 + i * 8192, R, C); const int Rb = (R & ~31) + perm32(R & 31);
        voffA[i] = (unsigned)(R * g.lda + C) * 2u; voffB[i] = (unsigned)(Rb * g.ldb + C) * 2u; }
    const size_t kstep = (size_t)(BK * 2);
    const size_t hstepA = (size_t)HALF * g.lda * 2, hstepB = (size_t)HALF * g.ldb * 2;
    const size_t tstepA = 2 * hstepA, tstepB = 2 * hstepB;
    const unsigned ldsw = (unsigned)wid * 1024u;
    const int aoff = lds_byte(wr * 64 + fr, fq * 8), boff = lds_byte(wc * 32 + fr, fq * 8);
#define PG8_SA(b, h) (((b) * 2 + (h)) * HTB)
#define PG8_SB(b, h) ((4 + (b) * 2 + (h)) * HTB)
#define PG8_STAGE(bufoff, gbase, voff) do { _Pragma("unroll") for (int _i = 0; _i < 2; ++_i) \
        __builtin_amdgcn_global_load_lds((const unsigned*)((const char*)(gbase) + (voff)[_i]), (LAS unsigned*)(lds + (bufoff) + ldsw + _i * 8192), 16, 0, 0); } while (0)
#define PG8_LDA(dst, b, h) do { _Pragma("unroll") for (int m = 0; m < 4; ++m) _Pragma("unroll") for (int k = 0; k < 2; ++k) dst[m][k] = *(const LAS bf16x8*)(lds + PG8_SA(b, h) + aoff + m * 2048 + k * 1024); } while (0)
#define PG8_LDB(dst, b, h) do { _Pragma("unroll") for (int n = 0; n < 2; ++n) _Pragma("unroll") for (int k = 0; k < 2; ++k) dst[n][k] = *(const LAS bf16x8*)(lds + PG8_SB(b, h) + boff + n * 2048 + k * 1024); } while (0)
#define PG8_MMA(ai, bj, At, Bt) do { __builtin_amdgcn_s_setprio(1); _Pragma("unroll") for (int m = 0; m < 4; ++m) _Pragma("unroll") for (int n = 0; n < 2; ++n) _Pragma("unroll") for (int k = 0; k < 2; ++k) \
        acc[ai][bj][m][n] = __builtin_amdgcn_mfma_f32_16x16x32_bf16(Bt[n][k], At[m][k], acc[ai][bj][m][n], 0, 0, 0); __builtin_amdgcn_s_setprio(0); } while (0)
#define PG8_WAIT_V(n) asm volatile("s_waitcnt vmcnt(" #n ")" ::: "memory")
#define PG8_WAIT_L(n) asm volatile("s_waitcnt lgkmcnt(" #n ")" ::: "memory")
#define PG8_BAR __builtin_amdgcn_s_barrier()
#define PG8_SCHED __builtin_amdgcn_sched_barrier(0)
    Unit cur, nxt; int ui = 0;
    if (!S.next(0, cur)) return;
    f32x4 acc[2][2][4][2];
#pragma unroll
    for (int a = 0; a < 2; ++a)
#pragma unroll
        for (int b = 0; b < 2; ++b)
#pragma unroll
            for (int m = 0; m < 4; ++m)
#pragma unroll
                for (int n = 0; n < 2; ++n) acc[a][b][m][n] = (f32x4){0.f, 0.f, 0.f, 0.f};
    bf16x8 At[4][2], B0[2][2], B1[2][2];
    const char* cA = (const char*)g.A + (size_t)cur.pm * tstepA; const char* cB = (const char*)g.Bt + (size_t)cur.pn * tstepB;
    const bool two = g.A2 != nullptr; const int ks = two ? g.ks : (1 << 30);
    const char* cA2 = two ? (const char*)g.A2 + (size_t)cur.pm * tstepA : cA;
    PG8_STAGE(PG8_SB(0, 0), cB, voffB); PG8_STAGE(PG8_SA(0, 0), cA, voffA); PG8_STAGE(PG8_SB(0, 1), cB + hstepB, voffB); PG8_STAGE(PG8_SA(0, 1), cA + hstepA, voffA);
    if (wr == 1) PG8_BAR;
    PG8_WAIT_V(4); PG8_BAR;
    PG8_STAGE(PG8_SB(1, 0), cB + kstep, voffB); PG8_STAGE(PG8_SA(1, 0), cA + kstep, voffA); PG8_STAGE(PG8_SB(1, 1), cB + hstepB + kstep, voffB);
    PG8_WAIT_V(6); PG8_BAR;
    for (;;) {
        const bool has_next = S.next(ui + 1, nxt);
        const char* nA = has_next ? (const char*)g.A + (size_t)nxt.pm * tstepA : cA; const char* nB = has_next ? (const char*)g.Bt + (size_t)nxt.pn * tstepB : cB;
        const char* nA2 = (two && has_next) ? (const char*)g.A2 + (size_t)nxt.pm * tstepA : cA2;
#pragma unroll 1
        for (int t = 0; t < nt; t += 2) {
            const bool last = (t == nt - 2);
            const char* a1 = (t + 1 < ks) ? cA + (size_t)(t + 1) * kstep : cA2 + (size_t)(t + 1 - ks) * kstep;
            const char* a2 = last ? nA : ((t + 2 < ks) ? cA + (size_t)(t + 2) * kstep : cA2 + (size_t)(t + 2 - ks) * kstep); const char* b2 = last ? nB : cB + (size_t)(t + 2) * kstep;
            const char* a3 = a2 + kstep; const char* b3 = b2 + kstep;
            PG8_LDB(B0, 0, 0); PG8_SCHED; PG8_LDA(At, 0, 0); PG8_STAGE(PG8_SA(1, 1), a1 + hstepA, voffA);
            PG8_WAIT_L(8); PG8_BAR; PG8_WAIT_L(0); PG8_MMA(0, 0, At, B0); PG8_BAR; PG8_SCHED;
            PG8_LDB(B1, 0, 1); PG8_STAGE(PG8_SB(0, 0), b2, voffB);
            PG8_BAR; PG8_WAIT_L(0); PG8_MMA(0, 1, At, B1); PG8_BAR;
            PG8_LDA(At, 0, 1); PG8_STAGE(PG8_SA(0, 0), a2, voffA);
            PG8_BAR; PG8_WAIT_L(0); PG8_MMA(1, 0, At, B0); PG8_BAR; PG8_SCHED;
            PG8_STAGE(PG8_SB(0, 1), b2 + hstepB, voffB);
            PG8_WAIT_V(6); PG8_BAR; PG8_MMA(1, 1, At, B1); PG8_BAR;
            PG8_LDB(B0, 1, 0); PG8_SCHED; PG8_LDA(At, 1, 0); PG8_STAGE(PG8_SA(0, 1), a2 + hstepA, voffA);
            PG8_WAIT_L(8); PG8_BAR; PG8_WAIT_L(0); PG8_MMA(0, 0, At, B0); PG8_BAR; PG8_SCHED;
            PG8_LDB(B1, 1, 1); PG8_STAGE(PG8_SB(1, 0), b3, voffB);
            PG8_BAR; PG8_WAIT_L(0); PG8_MMA(0, 1, At, B1); PG8_BAR;
            PG8_LDA(At, 1, 1); PG8_STAGE(PG8_SA(1, 0), a3, voffA);
            PG8_BAR; PG8_WAIT_L(0); PG8_MMA(1, 0, At, B0); PG8_BAR; PG8_SCHED;
            PG8_STAGE(PG8_SB(1, 1), b3 + hstepB, voffB);
            PG8_WAIT_V(6); PG8_BAR; PG8_MMA(1, 1, At, B1); PG8_BAR;
        }
        E(acc, cur, wr, wc, fr, fq);
        if (!has_next) break;
#pragma unroll
        for (int a = 0; a < 2; ++a)
#pragma unroll
            for (int b = 0; b < 2; ++b)
#pragma unroll
                for (int m = 0; m < 4; ++m)
#pragma unroll
                    for (int n = 0; n < 2; ++n) acc[a][b][m][n] = (f32x4){0.f, 0.f, 0.f, 0.f};
        cur = nxt; cA = nA; cA2 = nA2; cB = nB; ++ui;
    }
    PG8_WAIT_V(0);
    if (wr == 0) PG8_BAR;
    PG8_BAR;
#undef PG8_SA
#undef PG8_SB
#undef PG8_STAGE
#undef PG8_LDA
#undef PG8_LDB
#undef PG8_MMA
#undef PG8_WAIT_V
#undef PG8_WAIT_L
#undef PG8_BAR
#undef PG8_SCHED
}
}
using pg8::Unit;

#define EPI_LOOP_BEGIN const int row0 = u.pm * 256 + wr * 64 + fr, col0 = u.pn * 256 + wc * 32 + 8 * fq; \
    _Pragma("unroll") for (int ai = 0; ai < 2; ++ai) _Pragma("unroll") for (int m = 0; m < 4; ++m) { const int row = row0 + ai * 128 + m * 16;
#define EPI_BJ _Pragma("unroll") for (int bj = 0; bj < 2; ++bj) { const int col = col0 + bj * 128; const f32x4 v0 = acc[ai][bj][m][0], v1 = acc[ai][bj][m][1];
#define EPI_ACC const f32x4 (&acc)[2][2][4][2], const Unit& u, int wr, int wc, int fr, int fq

__device__ __forceinline__ u32x4 pack8(const f32x4 a, const f32x4 b) { u32x4 w; w.x = pk_bf16(a[0], a[1]); w.y = pk_bf16(a[2], a[3]); w.z = pk_bf16(b[0], b[1]); w.w = pk_bf16(b[2], b[3]); return w; }
__device__ __forceinline__ void unpack8(const u32x4 w, f32x4& a, f32x4& b) { a = (f32x4){bf_lo(w.x), bf_hi(w.x), bf_lo(w.y), bf_hi(w.y)}; b = (f32x4){bf_lo(w.z), bf_hi(w.z), bf_lo(w.w), bf_hi(w.w)}; }

struct EpiStore {
    bf16_t* O; int ldc;
    __device__ __forceinline__ void operator()(EPI_ACC) const { EPI_LOOP_BEGIN EPI_BJ *(u32x4*)(O + (size_t)row * ldc + col) = pack8(v0, v1); } } }
};
struct EpiMulInPlace {
    bf16_t* Y;
    __device__ __forceinline__ void operator()(EPI_ACC) const { EPI_LOOP_BEGIN if ((m & 1) == 0) __builtin_amdgcn_sched_barrier(0);
        EPI_BJ u32x4* ptr = (u32x4*)(Y + (size_t)row * 1024 + col); f32x4 a, b; unpack8(*ptr, a, b); *ptr = pack8(a * v0, b * v1); } } }
};
struct EpiGates {
    bf16_t* G; const float* bias;
    __device__ __forceinline__ void operator()(EPI_ACC) const { EPI_LOOP_BEGIN EPI_BJ
        const f32x4 b0 = *(const f32x4*)(bias + col), b1 = *(const f32x4*)(bias + col + 4); f32x4 a, b;
#pragma unroll
        for (int j = 0; j < 4; ++j) { a[j] = sigmoidf_(v0[j] + b0[j]); b[j] = sigmoidf_(v1[j] + b1[j]); }
        *(u32x4*)(G + (size_t)row * 2048 + col) = pack8(a, b); } } }
};
struct EpiPool {
    bf16_t* P; const bf16_t* G;
    __device__ __forceinline__ void operator()(EPI_ACC) const { EPI_LOOP_BEGIN EPI_BJ f32x4 a, b; unpack8(*(const u32x4*)(G + (size_t)row * 2048 + col), a, b);
        *(u32x4*)(P + (size_t)row * 1024 + col) = pack8(a * v0, b * v1); } } }
};
struct EpiMerge {
    bf16_t* P; const bf16_t* G;
    __device__ __forceinline__ void operator()(EPI_ACC) const { EPI_LOOP_BEGIN EPI_BJ f32x4 a, b, pa, pb; unpack8(*(const u32x4*)(G + (size_t)row * 2048 + 1024 + col), a, b);
        u32x4* ptr = (u32x4*)(P + (size_t)row * 1024 + col); unpack8(*ptr, pa, pb); *ptr = pack8(pa + a * v0, pb + b * v1); } } }
};
struct EpiOut {
    const float* xp; const float* xs; float* X1; bf16_t* X1B; float* rowsq;
    __device__ __forceinline__ void operator()(EPI_ACC) const { EPI_LOOP_BEGIN const float* xr = row < TP ? xp + (size_t)row * DM : xs + (size_t)(row - TP) * DM; float ss = 0.f; EPI_BJ
        f32x4 a = *(const f32x4*)(xr + col) + v0, b = *(const f32x4*)(xr + col + 4) + v1;
        *(f32x4*)(X1 + (size_t)row * 1024 + col) = a; *(f32x4*)(X1 + (size_t)row * 1024 + col + 4) = b; *(u32x4*)(X1B + (size_t)row * 1024 + col) = pack8(a, b);
#pragma unroll
        for (int j = 0; j < 4; ++j) ss += a[j] * a[j] + b[j] * b[j]; }
        ss += __shfl_xor(ss, 16); ss += __shfl_xor(ss, 32); if (fq == 0) atomicAdd(rowsq + row, ss); } }
};
struct EpiFF1 {
    bf16_t* Hlo; bf16_t* Hhi; const float* rowsq;
    __device__ __forceinline__ void operator()(EPI_ACC) const { bf16_t* H = u.pn < 8 ? Hlo : Hhi; const int cshift = u.pn < 8 ? 0 : 2048;
        EPI_LOOP_BEGIN const float rinv = rsqrtf(rowsq[row] * (1.0f / 1024.0f) + 1e-6f); EPI_BJ f32x4 a, b;
#pragma unroll
        for (int j = 0; j < 4; ++j) { float t0 = fmaxf(v0[j] * rinv, 0.f), t1 = fmaxf(v1[j] * rinv, 0.f); a[j] = t0 * t0; b[j] = t1 * t1; }
        *(u32x4*)(H + (size_t)row * 2048 + (col - cshift)) = pack8(a, b); } } }
};
struct EpiAddInPlace {
    float* X;
    __device__ __forceinline__ void operator()(EPI_ACC) const { EPI_LOOP_BEGIN EPI_BJ f32x4* ptr = (f32x4*)(X + (size_t)row * 1024 + col); ptr[0] = ptr[0] + v0; ptr[1] = ptr[1] + v1; } } }
};
struct EpiFinal {
    float* X; float* rowsq;
    __device__ __forceinline__ void operator()(EPI_ACC) const { EPI_LOOP_BEGIN float ss = 0.f; EPI_BJ f32x4* ptr = (f32x4*)(X + (size_t)row * 1024 + col); const f32x4 a = ptr[0] + v0, b = ptr[1] + v1; ptr[0] = a; ptr[1] = b;
#pragma unroll
        for (int j = 0; j < 4; ++j) ss += a[j] * a[j] + b[j] * b[j]; }
        ss += __shfl_xor(ss, 16); ss += __shfl_xor(ss, 32); if (fq == 0) atomicAdd(rowsq + row, ss); } }
};

template <class Epi>
__device__ __forceinline__ void run_gemm(unsigned char* shm, const bf16_t* A, int lda, const bf16_t* Bt, int ldb, int N, int K, const Epi& E, const bf16_t* A2 = nullptr, int ks = 0) {
    pg8::Gemm g; g.A = A; g.Bt = Bt; g.M = T_TOK; g.N = N; g.K = K; g.lda = lda; g.ldb = ldb; g.A2 = A2; g.ks = ks;
    pg8::StaticOrder S; S.init(T_TOK, N, (int)gridDim.x, (int)blockIdx.x);
    pg8::gemm_phase<Epi>((LAS unsigned char*)shm, g, S, E);
}

__device__ void transpose_cvt(unsigned char* shm, const float* src, int K, int N, bf16_t* dst, int ldd, const float* kscale) {
    float* tile = (float*)shm;
    const int tid = opaque_tid(), ntk = K / 64, ntn = N / 64;
    for (int t = blockIdx.x; t < ntk * ntn; t += gridDim.x) {
        const int tk = t / ntn, tn = t % ntn;
#pragma unroll
        for (int i = 0; i < 8; ++i) { const int kl = (tid >> 6) + 8 * i, nl = tid & 63; const int k = tk * 64 + kl;
            tile[kl * 65 + nl] = src[(size_t)k * N + tn * 64 + nl] * (kscale ? kscale[k] : 1.0f); }
        __syncthreads();
#pragma unroll
        for (int i = 0; i < 8; ++i) { const int nl = (tid >> 6) + 8 * i, kl = tid & 63;
            const unsigned w = pk_bf16(tile[kl * 65 + nl], 0.f); dst[(size_t)(tn * 64 + nl) * ldd + tk * 64 + kl] = (bf16_t)(w & 0xFFFFu); }
        __syncthreads();
    }
}

__device__ void rmsnorm_rows(const Params& p, const float* g, bf16_t* dst) {
    const int tidx = opaque_tid(); const int lane = tidx & 63, wave = (blockIdx.x * 512 + tidx) >> 6, nw = (gridDim.x * 512) >> 6;
    f32x4 gv[4];
#pragma unroll
    for (int i = 0; i < 4; ++i) gv[i] = *(const f32x4*)(g + lane * 4 + 256 * i);
    for (int t = wave; t < T_TOK; t += nw) {
        const float* xr = xrow(p, t); f32x4 v[4]; float ss = 0.f;
#pragma unroll
        for (int i = 0; i < 4; ++i) { v[i] = *(const f32x4*)(xr + lane * 4 + 256 * i); ss += v[i][0] * v[i][0] + v[i][1] * v[i][1] + v[i][2] * v[i][2] + v[i][3] * v[i][3]; }
#pragma unroll
        for (int o = 1; o < 64; o <<= 1) ss += __shfl_xor(ss, o);
        const float rinv = rsqrtf(ss * (1.0f / 1024.0f) + 1e-6f);
#pragma unroll
        for (int i = 0; i < 4; ++i) { u32x2 w; w.x = pk_bf16(v[i][0] * rinv * gv[i][0], v[i][1] * rinv * gv[i][1]); w.y = pk_bf16(v[i][2] * rinv * gv[i][2], v[i][3] * rinv * gv[i][3]);
            *(u32x2*)(dst + (size_t)t * 1024 + lane * 4 + 256 * i) = w; }
    }
}

__device__ void prep_phase(const Params& p, unsigned char* shm) {
    unsigned char* ws = p.ws;
    const int gtid = blockIdx.x * 512 + opaque_tid(), gn = gridDim.x * 512;
    for (int i = gtid; i < T_TOK; i += gn) { ((float*)(ws + OFF_ROWSQ))[i] = 0.f; ((float*)(ws + OFF_ROWSQ2))[i] = 0.f; }
    if (gtid < 64) ((unsigned*)(ws + OFF_QUEUE))[gtid] = 0u;
    transpose_cvt(shm, p.w_in, 1024, 5888, (bf16_t*)(ws + OFF_WIN), 1024, nullptr);
    transpose_cvt(shm, p.w_rwkv_br, 1024, 1024, (bf16_t*)(ws + OFF_WRBR), 1024, nullptr);
    transpose_cvt(shm, p.w_out, 1024, 1024, (bf16_t*)(ws + OFF_WOUT), 1024, nullptr);
    transpose_cvt(shm, p.w_ff1, 1024, 4096, (bf16_t*)(ws + OFF_WFF1), 1024, p.g_ffn);
    transpose_cvt(shm, p.w_ff2, 4096, 1024, (bf16_t*)(ws + OFF_WFF2), 4096, nullptr);
    transpose_cvt(shm, p.g_up, 128, 1024, (bf16_t*)(ws + OFF_WG), 256, nullptr);
    { bf16_t* wg = (bf16_t*)(ws + OFF_WG); for (int i = gtid; i < 1024 * 128; i += gn) wg[(size_t)(i >> 7) * 256 + 128 + (i & 127)] = 0; }
    { bf16_t* we = (bf16_t*)(ws + OFF_WEFF);
      for (int i = gtid; i < 512 * 1024; i += gn) { const int k = i >> 10, n = i & 1023, gI = k >> 7; const float* pw = p.pool_w + (size_t)k * 128; float acc = 0.f;
          for (int d = 0; d < 128; ++d) acc += pw[d] * p.pool_scale[gI * 128 + d] * p.w_pool_br[(size_t)(gI * 128 + d) * 1024 + n];
          we[(size_t)n * 512 + k] = (bf16_t)(pk_bf16(acc, 0.f) & 0xFFFFu); } }
    rmsnorm_rows(p, p.g_mix, (bf16_t*)(ws + OFF_R1));
}

#define LDS_BAR() do { asm volatile("s_waitcnt lgkmcnt(0)" ::: "memory"); __builtin_amdgcn_s_barrier(); asm volatile("" ::: "memory"); } while (0)
constexpr int N_SAMPLE_ITEMS = 128, N_ITEMS = N_SAMPLE_ITEMS + 1024;

template <int LPR, int DIR>
__device__ __forceinline__ void scan_item(const Params& p, unsigned char* shm, const int tid, const int tbase, const int L, const int h, const int half) {
    constexpr int dir = DIR;
    constexpr int EC = 64 / LPR, RPW = 2 * (64 / LPR), NS = EC / 2;
    float* sW = (float*)shm; float* sAV = sW + 2048; float* sBV = sW + 4096; float* sKD = sW + 6144; float* sWR = sW + 8192; float* sR = sW + 10240; float* sV = sW + 12288; float* sY = sW + 14336;
    float* sBK = sW + 16384;
    bf16_t* sTW = (bf16_t*)(sW + 16384 + 64);
    bf16_t* sZA = sTW + 32 * 72;
    const int lane = tid & 63, wv = tid >> 6;
    const bf16_t* zall = (const bf16_t*)(p.ws + OFF_Z);
    const int tokA = tid >> 4, q = tid & 15;
    const int rowS = (LPR == 16 ? half * 32 : 0) + (wv & 3) * RPW + 2 * (lane / LPR), gS = lane % LPR;
    const int NC = L / 32;
    bf16_t* ybuf = (bf16_t*)p.out + (dir ? (size_t)T_TOK * 1024 : 0);
    float* bonus = (float*)(p.ws + OFF_BONUS) + (dir ? (size_t)T_TOK * 16 : 0);
    const float* w_up = dir ? p.w_up_b : p.w_up_f; const float* a_up = dir ? p.a_up_b : p.a_up_f;
    const float* w0 = dir ? p.w0_b : p.w0_f; const float* a0 = dir ? p.a0_b : p.a0_f;
    const int mat = wv >> 2, cbk = wv & 3, colB = cbk * 16 + (lane & 15), quad = lane >> 4;
    u32x4* sBF = (u32x4*)(shm + 84 * 1024);
    { const float* up = mat ? a_up : w_up;
#pragma unroll
      for (int kb = 0; kb < 2; ++kb) { float f[8];
#pragma unroll
          for (int j = 0; j < 8; ++j) f[j] = up[(size_t)(kb * 32 + quad * 8 + j) * 1024 + h * 64 + colB];
          u32x4 w; w.x = pk_bf16(f[0], f[1]); w.y = pk_bf16(f[2], f[3]); w.z = pk_bf16(f[4], f[5]); w.w = pk_bf16(f[6], f[7]); sBF[kb * 512 + tid] = w; } }
    const float c0B = (mat ? a0 : w0)[h * 64 + colB];
    const float kaB = p.k_a[h * 64 + colB];
    int colz[5];
    float* sMU = (float*)(shm + 76 * 1024);
#pragma unroll
    for (int gi = 0; gi < 5; ++gi) colz[gi] = (gi == 0 ? COL_R + h * 64 : gi == 1 ? COL_K + h * 64 : gi == 2 ? COL_V + h * 64 : gi == 3 ? COL_W : COL_A) + 4 * q;
    if (tid < 320) { const int gi = tid >> 6, c = tid & 63; const int col = (gi == 0 ? COL_R + h * 64 : gi == 1 ? COL_K + h * 64 : gi == 2 ? COL_V + h * 64 : gi == 3 ? COL_W : COL_A) + c - COL_R;
        sMU[gi * 64 + c] = p.mu_prev[col]; sMU[320 + gi * 64 + c] = p.mu_next[col]; }
    else if (tid < 384) sMU[640 + (tid - 320)] = p.k_k[h * 64 + (tid - 320)];
    else if (tid < 448) sMU[704 + (tid - 384)] = p.r_k[h * 64 + (tid - 384)];
    __syncthreads();
    f32x2 s[2][NS];
#pragma unroll
    for (int j = 0; j < NS; ++j) { s[0][j] = (f32x2){0.f, 0.f}; s[1][j] = (f32x2){0.f, 0.f}; }
    u32x2 zc[5], zp[5], zn[5];
    auto load_chunk = [&](int ci) {
        const int t = tbase + 32 * (dir ? NC - 1 - ci : ci) + tokA; const bool hasPrev = t > tbase, hasNext = t < tbase + L - 1;
        const bf16_t* zr = zall + (size_t)t * ZLD;
#pragma unroll
        for (int gi = 0; gi < 5; ++gi) { zc[gi] = *(const u32x2*)(zr + colz[gi]); zp[gi] = (u32x2){0u, 0u}; zn[gi] = (u32x2){0u, 0u};
            if (hasPrev) zp[gi] = *(const u32x2*)(zr - ZLD + colz[gi]);
            if (hasNext) zn[gi] = *(const u32x2*)(zr + ZLD + colz[gi]); }
    };
    load_chunk(0);
    for (int ci = 0; ci < NC; ++ci) {
        const int t0 = tbase + 32 * (dir ? NC - 1 - ci : ci);
        { float zs[5][4];
#pragma unroll
          for (int gi = 0; gi < 5; ++gi) {
              const float c[4] = {bf_lo(zc[gi].x), bf_hi(zc[gi].x), bf_lo(zc[gi].y), bf_hi(zc[gi].y)}, pv[4] = {bf_lo(zp[gi].x), bf_hi(zp[gi].x), bf_lo(zp[gi].y), bf_hi(zp[gi].y)}, nx[4] = {bf_lo(zn[gi].x), bf_hi(zn[gi].x), bf_lo(zn[gi].y), bf_hi(zn[gi].y)};
              const f32x4 mp = *(const f32x4*)(sMU + gi * 64 + 4 * q), mn = *(const f32x4*)(sMU + 320 + gi * 64 + 4 * q);
#pragma unroll
              for (int j = 0; j < 4; ++j) zs[gi][j] = c[j] + mp[j] * (pv[j] - c[j]) + mn[j] * (nx[j] - c[j]);
          }
          if (ci + 1 < NC) load_chunk(ci + 1);
          *(f32x4*)(sR + tokA * 64 + 4 * q) = (f32x4){zs[0][0], zs[0][1], zs[0][2], zs[0][3]};
          *(f32x4*)(sKD + tokA * 64 + 4 * q) = (f32x4){zs[1][0], zs[1][1], zs[1][2], zs[1][3]};
          *(f32x4*)(sV + tokA * 64 + 4 * q) = (f32x4){zs[2][0], zs[2][1], zs[2][2], zs[2][3]};
          float kk[4], ss = 0.f; const f32x4 kk4c = *(const f32x4*)(sMU + 640 + 4 * q);
#pragma unroll
          for (int j = 0; j < 4; ++j) { kk[j] = zs[1][j] * kk4c[j]; ss += kk[j] * kk[j]; }
          ss = red16(ss);
          const float inv = -1.0f / fmaxf(sqrtf(ss), 1e-12f);
          *(f32x4*)(sAV + tokA * 64 + 4 * q) = (f32x4){kk[0] * inv, kk[1] * inv, kk[2] * inv, kk[3] * inv};
          float tw[4];
#pragma unroll
          for (int j = 0; j < 4; ++j) tw[j] = 1.0f - 2.0f / (1.0f + __expf(2.0f * zs[3][j]));
          u32x2 w; w.x = pk_bf16(tw[0], tw[1]); w.y = pk_bf16(tw[2], tw[3]); *(u32x2*)(sTW + tokA * 72 + 4 * q) = w;
          w.x = pk_bf16(zs[4][0], zs[4][1]); w.y = pk_bf16(zs[4][2], zs[4][3]); *(u32x2*)(sZA + tokA * 72 + 4 * q) = w;
        }
        LDS_BAR();
        { const bf16_t* sX = mat ? sZA : sTW;
#pragma unroll
          for (int rb = 0; rb < 2; ++rb) {
              f32x4 acc = (f32x4){0.f, 0.f, 0.f, 0.f};
#pragma unroll
              for (int kb = 0; kb < 2; ++kb) { const bf16x8 af = *(const bf16x8*)(sX + (rb * 16 + (lane & 15)) * 72 + kb * 32 + quad * 8);
                  acc = __builtin_amdgcn_mfma_f32_16x16x32_bf16(af, __builtin_bit_cast(bf16x8, sBF[kb * 512 + tid]), acc, 0, 0, 0); }
#pragma unroll
              for (int j = 0; j < 4; ++j) { const int idx = (rb * 16 + quad * 4 + j) * 64 + colB; const float pre = c0B + acc[j];
                  if (mat == 0) { const float w = __expf(-0.6065306597f * sigmoidf_(pre)); sW[idx] = w; sWR[idx] = w * sR[idx]; }
                  else { const float a = sigmoidf_(pre); const float k = sKD[idx]; sKD[idx] = k * (1.0f + (a - 1.0f) * kaB); sBV[idx] = -sAV[idx] * a; } }
          } }
        LDS_BAR();
        { const f32x4 r4 = *(const f32x4*)(sR + tokA * 64 + 4 * q), b4 = *(const f32x4*)(sBV + tokA * 64 + 4 * q), k4 = *(const f32x4*)(sKD + tokA * 64 + 4 * q);
          float br = 0.f, kr = 0.f, cb = 0.f; const f32x4 rk4 = *(const f32x4*)(sMU + 704 + 4 * q);
#pragma unroll
          for (int j = 0; j < 4; ++j) { br += b4[j] * r4[j]; kr += k4[j] * r4[j]; cb += r4[j] * k4[j] * rk4[j]; }
          br = red16(br); kr = red16(kr); cb = red16(cb);
          if (q == 0) { sBK[tokA * 2] = br; sBK[tokA * 2 + 1] = kr; if (half == 0) bonus[(size_t)(t0 + tokA) * 16 + h] = cb; } }
        LDS_BAR();
        {
            constexpr int NV = EC / 4;
            struct Ops { f32x4 w[NV], a[NV], b[NV], k[NV], q[NV]; f32x2 v; f32x2 bk; };
            auto ld = [&](Ops& o, int i) { const int tk = DIR ? 31 - i : i; const int off = tk * 64 + 4 * gS;
#pragma unroll
                for (int c = 0; c < NV; ++c) { o.w[c] = *(const f32x4*)(sW + off + 32 * c); o.a[c] = *(const f32x4*)(sAV + off + 32 * c); o.b[c] = *(const f32x4*)(sBV + off + 32 * c);
                    o.k[c] = *(const f32x4*)(sKD + off + 32 * c); o.q[c] = *(const f32x4*)(sWR + off + 32 * c); }
                o.v = *(const f32x2*)(sV + tk * 64 + rowS); o.bk = *(const f32x2*)(sBK + tk * 2); };
            auto step = [&](const Ops& cur, int i) {
                float sa[2], yp[2];
#pragma unroll
                for (int r = 0; r < 2; ++r) {
                    f32x2 sa2 = (f32x2){0.f, 0.f}, yp2 = (f32x2){0.f, 0.f};
#pragma unroll
                    for (int c = 0; c < NV; ++c) {
                        sa2 = __builtin_elementwise_fma(s[r][2 * c], (f32x2){cur.a[c][0], cur.a[c][1]}, sa2); sa2 = __builtin_elementwise_fma(s[r][2 * c + 1], (f32x2){cur.a[c][2], cur.a[c][3]}, sa2);
                        yp2 = __builtin_elementwise_fma(s[r][2 * c], (f32x2){cur.q[c][0], cur.q[c][1]}, yp2); yp2 = __builtin_elementwise_fma(s[r][2 * c + 1], (f32x2){cur.q[c][2], cur.q[c][3]}, yp2); }
                    sa[r] = sa2.x + sa2.y; yp[r] = yp2.x + yp2.y; }
#pragma unroll
                for (int r = 0; r < 2; ++r) { if constexpr (LPR == 8) { sa[r] = red8(sa[r]); yp[r] = red8(yp[r]); } else { sa[r] = red16(sa[r]); yp[r] = red16(yp[r]); } }
                f32x2 y;
#pragma unroll
                for (int r = 0; r < 2; ++r) { const float vr = r ? cur.v.y : cur.v.x;
                    const f32x2 vv = (f32x2){vr, vr}, sasa = (f32x2){sa[r], sa[r]};
#pragma unroll
                    for (int c = 0; c < NV; ++c) {
                        s[r][2 * c] = __builtin_elementwise_fma(s[r][2 * c], (f32x2){cur.w[c][0], cur.w[c][1]}, __builtin_elementwise_fma(sasa, (f32x2){cur.b[c][0], cur.b[c][1]}, vv * (f32x2){cur.k[c][0], cur.k[c][1]}));
                        s[r][2 * c + 1] = __builtin_elementwise_fma(s[r][2 * c + 1], (f32x2){cur.w[c][2], cur.w[c][3]}, __builtin_elementwise_fma(sasa, (f32x2){cur.b[c][2], cur.b[c][3]}, vv * (f32x2){cur.k[c][2], cur.k[c][3]})); }
                    const float yr = yp[r] + sa[r] * cur.bk.x + vr * cur.bk.y; if (r) y.y = yr; else y.x = yr; }
                if (gS == 0) *(f32x2*)(sY + (DIR ? 31 - i : i) * 64 + rowS) = y;
            };
            if (wv < 4) {
                Ops o0, o1; ld(o0, 0);
#pragma unroll 1
                for (int i = 0; i < 32; i += 2) {
                    ld(o1, i + 1);
                    step(o0, i);
                    ld(o0, min(i + 2, 31));
                    step(o1, i + 1);
                }
            }
        }
        LDS_BAR();
        if (LPR == 8 || (q >> 3) == half) { const f32x4 y4 = *(const f32x4*)(sY + tokA * 64 + 4 * q); u32x2 w; w.x = pk_bf16(y4[0], y4[1]); w.y = pk_bf16(y4[2], y4[3]);
          *(u32x2*)(ybuf + (size_t)(t0 + tokA) * 1024 + h * 64 + 4 * q) = w; }
    }
}

__device__ void scan_phase(const Params& p, unsigned char* shm) {
    int* sItem = (int*)(shm + 80 * 1024);
    const int tid = opaque_tid();
    unsigned* queue = (unsigned*)(p.ws + OFF_QUEUE);
    for (;;) {
        if (tid == 0) *sItem = (int)atomicAdd(queue, 1u);
        __syncthreads();
        const int item = *sItem;
        __syncthreads();
        if (item >= N_ITEMS) break;
        int tid2 = tid; asm volatile("" : "+v"(tid2));
        if (item < N_SAMPLE_ITEMS) {
            const int half = item & 1, j = item >> 1;
            if (j & 1) scan_item<16, 1>(p, shm, tid2, TP + (j >> 5) * 16384, 16384, (j >> 1) & 15, half); else scan_item<16, 0>(p, shm, tid2, TP + (j >> 5) * 16384, 16384, (j >> 1) & 15, half);
        } else { const int j = item - N_SAMPLE_ITEMS;
            if (j & 1) scan_item<8, 1>(p, shm, tid2, (j >> 5) * 2048, 2048, (j >> 1) & 15, 0); else scan_item<8, 0>(p, shm, tid2, (j >> 5) * 2048, 2048, (j >> 1) & 15, 0); }
        __syncthreads();
    }
}

__device__ void mix_phase(const Params& p) {
    const int tidx = opaque_tid(); const int lane = tidx & 63, wave = (blockIdx.x * 512 + tidx) >> 6, nw = (gridDim.x * 512) >> 6;
    const bf16_t* zall = (const bf16_t*)(p.ws + OFF_Z);
    bf16_t* yf = (bf16_t*)p.out; const bf16_t* yb = (const bf16_t*)p.out + (size_t)T_TOK * 1024;
    const float* bonus_f = (const float*)(p.ws + OFF_BONUS); const float* bonus_b = bonus_f + (size_t)T_TOK * 16;
    bf16_t* pooled = (bf16_t*)(p.ws + OFF_POOLED); bf16_t* sg = (bf16_t*)(p.ws + OFF_SG);
    const int hL = lane >> 2;
    const int tpw = (T_TOK + nw - 1) / nw;
    for (int t = wave * tpw; t < min(T_TOK, (wave + 1) * tpw); ++t) {
        int tbase, L; seq_of(t, tbase, L); const int pos = t - tbase; const bool hasPrev = pos > 0, hasNext = pos < L - 1;
        const bf16_t* zr = zall + (size_t)t * ZLD;
        { const int c0 = lane * 16; float y[16];
          { const u32x4 a0 = *(const u32x4*)(yf + (size_t)t * 1024 + c0), a1 = *(const u32x4*)(yf + (size_t)t * 1024 + c0 + 8);
            const u32x4 b0 = *(const u32x4*)(yb + (size_t)t * 1024 + c0), b1 = *(const u32x4*)(yb + (size_t)t * 1024 + c0 + 8);
            f32x4 fa, fb, ga, gb; unpack8(a0, fa, fb); unpack8(b0, ga, gb);
#pragma unroll
            for (int j = 0; j < 4; ++j) { y[j] = fa[j] + ga[j]; y[4 + j] = fb[j] + gb[j]; }
            unpack8(a1, fa, fb); unpack8(b1, ga, gb);
#pragma unroll
            for (int j = 0; j < 4; ++j) { y[8 + j] = fa[j] + ga[j]; y[12 + j] = fb[j] + gb[j]; } }
          float sm = 0.f;
#pragma unroll
          for (int j = 0; j < 16; ++j) sm += y[j];
          const float mean = red4(sm) * (1.0f / 64.0f); float vs = 0.f;
#pragma unroll
          for (int j = 0; j < 16; ++j) { const float d = y[j] - mean; vs += d * d; }
          const float rstd = rsqrtf(red4(vs) * (1.0f / 64.0f) + 64e-5f);
          const float bon = bonus_f[(size_t)t * 16 + hL] + bonus_b[(size_t)t * 16 + hL];
          float vv[16];
          { const bf16_t* zc = zr + COL_V + c0;
            u32x4 c_[2], p_[2], n_[2];
#pragma unroll
            for (int i = 0; i < 2; ++i) { c_[i] = *(const u32x4*)(zc + 8 * i); p_[i] = hasPrev ? *(const u32x4*)(zc - ZLD + 8 * i) : (u32x4){0u, 0u, 0u, 0u}; n_[i] = hasNext ? *(const u32x4*)(zc + ZLD + 8 * i) : (u32x4){0u, 0u, 0u, 0u}; }
#pragma unroll
            for (int i = 0; i < 2; ++i) { f32x4 ca, cb, pa, pb, na, nb; unpack8(c_[i], ca, cb); unpack8(p_[i], pa, pb); unpack8(n_[i], na, nb);
                const float* mp = p.mu_prev + (COL_V - COL_R) + c0 + 8 * i; const float* mn = p.mu_next + (COL_V - COL_R) + c0 + 8 * i;
                const f32x4 mp0 = *(const f32x4*)mp, mp1 = *(const f32x4*)(mp + 4), mn0 = *(const f32x4*)mn, mn1 = *(const f32x4*)(mn + 4);
#pragma unroll
                for (int j = 0; j < 4; ++j) { vv[8 * i + j] = ca[j] + mp0[j] * (pa[j] - ca[j]) + mn0[j] * (na[j] - ca[j]); vv[8 * i + 4 + j] = cb[j] + mp1[j] * (pb[j] - cb[j]) + mn1[j] * (nb[j] - cb[j]); } } }
          float o[16];
#pragma unroll
          for (int i = 0; i < 4; ++i) { const f32x4 lw = *(const f32x4*)(p.ln_w + c0 + 4 * i), lb = *(const f32x4*)(p.ln_b + c0 + 4 * i);
#pragma unroll
              for (int j = 0; j < 4; ++j) o[4 * i + j] = (y[4 * i + j] - mean) * rstd * lw[j] + lb[j] + bon * vv[4 * i + j]; }
          u32x4 w0, w1; w0.x = pk_bf16(o[0], o[1]); w0.y = pk_bf16(o[2], o[3]); w0.z = pk_bf16(o[4], o[5]); w0.w = pk_bf16(o[6], o[7]);
          w1.x = pk_bf16(o[8], o[9]); w1.y = pk_bf16(o[10], o[11]); w1.z = pk_bf16(o[12], o[13]); w1.w = pk_bf16(o[14], o[15]);
          *(u32x4*)(yf + (size_t)t * 1024 + c0) = w0; *(u32x4*)(yf + (size_t)t * 1024 + c0 + 8) = w1; }
        { const int c = 2 * lane; const bf16_t* zc = zr + COL_G + c; const unsigned wc_ = *(const unsigned*)zc; const unsigned wp = hasPrev ? *(const unsigned*)(zc - ZLD) : 0u, wn = hasNext ? *(const unsigned*)(zc + ZLD) : 0u;
          const float mp0 = p.mu_prev[COL_G - COL_R + c], mp1 = p.mu_prev[COL_G - COL_R + c + 1], mn0 = p.mu_next[COL_G - COL_R + c], mn1 = p.mu_next[COL_G - COL_R + c + 1];
          const float c0v = bf_lo(wc_), c1v = bf_hi(wc_);
          const float z0 = c0v + mp0 * (bf_lo(wp) - c0v) + mn0 * (bf_lo(wn) - c0v), z1 = c1v + mp1 * (bf_hi(wp) - c1v) + mn1 * (bf_hi(wn) - c1v);
          *(unsigned*)(sg + (size_t)t * 256 + c) = pk_bf16(sigmoidf_(z0), sigmoidf_(z1)); *(unsigned*)(sg + (size_t)t * 256 + 128 + c) = 0u; }
        { const int c = lane * 8, gi = lane >> 4, w = 2 << gi; const int lo = max(pos - (w >> 1), 0), hi = min(pos + (w >> 1) - 1, L - 1);
          float sum[8];
#pragma unroll
          for (int j = 0; j < 8; ++j) sum[j] = 0.f;
          u32x4 wr_[16];
#pragma unroll
          for (int d = 0; d < 16; ++d) { const int r = pos - 8 + d; wr_[d] = (u32x4){0u, 0u, 0u, 0u}; if (r >= lo && r <= hi) wr_[d] = *(const u32x4*)(zall + (size_t)(tbase + r) * ZLD + c); }
#pragma unroll
          for (int d = 0; d < 16; ++d) { f32x4 a, b; unpack8(wr_[d], a, b);
#pragma unroll
              for (int j = 0; j < 4; ++j) { sum[j] += a[j]; sum[4 + j] += b[j]; } }
          const float icnt = 1.0f / (float)(hi - lo + 1); f32x4 a, b; unpack8(*(const u32x4*)(zr + c), a, b); f32x4 oa, ob;
#pragma unroll
          for (int j = 0; j < 4; ++j) { oa[j] = sum[j] * icnt - a[j]; ob[j] = sum[4 + j] * icnt - b[j]; }
          *(u32x4*)(pooled + (size_t)t * 512 + c) = pack8(oa, ob); }
    }
}

__device__ void final_phase(const Params& p) {
    const int tidx = opaque_tid(); const int lane = tidx & 63, wave = (blockIdx.x * 512 + tidx) >> 6, nw = (gridDim.x * 512) >> 6;
    const float* x2 = (const float*)(p.ws + OFF_X1); const float* rowsq2 = (const float*)(p.ws + OFF_ROWSQ2);
    f32x4 gv[4];
#pragma unroll
    for (int i = 0; i < 4; ++i) gv[i] = *(const f32x4*)(p.g_final + lane * 4 + 256 * i);
    for (int t = wave; t < T_TOK; t += nw) {
        const float rinv = rsqrtf(rowsq2[t] * (1.0f / 1024.0f) + 1e-6f);
#pragma unroll
        for (int i = 0; i < 4; ++i) { const f32x4 v = *(const f32x4*)(x2 + (size_t)t * 1024 + lane * 4 + 256 * i); *(f32x4*)(p.out + (size_t)t * 1024 + lane * 4 + 256 * i) = v * rinv * gv[i]; }
    }
}

__global__ void __launch_bounds__(512, 2) fwd_megakernel(Params p) {
    extern __shared__ __attribute__((aligned(16))) unsigned char shm[];
    unsigned char* ws = p.ws;
    prep_phase(p, shm);
    cg::this_grid().sync();
    { EpiStore E; E.O = (bf16_t*)(ws + OFF_Z); E.ldc = ZLD; run_gemm(shm, (const bf16_t*)(ws + OFF_R1), 1024, (const bf16_t*)(ws + OFF_WIN), 1024, 3840, 1024, E); }
    cg::this_grid().sync();
    scan_phase(p, shm);
    cg::this_grid().sync();
    mix_phase(p);
    cg::this_grid().sync();
    rmsnorm_rows(p, p.g_mix, (bf16_t*)(ws + OFF_XN2));
    { EpiMulInPlace E; E.Y = (bf16_t*)p.out; run_gemm(shm, (const bf16_t*)(ws + OFF_SG), 256, (const bf16_t*)(ws + OFF_WG), 256, 1024, 256, E); }
    cg::this_grid().sync();
    { EpiGates E; E.G = (bf16_t*)(ws + OFF_GATES); E.bias = p.b_gate; run_gemm(shm, (const bf16_t*)(ws + OFF_XN2), 1024, (const bf16_t*)(ws + OFF_WIN) + (size_t)3840 * 1024, 1024, 2048, 1024, E); }
    cg::this_grid().sync();
    { EpiPool E; E.P = (bf16_t*)(ws + OFF_MERGED); E.G = (const bf16_t*)(ws + OFF_GATES); run_gemm(shm, (const bf16_t*)(ws + OFF_POOLED), 512, (const bf16_t*)(ws + OFF_WEFF), 512, 1024, 512, E); }
    { EpiMerge E; E.P = (bf16_t*)(ws + OFF_MERGED); E.G = (const bf16_t*)(ws + OFF_GATES); run_gemm(shm, (const bf16_t*)p.out, 1024, (const bf16_t*)(ws + OFF_WRBR), 1024, 1024, 1024, E); }
    cg::this_grid().sync();
    { EpiOut E; E.xp = p.x_prompt; E.xs = p.x_sample; E.X1 = (float*)(ws + OFF_X1); E.X1B = (bf16_t*)(ws + OFF_X1B); E.rowsq = (float*)(ws + OFF_ROWSQ); run_gemm(shm, (const bf16_t*)(ws + OFF_MERGED), 1024, (const bf16_t*)(ws + OFF_WOUT), 1024, 1024, 1024, E); }
    cg::this_grid().sync();
    { EpiFF1 E; E.Hlo = (bf16_t*)(ws + OFF_HLO); E.Hhi = (bf16_t*)p.out; E.rowsq = (const float*)(ws + OFF_ROWSQ); run_gemm(shm, (const bf16_t*)(ws + OFF_X1B), 1024, (const bf16_t*)(ws + OFF_WFF1), 1024, 4096, 1024, E); }
    cg::this_grid().sync();
    { EpiFinal E; E.X = (float*)(ws + OFF_X1); E.rowsq = (float*)(ws + OFF_ROWSQ2);
      run_gemm(shm, (const bf16_t*)(ws + OFF_HLO), 2048, (const bf16_t*)(ws + OFF_WFF2), 4096, 1024, 4096, E, (const bf16_t*)p.out, 32); }
    cg::this_grid().sync();
    final_phase(p);
}

extern "C" void kernel_launch(void* const* d_in, const int* in_sizes, int n_in, void* d_out, int out_size, void* d_ws, size_t ws_size, hipStream_t stream) {
    constexpr size_t kDynLds = 131072;
    static int grid_blocks = 0;
    if (!grid_blocks) {
        hipFuncSetAttribute((const void*)fwd_megakernel, hipFuncAttributeMaxDynamicSharedMemorySize, (int)kDynLds);
        int dev = 0, cus = 0, per_cu = 0;
        hipGetDevice(&dev);
        hipDeviceGetAttribute(&cus, hipDeviceAttributeMultiprocessorCount, dev);
        hipOccupancyMaxActiveBlocksPerMultiprocessor(&per_cu, fwd_megakernel, 512, kDynLds);
        if (per_cu < 1) per_cu = 1;
        grid_blocks = cus;
    }
    Params p{};
    const float** pf = (const float**)&p;
    for (int i = 0; i < 30; ++i) pf[i] = (const float*)d_in[i];
    p.out = (float*)d_out; p.ws = (unsigned char*)d_ws;
    void* args[] = {&p};
    hipError_t e = hipLaunchCooperativeKernel((const void*)fwd_megakernel, dim3(grid_blocks), dim3(512), args, kDynLds, stream);
    if (e != hipSuccess) fprintf(stderr, "cooperative launch failed: %s (grid %d)\n", hipGetErrorString(e), grid_blocks);
}
```

```cpp
#include <hip/hip_runtime.h>
#include <hip/hip_cooperative_groups.h>
#include <cstdio>
namespace cg = cooperative_groups;

#define LAS __attribute__((address_space(3)))
typedef unsigned short bf16_t;
typedef short bf16x8 __attribute__((ext_vector_type(8)));
typedef float f32x4 __attribute__((ext_vector_type(4)));
typedef float f32x2 __attribute__((ext_vector_type(2)));
typedef unsigned u32x4 __attribute__((ext_vector_type(4)));
typedef unsigned u32x2 __attribute__((ext_vector_type(2)));

constexpr int T_TOK = 98304, DM = 1024, TP = 65536;
constexpr int ZLD = 3840;
constexpr int COL_R = 512, COL_K = 1536, COL_V = 2560, COL_W = 3584, COL_A = 3648, COL_G = 3712;
constexpr size_t MiB = 1ull << 20;
constexpr size_t OFF_WIN = 0, OFF_WEFF = 12 * MiB, OFF_WRBR = 13 * MiB, OFF_WOUT = 15 * MiB, OFF_WFF1 = 17 * MiB, OFF_WFF2 = 25 * MiB, OFF_WG = 33 * MiB;
constexpr size_t OFF_ROWSQ = 34 * MiB, OFF_ROWSQ2 = 34 * MiB + 512 * 1024, OFF_QUEUE = 35 * MiB, OFF_BONUS = 36 * MiB;
constexpr size_t OFF_R1 = 48 * MiB, OFF_Z = 240 * MiB;
constexpr size_t OFF_POOLED = OFF_R1, OFF_SG = OFF_R1 + 96 * MiB, OFF_XN2 = OFF_Z, OFF_GATES = OFF_Z + 192 * MiB, OFF_MERGED = OFF_Z + 576 * MiB;
constexpr size_t OFF_X1B = OFF_R1, OFF_X1 = OFF_Z, OFF_HLO = OFF_Z + 384 * MiB;
constexpr size_t U_BYTES = (size_t)T_TOK * 1024 * 2;

struct Params {
    const float *x_prompt, *x_sample, *g_mix, *w_in, *b_gate, *mu_prev, *mu_next, *pool_w, *pool_scale, *w_pool_br, *k_k, *k_a, *r_k,
        *w0_f, *w_up_f, *a0_f, *a_up_f, *w0_b, *w_up_b, *a0_b, *a_up_b, *g_up, *ln_w, *ln_b, *w_rwkv_br, *w_out, *g_ffn, *w_ff1, *w_ff2, *g_final;
    float* out; unsigned char* ws;
};

__device__ __forceinline__ float bf_lo(unsigned w) { return __uint_as_float(w << 16); }
__device__ __forceinline__ float bf_hi(unsigned w) { return __uint_as_float(w & 0xFFFF0000u); }
typedef __bf16 bf16x2_t __attribute__((ext_vector_type(2)));
__device__ __forceinline__ unsigned pk_bf16(float lo, float hi) { f32x2 v = {lo, hi}; bf16x2_t b = __builtin_convertvector(v, bf16x2_t); return __builtin_bit_cast(unsigned, b); }
__device__ __forceinline__ float sigmoidf_(float x) { return __builtin_amdgcn_rcpf(1.0f + __expf(-x)); }
template <int CTRL> __device__ __forceinline__ float dppf(float x) { return __int_as_float(__builtin_amdgcn_update_dpp(0, __float_as_int(x), CTRL, 0xF, 0xF, true)); }
__device__ __forceinline__ float red4(float x) { x += dppf<0xB1>(x); x += dppf<0x4E>(x); return x; }
__device__ __forceinline__ float red8(float x) { x = red4(x); x += dppf<0x141>(x); return x; }
__device__ __forceinline__ float red16(float x) { x = red8(x); x += dppf<0x140>(x); return x; }
__device__ __forceinline__ int opaque_tid() { int t = threadIdx.x; asm volatile("" : "+v"(t)); return t; }
__device__ __forceinline__ const float* xrow(const Params& p, int t) { return t < TP ? p.x_prompt + (size_t)t * DM : p.x_sample + (size_t)(t - TP) * DM; }
__device__ __forceinline__ void seq_of(int t, int& base, int& len) { if (t < TP) { base = t & ~2047; len = 2048; } else { base = TP + ((t - TP) & ~16383); len = 16384; } }

namespace pg8 {
constexpr int BM = 256, BK = 64, HALF = 128, HTB = HALF * BK * 2, STAGE_BYTES = 8 * HTB, NXCD = 8, WGM = 8;
__device__ __forceinline__ int lds_byte(int r, int c) { const int st = (r >> 4) * 2 + (c >> 5), rr = r & 15, cc = c & 31, ob = rr * 64 + cc * 2; return st * 1024 + (ob ^ (((ob >> 9) & 1) << 5)); }
__device__ __forceinline__ void stage_rc(int b, int& R, int& C) { const int st = b / 1024, sb = b % 1024, swz = sb ^ (((sb >> 9) & 1) << 5); R = (st >> 1) * 16 + swz / 64; C = (st & 1) * 32 + (swz % 64) / 2; }
__device__ __forceinline__ int perm32(int rho) { const int n = rho >> 4, i = rho & 15; return 8 * (i >> 2) + 4 * n + (i & 3); }
struct Unit { int pm, pn; };
struct Gemm { const bf16_t* A; const bf16_t* Bt; int M, N, K, lda, ldb; const bf16_t* A2; int ks; };
struct StaticOrder {
    int nM, nN, nwg, G, c;
    __device__ void init(int M, int N, int G_, int c_) { nM = M / BM; nN = N / BM; nwg = nM * nN; G = G_; c = c_; }
    __device__ bool next(int i, Unit& u) const {
        const long L = (long)i * G + c; if (L >= nwg) return false;
        int wgid = (int)L; { const int q = nwg / NXCD, r = nwg % NXCD, xcd = wgid % NXCD, off = wgid / NXCD; wgid = (xcd < r ? xcd * (q + 1) : r * (q + 1) + (xcd - r) * q) + off; }
        const int nig = WGM * nN, gid = wgid / nig, fm = gid * WGM, gsz = (nM - fm) < WGM ? (nM - fm) : WGM;
        u.pm = fm + ((wgid % nig) % gsz); u.pn = (wgid % nig) / gsz; return true;
    }
};

template <class Epi>
__device__ __forceinline__ void gemm_phase(LAS unsigned char* lds, const Gemm g, const StaticOrder& S, const Epi& E) {
    const int tid = opaque_tid();
    const int wid = __builtin_amdgcn_readfirstlane(tid >> 6), lane = tid & 63, wr = wid >> 2, wc = wid & 3, fr = lane & 15, fq = lane >> 4;
    const int K = g.K, nt = K / BK;
    unsigned voffA[2], voffB[2];
#pragma unroll
    for (int i = 0; i < 2; ++i) { int R, C; stage_rc(tid * 16 + i * 8192, R, C); const int Rb = (R & ~31) + perm32(R & 31);
        voffA[i] = (unsigned)(R * g.lda + C) * 2u; voffB[i] = (unsigned)(Rb * g.ldb + C) * 2u; }
    const size_t kstep = (size_t)(BK * 2);
    const size_t hstepA = (size_t)HALF * g.lda * 2, hstepB = (size_t)HALF * g.ldb * 2;
    const size_t tstepA = 2 * hstepA, tstepB = 2 * hstepB;
    const unsigned ldsw = (unsigned)wid * 1024u;
    const int aoff = lds_byte(wr * 64 + fr, fq * 8), boff = lds_byte(wc * 32 + fr, fq * 8);
#define PG8_SA(b, h) (((b) * 2 + (h)) * HTB)
#define PG8_SB(b, h) ((4 + (b) * 2 + (h)) * HTB)
#define PG8_STAGE(bufoff, gbase, voff) do { _Pragma("unroll") for (int _i = 0; _i < 2; ++_i) \
        __builtin_amdgcn_global_load_lds((const unsigned*)((const char*)(gbase) + (voff)[_i]), (LAS unsigned*)(lds + (bufoff) + ldsw + _i * 8192), 16, 0, 0); } while (0)
#define PG8_LDA(dst, b, h) do { _Pragma("unroll") for (int m = 0; m < 4; ++m) _Pragma("unroll") for (int k = 0; k < 2; ++k) dst[m][k] = *(const LAS bf16x8*)(lds + PG8_SA(b, h) + aoff + m * 2048 + k * 1024); } while (0)
#define PG8_LDB(dst, b, h) do { _Pragma("unroll") for (int n = 0; n < 2; ++n) _Pragma("unroll") for (int k = 0; k < 2; ++k) dst[n][k] = *(const LAS bf16x8*)(lds + PG8_SB(b, h) + boff + n * 2048 + k * 1024); } while (0)
#define PG8_MMA(ai, bj, At, Bt) do { __builtin_amdgcn_s_setprio(1); _Pragma("unroll") for (int m = 0; m < 4; ++m) _Pragma("unroll") for (int n = 0; n < 2; ++n) _Pragma("unroll") for (int k = 0; k < 2; ++k) \
        acc[ai][bj][m][n] = __builtin_amdgcn_mfma_f32_16x16x32_bf16(Bt[n][k], At[m][k], acc[ai][bj][m][n], 0, 0, 0); __builtin_amdgcn_s_setprio(0); } while (0)
#define PG8_WAIT_V(n) asm volatile("s_waitcnt vmcnt(" #n ")" ::: "memory")
#define PG8_WAIT_L(n) asm volatile("s_waitcnt lgkmcnt(" #n ")" ::: "memory")
#define PG8_BAR __builtin_amdgcn_s_barrier()
#define PG8_SCHED __builtin_amdgcn_sched_barrier(0)
    Unit cur, nxt; int ui = 0;
    if (!S.next(0, cur)) return;
    f32x4 acc[2][2][4][2];
#pragma unroll
    for (int a = 0; a < 2; ++a)
#pragma unroll
        for (int b = 0; b < 2; ++b)
#pragma unroll
            for (int m = 0; m < 4; ++m)
#pragma unroll
                for (int n = 0; n < 2; ++n) acc[a][b][m][n] = (f32x4){0.f, 0.f, 0.f, 0.f};
    bf16x8 At[4][2], B0[2][2], B1[2][2];
    const char* cA = (const char*)g.A + (size_t)cur.pm * tstepA; const char* cB = (const char*)g.Bt + (size_t)cur.pn * tstepB;
    const bool two = g.A2 != nullptr; const int ks = two ? g.ks : (1 << 30);
    const char* cA2 = two ? (const char*)g.A2 + (size_t)cur.pm * tstepA : cA;
    PG8_STAGE(PG8_SB(0, 0), cB, voffB); PG8_STAGE(PG8_SA(0, 0), cA, voffA); PG8_STAGE(PG8_SB(0, 1), cB + hstepB, voffB); PG8_STAGE(PG8_SA(0, 1), cA + hstepA, voffA);
    if (wr == 1) PG8_BAR;
    PG8_WAIT_V(4); PG8_BAR;
    PG8_STAGE(PG8_SB(1, 0), cB + kstep, voffB); PG8_STAGE(PG8_SA(1, 0), cA + kstep, voffA); PG8_STAGE(PG8_SB(1, 1), cB + hstepB + kstep, voffB);
    PG8_WAIT_V(6); PG8_BAR;
    for (;;) {
        const bool has_next = S.next(ui + 1, nxt);
        const char* nA = has_next ? (const char*)g.A + (size_t)nxt.pm * tstepA : cA; const char* nB = has_next ? (const char*)g.Bt + (size_t)nxt.pn * tstepB : cB;
        const char* nA2 = (two && has_next) ? (const char*)g.A2 + (size_t)nxt.pm * tstepA : cA2;
#pragma unroll 1
        for (int t = 0; t < nt; t += 2) {
            const bool last = (t == nt - 2);
            const char* a1 = (t + 1 < ks) ? cA + (size_t)(t + 1) * kstep : cA2 + (size_t)(t + 1 - ks) * kstep;
            const char* a2 = last ? nA : ((t + 2 < ks) ? cA + (size_t)(t + 2) * kstep : cA2 + (size_t)(t + 2 - ks) * kstep); const char* b2 = last ? nB : cB + (size_t)(t + 2) * kstep;
            const char* a3 = a2 + kstep; const char* b3 = b2 + kstep;
            PG8_LDB(B0, 0, 0); PG8_SCHED; PG8_LDA(At, 0, 0); PG8_STAGE(PG8_SA(1, 1), a1 + hstepA, voffA);
            PG8_WAIT_L(8); PG8_BAR; PG8_WAIT_L(0); PG8_MMA(0, 0, At, B0); PG8_BAR; PG8_SCHED;
            PG8_LDB(B1, 0, 1); PG8_STAGE(PG8_SB(0, 0), b2, voffB);
            PG8_BAR; PG8_WAIT_L(0); PG8_MMA(0, 1, At, B1); PG8_BAR;
            PG8_LDA(At, 0, 1); PG8_STAGE(PG8_SA(0, 0), a2, voffA);
            PG8_BAR; PG8_WAIT_L(0); PG8_MMA(1, 0, At, B0); PG8_BAR; PG8_SCHED;
            PG8_STAGE(PG8_SB(0, 1), b2 + hstepB, voffB);
            PG8_WAIT_V(6); PG8_BAR; PG8_MMA(1, 1, At, B1); PG8_BAR;
            PG8_LDB(B0, 1, 0); PG8_SCHED; PG8_LDA(At, 1, 0); PG8_STAGE(PG8_SA(0, 1), a2 + hstepA, voffA);
            PG8_WAIT_L(8); PG8_BAR; PG8_WAIT_L(0); PG8_MMA(0, 0, At, B0); PG8_BAR; PG8_SCHED;
            PG8_LDB(B1, 1, 1); PG8_STAGE(PG8_SB(1, 0), b3, voffB);
            PG8_BAR; PG8_WAIT_L(0); PG8_MMA(0, 1, At, B1); PG8_BAR;
            PG8_LDA(At, 1, 1); PG8_STAGE(PG8_SA(1, 0), a3, voffA);
            PG8_BAR; PG8_WAIT_L(0); PG8_MMA(1, 0, At, B0); PG8_BAR; PG8_SCHED;
            PG8_STAGE(PG8_SB(1, 1), b3 + hstepB, voffB);
            PG8_WAIT_V(6); PG8_BAR; PG8_MMA(1, 1, At, B1); PG8_BAR;
        }
        E(acc, cur, wr, wc, fr, fq);
        if (!has_next) break;
#pragma unroll
        for (int a = 0; a < 2; ++a)
#pragma unroll
            for (int b = 0; b < 2; ++b)
#pragma unroll
                for (int m = 0; m < 4; ++m)
#pragma unroll
                    for (int n = 0; n < 2; ++n) acc[a][b][m][n] = (f32x4){0.f, 0.f, 0.f, 0.f};
        cur = nxt; cA = nA; cA2 = nA2; cB = nB; ++ui;
    }
    PG8_WAIT_V(0);
    if (wr == 0) PG8_BAR;
    PG8_BAR;
#undef PG8_SA
#undef PG8_SB
#undef PG8_STAGE
#undef PG8_LDA
#undef PG8_LDB
#undef PG8_MMA
#undef PG8_WAIT_V
#undef PG8_WAIT_L
#undef PG8_BAR
#undef PG8_SCHED
}
}
using pg8::Unit;

#define EPI_LOOP_BEGIN const int row0 = u.pm * 256 + wr * 64 + fr, col0 = u.pn * 256 + wc * 32 + 8 * fq; \
    _Pragma("unroll") for (int ai = 0; ai < 2; ++ai) _Pragma("unroll") for (int m = 0; m < 4; ++m) { const int row = row0 + ai * 128 + m * 16;
#define EPI_BJ _Pragma("unroll") for (int bj = 0; bj < 2; ++bj) { const int col = col0 + bj * 128; const f32x4 v0 = acc[ai][bj][m][0], v1 = acc[ai][bj][m][1];
#define EPI_ACC const f32x4 (&acc)[2][2][4][2], const Unit& u, int wr, int wc, int fr, int fq

__device__ __forceinline__ u32x4 pack8(const f32x4 a, const f32x4 b) { u32x4 w; w.x = pk_bf16(a[0], a[1]); w.y = pk_bf16(a[2], a[3]); w.z = pk_bf16(b[0], b[1]); w.w = pk_bf16(b[2], b[3]); return w; }
__device__ __forceinline__ void unpack8(const u32x4 w, f32x4& a, f32x4& b) { a = (f32x4){bf_lo(w.x), bf_hi(w.x), bf_lo(w.y), bf_hi(w.y)}; b = (f32x4){bf_lo(w.z), bf_hi(w.z), bf_lo(w.w), bf_hi(w.w)}; }

struct EpiStore {
    bf16_t* O; int ldc;
    __device__ __forceinline__ void operator()(EPI_ACC) const { EPI_LOOP_BEGIN EPI_BJ *(u32x4*)(O + (size_t)row * ldc + col) = pack8(v0, v1); } } }
};
struct EpiMulInPlace {
    bf16_t* Y;
    __device__ __forceinline__ void operator()(EPI_ACC) const { EPI_LOOP_BEGIN if ((m & 1) == 0) __builtin_amdgcn_sched_barrier(0);
        EPI_BJ u32x4* ptr = (u32x4*)(Y + (size_t)row * 1024 + col); f32x4 a, b; unpack8(*ptr, a, b); *ptr = pack8(a * v0, b * v1); } } }
};
struct EpiGates {
    bf16_t* G; const float* bias;
    __device__ __forceinline__ void operator()(EPI_ACC) const { EPI_LOOP_BEGIN EPI_BJ
        const f32x4 b0 = *(const f32x4*)(bias + col), b1 = *(const f32x4*)(bias + col + 4); f32x4 a, b;
#pragma unroll
        for (int j = 0; j < 4; ++j) { a[j] = sigmoidf_(v0[j] + b0[j]); b[j] = sigmoidf_(v1[j] + b1[j]); }
        *(u32x4*)(G + (size_t)row * 2048 + col) = pack8(a, b); } } }
};
struct EpiPool {
    bf16_t* P; const bf16_t* G;
    __device__ __forceinline__ void operator()(EPI_ACC) const { EPI_LOOP_BEGIN EPI_BJ f32x4 a, b; unpack8(*(const u32x4*)(G + (size_t)row * 2048 + col), a, b);
        *(u32x4*)(P + (size_t)row * 1024 + col) = pack8(a * v0, b * v1); } } }
};
struct EpiMerge {
    bf16_t* P; const bf16_t* G;
    __device__ __forceinline__ void operator()(EPI_ACC) const { EPI_LOOP_BEGIN EPI_BJ f32x4 a, b, pa, pb; unpack8(*(const u32x4*)(G + (size_t)row * 2048 + 1024 + col), a, b);
        u32x4* ptr = (u32x4*)(P + (size_t)row * 1024 + col); unpack8(*ptr, pa, pb); *ptr = pack8(pa + a * v0, pb + b * v1); } } }
};
struct EpiOut {
    const float* xp; const float* xs; float* X1; bf16_t* X1B; float* rowsq;
    __device__ __forceinline__ void operator()(EPI_ACC) const { EPI_LOOP_BEGIN const float* xr = row < TP ? xp + (size_t)row * DM : xs + (size_t)(row - TP) * DM; float ss = 0.f; EPI_BJ
        f32x4 a = *(const f32x4*)(xr + col) + v0, b = *(const f32x4*)(xr + col + 4) + v1;
        *(f32x4*)(X1 + (size_t)row * 1024 + col) = a; *(f32x4*)(X1 + (size_t)row * 1024 + col + 4) = b; *(u32x4*)(X1B + (size_t)row * 1024 + col) = pack8(a, b);
#pragma unroll
        for (int j = 0; j < 4; ++j) ss += a[j] * a[j] + b[j] * b[j]; }
        ss += __shfl_xor(ss, 16); ss += __shfl_xor(ss, 32); if (fq == 0) atomicAdd(rowsq + row, ss); } }
};
struct EpiFF1 {
    bf16_t* Hlo; bf16_t* Hhi; const float* rowsq;
    __device__ __forceinline__ void operator()(EPI_ACC) const { bf16_t* H = u.pn < 8 ? Hlo : Hhi; const int cshift = u.pn < 8 ? 0 : 2048;
        EPI_LOOP_BEGIN const float rinv = rsqrtf(rowsq[row] * (1.0f / 1024.0f) + 1e-6f); EPI_BJ f32x4 a, b;
#pragma unroll
        for (int j = 0; j < 4; ++j) { float t0 = fmaxf(v0[j] * rinv, 0.f), t1 = fmaxf(v1[j] * rinv, 0.f); a[j] = t0 * t0; b[j] = t1 * t1; }
        *(u32x4*)(H + (size_t)row * 2048 + (col - cshift)) = pack8(a, b); } } }
};
struct EpiAddInPlace {
    float* X;
    __device__ __forceinline__ void operator()(EPI_ACC) const { EPI_LOOP_BEGIN EPI_BJ f32x4* ptr = (f32x4*)(X + (size_t)row * 1024 + col); ptr[0] = ptr[0] + v0; ptr[1] = ptr[1] + v1; } } }
};
struct EpiFinal {
    float* X; float* rowsq;
    __device__ __forceinline__ void operator()(EPI_ACC) const { EPI_LOOP_BEGIN float ss = 0.f; EPI_BJ f32x4* ptr = (f32x4*)(X + (size_t)row * 1024 + col); const f32x4 a = ptr[0] + v0, b = ptr[1] + v1; ptr[0] = a; ptr[1] = b;
#pragma unroll
        for (int j = 0; j < 4; ++j) ss += a[j] * a[j] + b[j] * b[j]; }
        ss += __shfl_xor(ss, 16); ss += __shfl_xor(ss, 32); if (fq == 0) atomicAdd(rowsq + row, ss); } }
};

template <class Epi>
__device__ __forceinline__ void run_gemm(unsigned char* shm, const bf16_t* A, int lda, const bf16_t* Bt, int ldb, int N, int K, const Epi& E, const bf16_t* A2 = nullptr, int ks = 0) {
    pg8::Gemm g; g.A = A; g.Bt = Bt; g.M = T_TOK; g.N = N; g.K = K; g.lda = lda; g.ldb = ldb; g.A2 = A2; g.ks = ks;
    pg8::StaticOrder S; S.init(T_TOK, N, (int)gridDim.x, (int)blockIdx.x);
    pg8::gemm_phase<Epi>((LAS unsigned char*)shm, g, S, E);
}

__device__ void transpose_cvt(unsigned char* shm, const float* src, int K, int N, bf16_t* dst, int ldd, const float* kscale) {
    float* tile = (float*)shm;
    const int tid = opaque_tid(), ntk = K / 64, ntn = N / 64;
    for (int t = blockIdx.x; t < ntk * ntn; t += gridDim.x) {
        const int tk = t / ntn, tn = t % ntn;
#pragma unroll
        for (int i = 0; i < 8; ++i) { const int kl = (tid >> 6) + 8 * i, nl = tid & 63; const int k = tk * 64 + kl;
            tile[kl * 65 + nl] = src[(size_t)k * N + tn * 64 + nl] * (kscale ? kscale[k] : 1.0f); }
        __syncthreads();
#pragma unroll
        for (int i = 0; i < 8; ++i) { const int nl = (tid >> 6) + 8 * i, kl = tid & 63;
            const unsigned w = pk_bf16(tile[kl * 65 + nl], 0.f); dst[(size_t)(tn * 64 + nl) * ldd + tk * 64 + kl] = (bf16_t)(w & 0xFFFFu); }
        __syncthreads();
    }
}

__device__ void rmsnorm_rows(const Params& p, const float* g, bf16_t* dst) {
    const int tidx = opaque_tid(); const int lane = tidx & 63, wave = (blockIdx.x * 512 + tidx) >> 6, nw = (gridDim.x * 512) >> 6;
    f32x4 gv[4];
#pragma unroll
    for (int i = 0; i < 4; ++i) gv[i] = *(const f32x4*)(g + lane * 4 + 256 * i);
    for (int t = wave; t < T_TOK; t += nw) {
        const float* xr = xrow(p, t); f32x4 v[4]; float ss = 0.f;
#pragma unroll
        for (int i = 0; i < 4; ++i) { v[i] = *(const f32x4*)(xr + lane * 4 + 256 * i); ss += v[i][0] * v[i][0] + v[i][1] * v[i][1] + v[i][2] * v[i][2] + v[i][3] * v[i][3]; }
#pragma unroll
        for (int o = 1; o < 64; o <<= 1) ss += __shfl_xor(ss, o);
        const float rinv = rsqrtf(ss * (1.0f / 1024.0f) + 1e-6f);
#pragma unroll
        for (int i = 0; i < 4; ++i) { u32x2 w; w.x = pk_bf16(v[i][0] * rinv * gv[i][0], v[i][1] * rinv * gv[i][1]); w.y = pk_bf16(v[i][2] * rinv * gv[i][2], v[i][3] * rinv * gv[i][3]);
            *(u32x2*)(dst + (size_t)t * 1024 + lane * 4 + 256 * i) = w; }
    }
}

__device__ void prep_phase(const Params& p, unsigned char* shm) {
    unsigned char* ws = p.ws;
    const int gtid = blockIdx.x * 512 + opaque_tid(), gn = gridDim.x * 512;
    for (int i = gtid; i < T_TOK; i += gn) { ((float*)(ws + OFF_ROWSQ))[i] = 0.f; ((float*)(ws + OFF_ROWSQ2))[i] = 0.f; }
    if (gtid < 64) ((unsigned*)(ws + OFF_QUEUE))[gtid] = 0u;
    transpose_cvt(shm, p.w_in, 1024, 5888, (bf16_t*)(ws + OFF_WIN), 1024, nullptr);
    transpose_cvt(shm, p.w_rwkv_br, 1024, 1024, (bf16_t*)(ws + OFF_WRBR), 1024, nullptr);
    transpose_cvt(shm, p.w_out, 1024, 1024, (bf16_t*)(ws + OFF_WOUT), 1024, nullptr);
    transpose_cvt(shm, p.w_ff1, 1024, 4096, (bf16_t*)(ws + OFF_WFF1), 1024, p.g_ffn);
    transpose_cvt(shm, p.w_ff2, 4096, 1024, (bf16_t*)(ws + OFF_WFF2), 4096, nullptr);
    transpose_cvt(shm, p.g_up, 128, 1024, (bf16_t*)(ws + OFF_WG), 256, nullptr);
    { bf16_t* wg = (bf16_t*)(ws + OFF_WG); for (int i = gtid; i < 1024 * 128; i += gn) wg[(size_t)(i >> 7) * 256 + 128 + (i & 127)] = 0; }
    { bf16_t* we = (bf16_t*)(ws + OFF_WEFF);
      for (int i = gtid; i < 512 * 1024; i += gn) { const int k = i >> 10, n = i & 1023, gI = k >> 7; const float* pw = p.pool_w + (size_t)k * 128; float acc = 0.f;
          for (int d = 0; d < 128; ++d) acc += pw[d] * p.pool_scale[gI * 128 + d] * p.w_pool_br[(size_t)(gI * 128 + d) * 1024 + n];
          we[(size_t)n * 512 + k] = (bf16_t)(pk_bf16(acc, 0.f) & 0xFFFFu); } }
    rmsnorm_rows(p, p.g_mix, (bf16_t*)(ws + OFF_R1));
}

#define LDS_BAR() do { asm volatile("s_waitcnt lgkmcnt(0)" ::: "memory"); __builtin_amdgcn_s_barrier(); asm volatile("" ::: "memory"); } while (0)
constexpr int N_SAMPLE_ITEMS = 128, N_ITEMS = N_SAMPLE_ITEMS + 1024;

template <int LPR, int DIR>
__device__ __forceinline__ void scan_item(const Params& p, unsigned char* shm, const int tid, const int tbase, const int L, const int h, const int half) {
    constexpr int dir = DIR;
    constexpr int EC = 64 / LPR, RPW = 2 * (64 / LPR), NS = EC / 2;
    float* sW = (float*)shm; float* sAV = sW + 2048; float* sBV = sW + 4096; float* sKD = sW + 6144; float* sWR = sW + 8192; float* sR = sW + 10240; float* sV = sW + 12288; float* sY = sW + 14336;
    float* sBK = sW + 16384;
    bf16_t* sTW = (bf16_t*)(sW + 16384 + 64);
    bf16_t* sZA = sTW + 32 * 72;
    const int lane = tid & 63, wv = tid >> 6;
    const bf16_t* zall = (const bf16_t*)(p.ws + OFF_Z);
    const int tokA = tid >> 4, q = tid & 15;
    const int rowS = (LPR == 16 ? half * 32 : 0) + (wv & 3) * RPW + 2 * (lane / LPR), gS = lane % LPR;
    const int NC = L / 32;
    bf16_t* ybuf = (bf16_t*)p.out + (dir ? (size_t)T_TOK * 1024 : 0);
    float* bonus = (float*)(p.ws + OFF_BONUS) + (dir ? (size_t)T_TOK * 16 : 0);
    const float* w_up = dir ? p.w_up_b : p.w_up_f; const float* a_up = dir ? p.a_up_b : p.a_up_f;
    const float* w0 = dir ? p.w0_b : p.w0_f; const float* a0 = dir ? p.a0_b : p.a0_f;
    const int mat = wv >> 2, cbk = wv & 3, colB = cbk * 16 + (lane & 15), quad = lane >> 4;
    u32x4* sBF = (u32x4*)(shm + 84 * 1024);
    { const float* up = mat ? a_up : w_up;
#pragma unroll
      for (int kb = 0; kb < 2; ++kb) { float f[8];
#pragma unroll
          for (int j = 0; j < 8; ++j) f[j] = up[(size_t)(kb * 32 + quad * 8 + j) * 1024 + h * 64 + colB];
          u32x4 w; w.x = pk_bf16(f[0], f[1]); w.y = pk_bf16(f[2], f[3]); w.z = pk_bf16(f[4], f[5]); w.w = pk_bf16(f[6], f[7]); sBF[kb * 512 + tid] = w; } }
    const float c0B = (mat ? a0 : w0)[h * 64 + colB];
    const float kaB = p.k_a[h * 64 + colB];
    int colz[5];
    float* sMU = (float*)(shm + 76 * 1024);
#pragma unroll
    for (int gi = 0; gi < 5; ++gi) colz[gi] = (gi == 0 ? COL_R + h * 64 : gi == 1 ? COL_K + h * 64 : gi == 2 ? COL_V + h * 64 : gi == 3 ? COL_W : COL_A) + 4 * q;
    if (tid < 320) { const int gi = tid >> 6, c = tid & 63; const int col = (gi == 0 ? COL_R + h * 64 : gi == 1 ? COL_K + h * 64 : gi == 2 ? COL_V + h * 64 : gi == 3 ? COL_W : COL_A) + c - COL_R;
        sMU[gi * 64 + c] = p.mu_prev[col]; sMU[320 + gi * 64 + c] = p.mu_next[col]; }
    else if (tid < 384) sMU[640 + (tid - 320)] = p.k_k[h * 64 + (tid - 320)];
    else if (tid < 448) sMU[704 + (tid - 384)] = p.r_k[h * 64 + (tid - 384)];
    __syncthreads();
    f32x2 s[2][NS];
#pragma unroll
    for (int j = 0; j < NS; ++j) { s[0][j] = (f32x2){0.f, 0.f}; s[1][j] = (f32x2){0.f, 0.f}; }
    u32x2 zc[5], zp[5], zn[5];
    auto load_chunk = [&](int ci) {
        const int t = tbase + 32 * (dir ? NC - 1 - ci : ci) + tokA; const bool hasPrev = t > tbase, hasNext = t < tbase + L - 1;
        const bf16_t* zr = zall + (size_t)t * ZLD;
#pragma unroll
        for (int gi = 0; gi < 5; ++gi) { zc[gi] = *(const u32x2*)(zr + colz[gi]); zp[gi] = (u32x2){0u, 0u}; zn[gi] = (u32x2){0u, 0u};
            if (hasPrev) zp[gi] = *(const u32x2*)(zr - ZLD + colz[gi]);
            if (hasNext) zn[gi] = *(const u32x2*)(zr + ZLD + colz[gi]); }
    };
    load_chunk(0);
    for (int ci = 0; ci < NC; ++ci) {
        const int t0 = tbase + 32 * (dir ? NC - 1 - ci : ci);
        { float zs[5][4];
#pragma unroll
          for (int gi = 0; gi < 5; ++gi) {
              const float c[4] = {bf_lo(zc[gi].x), bf_hi(zc[gi].x), bf_lo(zc[gi].y), bf_hi(zc[gi].y)}, pv[4] = {bf_lo(zp[gi].x), bf_hi(zp[gi].x), bf_lo(zp[gi].y), bf_hi(zp[gi].y)}, nx[4] = {bf_lo(zn[gi].x), bf_hi(zn[gi].x), bf_lo(zn[gi].y), bf_hi(zn[gi].y)};
              const f32x4 mp = *(const f32x4*)(sMU + gi * 64 + 4 * q), mn = *(const f32x4*)(sMU + 320 + gi * 64 + 4 * q);
#pragma unroll
              for (int j = 0; j < 4; ++j) zs[gi][j] = c[j] + mp[j] * (pv[j] - c[j]) + mn[j] * (nx[j] - c[j]);
          }
          if (ci + 1 < NC) load_chunk(ci + 1);
          *(f32x4*)(sR + tokA * 64 + 4 * q) = (f32x4){zs[0][0], zs[0][1], zs[0][2], zs[0][3]};
          *(f32x4*)(sKD + tokA * 64 + 4 * q) = (f32x4){zs[1][0], zs[1][1], zs[1][2], zs[1][3]};
          *(f32x4*)(sV + tokA * 64 + 4 * q) = (f32x4){zs[2][0], zs[2][1], zs[2][2], zs[2][3]};
          float kk[4], ss = 0.f; const f32x4 kk4c = *(const f32x4*)(sMU + 640 + 4 * q);
#pragma unroll
          for (int j = 0; j < 4; ++j) { kk[j] = zs[1][j] * kk4c[j]; ss += kk[j] * kk[j]; }
          ss = red16(ss);
          const float inv = -__builtin_amdgcn_rsqf(fmaxf(ss, 1e-24f));
          *(f32x4*)(sAV + tokA * 64 + 4 * q) = (f32x4){kk[0] * inv, kk[1] * inv, kk[2] * inv, kk[3] * inv};
          float tw[4];
#pragma unroll
          for (int j = 0; j < 4; ++j) tw[j] = 1.0f - 2.0f * __builtin_amdgcn_rcpf(1.0f + __expf(2.0f * zs[3][j]));
          u32x2 w; w.x = pk_bf16(tw[0], tw[1]); w.y = pk_bf16(tw[2], tw[3]); *(u32x2*)(sTW + tokA * 72 + 4 * q) = w;
          w.x = pk_bf16(zs[4][0], zs[4][1]); w.y = pk_bf16(zs[4][2], zs[4][3]); *(u32x2*)(sZA + tokA * 72 + 4 * q) = w;
        }
        LDS_BAR();
        { const bf16_t* sX = mat ? sZA : sTW;
#pragma unroll
          for (int rb = 0; rb < 2; ++rb) {
              f32x4 acc = (f32x4){0.f, 0.f, 0.f, 0.f};
#pragma unroll
              for (int kb = 0; kb < 2; ++kb) { const bf16x8 af = *(const bf16x8*)(sX + (rb * 16 + (lane & 15)) * 72 + kb * 32 + quad * 8);
                  acc = __builtin_amdgcn_mfma_f32_16x16x32_bf16(af, __builtin_bit_cast(bf16x8, sBF[kb * 512 + tid]), acc, 0, 0, 0); }
#pragma unroll
              for (int j = 0; j < 4; ++j) { const int idx = (rb * 16 + quad * 4 + j) * 64 + colB; const float pre = c0B + acc[j];
                  if (mat == 0) { const float w = __expf(-0.6065306597f * sigmoidf_(pre)); sW[idx] = w; sWR[idx] = w * sR[idx]; }
                  else { const float a = sigmoidf_(pre); const float k = sKD[idx]; sKD[idx] = k * (1.0f + (a - 1.0f) * kaB); sBV[idx] = -sAV[idx] * a; } }
          } }
        LDS_BAR();
        { const f32x4 r4 = *(const f32x4*)(sR + tokA * 64 + 4 * q), b4 = *(const f32x4*)(sBV + tokA * 64 + 4 * q), k4 = *(const f32x4*)(sKD + tokA * 64 + 4 * q);
          float br = 0.f, kr = 0.f, cb = 0.f; const f32x4 rk4 = *(const f32x4*)(sMU + 704 + 4 * q);
#pragma unroll
          for (int j = 0; j < 4; ++j) { br += b4[j] * r4[j]; kr += k4[j] * r4[j]; cb += r4[j] * k4[j] * rk4[j]; }
          br = red16(br); kr = red16(kr); cb = red16(cb);
          if (q == 0) { sBK[tokA * 2] = br; sBK[tokA * 2 + 1] = kr; if (half == 0) bonus[(size_t)(t0 + tokA) * 16 + h] = cb; } }
        LDS_BAR();
        {
            constexpr int NV = EC / 4;
            struct Ops { f32x4 w[NV], a[NV], b[NV], k[NV], q[NV]; f32x2 v; f32x2 bk; };
            auto ld = [&](Ops& o, int i) { const int tk = DIR ? 31 - i : i; const int off = tk * 64 + 4 * gS;
#pragma unroll
                for (int c = 0; c < NV; ++c) { o.w[c] = *(const f32x4*)(sW + off + 32 * c); o.a[c] = *(const f32x4*)(sAV + off + 32 * c); o.b[c] = *(const f32x4*)(sBV + off + 32 * c);
                    o.k[c] = *(const f32x4*)(sKD + off + 32 * c); o.q[c] = *(const f32x4*)(sWR + off + 32 * c); }
                o.v = *(const f32x2*)(sV + tk * 64 + rowS); o.bk = *(const f32x2*)(sBK + tk * 2); };
            auto step = [&](const Ops& cur, int i) {
                float sa[2], yp[2];
#pragma unroll
                for (int r = 0; r < 2; ++r) {
                    f32x2 sa2 = (f32x2){0.f, 0.f}, yp2 = (f32x2){0.f, 0.f};
#pragma unroll
                    for (int c = 0; c < NV; ++c) {
                        sa2 = __builtin_elementwise_fma(s[r][2 * c], (f32x2){cur.a[c][0], cur.a[c][1]}, sa2); sa2 = __builtin_elementwise_fma(s[r][2 * c + 1], (f32x2){cur.a[c][2], cur.a[c][3]}, sa2);
                        yp2 = __builtin_elementwise_fma(s[r][2 * c], (f32x2){cur.q[c][0], cur.q[c][1]}, yp2); yp2 = __builtin_elementwise_fma(s[r][2 * c + 1], (f32x2){cur.q[c][2], cur.q[c][3]}, yp2); }
                    sa[r] = sa2.x + sa2.y; yp[r] = yp2.x + yp2.y; }
#pragma unroll
                for (int r = 0; r < 2; ++r) { if constexpr (LPR == 8) { sa[r] = red8(sa[r]); yp[r] = red8(yp[r]); } else { sa[r] = red16(sa[r]); yp[r] = red16(yp[r]); } }
                f32x2 y;
#pragma unroll
                for (int r = 0; r < 2; ++r) { const float vr = r ? cur.v.y : cur.v.x;
                    const f32x2 vv = (f32x2){vr, vr}, sasa = (f32x2){sa[r], sa[r]};
#pragma unroll
                    for (int c = 0; c < NV; ++c) {
                        s[r][2 * c] = __builtin_elementwise_fma(s[r][2 * c], (f32x2){cur.w[c][0], cur.w[c][1]}, __builtin_elementwise_fma(sasa, (f32x2){cur.b[c][0], cur.b[c][1]}, vv * (f32x2){cur.k[c][0], cur.k[c][1]}));
                        s[r][2 * c + 1] = __builtin_elementwise_fma(s[r][2 * c + 1], (f32x2){cur.w[c][2], cur.w[c][3]}, __builtin_elementwise_fma(sasa, (f32x2){cur.b[c][2], cur.b[c][3]}, vv * (f32x2){cur.k[c][2], cur.k[c][3]})); }
                    const float yr = yp[r] + sa[r] * cur.bk.x + vr * cur.bk.y; if (r) y.y = yr; else y.x = yr; }
                if (gS == 0) *(f32x2*)(sY + (DIR ? 31 - i : i) * 64 + rowS) = y;
            };
            if (wv < 4) {
                Ops o0, o1; ld(o0, 0);
#pragma unroll 1
                for (int i = 0; i < 32; i += 2) {
                    ld(o1, i + 1);
                    step(o0, i);
                    ld(o0, min(i + 2, 31));
                    step(o1, i + 1);
                }
            }
        }
        LDS_BAR();
        if (LPR == 8 || (q >> 3) == half) { const f32x4 y4 = *(const f32x4*)(sY + tokA * 64 + 4 * q); u32x2 w; w.x = pk_bf16(y4[0], y4[1]); w.y = pk_bf16(y4[2], y4[3]);
          *(u32x2*)(ybuf + (size_t)(t0 + tokA) * 1024 + h * 64 + 4 * q) = w; }
    }
}

__device__ void scan_phase(const Params& p, unsigned char* shm) {
    int* sItem = (int*)(shm + 80 * 1024);
    const int tid = opaque_tid();
    unsigned* queue = (unsigned*)(p.ws + OFF_QUEUE);
    for (;;) {
        if (tid == 0) *sItem = (int)atomicAdd(queue, 1u);
        __syncthreads();
        const int item = *sItem;
        __syncthreads();
        if (item >= N_ITEMS) break;
        int tid2 = tid; asm volatile("" : "+v"(tid2));
        if (item < N_SAMPLE_ITEMS) {
            const int half = item & 1, j = item >> 1;
            if (j & 1) scan_item<16, 1>(p, shm, tid2, TP + (j >> 5) * 16384, 16384, (j >> 1) & 15, half); else scan_item<16, 0>(p, shm, tid2, TP + (j >> 5) * 16384, 16384, (j >> 1) & 15, half);
        } else { const int j = item - N_SAMPLE_ITEMS;
            if (j & 1) scan_item<8, 1>(p, shm, tid2, (j >> 5) * 2048, 2048, (j >> 1) & 15, 0); else scan_item<8, 0>(p, shm, tid2, (j >> 5) * 2048, 2048, (j >> 1) & 15, 0); }
        __syncthreads();
    }
}

__device__ void mix_phase(const Params& p) {
    const int tidx = opaque_tid(); const int lane = tidx & 63, wave = (blockIdx.x * 512 + tidx) >> 6, nw = (gridDim.x * 512) >> 6;
    const bf16_t* zall = (const bf16_t*)(p.ws + OFF_Z);
    bf16_t* yf = (bf16_t*)p.out; const bf16_t* yb = (const bf16_t*)p.out + (size_t)T_TOK * 1024;
    const float* bonus_f = (const float*)(p.ws + OFF_BONUS); const float* bonus_b = bonus_f + (size_t)T_TOK * 16;
    bf16_t* pooled = (bf16_t*)(p.ws + OFF_POOLED); bf16_t* sg = (bf16_t*)(p.ws + OFF_SG);
    const int hL = lane >> 2;
    const int tpw = (T_TOK + nw - 1) / nw;
    for (int t = wave * tpw; t < min(T_TOK, (wave + 1) * tpw); ++t) {
        int tbase, L; seq_of(t, tbase, L); const int pos = t - tbase; const bool hasPrev = pos > 0, hasNext = pos < L - 1;
        const bf16_t* zr = zall + (size_t)t * ZLD;
        { const int c0 = lane * 16; float y[16];
          { const u32x4 a0 = *(const u32x4*)(yf + (size_t)t * 1024 + c0), a1 = *(const u32x4*)(yf + (size_t)t * 1024 + c0 + 8);
            const u32x4 b0 = *(const u32x4*)(yb + (size_t)t * 1024 + c0), b1 = *(const u32x4*)(yb + (size_t)t * 1024 + c0 + 8);
            f32x4 fa, fb, ga, gb; unpack8(a0, fa, fb); unpack8(b0, ga, gb);
#pragma unroll
            for (int j = 0; j < 4; ++j) { y[j] = fa[j] + ga[j]; y[4 + j] = fb[j] + gb[j]; }
            unpack8(a1, fa, fb); unpack8(b1, ga, gb);
#pragma unroll
            for (int j = 0; j < 4; ++j) { y[8 + j] = fa[j] + ga[j]; y[12 + j] = fb[j] + gb[j]; } }
          float sm = 0.f;
#pragma unroll
          for (int j = 0; j < 16; ++j) sm += y[j];
          const float mean = red4(sm) * (1.0f / 64.0f); float vs = 0.f;
#pragma unroll
          for (int j = 0; j < 16; ++j) { const float d = y[j] - mean; vs += d * d; }
          const float rstd = rsqrtf(red4(vs) * (1.0f / 64.0f) + 64e-5f);
          const float bon = bonus_f[(size_t)t * 16 + hL] + bonus_b[(size_t)t * 16 + hL];
          float vv[16];
          { const bf16_t* zc = zr + COL_V + c0;
            u32x4 c_[2], p_[2], n_[2];
#pragma unroll
            for (int i = 0; i < 2; ++i) { c_[i] = *(const u32x4*)(zc + 8 * i); p_[i] = hasPrev ? *(const u32x4*)(zc - ZLD + 8 * i) : (u32x4){0u, 0u, 0u, 0u}; n_[i] = hasNext ? *(const u32x4*)(zc + ZLD + 8 * i) : (u32x4){0u, 0u, 0u, 0u}; }
#pragma unroll
            for (int i = 0; i < 2; ++i) { f32x4 ca, cb, pa, pb, na, nb; unpack8(c_[i], ca, cb); unpack8(p_[i], pa, pb); unpack8(n_[i], na, nb);
                const float* mp = p.mu_prev + (COL_V - COL_R) + c0 + 8 * i; const float* mn = p.mu_next + (COL_V - COL_R) + c0 + 8 * i;
                const f32x4 mp0 = *(const f32x4*)mp, mp1 = *(const f32x4*)(mp + 4), mn0 = *(const f32x4*)mn, mn1 = *(const f32x4*)(mn + 4);
#pragma unroll
                for (int j = 0; j < 4; ++j) { vv[8 * i + j] = ca[j] + mp0[j] * (pa[j] - ca[j]) + mn0[j] * (na[j] - ca[j]); vv[8 * i + 4 + j] = cb[j] + mp1[j] * (pb[j] - cb[j]) + mn1[j] * (nb[j] - cb[j]); } } }
          float o[16];
#pragma unroll
          for (int i = 0; i < 4; ++i) { const f32x4 lw = *(const f32x4*)(p.ln_w + c0 + 4 * i), lb = *(const f32x4*)(p.ln_b + c0 + 4 * i);
#pragma unroll
              for (int j = 0; j < 4; ++j) o[4 * i + j] = (y[4 * i + j] - mean) * rstd * lw[j] + lb[j] + bon * vv[4 * i + j]; }
          u32x4 w0, w1; w0.x = pk_bf16(o[0], o[1]); w0.y = pk_bf16(o[2], o[3]); w0.z = pk_bf16(o[4], o[5]); w0.w = pk_bf16(o[6], o[7]);
          w1.x = pk_bf16(o[8], o[9]); w1.y = pk_bf16(o[10], o[11]); w1.z = pk_bf16(o[12], o[13]); w1.w = pk_bf16(o[14], o[15]);
          *(u32x4*)(yf + (size_t)t * 1024 + c0) = w0; *(u32x4*)(yf + (size_t)t * 1024 + c0 + 8) = w1; }
        { const int c = 2 * lane; const bf16_t* zc = zr + COL_G + c; const unsigned wc_ = *(const unsigned*)zc; const unsigned wp = hasPrev ? *(const unsigned*)(zc - ZLD) : 0u, wn = hasNext ? *(const unsigned*)(zc + ZLD) : 0u;
          const float mp0 = p.mu_prev[COL_G - COL_R + c], mp1 = p.mu_prev[COL_G - COL_R + c + 1], mn0 = p.mu_next[COL_G - COL_R + c], mn1 = p.mu_next[COL_G - COL_R + c + 1];
          const float c0v = bf_lo(wc_), c1v = bf_hi(wc_);
          const float z0 = c0v + mp0 * (bf_lo(wp) - c0v) + mn0 * (bf_lo(wn) - c0v), z1 = c1v + mp1 * (bf_hi(wp) - c1v) + mn1 * (bf_hi(wn) - c1v);
          *(unsigned*)(sg + (size_t)t * 256 + c) = pk_bf16(sigmoidf_(z0), sigmoidf_(z1)); *(unsigned*)(sg + (size_t)t * 256 + 128 + c) = 0u; }
        { const int c = lane * 8, gi = lane >> 4, w = 2 << gi; const int lo = max(pos - (w >> 1), 0), hi = min(pos + (w >> 1) - 1, L - 1);
          float sum[8];
#pragma unroll
          for (int j = 0; j < 8; ++j) sum[j] = 0.f;
          u32x4 wr_[16];
#pragma unroll
          for (int d = 0; d < 16; ++d) { const int r = pos - 8 + d; wr_[d] = (u32x4){0u, 0u, 0u, 0u}; if (r >= lo && r <= hi) wr_[d] = *(const u32x4*)(zall + (size_t)(tbase + r) * ZLD + c); }
#pragma unroll
          for (int d = 0; d < 16; ++d) { f32x4 a, b; unpack8(wr_[d], a, b);
#pragma unroll
              for (int j = 0; j < 4; ++j) { sum[j] += a[j]; sum[4 + j] += b[j]; } }
          const float icnt = 1.0f / (float)(hi - lo + 1); f32x4 a, b; unpack8(*(const u32x4*)(zr + c), a, b); f32x4 oa, ob;
#pragma unroll
          for (int j = 0; j < 4; ++j) { oa[j] = sum[j] * icnt - a[j]; ob[j] = sum[4 + j] * icnt - b[j]; }
          *(u32x4*)(pooled + (size_t)t * 512 + c) = pack8(oa, ob); }
    }
}

__device__ void final_phase(const Params& p) {
    const int tidx = opaque_tid(); const int lane = tidx & 63, wave = (blockIdx.x * 512 + tidx) >> 6, nw = (gridDim.x * 512) >> 6;
    const float* x2 = (const float*)(p.ws + OFF_X1); const float* rowsq2 = (const float*)(p.ws + OFF_ROWSQ2);
    f32x4 gv[4];
#pragma unroll
    for (int i = 0; i < 4; ++i) gv[i] = *(const f32x4*)(p.g_final + lane * 4 + 256 * i);
    for (int t = wave; t < T_TOK; t += nw) {
        const float rinv = rsqrtf(rowsq2[t] * (1.0f / 1024.0f) + 1e-6f);
#pragma unroll
        for (int i = 0; i < 4; ++i) { const f32x4 v = *(const f32x4*)(x2 + (size_t)t * 1024 + lane * 4 + 256 * i); *(f32x4*)(p.out + (size_t)t * 1024 + lane * 4 + 256 * i) = v * rinv * gv[i]; }
    }
}

__global__ void __launch_bounds__(512, 2) fwd_megakernel(Params p) {
    extern __shared__ __attribute__((aligned(16))) unsigned char shm[];
    unsigned char* ws = p.ws;
    prep_phase(p, shm);
    cg::this_grid().sync();
    { EpiStore E; E.O = (bf16_t*)(ws + OFF_Z); E.ldc = ZLD; run_gemm(shm, (const bf16_t*)(ws + OFF_R1), 1024, (const bf16_t*)(ws + OFF_WIN), 1024, 3840, 1024, E); }
    cg::this_grid().sync();
    scan_phase(p, shm);
    cg::this_grid().sync();
    mix_phase(p);
    cg::this_grid().sync();
    rmsnorm_rows(p, p.g_mix, (bf16_t*)(ws + OFF_XN2));
    { EpiMulInPlace E; E.Y = (bf16_t*)p.out; run_gemm(shm, (const bf16_t*)(ws + OFF_SG), 256, (const bf16_t*)(ws + OFF_WG), 256, 1024, 256, E); }
    cg::this_grid().sync();
    { EpiGates E; E.G = (bf16_t*)(ws + OFF_GATES); E.bias = p.b_gate; run_gemm(shm, (const bf16_t*)(ws + OFF_XN2), 1024, (const bf16_t*)(ws + OFF_WIN) + (size_t)3840 * 1024, 1024, 2048, 1024, E); }
    cg::this_grid().sync();
    { EpiPool E; E.P = (bf16_t*)(ws + OFF_MERGED); E.G = (const bf16_t*)(ws + OFF_GATES); run_gemm(shm, (const bf16_t*)(ws + OFF_POOLED), 512, (const bf16_t*)(ws + OFF_WEFF), 512, 1024, 512, E); }
    { EpiMerge E; E.P = (bf16_t*)(ws + OFF_MERGED); E.G = (const bf16_t*)(ws + OFF_GATES); run_gemm(shm, (const bf16_t*)p.out, 1024, (const bf16_t*)(ws + OFF_WRBR), 1024, 1024, 1024, E); }
    cg::this_grid().sync();
    { EpiOut E; E.xp = p.x_prompt; E.xs = p.x_sample; E.X1 = (float*)(ws + OFF_X1); E.X1B = (bf16_t*)(ws + OFF_X1B); E.rowsq = (float*)(ws + OFF_ROWSQ); run_gemm(shm, (const bf16_t*)(ws + OFF_MERGED), 1024, (const bf16_t*)(ws + OFF_WOUT), 1024, 1024, 1024, E); }
    cg::this_grid().sync();
    { EpiFF1 E; E.Hlo = (bf16_t*)(ws + OFF_HLO); E.Hhi = (bf16_t*)p.out; E.rowsq = (const float*)(ws + OFF_ROWSQ); run_gemm(shm, (const bf16_t*)(ws + OFF_X1B), 1024, (const bf16_t*)(ws + OFF_WFF1), 1024, 4096, 1024, E); }
    cg::this_grid().sync();
    { EpiFinal E; E.X = (float*)(ws + OFF_X1); E.rowsq = (float*)(ws + OFF_ROWSQ2);
      run_gemm(shm, (const bf16_t*)(ws + OFF_HLO), 2048, (const bf16_t*)(ws + OFF_WFF2), 4096, 1024, 4096, E, (const bf16_t*)p.out, 32); }
    cg::this_grid().sync();
    final_phase(p);
}

extern "C" void kernel_launch(void* const* d_in, const int* in_sizes, int n_in, void* d_out, int out_size, void* d_ws, size_t ws_size, hipStream_t stream) {
    constexpr size_t kDynLds = 131072;
    static int grid_blocks = 0;
    if (!grid_blocks) {
        hipFuncSetAttribute((const void*)fwd_megakernel, hipFuncAttributeMaxDynamicSharedMemorySize, (int)kDynLds);
        int dev = 0, cus = 0, per_cu = 0;
        hipGetDevice(&dev);
        hipDeviceGetAttribute(&cus, hipDeviceAttributeMultiprocessorCount, dev);
        hipOccupancyMaxActiveBlocksPerMultiprocessor(&per_cu, fwd_megakernel, 512, kDynLds);
        if (per_cu < 1) per_cu = 1;
        grid_blocks = cus;
    }
    Params p{};
    const float** pf = (const float**)&p;
    for (int i = 0; i < 30; ++i) pf[i] = (const float*)d_in[i];
    p.out = (float*)d_out; p.ws = (unsigned char*)d_ws;
    void* args[] = {&p};
    hipError_t e = hipLaunchCooperativeKernel((const void*)fwd_megakernel, dim3(grid_blocks), dim3(512), args, kDynLds, stream);
    if (e != hipSuccess) fprintf(stderr, "cooperative launch failed: %s (grid %d)\n", hipGetErrorString(e), grid_blocks);
}
```

```cpp
#include <hip/hip_runtime.h>
#include <hip/hip_cooperative_groups.h>
#include <cstdio>
namespace cg = cooperative_groups;

#define LAS __attribute__((address_space(3)))
typedef unsigned short bf16_t;
typedef short bf16x8 __attribute__((ext_vector_type(8)));
typedef float f32x4 __attribute__((ext_vector_type(4)));
typedef float f32x2 __attribute__((ext_vector_type(2)));
typedef unsigned u32x4 __attribute__((ext_vector_type(4)));
typedef unsigned u32x2 __attribute__((ext_vector_type(2)));

constexpr int T_TOK = 98304, DM = 1024, TP = 65536;
constexpr int ZLD = 3840;
constexpr int COL_R = 512, COL_K = 1536, COL_V = 2560, COL_W = 3584, COL_A = 3648, COL_G = 3712;
constexpr size_t MiB = 1ull << 20;
constexpr size_t OFF_WIN = 0, OFF_WEFF = 12 * MiB, OFF_WRBR = 13 * MiB, OFF_WOUT = 15 * MiB, OFF_WFF1 = 17 * MiB, OFF_WFF2 = 25 * MiB, OFF_WG = 33 * MiB;
constexpr size_t OFF_ROWSQ = 34 * MiB, OFF_ROWSQ2 = 34 * MiB + 512 * 1024, OFF_QUEUE = 35 * MiB, OFF_BONUS = 36 * MiB;
constexpr size_t OFF_R1 = 48 * MiB, OFF_Z = 240 * MiB;
constexpr size_t OFF_POOLED = OFF_R1, OFF_SG = OFF_R1 + 96 * MiB, OFF_XN2 = OFF_Z, OFF_GATES = OFF_Z + 192 * MiB, OFF_MERGED = OFF_Z + 576 * MiB;
constexpr size_t OFF_X1B = OFF_R1, OFF_X1 = OFF_Z, OFF_HLO = OFF_Z + 384 * MiB;
constexpr size_t U_BYTES = (size_t)T_TOK * 1024 * 2;

struct Params {
    const float *x_prompt, *x_sample, *g_mix, *w_in, *b_gate, *mu_prev, *mu_next, *pool_w, *pool_scale, *w_pool_br, *k_k, *k_a, *r_k,
        *w0_f, *w_up_f, *a0_f, *a_up_f, *w0_b, *w_up_b, *a0_b, *a_up_b, *g_up, *ln_w, *ln_b, *w_rwkv_br, *w_out, *g_ffn, *w_ff1, *w_ff2, *g_final;
    float* out; unsigned char* ws;
};

__device__ __forceinline__ float bf_lo(unsigned w) { return __uint_as_float(w << 16); }
__device__ __forceinline__ float bf_hi(unsigned w) { return __uint_as_float(w & 0xFFFF0000u); }
typedef __bf16 bf16x2_t __attribute__((ext_vector_type(2)));
__device__ __forceinline__ unsigned pk_bf16(float lo, float hi) { f32x2 v = {lo, hi}; bf16x2_t b = __builtin_convertvector(v, bf16x2_t); return __builtin_bit_cast(unsigned, b); }
__device__ __forceinline__ float sigmoidf_(float x) { return __builtin_amdgcn_rcpf(1.0f + __expf(-x)); }
__device__ __forceinline__ float fma_s(float a, float b, float c) { float d; asm("v_fma_f32 %0, %1, %2, %3" : "=v"(d) : "v"(a), "v"(b), "v"(c)); return d; }
__device__ __forceinline__ float mul_s(float a, float b) { float d; asm("v_mul_f32 %0, %1, %2" : "=v"(d) : "v"(a), "v"(b)); return d; }
__device__ __forceinline__ float add_s(float a, float b) { float d; asm("v_add_f32 %0, %1, %2" : "=v"(d) : "v"(a), "v"(b)); return d; }
#define DPPA(x, c) "v_add_f32_dpp " x ", " x ", " x " " c " row_mask:0xf bank_mask:0xf bound_ctrl:1\n"
#define DPP4(c) DPPA("%0", c) DPPA("%1", c) DPPA("%2", c) DPPA("%3", c)
#define DPP2(c) DPPA("%0", c) DPPA("%1", c) "s_nop 0\n"
__device__ __forceinline__ void red16x4(float& a, float& b, float& c, float& d) {
    asm("s_nop 1\n" DPP4("quad_perm:[1,0,3,2]") DPP4("quad_perm:[2,3,0,1]") DPP4("row_half_mirror") DPP4("row_mirror") : "+v"(a), "+v"(b), "+v"(c), "+v"(d)); }
__device__ __forceinline__ void red16x2(float& a, float& b) {
    asm("s_nop 1\n" DPP2("quad_perm:[1,0,3,2]") DPP2("quad_perm:[2,3,0,1]") DPP2("row_half_mirror") DPP2("row_mirror") : "+v"(a), "+v"(b)); }
__device__ __forceinline__ void row_dots(const float (&s)[4], const f32x4 a, const f32x4 q, float& sa, float& yp) {
    asm("v_mul_f32 %0, %2, %6\n v_mul_f32 %1, %2, %10\n v_fma_f32 %0, %3, %7, %0\n v_fma_f32 %1, %3, %11, %1\n v_fma_f32 %0, %4, %8, %0\n v_fma_f32 %1, %4, %12, %1\n v_fma_f32 %0, %5, %9, %0\n v_fma_f32 %1, %5, %13, %1"
        : "=&v"(sa), "=&v"(yp) : "v"(s[0]), "v"(s[1]), "v"(s[2]), "v"(s[3]), "v"(a[0]), "v"(a[1]), "v"(a[2]), "v"(a[3]), "v"(q[0]), "v"(q[1]), "v"(q[2]), "v"(q[3])); }
__device__ __forceinline__ void row_update(float (&s)[4], const f32x4 w, const f32x4 b, const f32x4 k, float v, float sa, float yp, float bkx, float bky, float& y) {
    float t0, t1, t2, t3;
    asm("v_mul_f32 %5, %9, %18\n v_mul_f32 %6, %9, %19\n v_mul_f32 %7, %9, %20\n v_mul_f32 %8, %9, %21\n"
        "v_fma_f32 %5, %10, %14, %5\n v_fma_f32 %6, %10, %15, %6\n v_fma_f32 %7, %10, %16, %7\n v_fma_f32 %8, %10, %17, %8\n"
        "v_fma_f32 %4, %10, %12, %11\n"
        "v_fma_f32 %0, %0, %22, %5\n v_fma_f32 %1, %1, %23, %6\n v_fma_f32 %2, %2, %24, %7\n v_fma_f32 %3, %3, %25, %8\n"
        "v_fma_f32 %4, %9, %13, %4"
        : "+v"(s[0]), "+v"(s[1]), "+v"(s[2]), "+v"(s[3]), "=&v"(y), "=&v"(t0), "=&v"(t1), "=&v"(t2), "=&v"(t3)
        : "v"(v), "v"(sa), "v"(yp), "v"(bkx), "v"(bky), "v"(b[0]), "v"(b[1]), "v"(b[2]), "v"(b[3]), "v"(k[0]), "v"(k[1]), "v"(k[2]), "v"(k[3]), "v"(w[0]), "v"(w[1]), "v"(w[2]), "v"(w[3])); }
__device__ __forceinline__ void shift4(float (&z)[4], const float (&c)[4], const float (&pv)[4], const float (&nx)[4], const f32x4 m0, const f32x4 mp, const f32x4 mn) {
    asm("v_mul_f32 %0, %4, %16\n v_mul_f32 %1, %5, %17\n v_mul_f32 %2, %6, %18\n v_mul_f32 %3, %7, %19\n"
        "v_fma_f32 %0, %8, %20, %0\n v_fma_f32 %1, %9, %21, %1\n v_fma_f32 %2, %10, %22, %2\n v_fma_f32 %3, %11, %23, %3\n"
        "v_fma_f32 %0, %12, %24, %0\n v_fma_f32 %1, %13, %25, %1\n v_fma_f32 %2, %14, %26, %2\n v_fma_f32 %3, %15, %27, %3"
        : "=&v"(z[0]), "=&v"(z[1]), "=&v"(z[2]), "=&v"(z[3])
        : "v"(c[0]), "v"(c[1]), "v"(c[2]), "v"(c[3]), "v"(pv[0]), "v"(pv[1]), "v"(pv[2]), "v"(pv[3]), "v"(nx[0]), "v"(nx[1]), "v"(nx[2]), "v"(nx[3]),
          "v"(m0[0]), "v"(m0[1]), "v"(m0[2]), "v"(m0[3]), "v"(mp[0]), "v"(mp[1]), "v"(mp[2]), "v"(mp[3]), "v"(mn[0]), "v"(mn[1]), "v"(mn[2]), "v"(mn[3])); }
__device__ __forceinline__ void kk4(float (&kk)[4], float& ss, const float (&k)[4], const f32x4 c) {
    asm("v_mul_f32 %0, %5, %9\n v_mul_f32 %1, %6, %10\n v_mul_f32 %2, %7, %11\n v_mul_f32 %3, %8, %12\n"
        "v_mul_f32 %4, %0, %0\n v_fma_f32 %4, %1, %1, %4\n v_fma_f32 %4, %2, %2, %4\n v_fma_f32 %4, %3, %3, %4"
        : "=&v"(kk[0]), "=&v"(kk[1]), "=&v"(kk[2]), "=&v"(kk[3]), "=&v"(ss) : "v"(k[0]), "v"(k[1]), "v"(k[2]), "v"(k[3]), "v"(c[0]), "v"(c[1]), "v"(c[2]), "v"(c[3])); }
template <int CTRL> __device__ __forceinline__ float dppf(float x) { return __int_as_float(__builtin_amdgcn_update_dpp(0, __float_as_int(x), CTRL, 0xF, 0xF, true)); }
__device__ __forceinline__ float red4(float x) { x += dppf<0xB1>(x); x += dppf<0x4E>(x); return x; }
__device__ __forceinline__ float red8(float x) { x = red4(x); x += dppf<0x141>(x); return x; }
__device__ __forceinline__ float red16(float x) { x = red8(x); x += dppf<0x140>(x); return x; }
__device__ __forceinline__ int opaque_tid() { int t = threadIdx.x; asm volatile("" : "+v"(t)); return t; }
__device__ __forceinline__ const float* xrow(const Params& p, int t) { return t < TP ? p.x_prompt + (size_t)t * DM : p.x_sample + (size_t)(t - TP) * DM; }
__device__ __forceinline__ void seq_of(int t, int& base, int& len) { if (t < TP) { base = t & ~2047; len = 2048; } else { base = TP + ((t - TP) & ~16383); len = 16384; } }

namespace pg8 {
constexpr int BM = 256, BK = 64, HALF = 128, HTB = HALF * BK * 2, STAGE_BYTES = 8 * HTB, NXCD = 8, WGM = 8;
__device__ __forceinline__ int lds_byte(int r, int c) { const int st = (r >> 4) * 2 + (c >> 5), rr = r & 15, cc = c & 31, ob = rr * 64 + cc * 2; return st * 1024 + (ob ^ (((ob >> 9) & 1) << 5)); }
__device__ __forceinline__ void stage_rc(int b, int& R, int& C) { const int st = b / 1024, sb = b % 1024, swz = sb ^ (((sb >> 9) & 1) << 5); R = (st >> 1) * 16 + swz / 64; C = (st & 1) * 32 + (swz % 64) / 2; }
__device__ __forceinline__ int perm32(int rho) { const int n = rho >> 4, i = rho & 15; return 8 * (i >> 2) + 4 * n + (i & 3); }
struct Unit { int pm, pn; };
struct Gemm { const bf16_t* A; const bf16_t* Bt; int M, N, K, lda, ldb; const bf16_t* A2; int ks; };
struct StaticOrder {
    int nM, nN, nwg, G, c;
    __device__ void init(int M, int N, int G_, int c_) { nM = M / BM; nN = N / BM; nwg = nM * nN; G = G_; c = c_; }
    __device__ bool next(int i, Unit& u) const {
        const long L = (long)i * G + c; if (L >= nwg) return false;
        int wgid = (int)L; { const int q = nwg / NXCD, r = nwg % NXCD, xcd = wgid % NXCD, off = wgid / NXCD; wgid = (xcd < r ? xcd * (q + 1) : r * (q + 1) + (xcd - r) * q) + off; }
        const int nig = WGM * nN, gid = wgid / nig, fm = gid * WGM, gsz = (nM - fm) < WGM ? (nM - fm) : WGM;
        u.pm = fm + ((wgid % nig) % gsz); u.pn = (wgid % nig) / gsz; return true;
    }
};

template <class Epi>
__device__ __forceinline__ void gemm_phase(LAS unsigned char* lds, const Gemm g, const StaticOrder& S, const Epi& E) {
    const int tid = opaque_tid();
    const int wid = __builtin_amdgcn_readfirstlane(tid >> 6), lane = tid & 63, wr = wid >> 2, wc = wid & 3, fr = lane & 15, fq = lane >> 4;
    const int K = g.K, nt = K / BK;
    unsigned voffA[2], voffB[2];
#pragma unroll
    for (int i = 0; i < 2; ++i) { int R, C; stage_rc(tid * 16 + i * 8192, R, C); const int Rb = (R & ~31) + perm32(R & 31);
        voffA[i] = (unsigned)(R * g.lda + C) * 2u; voffB[i] = (unsigned)(Rb * g.ldb + C) * 2u; }
    const size_t kstep = (size_t)(BK * 2);
    const size_t hstepA = (size_t)HALF * g.lda * 2, hstepB = (size_t)HALF * g.ldb * 2;
    const size_t tstepA = 2 * hstepA, tstepB = 2 * hstepB;
    const unsigned ldsw = (unsigned)wid * 1024u;
    const int aoff = lds_byte(wr * 64 + fr, fq * 8), boff = lds_byte(wc * 32 + fr, fq * 8);
#define PG8_SA(b, h) (((b) * 2 + (h)) * HTB)
#define PG8_SB(b, h) ((4 + (b) * 2 + (h)) * HTB)
#define PG8_STAGE(bufoff, gbase, voff) do { _Pragma("unroll") for (int _i = 0; _i < 2; ++_i) \
        __builtin_amdgcn_global_load_lds((const unsigned*)((const char*)(gbase) + (voff)[_i]), (LAS unsigned*)(lds + (bufoff) + ldsw + _i * 8192), 16, 0, 0); } while (0)
#define PG8_LDA(dst, b, h) do { _Pragma("unroll") for (int m = 0; m < 4; ++m) _Pragma("unroll") for (int k = 0; k < 2; ++k) dst[m][k] = *(const LAS bf16x8*)(lds + PG8_SA(b, h) + aoff + m * 2048 + k * 1024); } while (0)
#define PG8_LDB(dst, b, h) do { _Pragma("unroll") for (int n = 0; n < 2; ++n) _Pragma("unroll") for (int k = 0; k < 2; ++k) dst[n][k] = *(const LAS bf16x8*)(lds + PG8_SB(b, h) + boff + n * 2048 + k * 1024); } while (0)
#define PG8_MMA(ai, bj, At, Bt) do { __builtin_amdgcn_s_setprio(1); _Pragma("unroll") for (int m = 0; m < 4; ++m) _Pragma("unroll") for (int n = 0; n < 2; ++n) _Pragma("unroll") for (int k = 0; k < 2; ++k) \
        acc[ai][bj][m][n] = __builtin_amdgcn_mfma_f32_16x16x32_bf16(Bt[n][k], At[m][k], acc[ai][bj][m][n], 0, 0, 0); __builtin_amdgcn_s_setprio(0); } while (0)
#define PG8_WAIT_V(n) asm volatile("s_waitcnt vmcnt(" #n ")" ::: "memory")
#define PG8_WAIT_L(n) asm volatile("s_waitcnt lgkmcnt(" #n ")" ::: "memory")
#define PG8_BAR __builtin_amdgcn_s_barrier()
#define PG8_SCHED __builtin_amdgcn_sched_barrier(0)
    Unit cur, nxt; int ui = 0;
    if (!S.next(0, cur)) return;
    f32x4 acc[2][2][4][2];
#pragma unroll
    for (int a = 0; a < 2; ++a)
#pragma unroll
        for (int b = 0; b < 2; ++b)
#pragma unroll
            for (int m = 0; m < 4; ++m)
#pragma unroll
                for (int n = 0; n < 2; ++n) acc[a][b][m][n] = (f32x4){0.f, 0.f, 0.f, 0.f};
    bf16x8 At[4][2], B0[2][2], B1[2][2];
    const char* cA = (const char*)g.A + (size_t)cur.pm * tstepA; const char* cB = (const char*)g.Bt + (size_t)cur.pn * tstepB;
    const bool two = g.A2 != nullptr; const int ks = two ? g.ks : (1 << 30);
    const char* cA2 = two ? (const char*)g.A2 + (size_t)cur.pm * tstepA : cA;
    PG8_STAGE(PG8_SB(0, 0), cB, voffB); PG8_STAGE(PG8_SA(0, 0), cA, voffA); PG8_STAGE(PG8_SB(0, 1), cB + hstepB, voffB); PG8_STAGE(PG8_SA(0, 1), cA + hstepA, voffA);
    if (wr == 1) PG8_BAR;
    PG8_WAIT_V(4); PG8_BAR;
    PG8_STAGE(PG8_SB(1, 0), cB + kstep, voffB); PG8_STAGE(PG8_SA(1, 0), cA + kstep, voffA); PG8_STAGE(PG8_SB(1, 1), cB + hstepB + kstep, voffB);
    PG8_WAIT_V(6); PG8_BAR;
    for (;;) {
        const bool has_next = S.next(ui + 1, nxt);
        const char* nA = has_next ? (const char*)g.A + (size_t)nxt.pm * tstepA : cA; const char* nB = has_next ? (const char*)g.Bt + (size_t)nxt.pn * tstepB : cB;
        const char* nA2 = (two && has_next) ? (const char*)g.A2 + (size_t)nxt.pm * tstepA : cA2;
#pragma unroll 1
        for (int t = 0; t < nt; t += 2) {
            const bool last = (t == nt - 2);
            const char* a1 = (t + 1 < ks) ? cA + (size_t)(t + 1) * kstep : cA2 + (size_t)(t + 1 - ks) * kstep;
            const char* a2 = last ? nA : ((t + 2 < ks) ? cA + (size_t)(t + 2) * kstep : cA2 + (size_t)(t + 2 - ks) * kstep); const char* b2 = last ? nB : cB + (size_t)(t + 2) * kstep;
            const char* a3 = a2 + kstep; const char* b3 = b2 + kstep;
            PG8_LDB(B0, 0, 0); PG8_SCHED; PG8_LDA(At, 0, 0); PG8_STAGE(PG8_SA(1, 1), a1 + hstepA, voffA);
            PG8_WAIT_L(8); PG8_BAR; PG8_WAIT_L(0); PG8_MMA(0, 0, At, B0); PG8_BAR; PG8_SCHED;
            PG8_LDB(B1, 0, 1); PG8_STAGE(PG8_SB(0, 0), b2, voffB);
            PG8_BAR; PG8_WAIT_L(0); PG8_MMA(0, 1, At, B1); PG8_BAR;
            PG8_LDA(At, 0, 1); PG8_STAGE(PG8_SA(0, 0), a2, voffA);
            PG8_BAR; PG8_WAIT_L(0); PG8_MMA(1, 0, At, B0); PG8_BAR; PG8_SCHED;
            PG8_STAGE(PG8_SB(0, 1), b2 + hstepB, voffB);
            PG8_WAIT_V(6); PG8_BAR; PG8_MMA(1, 1, At, B1); PG8_BAR;
            PG8_LDB(B0, 1, 0); PG8_SCHED; PG8_LDA(At, 1, 0); PG8_STAGE(PG8_SA(0, 1), a2 + hstepA, voffA);
            PG8_WAIT_L(8); PG8_BAR; PG8_WAIT_L(0); PG8_MMA(0, 0, At, B0); PG8_BAR; PG8_SCHED;
            PG8_LDB(B1, 1, 1); PG8_STAGE(PG8_SB(1, 0), b3, voffB);
            PG8_BAR; PG8_WAIT_L(0); PG8_MMA(0, 1, At, B1); PG8_BAR;
            PG8_LDA(At, 1, 1); PG8_STAGE(PG8_SA(1, 0), a3, voffA);
            PG8_BAR; PG8_WAIT_L(0); PG8_MMA(1, 0, At, B0); PG8_BAR; PG8_SCHED;
            PG8_STAGE(PG8_SB(1, 1), b3 + hstepB, voffB);
            PG8_WAIT_V(6); PG8_BAR; PG8_MMA(1, 1, At, B1); PG8_BAR;
        }
        E(acc, cur, wr, wc, fr, fq);
        if (!has_next) break;
#pragma unroll
        for (int a = 0; a < 2; ++a)
#pragma unroll
            for (int b = 0; b < 2; ++b)
#pragma unroll
                for (int m = 0; m < 4; ++m)
#pragma unroll
                    for (int n = 0; n < 2; ++n) acc[a][b][m][n] = (f32x4){0.f, 0.f, 0.f, 0.f};
        cur = nxt; cA = nA; cA2 = nA2; cB = nB; ++ui;
    }
    PG8_WAIT_V(0);
    if (wr == 0) PG8_BAR;
    PG8_BAR;
#undef PG8_SA
#undef PG8_SB
#undef PG8_STAGE
#undef PG8_LDA
#undef PG8_LDB
#undef PG8_MMA
#undef PG8_WAIT_V
#undef PG8_WAIT_L
#undef PG8_BAR
#undef PG8_SCHED
}
}
using pg8::Unit;

#define EPI_LOOP_BEGIN const int row0 = u.pm * 256 + wr * 64 + fr, col0 = u.pn * 256 + wc * 32 + 8 * fq; \
    _Pragma("unroll") for (int ai = 0; ai < 2; ++ai) _Pragma("unroll") for (int m = 0; m < 4; ++m) { const int row = row0 + ai * 128 + m * 16;
#define EPI_BJ _Pragma("unroll") for (int bj = 0; bj < 2; ++bj) { const int col = col0 + bj * 128; const f32x4 v0 = acc[ai][bj][m][0], v1 = acc[ai][bj][m][1];
#define EPI_ACC const f32x4 (&acc)[2][2][4][2], const Unit& u, int wr, int wc, int fr, int fq

__device__ __forceinline__ u32x4 pack8(const f32x4 a, const f32x4 b) { u32x4 w; w.x = pk_bf16(a[0], a[1]); w.y = pk_bf16(a[2], a[3]); w.z = pk_bf16(b[0], b[1]); w.w = pk_bf16(b[2], b[3]); return w; }
__device__ __forceinline__ void unpack8(const u32x4 w, f32x4& a, f32x4& b) { a = (f32x4){bf_lo(w.x), bf_hi(w.x), bf_lo(w.y), bf_hi(w.y)}; b = (f32x4){bf_lo(w.z), bf_hi(w.z), bf_lo(w.w), bf_hi(w.w)}; }

struct EpiStore {
    bf16_t* O; int ldc;
    __device__ __forceinline__ void operator()(EPI_ACC) const { EPI_LOOP_BEGIN EPI_BJ *(u32x4*)(O + (size_t)row * ldc + col) = pack8(v0, v1); } } }
};
struct EpiMulInPlace {
    bf16_t* Y;
    __device__ __forceinline__ void operator()(EPI_ACC) const { EPI_LOOP_BEGIN if ((m & 1) == 0) __builtin_amdgcn_sched_barrier(0);
        EPI_BJ u32x4* ptr = (u32x4*)(Y + (size_t)row * 1024 + col); f32x4 a, b; unpack8(*ptr, a, b); *ptr = pack8(a * v0, b * v1); } } }
};
struct EpiGates {
    bf16_t* G; const float* bias;
    __device__ __forceinline__ void operator()(EPI_ACC) const { EPI_LOOP_BEGIN EPI_BJ
        const f32x4 b0 = *(const f32x4*)(bias + col), b1 = *(const f32x4*)(bias + col + 4); f32x4 a, b;
#pragma unroll
        for (int j = 0; j < 4; ++j) { a[j] = sigmoidf_(v0[j] + b0[j]); b[j] = sigmoidf_(v1[j] + b1[j]); }
        *(u32x4*)(G + (size_t)row * 2048 + col) = pack8(a, b); } } }
};
struct EpiPool {
    bf16_t* P; const bf16_t* G;
    __device__ __forceinline__ void operator()(EPI_ACC) const { EPI_LOOP_BEGIN EPI_BJ f32x4 a, b; unpack8(*(const u32x4*)(G + (size_t)row * 2048 + col), a, b);
        *(u32x4*)(P + (size_t)row * 1024 + col) = pack8(a * v0, b * v1); } } }
};
struct EpiMerge {
    bf16_t* P; const bf16_t* G;
    __device__ __forceinline__ void operator()(EPI_ACC) const { EPI_LOOP_BEGIN EPI_BJ f32x4 a, b, pa, pb; unpack8(*(const u32x4*)(G + (size_t)row * 2048 + 1024 + col), a, b);
        u32x4* ptr = (u32x4*)(P + (size_t)row * 1024 + col); unpack8(*ptr, pa, pb); *ptr = pack8(pa + a * v0, pb + b * v1); } } }
};
struct EpiOut {
    const float* xp; const float* xs; float* X1; bf16_t* X1B; float* rowsq;
    __device__ __forceinline__ void operator()(EPI_ACC) const { EPI_LOOP_BEGIN const float* xr = row < TP ? xp + (size_t)row * DM : xs + (size_t)(row - TP) * DM; float ss = 0.f; EPI_BJ
        f32x4 a = *(const f32x4*)(xr + col) + v0, b = *(const f32x4*)(xr + col + 4) + v1;
        *(f32x4*)(X1 + (size_t)row * 1024 + col) = a; *(f32x4*)(X1 + (size_t)row * 1024 + col + 4) = b; *(u32x4*)(X1B + (size_t)row * 1024 + col) = pack8(a, b);
#pragma unroll
        for (int j = 0; j < 4; ++j) ss += a[j] * a[j] + b[j] * b[j]; }
        ss += __shfl_xor(ss, 16); ss += __shfl_xor(ss, 32); if (fq == 0) atomicAdd(rowsq + row, ss); } }
};
struct EpiFF1 {
    bf16_t* Hlo; bf16_t* Hhi; const float* rowsq;
    __device__ __forceinline__ void operator()(EPI_ACC) const { bf16_t* H = u.pn < 8 ? Hlo : Hhi; const int cshift = u.pn < 8 ? 0 : 2048;
        EPI_LOOP_BEGIN const float rinv = rsqrtf(rowsq[row] * (1.0f / 1024.0f) + 1e-6f); EPI_BJ f32x4 a, b;
#pragma unroll
        for (int j = 0; j < 4; ++j) { float t0 = fmaxf(v0[j] * rinv, 0.f), t1 = fmaxf(v1[j] * rinv, 0.f); a[j] = t0 * t0; b[j] = t1 * t1; }
        *(u32x4*)(H + (size_t)row * 2048 + (col - cshift)) = pack8(a, b); } } }
};
struct EpiAddInPlace {
    float* X;
    __device__ __forceinline__ void operator()(EPI_ACC) const { EPI_LOOP_BEGIN EPI_BJ f32x4* ptr = (f32x4*)(X + (size_t)row * 1024 + col); ptr[0] = ptr[0] + v0; ptr[1] = ptr[1] + v1; } } }
};
struct EpiFinal {
    float* X; float* rowsq;
    __device__ __forceinline__ void operator()(EPI_ACC) const { EPI_LOOP_BEGIN float ss = 0.f; EPI_BJ f32x4* ptr = (f32x4*)(X + (size_t)row * 1024 + col); const f32x4 a = ptr[0] + v0, b = ptr[1] + v1; ptr[0] = a; ptr[1] = b;
#pragma unroll
        for (int j = 0; j < 4; ++j) ss += a[j] * a[j] + b[j] * b[j]; }
        ss += __shfl_xor(ss, 16); ss += __shfl_xor(ss, 32); if (fq == 0) atomicAdd(rowsq + row, ss); } }
};

template <class Epi>
__device__ __forceinline__ void run_gemm(unsigned char* shm, const bf16_t* A, int lda, const bf16_t* Bt, int ldb, int N, int K, const Epi& E, const bf16_t* A2 = nullptr, int ks = 0) {
    pg8::Gemm g; g.A = A; g.Bt = Bt; g.M = T_TOK; g.N = N; g.K = K; g.lda = lda; g.ldb = ldb; g.A2 = A2; g.ks = ks;
    pg8::StaticOrder S; S.init(T_TOK, N, (int)gridDim.x, (int)blockIdx.x);
    pg8::gemm_phase<Epi>((LAS unsigned char*)shm, g, S, E);
}

__device__ void transpose_cvt(unsigned char* shm, const float* src, int K, int N, bf16_t* dst, int ldd, const float* kscale) {
    float* tile = (float*)shm;
    const int tid = opaque_tid(), ntk = K / 64, ntn = N / 64;
    for (int t = blockIdx.x; t < ntk * ntn; t += gridDim.x) {
        const int tk = t / ntn, tn = t % ntn;
#pragma unroll
        for (int i = 0; i < 8; ++i) { const int kl = (tid >> 6) + 8 * i, nl = tid & 63; const int k = tk * 64 + kl;
            tile[kl * 65 + nl] = src[(size_t)k * N + tn * 64 + nl] * (kscale ? kscale[k] : 1.0f); }
        __syncthreads();
#pragma unroll
        for (int i = 0; i < 8; ++i) { const int nl = (tid >> 6) + 8 * i, kl = tid & 63;
            const unsigned w = pk_bf16(tile[kl * 65 + nl], 0.f); dst[(size_t)(tn * 64 + nl) * ldd + tk * 64 + kl] = (bf16_t)(w & 0xFFFFu); }
        __syncthreads();
    }
}

__device__ void rmsnorm_rows(const Params& p, const float* g, bf16_t* dst) {
    const int tidx = opaque_tid(); const int lane = tidx & 63, wave = (blockIdx.x * 512 + tidx) >> 6, nw = (gridDim.x * 512) >> 6;
    f32x4 gv[4];
#pragma unroll
    for (int i = 0; i < 4; ++i) gv[i] = *(const f32x4*)(g + lane * 4 + 256 * i);
    for (int t = wave; t < T_TOK; t += nw) {
        const float* xr = xrow(p, t); f32x4 v[4]; float ss = 0.f;
#pragma unroll
        for (int i = 0; i < 4; ++i) { v[i] = *(const f32x4*)(xr + lane * 4 + 256 * i); ss += v[i][0] * v[i][0] + v[i][1] * v[i][1] + v[i][2] * v[i][2] + v[i][3] * v[i][3]; }
#pragma unroll
        for (int o = 1; o < 64; o <<= 1) ss += __shfl_xor(ss, o);
        const float rinv = rsqrtf(ss * (1.0f / 1024.0f) + 1e-6f);
#pragma unroll
        for (int i = 0; i < 4; ++i) { u32x2 w; w.x = pk_bf16(v[i][0] * rinv * gv[i][0], v[i][1] * rinv * gv[i][1]); w.y = pk_bf16(v[i][2] * rinv * gv[i][2], v[i][3] * rinv * gv[i][3]);
            *(u32x2*)(dst + (size_t)t * 1024 + lane * 4 + 256 * i) = w; }
    }
}

__device__ void prep_phase(const Params& p, unsigned char* shm) {
    unsigned char* ws = p.ws;
    const int gtid = blockIdx.x * 512 + opaque_tid(), gn = gridDim.x * 512;
    for (int i = gtid; i < T_TOK; i += gn) { ((float*)(ws + OFF_ROWSQ))[i] = 0.f; ((float*)(ws + OFF_ROWSQ2))[i] = 0.f; }
    if (gtid < 64) ((unsigned*)(ws + OFF_QUEUE))[gtid] = 0u;
    transpose_cvt(shm, p.w_in, 1024, 5888, (bf16_t*)(ws + OFF_WIN), 1024, nullptr);
    transpose_cvt(shm, p.w_rwkv_br, 1024, 1024, (bf16_t*)(ws + OFF_WRBR), 1024, nullptr);
    transpose_cvt(shm, p.w_out, 1024, 1024, (bf16_t*)(ws + OFF_WOUT), 1024, nullptr);
    transpose_cvt(shm, p.w_ff1, 1024, 4096, (bf16_t*)(ws + OFF_WFF1), 1024, p.g_ffn);
    transpose_cvt(shm, p.w_ff2, 4096, 1024, (bf16_t*)(ws + OFF_WFF2), 4096, nullptr);
    transpose_cvt(shm, p.g_up, 128, 1024, (bf16_t*)(ws + OFF_WG), 256, nullptr);
    { bf16_t* wg = (bf16_t*)(ws + OFF_WG); for (int i = gtid; i < 1024 * 128; i += gn) wg[(size_t)(i >> 7) * 256 + 128 + (i & 127)] = 0; }
    { bf16_t* we = (bf16_t*)(ws + OFF_WEFF);
      for (int i = gtid; i < 512 * 1024; i += gn) { const int k = i >> 10, n = i & 1023, gI = k >> 7; const float* pw = p.pool_w + (size_t)k * 128; float acc = 0.f;
          for (int d = 0; d < 128; ++d) acc += pw[d] * p.pool_scale[gI * 128 + d] * p.w_pool_br[(size_t)(gI * 128 + d) * 1024 + n];
          we[(size_t)n * 512 + k] = (bf16_t)(pk_bf16(acc, 0.f) & 0xFFFFu); } }
    rmsnorm_rows(p, p.g_mix, (bf16_t*)(ws + OFF_R1));
}

#define LDS_BAR() do { asm volatile("s_waitcnt lgkmcnt(0)" ::: "memory"); __builtin_amdgcn_s_barrier(); asm volatile("" ::: "memory"); } while (0)
constexpr int N_SAMPLE_ITEMS = 128, N_ITEMS = N_SAMPLE_ITEMS + 1024;

template <int LPR, int RPL, int DIR>
__device__ __forceinline__ void scan_item(const Params& p, unsigned char* shm, const int tid, const int tbase, const int L, const int h, const int half) {
    constexpr int dir = DIR;
    constexpr int EC = 64 / LPR, RPW = RPL * (64 / LPR);
    float* sW = (float*)shm; float* sAV = sW + 2048; float* sBV = sW + 4096; float* sKD = sW + 6144; float* sWR = sW + 8192; float* sR = sW + 10240; float* sV = sW + 12288; float* sY = sW + 14336;
    float* sBK = sW + 16384;
    bf16_t* sTW = (bf16_t*)(sW + 16384 + 64);
    bf16_t* sZA = sTW + 32 * 72;
    const int lane = tid & 63, wv = tid >> 6;
    const bf16_t* zall = (const bf16_t*)(p.ws + OFF_Z);
    const int tokA = tid >> 4, q = tid & 15;
    const int rowS = half * 32 + wv * RPW + RPL * (lane / LPR), gS = lane % LPR;
    const int NC = L / 32;
    bf16_t* ybuf = (bf16_t*)p.out + (dir ? (size_t)T_TOK * 1024 : 0);
    float* bonus = (float*)(p.ws + OFF_BONUS) + (dir ? (size_t)T_TOK * 16 : 0);
    const float* w_up = dir ? p.w_up_b : p.w_up_f; const float* a_up = dir ? p.a_up_b : p.a_up_f;
    const float* w0 = dir ? p.w0_b : p.w0_f; const float* a0 = dir ? p.a0_b : p.a0_f;
    const int mat = wv >> 2, cbk = wv & 3, colB = cbk * 16 + (lane & 15), quad = lane >> 4;
    u32x4* sBF = (u32x4*)(shm + 84 * 1024);
    { const float* up = mat ? a_up : w_up;
#pragma unroll
      for (int kb = 0; kb < 2; ++kb) { float f[8];
#pragma unroll
          for (int j = 0; j < 8; ++j) f[j] = up[(size_t)(kb * 32 + quad * 8 + j) * 1024 + h * 64 + colB];
          u32x4 w; w.x = pk_bf16(f[0], f[1]); w.y = pk_bf16(f[2], f[3]); w.z = pk_bf16(f[4], f[5]); w.w = pk_bf16(f[6], f[7]); sBF[kb * 512 + tid] = w; } }
    const float c0B = (mat ? a0 : w0)[h * 64 + colB];
    const float kaB = p.k_a[h * 64 + colB];
    int colz[5];
    float* sM0 = (float*)(shm + 100 * 1024);
    float* sMU = (float*)(shm + 76 * 1024);
#pragma unroll
    for (int gi = 0; gi < 5; ++gi) colz[gi] = (gi == 0 ? COL_R + h * 64 : gi == 1 ? COL_K + h * 64 : gi == 2 ? COL_V + h * 64 : gi == 3 ? COL_W : COL_A) + 4 * q;
    if (tid < 320) { const int gi = tid >> 6, c = tid & 63; const int col = (gi == 0 ? COL_R + h * 64 : gi == 1 ? COL_K + h * 64 : gi == 2 ? COL_V + h * 64 : gi == 3 ? COL_W : COL_A) + c - COL_R;
        const float mpv_ = p.mu_prev[col], mnv_ = p.mu_next[col]; sMU[gi * 64 + c] = mpv_; sMU[320 + gi * 64 + c] = mnv_; sM0[gi * 64 + c] = 1.0f - mpv_ - mnv_; }
    else if (tid < 384) sMU[640 + (tid - 320)] = p.k_k[h * 64 + (tid - 320)];
    else if (tid < 448) sMU[704 + (tid - 384)] = p.r_k[h * 64 + (tid - 384)];
    __syncthreads();
    float s[RPL][EC];
#pragma unroll
    for (int r = 0; r < RPL; ++r)
#pragma unroll
        for (int j = 0; j < EC; ++j) s[r][j] = 0.f;
    u32x2 zc[5], zp[5], zn[5];
    auto load_chunk = [&](int ci) {
        const int t = tbase + 32 * (dir ? NC - 1 - ci : ci) + tokA; const bool hasPrev = t > tbase, hasNext = t < tbase + L - 1;
        const bf16_t* zr = zall + (size_t)t * ZLD;
#pragma unroll
        for (int gi = 0; gi < 5; ++gi) { zc[gi] = *(const u32x2*)(zr + colz[gi]); zp[gi] = (u32x2){0u, 0u}; zn[gi] = (u32x2){0u, 0u};
            if (hasPrev) zp[gi] = *(const u32x2*)(zr - ZLD + colz[gi]);
            if (hasNext) zn[gi] = *(const u32x2*)(zr + ZLD + colz[gi]); }
    };
    load_chunk(0);
    for (int ci = 0; ci < NC; ++ci) {
        const int t0 = tbase + 32 * (dir ? NC - 1 - ci : ci);
        { float zs[5][4];
#pragma unroll
          for (int gi = 0; gi < 5; ++gi) {
              const float c[4] = {bf_lo(zc[gi].x), bf_hi(zc[gi].x), bf_lo(zc[gi].y), bf_hi(zc[gi].y)}, pv[4] = {bf_lo(zp[gi].x), bf_hi(zp[gi].x), bf_lo(zp[gi].y), bf_hi(zp[gi].y)}, nx[4] = {bf_lo(zn[gi].x), bf_hi(zn[gi].x), bf_lo(zn[gi].y), bf_hi(zn[gi].y)};
              const f32x4 mp = *(const f32x4*)(sMU + gi * 64 + 4 * q), mn = *(const f32x4*)(sMU + 320 + gi * 64 + 4 * q), m0 = *(const f32x4*)(sM0 + gi * 64 + 4 * q);
              shift4(zs[gi], c, pv, nx, m0, mp, mn);
          }
          if (ci + 1 < NC) load_chunk(ci + 1);
          *(f32x4*)(sR + tokA * 64 + 4 * q) = (f32x4){zs[0][0], zs[0][1], zs[0][2], zs[0][3]};
          *(f32x4*)(sKD + tokA * 64 + 4 * q) = (f32x4){zs[1][0], zs[1][1], zs[1][2], zs[1][3]};
          *(f32x4*)(sV + tokA * 64 + 4 * q) = (f32x4){zs[2][0], zs[2][1], zs[2][2], zs[2][3]};
          float kk[4], ss; const f32x4 kk4c = *(const f32x4*)(sMU + 640 + 4 * q);
          kk4(kk, ss, zs[1], kk4c);
          ss = ss + 0.0f * kk[0];
          ss = red16(ss);
          const float inv = -__builtin_amdgcn_rsqf(fmaxf(ss, 1e-24f));
          *(f32x4*)(sAV + tokA * 64 + 4 * q) = (f32x4){kk[0] * inv, kk[1] * inv, kk[2] * inv, kk[3] * inv};
          float tw[4];
#pragma unroll
          for (int j = 0; j < 4; ++j) tw[j] = 1.0f - 2.0f * __builtin_amdgcn_rcpf(1.0f + __expf(2.0f * zs[3][j]));
          u32x2 w; w.x = pk_bf16(tw[0], tw[1]); w.y = pk_bf16(tw[2], tw[3]); *(u32x2*)(sTW + tokA * 72 + 4 * q) = w;
          w.x = pk_bf16(zs[4][0], zs[4][1]); w.y = pk_bf16(zs[4][2], zs[4][3]); *(u32x2*)(sZA + tokA * 72 + 4 * q) = w;
        }
        LDS_BAR();
        { const bf16_t* sX = mat ? sZA : sTW;
#pragma unroll
          for (int rb = 0; rb < 2; ++rb) {
              f32x4 acc = (f32x4){0.f, 0.f, 0.f, 0.f};
#pragma unroll
              for (int kb = 0; kb < 2; ++kb) { const bf16x8 af = *(const bf16x8*)(sX + (rb * 16 + (lane & 15)) * 72 + kb * 32 + quad * 8);
                  acc = __builtin_amdgcn_mfma_f32_16x16x32_bf16(af, __builtin_bit_cast(bf16x8, sBF[kb * 512 + tid]), acc, 0, 0, 0); }
#pragma unroll
              for (int j = 0; j < 4; ++j) { const int idx = (rb * 16 + quad * 4 + j) * 64 + colB; const float pre = c0B + acc[j];
                  if (mat == 0) { const float w = __expf(-0.6065306597f * sigmoidf_(pre)); sW[idx] = w; sWR[idx] = w * sR[idx]; }
                  else { const float a = sigmoidf_(pre); const float k = sKD[idx]; sKD[idx] = k * (1.0f + (a - 1.0f) * kaB); sBV[idx] = -sAV[idx] * a; } }
          } }
        LDS_BAR();
        { const f32x4 r4 = *(const f32x4*)(sR + tokA * 64 + 4 * q), b4 = *(const f32x4*)(sBV + tokA * 64 + 4 * q), k4 = *(const f32x4*)(sKD + tokA * 64 + 4 * q);
          float br = 0.f, kr = 0.f, cb = 0.f; const f32x4 rk4 = *(const f32x4*)(sMU + 704 + 4 * q);
#pragma unroll
          for (int j = 0; j < 4; ++j) { br += b4[j] * r4[j]; kr += k4[j] * r4[j]; cb += r4[j] * k4[j] * rk4[j]; }
          br = red16(br); kr = red16(kr); cb = red16(cb);
          if (q == 0) { sBK[tokA * 2] = br; sBK[tokA * 2 + 1] = kr; if (half == 0) bonus[(size_t)(t0 + tokA) * 16 + h] = cb; } }
        LDS_BAR();
        {
            constexpr int NV = EC / 4;
            struct Ops { f32x4 w[NV], a[NV], b[NV], k[NV], q[NV]; float v[RPL]; f32x2 bk; };
            auto ld = [&](Ops& o, int i) { const int tk = DIR ? 31 - i : i; const int off = tk * 64 + 4 * gS;
#pragma unroll
                for (int c = 0; c < NV; ++c) { o.w[c] = *(const f32x4*)(sW + off + 32 * c); o.a[c] = *(const f32x4*)(sAV + off + 32 * c); o.b[c] = *(const f32x4*)(sBV + off + 32 * c);
                    o.k[c] = *(const f32x4*)(sKD + off + 32 * c); o.q[c] = *(const f32x4*)(sWR + off + 32 * c); }
                if constexpr (RPL == 2) { const f32x2 v2 = *(const f32x2*)(sV + tk * 64 + rowS); o.v[0] = v2.x; o.v[1] = v2.y; } else o.v[0] = sV[tk * 64 + rowS];
                o.bk = *(const f32x2*)(sBK + tk * 2); };
            auto step = [&](const Ops& cur, int i) {
                static_assert(EC == 4, "asm row helpers are written for 4 columns per lane");
                float sa[RPL], yp[RPL], y[RPL];
#pragma unroll
                for (int r = 0; r < RPL; ++r) row_dots(s[r], cur.a[0], cur.q[0], sa[r], yp[r]);
                if constexpr (RPL == 2) red16x4(sa[0], yp[0], sa[1], yp[1]); else red16x2(sa[0], yp[0]);
#pragma unroll
                for (int r = 0; r < RPL; ++r) row_update(s[r], cur.w[0], cur.b[0], cur.k[0], cur.v[r], sa[r], yp[r], cur.bk.x, cur.bk.y, y[r]);
                if (gS == 0) { if constexpr (RPL == 2) *(f32x2*)(sY + (DIR ? 31 - i : i) * 64 + rowS) = (f32x2){y[0], y[1]}; else sY[(DIR ? 31 - i : i) * 64 + rowS] = y[0]; }
            };
            {
                Ops o0, o1; ld(o0, 0);
#pragma unroll 1
                for (int i = 0; i < 32; i += 2) {
                    ld(o1, i + 1);
                    step(o0, i);
                    ld(o0, min(i + 2, 31));
                    step(o1, i + 1);
                }
            }
        }
        LDS_BAR();
        if (RPL == 2 || (q >> 3) == half) { const f32x4 y4 = *(const f32x4*)(sY + tokA * 64 + 4 * q); u32x2 w; w.x = pk_bf16(y4[0], y4[1]); w.y = pk_bf16(y4[2], y4[3]);
          *(u32x2*)(ybuf + (size_t)(t0 + tokA) * 1024 + h * 64 + 4 * q) = w; }
    }
}

__device__ void scan_phase(const Params& p, unsigned char* shm) {
    int* sItem = (int*)(shm + 80 * 1024);
    const int tid = opaque_tid();
    unsigned* queue = (unsigned*)(p.ws + OFF_QUEUE);
    for (;;) {
        if (tid == 0) *sItem = (int)atomicAdd(queue, 1u);
        __syncthreads();
        const int item = *sItem;
        __syncthreads();
        if (item >= N_ITEMS) break;
        int tid2 = tid; asm volatile("" : "+v"(tid2));
        if (item < N_SAMPLE_ITEMS) {
            const int half = item & 1, j = item >> 1;
            if (j & 1) scan_item<16, 1, 1>(p, shm, tid2, TP + (j >> 5) * 16384, 16384, (j >> 1) & 15, half); else scan_item<16, 1, 0>(p, shm, tid2, TP + (j >> 5) * 16384, 16384, (j >> 1) & 15, half);
        } else { const int j = item - N_SAMPLE_ITEMS;
            if (j & 1) scan_item<16, 2, 1>(p, shm, tid2, (j >> 5) * 2048, 2048, (j >> 1) & 15, 0); else scan_item<16, 2, 0>(p, shm, tid2, (j >> 5) * 2048, 2048, (j >> 1) & 15, 0); }
        __syncthreads();
    }
}

__device__ void mix_phase(const Params& p) {
    const int tidx = opaque_tid(); const int lane = tidx & 63, wave = (blockIdx.x * 512 + tidx) >> 6, nw = (gridDim.x * 512) >> 6;
    const bf16_t* zall = (const bf16_t*)(p.ws + OFF_Z);
    bf16_t* yf = (bf16_t*)p.out; const bf16_t* yb = (const bf16_t*)p.out + (size_t)T_TOK * 1024;
    const float* bonus_f = (const float*)(p.ws + OFF_BONUS); const float* bonus_b = bonus_f + (size_t)T_TOK * 16;
    bf16_t* pooled = (bf16_t*)(p.ws + OFF_POOLED); bf16_t* sg = (bf16_t*)(p.ws + OFF_SG);
    const int hL = lane >> 2;
    const int tpw = (T_TOK + nw - 1) / nw;
    for (int t = wave * tpw; t < min(T_TOK, (wave + 1) * tpw); ++t) {
        int tbase, L; seq_of(t, tbase, L); const int pos = t - tbase; const bool hasPrev = pos > 0, hasNext = pos < L - 1;
        const bf16_t* zr = zall + (size_t)t * ZLD;
        { const int c0 = lane * 16; float y[16];
          { const u32x4 a0 = *(const u32x4*)(yf + (size_t)t * 1024 + c0), a1 = *(const u32x4*)(yf + (size_t)t * 1024 + c0 + 8);
            const u32x4 b0 = *(const u32x4*)(yb + (size_t)t * 1024 + c0), b1 = *(const u32x4*)(yb + (size_t)t * 1024 + c0 + 8);
            f32x4 fa, fb, ga, gb; unpack8(a0, fa, fb); unpack8(b0, ga, gb);
#pragma unroll
            for (int j = 0; j < 4; ++j) { y[j] = fa[j] + ga[j]; y[4 + j] = fb[j] + gb[j]; }
            unpack8(a1, fa, fb); unpack8(b1, ga, gb);
#pragma unroll
            for (int j = 0; j < 4; ++j) { y[8 + j] = fa[j] + ga[j]; y[12 + j] = fb[j] + gb[j]; } }
          float sm = 0.f;
#pragma unroll
          for (int j = 0; j < 16; ++j) sm += y[j];
          const float mean = red4(sm) * (1.0f / 64.0f); float vs = 0.f;
#pragma unroll
          for (int j = 0; j < 16; ++j) { const float d = y[j] - mean; vs += d * d; }
          const float rstd = rsqrtf(red4(vs) * (1.0f / 64.0f) + 64e-5f);
          const float bon = bonus_f[(size_t)t * 16 + hL] + bonus_b[(size_t)t * 16 + hL];
          float vv[16];
          { const bf16_t* zc = zr + COL_V + c0;
            u32x4 c_[2], p_[2], n_[2];
#pragma unroll
            for (int i = 0; i < 2; ++i) { c_[i] = *(const u32x4*)(zc + 8 * i); p_[i] = hasPrev ? *(const u32x4*)(zc - ZLD + 8 * i) : (u32x4){0u, 0u, 0u, 0u}; n_[i] = hasNext ? *(const u32x4*)(zc + ZLD + 8 * i) : (u32x4){0u, 0u, 0u, 0u}; }
#pragma unroll
            for (int i = 0; i < 2; ++i) { f32x4 ca, cb, pa, pb, na, nb; unpack8(c_[i], ca, cb); unpack8(p_[i], pa, pb); unpack8(n_[i], na, nb);
                const float* mp = p.mu_prev + (COL_V - COL_R) + c0 + 8 * i; const float* mn = p.mu_next + (COL_V - COL_R) + c0 + 8 * i;
                const f32x4 mp0 = *(const f32x4*)mp, mp1 = *(const f32x4*)(mp + 4), mn0 = *(const f32x4*)mn, mn1 = *(const f32x4*)(mn + 4);
#pragma unroll
                for (int j = 0; j < 4; ++j) { vv[8 * i + j] = ca[j] + mp0[j] * (pa[j] - ca[j]) + mn0[j] * (na[j] - ca[j]); vv[8 * i + 4 + j] = cb[j] + mp1[j] * (pb[j] - cb[j]) + mn1[j] * (nb[j] - cb[j]); } } }
          float o[16];
#pragma unroll
          for (int i = 0; i < 4; ++i) { const f32x4 lw = *(const f32x4*)(p.ln_w + c0 + 4 * i), lb = *(const f32x4*)(p.ln_b + c0 + 4 * i);
#pragma unroll
              for (int j = 0; j < 4; ++j) o[4 * i + j] = (y[4 * i + j] - mean) * rstd * lw[j] + lb[j] + bon * vv[4 * i + j]; }
          u32x4 w0, w1; w0.x = pk_bf16(o[0], o[1]); w0.y = pk_bf16(o[2], o[3]); w0.z = pk_bf16(o[4], o[5]); w0.w = pk_bf16(o[6], o[7]);
          w1.x = pk_bf16(o[8], o[9]); w1.y = pk_bf16(o[10], o[11]); w1.z = pk_bf16(o[12], o[13]); w1.w = pk_bf16(o[14], o[15]);
          *(u32x4*)(yf + (size_t)t * 1024 + c0) = w0; *(u32x4*)(yf + (size_t)t * 1024 + c0 + 8) = w1; }
        { const int c = 2 * lane; const bf16_t* zc = zr + COL_G + c; const unsigned wc_ = *(const unsigned*)zc; const unsigned wp = hasPrev ? *(const unsigned*)(zc - ZLD) : 0u, wn = hasNext ? *(const unsigned*)(zc + ZLD) : 0u;
          const float mp0 = p.mu_prev[COL_G - COL_R + c], mp1 = p.mu_prev[COL_G - COL_R + c + 1], mn0 = p.mu_next[COL_G - COL_R + c], mn1 = p.mu_next[COL_G - COL_R + c + 1];
          const float c0v = bf_lo(wc_), c1v = bf_hi(wc_);
          const float z0 = c0v + mp0 * (bf_lo(wp) - c0v) + mn0 * (bf_lo(wn) - c0v), z1 = c1v + mp1 * (bf_hi(wp) - c1v) + mn1 * (bf_hi(wn) - c1v);
          *(unsigned*)(sg + (size_t)t * 256 + c) = pk_bf16(sigmoidf_(z0), sigmoidf_(z1)); *(unsigned*)(sg + (size_t)t * 256 + 128 + c) = 0u; }
        { const int c = lane * 8, gi = lane >> 4, w = 2 << gi; const int lo = max(pos - (w >> 1), 0), hi = min(pos + (w >> 1) - 1, L - 1);
          float sum[8];
#pragma unroll
          for (int j = 0; j < 8; ++j) sum[j] = 0.f;
          u32x4 wr_[16];
#pragma unroll
          for (int d = 0; d < 16; ++d) { const int r = pos - 8 + d; wr_[d] = (u32x4){0u, 0u, 0u, 0u}; if (r >= lo && r <= hi) wr_[d] = *(const u32x4*)(zall + (size_t)(tbase + r) * ZLD + c); }
#pragma unroll
          for (int d = 0; d < 16; ++d) { f32x4 a, b; unpack8(wr_[d], a, b);
#pragma unroll
              for (int j = 0; j < 4; ++j) { sum[j] += a[j]; sum[4 + j] += b[j]; } }
          const float icnt = 1.0f / (float)(hi - lo + 1); f32x4 a, b; unpack8(*(const u32x4*)(zr + c), a, b); f32x4 oa, ob;
#pragma unroll
          for (int j = 0; j < 4; ++j) { oa[j] = sum[j] * icnt - a[j]; ob[j] = sum[4 + j] * icnt - b[j]; }
          *(u32x4*)(pooled + (size_t)t * 512 + c) = pack8(oa, ob); }
    }
}

__device__ void final_phase(const Params& p) {
    const int tidx = opaque_tid(); const int lane = tidx & 63, wave = (blockIdx.x * 512 + tidx) >> 6, nw = (gridDim.x * 512) >> 6;
    const float* x2 = (const float*)(p.ws + OFF_X1); const float* rowsq2 = (const float*)(p.ws + OFF_ROWSQ2);
    f32x4 gv[4];
#pragma unroll
    for (int i = 0; i < 4; ++i) gv[i] = *(const f32x4*)(p.g_final + lane * 4 + 256 * i);
    for (int t = wave; t < T_TOK; t += nw) {
        const float rinv = rsqrtf(rowsq2[t] * (1.0f / 1024.0f) + 1e-6f);
#pragma unroll
        for (int i = 0; i < 4; ++i) { const f32x4 v = *(const f32x4*)(x2 + (size_t)t * 1024 + lane * 4 + 256 * i); *(f32x4*)(p.out + (size_t)t * 1024 + lane * 4 + 256 * i) = v * rinv * gv[i]; }
    }
}

__global__ void __launch_bounds__(512, 2) fwd_megakernel(Params p) {
    extern __shared__ __attribute__((aligned(16))) unsigned char shm[];
    unsigned char* ws = p.ws;
    prep_phase(p, shm);
    cg::this_grid().sync();
    { EpiStore E; E.O = (bf16_t*)(ws + OFF_Z); E.ldc = ZLD; run_gemm(shm, (const bf16_t*)(ws + OFF_R1), 1024, (const bf16_t*)(ws + OFF_WIN), 1024, 3840, 1024, E); }
    cg::this_grid().sync();
    scan_phase(p, shm);
    cg::this_grid().sync();
    mix_phase(p);
    cg::this_grid().sync();
    rmsnorm_rows(p, p.g_mix, (bf16_t*)(ws + OFF_XN2));
    { EpiMulInPlace E; E.Y = (bf16_t*)p.out; run_gemm(shm, (const bf16_t*)(ws + OFF_SG), 256, (const bf16_t*)(ws + OFF_WG), 256, 1024, 256, E); }
    cg::this_grid().sync();
    { EpiGates E; E.G = (bf16_t*)(ws + OFF_GATES); E.bias = p.b_gate; run_gemm(shm, (const bf16_t*)(ws + OFF_XN2), 1024, (const bf16_t*)(ws + OFF_WIN) + (size_t)3840 * 1024, 1024, 2048, 1024, E); }
    cg::this_grid().sync();
    { EpiPool E; E.P = (bf16_t*)(ws + OFF_MERGED); E.G = (const bf16_t*)(ws + OFF_GATES); run_gemm(shm, (const bf16_t*)(ws + OFF_POOLED), 512, (const bf16_t*)(ws + OFF_WEFF), 512, 1024, 512, E); }
    { EpiMerge E; E.P = (bf16_t*)(ws + OFF_MERGED); E.G = (const bf16_t*)(ws + OFF_GATES); run_gemm(shm, (const bf16_t*)p.out, 1024, (const bf16_t*)(ws + OFF_WRBR), 1024, 1024, 1024, E); }
    cg::this_grid().sync();
    { EpiOut E; E.xp = p.x_prompt; E.xs = p.x_sample; E.X1 = (float*)(ws + OFF_X1); E.X1B = (bf16_t*)(ws + OFF_X1B); E.rowsq = (float*)(ws + OFF_ROWSQ); run_gemm(shm, (const bf16_t*)(ws + OFF_MERGED), 1024, (const bf16_t*)(ws + OFF_WOUT), 1024, 1024, 1024, E); }
    cg::this_grid().sync();
    { EpiFF1 E; E.Hlo = (bf16_t*)(ws + OFF_HLO); E.Hhi = (bf16_t*)p.out; E.rowsq = (const float*)(ws + OFF_ROWSQ); run_gemm(shm, (const bf16_t*)(ws + OFF_X1B), 1024, (const bf16_t*)(ws + OFF_WFF1), 1024, 4096, 1024, E); }
    cg::this_grid().sync();
    { EpiFinal E; E.X = (float*)(ws + OFF_X1); E.rowsq = (float*)(ws + OFF_ROWSQ2);
      run_gemm(shm, (const bf16_t*)(ws + OFF_HLO), 2048, (const bf16_t*)(ws + OFF_WFF2), 4096, 1024, 4096, E, (const bf16_t*)p.out, 32); }
    cg::this_grid().sync();
    final_phase(p);
}

extern "C" void kernel_launch(void* const* d_in, const int* in_sizes, int n_in, void* d_out, int out_size, void* d_ws, size_t ws_size, hipStream_t stream) {
    constexpr size_t kDynLds = 131072;
    static int grid_blocks = 0;
    if (!grid_blocks) {
        hipFuncSetAttribute((const void*)fwd_megakernel, hipFuncAttributeMaxDynamicSharedMemorySize, (int)kDynLds);
        int dev = 0, cus = 0, per_cu = 0;
        hipGetDevice(&dev);
        hipDeviceGetAttribute(&cus, hipDeviceAttributeMultiprocessorCount, dev);
        hipOccupancyMaxActiveBlocksPerMultiprocessor(&per_cu, fwd_megakernel, 512, kDynLds);
        if (per_cu < 1) per_cu = 1;
        grid_blocks = cus;
    }
    Params p{};
    const float** pf = (const float**)&p;
    for (int i = 0; i < 30; ++i) pf[i] = (const float*)d_in[i];
    p.out = (float*)d_out; p.ws = (unsigned char*)d_ws;
    void* args[] = {&p};
    hipError_t e = hipLaunchCooperativeKernel((const void*)fwd_megakernel, dim3(grid_blocks), dim3(512), args, kDynLds, stream);
    if (e != hipSuccess) fprintf(stderr, "cooperative launch failed: %s (grid %d)\n", hipGetErrorString(e), grid_blocks);
}
```

```cpp
#include <hip/hip_runtime.h>
#include <hip/hip_cooperative_groups.h>
#include <cstdio>
namespace cg = cooperative_groups;

#define LAS __attribute__((address_space(3)))
typedef unsigned short bf16_t;
typedef short bf16x8 __attribute__((ext_vector_type(8)));
typedef float f32x4 __attribute__((ext_vector_type(4)));
typedef float f32x2 __attribute__((ext_vector_type(2)));
typedef unsigned u32x4 __attribute__((ext_vector_type(4)));
typedef unsigned u32x2 __attribute__((ext_vector_type(2)));

constexpr int T_TOK = 98304, DM = 1024, TP = 65536;
constexpr int ZLD = 3840;
constexpr int COL_R = 512, COL_K = 1536, COL_V = 2560, COL_W = 3584, COL_A = 3648, COL_G = 3712;
constexpr size_t MiB = 1ull << 20;
constexpr size_t OFF_WIN = 0, OFF_WEFF = 12 * MiB, OFF_WRBR = 13 * MiB, OFF_WOUT = 15 * MiB, OFF_WFF1 = 17 * MiB, OFF_WFF2 = 25 * MiB, OFF_WG = 33 * MiB;
constexpr size_t OFF_ROWSQ = 34 * MiB, OFF_ROWSQ2 = 34 * MiB + 512 * 1024, OFF_QUEUE = 35 * MiB, OFF_BONUS = 36 * MiB;
constexpr size_t OFF_R1 = 48 * MiB, OFF_Z = 240 * MiB;
constexpr size_t OFF_POOLED = OFF_R1, OFF_SG = OFF_R1 + 96 * MiB, OFF_XN2 = OFF_Z, OFF_GATES = OFF_Z + 192 * MiB, OFF_MERGED = OFF_Z + 576 * MiB;
constexpr size_t OFF_X1B = OFF_R1, OFF_X1 = OFF_Z, OFF_HLO = OFF_Z + 384 * MiB;
constexpr size_t U_BYTES = (size_t)T_TOK * 1024 * 2;

struct Params {
    const float *x_prompt, *x_sample, *g_mix, *w_in, *b_gate, *mu_prev, *mu_next, *pool_w, *pool_scale, *w_pool_br, *k_k, *k_a, *r_k,
        *w0_f, *w_up_f, *a0_f, *a_up_f, *w0_b, *w_up_b, *a0_b, *a_up_b, *g_up, *ln_w, *ln_b, *w_rwkv_br, *w_out, *g_ffn, *w_ff1, *w_ff2, *g_final;
    float* out; unsigned char* ws;
};

__device__ __forceinline__ float bf_lo(unsigned w) { return __uint_as_float(w << 16); }
__device__ __forceinline__ float bf_hi(unsigned w) { return __uint_as_float(w & 0xFFFF0000u); }
typedef __bf16 bf16x2_t __attribute__((ext_vector_type(2)));
__device__ __forceinline__ unsigned pk_bf16(float lo, float hi) { f32x2 v = {lo, hi}; bf16x2_t b = __builtin_convertvector(v, bf16x2_t); return __builtin_bit_cast(unsigned, b); }
__device__ __forceinline__ float fexp2_scaled(float x, float scale_log2e) { return __builtin_amdgcn_exp2f(x * scale_log2e); }
__device__ __forceinline__ float sigmoidf_(float x) { return __builtin_amdgcn_rcpf(1.0f + fexp2_scaled(x, -1.4426950409f)); }
__device__ __forceinline__ float fma_s(float a, float b, float c) { float d; asm("v_fma_f32 %0, %1, %2, %3" : "=v"(d) : "v"(a), "v"(b), "v"(c)); return d; }
__device__ __forceinline__ float mul_s(float a, float b) { float d; asm("v_mul_f32 %0, %1, %2" : "=v"(d) : "v"(a), "v"(b)); return d; }
__device__ __forceinline__ float add_s(float a, float b) { float d; asm("v_add_f32 %0, %1, %2" : "=v"(d) : "v"(a), "v"(b)); return d; }
#define DPPA(x, c) "v_add_f32_dpp " x ", " x ", " x " " c " row_mask:0xf bank_mask:0xf bound_ctrl:1\n"
#define DPP4(c) DPPA("%0", c) DPPA("%1", c) DPPA("%2", c) DPPA("%3", c)
#define DPP2(c) DPPA("%0", c) DPPA("%1", c) "s_nop 0\n"
__device__ __forceinline__ void red16x4(float& a, float& b, float& c, float& d) {
    asm("s_nop 1\n" DPP4("quad_perm:[1,0,3,2]") DPP4("quad_perm:[2,3,0,1]") DPP4("row_half_mirror") DPP4("row_mirror") : "+v"(a), "+v"(b), "+v"(c), "+v"(d)); }
__device__ __forceinline__ void red16x2(float& a, float& b) {
    asm("s_nop 1\n" DPP2("quad_perm:[1,0,3,2]") DPP2("quad_perm:[2,3,0,1]") DPP2("row_half_mirror") DPP2("row_mirror") : "+v"(a), "+v"(b)); }
__device__ __forceinline__ void row_dots(const float (&s)[4], const f32x4 a, const f32x4 q, float& sa, float& yp) {
    asm("v_mul_f32 %0, %2, %6\n v_mul_f32 %1, %2, %10\n v_fma_f32 %0, %3, %7, %0\n v_fma_f32 %1, %3, %11, %1\n v_fma_f32 %0, %4, %8, %0\n v_fma_f32 %1, %4, %12, %1\n v_fma_f32 %0, %5, %9, %0\n v_fma_f32 %1, %5, %13, %1"
        : "=&v"(sa), "=&v"(yp) : "v"(s[0]), "v"(s[1]), "v"(s[2]), "v"(s[3]), "v"(a[0]), "v"(a[1]), "v"(a[2]), "v"(a[3]), "v"(q[0]), "v"(q[1]), "v"(q[2]), "v"(q[3])); }
__device__ __forceinline__ void row_update(float (&s)[4], const f32x4 w, const f32x4 b, const f32x4 k, float v, float sa, float yp, float bkx, float bky, float& y) {
    float t0, t1, t2, t3;
    asm("v_mul_f32 %5, %9, %18\n v_mul_f32 %6, %9, %19\n v_mul_f32 %7, %9, %20\n v_mul_f32 %8, %9, %21\n"
        "v_fma_f32 %5, %10, %14, %5\n v_fma_f32 %6, %10, %15, %6\n v_fma_f32 %7, %10, %16, %7\n v_fma_f32 %8, %10, %17, %8\n"
        "v_fma_f32 %4, %10, %12, %11\n"
        "v_fma_f32 %0, %0, %22, %5\n v_fma_f32 %1, %1, %23, %6\n v_fma_f32 %2, %2, %24, %7\n v_fma_f32 %3, %3, %25, %8\n"
        "v_fma_f32 %4, %9, %13, %4"
        : "+v"(s[0]), "+v"(s[1]), "+v"(s[2]), "+v"(s[3]), "=&v"(y), "=&v"(t0), "=&v"(t1), "=&v"(t2), "=&v"(t3)
        : "v"(v), "v"(sa), "v"(yp), "v"(bkx), "v"(bky), "v"(b[0]), "v"(b[1]), "v"(b[2]), "v"(b[3]), "v"(k[0]), "v"(k[1]), "v"(k[2]), "v"(k[3]), "v"(w[0]), "v"(w[1]), "v"(w[2]), "v"(w[3])); }
__device__ __forceinline__ void shift4(float (&z)[4], const float (&c)[4], const float (&pv)[4], const float (&nx)[4], const f32x4 m0, const f32x4 mp, const f32x4 mn) {
    asm("v_mul_f32 %0, %4, %16\n v_mul_f32 %1, %5, %17\n v_mul_f32 %2, %6, %18\n v_mul_f32 %3, %7, %19\n"
        "v_fma_f32 %0, %8, %20, %0\n v_fma_f32 %1, %9, %21, %1\n v_fma_f32 %2, %10, %22, %2\n v_fma_f32 %3, %11, %23, %3\n"
        "v_fma_f32 %0, %12, %24, %0\n v_fma_f32 %1, %13, %25, %1\n v_fma_f32 %2, %14, %26, %2\n v_fma_f32 %3, %15, %27, %3"
        : "=&v"(z[0]), "=&v"(z[1]), "=&v"(z[2]), "=&v"(z[3])
        : "v"(c[0]), "v"(c[1]), "v"(c[2]), "v"(c[3]), "v"(pv[0]), "v"(pv[1]), "v"(pv[2]), "v"(pv[3]), "v"(nx[0]), "v"(nx[1]), "v"(nx[2]), "v"(nx[3]),
          "v"(m0[0]), "v"(m0[1]), "v"(m0[2]), "v"(m0[3]), "v"(mp[0]), "v"(mp[1]), "v"(mp[2]), "v"(mp[3]), "v"(mn[0]), "v"(mn[1]), "v"(mn[2]), "v"(mn[3])); }
__device__ __forceinline__ void kk4(float (&kk)[4], float& ss, const float (&k)[4], const f32x4 c) {
    asm("v_mul_f32 %0, %5, %9\n v_mul_f32 %1, %6, %10\n v_mul_f32 %2, %7, %11\n v_mul_f32 %3, %8, %12\n"
        "v_mul_f32 %4, %0, %0\n v_fma_f32 %4, %1, %1, %4\n v_fma_f32 %4, %2, %2, %4\n v_fma_f32 %4, %3, %3, %4"
        : "=&v"(kk[0]), "=&v"(kk[1]), "=&v"(kk[2]), "=&v"(kk[3]), "=&v"(ss) : "v"(k[0]), "v"(k[1]), "v"(k[2]), "v"(k[3]), "v"(c[0]), "v"(c[1]), "v"(c[2]), "v"(c[3])); }
template <int CTRL> __device__ __forceinline__ float dppf(float x) { return __int_as_float(__builtin_amdgcn_update_dpp(0, __float_as_int(x), CTRL, 0xF, 0xF, true)); }
__device__ __forceinline__ float red4(float x) { x += dppf<0xB1>(x); x += dppf<0x4E>(x); return x; }
__device__ __forceinline__ float red8(float x) { x = red4(x); x += dppf<0x141>(x); return x; }
__device__ __forceinline__ float red16(float x) { x = red8(x); x += dppf<0x140>(x); return x; }
__device__ __forceinline__ int opaque_tid() { int t = threadIdx.x; asm volatile("" : "+v"(t)); return t; }
__device__ __forceinline__ const float* xrow(const Params& p, int t) { return t < TP ? p.x_prompt + (size_t)t * DM : p.x_sample + (size_t)(t - TP) * DM; }
__device__ __forceinline__ void seq_of(int t, int& base, int& len) { if (t < TP) { base = t & ~2047; len = 2048; } else { base = TP + ((t - TP) & ~16383); len = 16384; } }

namespace pg8 {
constexpr int BM = 256, BK = 64, HALF = 128, HTB = HALF * BK * 2, STAGE_BYTES = 8 * HTB, NXCD = 8, WGM = 8;
__device__ __forceinline__ int lds_byte(int r, int c) { const int st = (r >> 4) * 2 + (c >> 5), rr = r & 15, cc = c & 31, ob = rr * 64 + cc * 2; return st * 1024 + (ob ^ (((ob >> 9) & 1) << 5)); }
__device__ __forceinline__ void stage_rc(int b, int& R, int& C) { const int st = b / 1024, sb = b % 1024, swz = sb ^ (((sb >> 9) & 1) << 5); R = (st >> 1) * 16 + swz / 64; C = (st & 1) * 32 + (swz % 64) / 2; }
__device__ __forceinline__ int perm32(int rho) { const int n = rho >> 4, i = rho & 15; return 8 * (i >> 2) + 4 * n + (i & 3); }
struct Unit { int pm, pn; };
struct Gemm { const bf16_t* A; const bf16_t* Bt; int M, N, K, lda, ldb; const bf16_t* A2; int ks; };
struct StaticOrder {
    int nM, nN, nwg, G, c;
    __device__ void init(int M, int N, int G_, int c_) { nM = M / BM; nN = N / BM; nwg = nM * nN; G = G_; c = c_; }
    __device__ bool next(int i, Unit& u) const {
        const long L = (long)i * G + c; if (L >= nwg) return false;
        int wgid = (int)L; { const int q = nwg / NXCD, r = nwg % NXCD, xcd = wgid % NXCD, off = wgid / NXCD; wgid = (xcd < r ? xcd * (q + 1) : r * (q + 1) + (xcd - r) * q) + off; }
        const int nig = WGM * nN, gid = wgid / nig, fm = gid * WGM, gsz = (nM - fm) < WGM ? (nM - fm) : WGM;
        u.pm = fm + ((wgid % nig) % gsz); u.pn = (wgid % nig) / gsz; return true;
    }
};

template <class Epi>
__device__ __forceinline__ void gemm_phase(LAS unsigned char* lds, const Gemm g, const StaticOrder& S, const Epi& E) {
    const int tid = opaque_tid();
    const int wid = __builtin_amdgcn_readfirstlane(tid >> 6), lane = tid & 63, wr = wid >> 2, wc = wid & 3, fr = lane & 15, fq = lane >> 4;
    const int K = g.K, nt = K / BK;
    unsigned voffA[2], voffB[2];
#pragma unroll
    for (int i = 0; i < 2; ++i) { int R, C; stage_rc(tid * 16 + i * 8192, R, C); const int Rb = (R & ~31) + perm32(R & 31);
        voffA[i] = (unsigned)(R * g.lda + C) * 2u; voffB[i] = (unsigned)(Rb * g.ldb + C) * 2u; }
    const size_t kstep = (size_t)(BK * 2);
    const size_t hstepA = (size_t)HALF * g.lda * 2, hstepB = (size_t)HALF * g.ldb * 2;
    const size_t tstepA = 2 * hstepA, tstepB = 2 * hstepB;
    const unsigned ldsw = (unsigned)wid * 1024u;
    const int aoff = lds_byte(wr * 64 + fr, fq * 8), boff = lds_byte(wc * 32 + fr, fq * 8);
#define PG8_SA(b, h) (((b) * 2 + (h)) * HTB)
#define PG8_SB(b, h) ((4 + (b) * 2 + (h)) * HTB)
#define PG8_STAGE(bufoff, gbase, voff) do { _Pragma("unroll") for (int _i = 0; _i < 2; ++_i) \
        __builtin_amdgcn_global_load_lds((const unsigned*)((const char*)(gbase) + (voff)[_i]), (LAS unsigned*)(lds + (bufoff) + ldsw + _i * 8192), 16, 0, 0); } while (0)
#define PG8_LDA(dst, b, h) do { _Pragma("unroll") for (int m = 0; m < 4; ++m) _Pragma("unroll") for (int k = 0; k < 2; ++k) dst[m][k] = *(const LAS bf16x8*)(lds + PG8_SA(b, h) + aoff + m * 2048 + k * 1024); } while (0)
#define PG8_LDB(dst, b, h) do { _Pragma("unroll") for (int n = 0; n < 2; ++n) _Pragma("unroll") for (int k = 0; k < 2; ++k) dst[n][k] = *(const LAS bf16x8*)(lds + PG8_SB(b, h) + boff + n * 2048 + k * 1024); } while (0)
#define PG8_MMA(ai, bj, At, Bt) do { __builtin_amdgcn_s_setprio(1); _Pragma("unroll") for (int m = 0; m < 4; ++m) _Pragma("unroll") for (int n = 0; n < 2; ++n) _Pragma("unroll") for (int k = 0; k < 2; ++k) \
        acc[ai][bj][m][n] = __builtin_amdgcn_mfma_f32_16x16x32_bf16(Bt[n][k], At[m][k], acc[ai][bj][m][n], 0, 0, 0); __builtin_amdgcn_s_setprio(0); } while (0)
#define PG8_WAIT_V(n) asm volatile("s_waitcnt vmcnt(" #n ")" ::: "memory")
#define PG8_WAIT_L(n) asm volatile("s_waitcnt lgkmcnt(" #n ")" ::: "memory")
#define PG8_BAR __builtin_amdgcn_s_barrier()
#define PG8_SCHED __builtin_amdgcn_sched_barrier(0)
    Unit cur, nxt; int ui = 0;
    if (!S.next(0, cur)) return;
    f32x4 acc[2][2][4][2];
#pragma unroll
    for (int a = 0; a < 2; ++a)
#pragma unroll
        for (int b = 0; b < 2; ++b)
#pragma unroll
            for (int m = 0; m < 4; ++m)
#pragma unroll
                for (int n = 0; n < 2; ++n) acc[a][b][m][n] = (f32x4){0.f, 0.f, 0.f, 0.f};
    bf16x8 At[4][2], B0[2][2], B1[2][2];
    const char* cA = (const char*)g.A + (size_t)cur.pm * tstepA; const char* cB = (const char*)g.Bt + (size_t)cur.pn * tstepB;
    const bool two = g.A2 != nullptr; const int ks = two ? g.ks : (1 << 30);
    const char* cA2 = two ? (const char*)g.A2 + (size_t)cur.pm * tstepA : cA;
    PG8_STAGE(PG8_SB(0, 0), cB, voffB); PG8_STAGE(PG8_SA(0, 0), cA, voffA); PG8_STAGE(PG8_SB(0, 1), cB + hstepB, voffB); PG8_STAGE(PG8_SA(0, 1), cA + hstepA, voffA);
    if (wr == 1) PG8_BAR;
    PG8_WAIT_V(4); PG8_BAR;
    PG8_STAGE(PG8_SB(1, 0), cB + kstep, voffB); PG8_STAGE(PG8_SA(1, 0), cA + kstep, voffA); PG8_STAGE(PG8_SB(1, 1), cB + hstepB + kstep, voffB);
    PG8_WAIT_V(6); PG8_BAR;
    for (;;) {
        const bool has_next = S.next(ui + 1, nxt);
        const char* nA = has_next ? (const char*)g.A + (size_t)nxt.pm * tstepA : cA; const char* nB = has_next ? (const char*)g.Bt + (size_t)nxt.pn * tstepB : cB;
        const char* nA2 = (two && has_next) ? (const char*)g.A2 + (size_t)nxt.pm * tstepA : cA2;
#pragma unroll 1
        for (int t = 0; t < nt; t += 2) {
            const bool last = (t == nt - 2);
            const char* a1 = (t + 1 < ks) ? cA + (size_t)(t + 1) * kstep : cA2 + (size_t)(t + 1 - ks) * kstep;
            const char* a2 = last ? nA : ((t + 2 < ks) ? cA + (size_t)(t + 2) * kstep : cA2 + (size_t)(t + 2 - ks) * kstep); const char* b2 = last ? nB : cB + (size_t)(t + 2) * kstep;
            const char* a3 = a2 + kstep; const char* b3 = b2 + kstep;
            PG8_LDB(B0, 0, 0); PG8_SCHED; PG8_LDA(At, 0, 0); PG8_STAGE(PG8_SA(1, 1), a1 + hstepA, voffA);
            PG8_WAIT_L(8); PG8_BAR; PG8_WAIT_L(0); PG8_MMA(0, 0, At, B0); PG8_BAR; PG8_SCHED;
            PG8_LDB(B1, 0, 1); PG8_STAGE(PG8_SB(0, 0), b2, voffB);
            PG8_BAR; PG8_WAIT_L(0); PG8_MMA(0, 1, At, B1); PG8_BAR;
            PG8_LDA(At, 0, 1); PG8_STAGE(PG8_SA(0, 0), a2, voffA);
            PG8_BAR; PG8_WAIT_L(0); PG8_MMA(1, 0, At, B0); PG8_BAR; PG8_SCHED;
            PG8_STAGE(PG8_SB(0, 1), b2 + hstepB, voffB);
            PG8_WAIT_V(6); PG8_BAR; PG8_MMA(1, 1, At, B1); PG8_BAR;
            PG8_LDB(B0, 1, 0); PG8_SCHED; PG8_LDA(At, 1, 0); PG8_STAGE(PG8_SA(0, 1), a2 + hstepA, voffA);
            PG8_WAIT_L(8); PG8_BAR; PG8_WAIT_L(0); PG8_MMA(0, 0, At, B0); PG8_BAR; PG8_SCHED;
            PG8_LDB(B1, 1, 1); PG8_STAGE(PG8_SB(1, 0), b3, voffB);
            PG8_BAR; PG8_WAIT_L(0); PG8_MMA(0, 1, At, B1); PG8_BAR;
            PG8_LDA(At, 1, 1); PG8_STAGE(PG8_SA(1, 0), a3, voffA);
            PG8_BAR; PG8_WAIT_L(0); PG8_MMA(1, 0, At, B0); PG8_BAR; PG8_SCHED;
            PG8_STAGE(PG8_SB(1, 1), b3 + hstepB, voffB);
            PG8_WAIT_V(6); PG8_BAR; PG8_MMA(1, 1, At, B1); PG8_BAR;
        }
        E(acc, cur, wr, wc, fr, fq);
        if (!has_next) break;
#pragma unroll
        for (int a = 0; a < 2; ++a)
#pragma unroll
            for (int b = 0; b < 2; ++b)
#pragma unroll
                for (int m = 0; m < 4; ++m)
#pragma unroll
                    for (int n = 0; n < 2; ++n) acc[a][b][m][n] = (f32x4){0.f, 0.f, 0.f, 0.f};
        cur = nxt; cA = nA; cA2 = nA2; cB = nB; ++ui;
    }
    PG8_WAIT_V(0);
    if (wr == 0) PG8_BAR;
    PG8_BAR;
#undef PG8_SA
#undef PG8_SB
#undef PG8_STAGE
#undef PG8_LDA
#undef PG8_LDB
#undef PG8_MMA
#undef PG8_WAIT_V
#undef PG8_WAIT_L
#undef PG8_BAR
#undef PG8_SCHED
}
}
using pg8::Unit;

#define EPI_LOOP_BEGIN const int row0 = u.pm * 256 + wr * 64 + fr, col0 = u.pn * 256 + wc * 32 + 8 * fq; \
    _Pragma("unroll") for (int ai = 0; ai < 2; ++ai) _Pragma("unroll") for (int m = 0; m < 4; ++m) { const int row = row0 + ai * 128 + m * 16;
#define EPI_BJ _Pragma("unroll") for (int bj = 0; bj < 2; ++bj) { const int col = col0 + bj * 128; const f32x4 v0 = acc[ai][bj][m][0], v1 = acc[ai][bj][m][1];
#define EPI_ACC const f32x4 (&acc)[2][2][4][2], const Unit& u, int wr, int wc, int fr, int fq

__device__ __forceinline__ u32x4 pack8(const f32x4 a, const f32x4 b) { u32x4 w; w.x = pk_bf16(a[0], a[1]); w.y = pk_bf16(a[2], a[3]); w.z = pk_bf16(b[0], b[1]); w.w = pk_bf16(b[2], b[3]); return w; }
__device__ __forceinline__ void unpack8(const u32x4 w, f32x4& a, f32x4& b) { a = (f32x4){bf_lo(w.x), bf_hi(w.x), bf_lo(w.y), bf_hi(w.y)}; b = (f32x4){bf_lo(w.z), bf_hi(w.z), bf_lo(w.w), bf_hi(w.w)}; }

struct EpiStore {
    bf16_t* O; int ldc;
    __device__ __forceinline__ void operator()(EPI_ACC) const { EPI_LOOP_BEGIN EPI_BJ *(u32x4*)(O + (size_t)row * ldc + col) = pack8(v0, v1); } } }
};
struct EpiMulInPlace {
    bf16_t* Y;
    __device__ __forceinline__ void operator()(EPI_ACC) const { EPI_LOOP_BEGIN if ((m & 1) == 0) __builtin_amdgcn_sched_barrier(0);
        EPI_BJ u32x4* ptr = (u32x4*)(Y + (size_t)row * 1024 + col); f32x4 a, b; unpack8(*ptr, a, b); *ptr = pack8(a * v0, b * v1); } } }
};
struct EpiGates {
    bf16_t* G; const float* bias;
    __device__ __forceinline__ void operator()(EPI_ACC) const { EPI_LOOP_BEGIN EPI_BJ
        const f32x4 b0 = *(const f32x4*)(bias + col), b1 = *(const f32x4*)(bias + col + 4); f32x4 a, b;
#pragma unroll
        for (int j = 0; j < 4; ++j) { a[j] = sigmoidf_(v0[j] + b0[j]); b[j] = sigmoidf_(v1[j] + b1[j]); }
        *(u32x4*)(G + (size_t)row * 2048 + col) = pack8(a, b); } } }
};
struct EpiPool {
    bf16_t* P; const bf16_t* G;
    __device__ __forceinline__ void operator()(EPI_ACC) const { EPI_LOOP_BEGIN EPI_BJ f32x4 a, b; unpack8(*(const u32x4*)(G + (size_t)row * 2048 + col), a, b);
        *(u32x4*)(P + (size_t)row * 1024 + col) = pack8(a * v0, b * v1); } } }
};
struct EpiMerge {
    bf16_t* P; const bf16_t* G;
    __device__ __forceinline__ void operator()(EPI_ACC) const { EPI_LOOP_BEGIN EPI_BJ f32x4 a, b, pa, pb; unpack8(*(const u32x4*)(G + (size_t)row * 2048 + 1024 + col), a, b);
        u32x4* ptr = (u32x4*)(P + (size_t)row * 1024 + col); unpack8(*ptr, pa, pb); *ptr = pack8(pa + a * v0, pb + b * v1); } } }
};
struct EpiOut {
    const float* xp; const float* xs; float* X1; bf16_t* X1B; float* rowsq;
    __device__ __forceinline__ void operator()(EPI_ACC) const { EPI_LOOP_BEGIN const float* xr = row < TP ? xp + (size_t)row * DM : xs + (size_t)(row - TP) * DM; float ss = 0.f; EPI_BJ
        f32x4 a = *(const f32x4*)(xr + col) + v0, b = *(const f32x4*)(xr + col + 4) + v1;
        *(f32x4*)(X1 + (size_t)row * 1024 + col) = a; *(f32x4*)(X1 + (size_t)row * 1024 + col + 4) = b; *(u32x4*)(X1B + (size_t)row * 1024 + col) = pack8(a, b);
#pragma unroll
        for (int j = 0; j < 4; ++j) ss += a[j] * a[j] + b[j] * b[j]; }
        ss += __shfl_xor(ss, 16); ss += __shfl_xor(ss, 32); if (fq == 0) atomicAdd(rowsq + row, ss); } }
};
struct EpiFF1 {
    bf16_t* Hlo; bf16_t* Hhi; const float* rowsq;
    __device__ __forceinline__ void operator()(EPI_ACC) const { bf16_t* H = u.pn < 8 ? Hlo : Hhi; const int cshift = u.pn < 8 ? 0 : 2048;
        EPI_LOOP_BEGIN const float rinv = rsqrtf(rowsq[row] * (1.0f / 1024.0f) + 1e-6f); EPI_BJ f32x4 a, b;
#pragma unroll
        for (int j = 0; j < 4; ++j) { float t0 = fmaxf(v0[j] * rinv, 0.f), t1 = fmaxf(v1[j] * rinv, 0.f); a[j] = t0 * t0; b[j] = t1 * t1; }
        *(u32x4*)(H + (size_t)row * 2048 + (col - cshift)) = pack8(a, b); } } }
};
struct EpiAddInPlace {
    float* X;
    __device__ __forceinline__ void operator()(EPI_ACC) const { EPI_LOOP_BEGIN EPI_BJ f32x4* ptr = (f32x4*)(X + (size_t)row * 1024 + col); ptr[0] = ptr[0] + v0; ptr[1] = ptr[1] + v1; } } }
};
struct EpiFinal {
    float* X; float* rowsq;
    __device__ __forceinline__ void operator()(EPI_ACC) const { EPI_LOOP_BEGIN float ss = 0.f; EPI_BJ f32x4* ptr = (f32x4*)(X + (size_t)row * 1024 + col); const f32x4 a = ptr[0] + v0, b = ptr[1] + v1; ptr[0] = a; ptr[1] = b;
#pragma unroll
        for (int j = 0; j < 4; ++j) ss += a[j] * a[j] + b[j] * b[j]; }
        ss += __shfl_xor(ss, 16); ss += __shfl_xor(ss, 32); if (fq == 0) atomicAdd(rowsq + row, ss); } }
};

template <class Epi>
__device__ __forceinline__ void run_gemm(unsigned char* shm, const bf16_t* A, int lda, const bf16_t* Bt, int ldb, int N, int K, const Epi& E, const bf16_t* A2 = nullptr, int ks = 0) {
    pg8::Gemm g; g.A = A; g.Bt = Bt; g.M = T_TOK; g.N = N; g.K = K; g.lda = lda; g.ldb = ldb; g.A2 = A2; g.ks = ks;
    pg8::StaticOrder S; S.init(T_TOK, N, (int)gridDim.x, (int)blockIdx.x);
    pg8::gemm_phase<Epi>((LAS unsigned char*)shm, g, S, E);
}

__device__ void transpose_cvt(unsigned char* shm, const float* src, int K, int N, bf16_t* dst, int ldd, const float* kscale) {
    float* tile = (float*)shm;
    const int tid = opaque_tid(), ntk = K / 64, ntn = N / 64;
    for (int t = blockIdx.x; t < ntk * ntn; t += gridDim.x) {
        const int tk = t / ntn, tn = t % ntn;
#pragma unroll
        for (int i = 0; i < 8; ++i) { const int kl = (tid >> 6) + 8 * i, nl = tid & 63; const int k = tk * 64 + kl;
            tile[kl * 65 + nl] = src[(size_t)k * N + tn * 64 + nl] * (kscale ? kscale[k] : 1.0f); }
        __syncthreads();
#pragma unroll
        for (int i = 0; i < 8; ++i) { const int nl = (tid >> 6) + 8 * i, kl = tid & 63;
            const unsigned w = pk_bf16(tile[kl * 65 + nl], 0.f); dst[(size_t)(tn * 64 + nl) * ldd + tk * 64 + kl] = (bf16_t)(w & 0xFFFFu); }
        __syncthreads();
    }
}

__device__ void rmsnorm_rows(const Params& p, const float* g, bf16_t* dst) {
    const int tidx = opaque_tid(); const int lane = tidx & 63, wave = (blockIdx.x * 512 + tidx) >> 6, nw = (gridDim.x * 512) >> 6;
    f32x4 gv[4];
#pragma unroll
    for (int i = 0; i < 4; ++i) gv[i] = *(const f32x4*)(g + lane * 4 + 256 * i);
    for (int t = wave; t < T_TOK; t += nw) {
        const float* xr = xrow(p, t); f32x4 v[4]; float ss = 0.f;
#pragma unroll
        for (int i = 0; i < 4; ++i) { v[i] = *(const f32x4*)(xr + lane * 4 + 256 * i); ss += v[i][0] * v[i][0] + v[i][1] * v[i][1] + v[i][2] * v[i][2] + v[i][3] * v[i][3]; }
#pragma unroll
        for (int o = 1; o < 64; o <<= 1) ss += __shfl_xor(ss, o);
        const float rinv = rsqrtf(ss * (1.0f / 1024.0f) + 1e-6f);
#pragma unroll
        for (int i = 0; i < 4; ++i) { u32x2 w; w.x = pk_bf16(v[i][0] * rinv * gv[i][0], v[i][1] * rinv * gv[i][1]); w.y = pk_bf16(v[i][2] * rinv * gv[i][2], v[i][3] * rinv * gv[i][3]);
            *(u32x2*)(dst + (size_t)t * 1024 + lane * 4 + 256 * i) = w; }
    }
}

__device__ void prep_phase(const Params& p, unsigned char* shm) {
    unsigned char* ws = p.ws;
    const int gtid = blockIdx.x * 512 + opaque_tid(), gn = gridDim.x * 512;
    for (int i = gtid; i < T_TOK; i += gn) { ((float*)(ws + OFF_ROWSQ))[i] = 0.f; ((float*)(ws + OFF_ROWSQ2))[i] = 0.f; }
    if (gtid < 64) ((unsigned*)(ws + OFF_QUEUE))[gtid] = 0u;
    transpose_cvt(shm, p.w_in, 1024, 5888, (bf16_t*)(ws + OFF_WIN), 1024, nullptr);
    transpose_cvt(shm, p.w_rwkv_br, 1024, 1024, (bf16_t*)(ws + OFF_WRBR), 1024, nullptr);
    transpose_cvt(shm, p.w_out, 1024, 1024, (bf16_t*)(ws + OFF_WOUT), 1024, nullptr);
    transpose_cvt(shm, p.w_ff1, 1024, 4096, (bf16_t*)(ws + OFF_WFF1), 1024, p.g_ffn);
    transpose_cvt(shm, p.w_ff2, 4096, 1024, (bf16_t*)(ws + OFF_WFF2), 4096, nullptr);
    transpose_cvt(shm, p.g_up, 128, 1024, (bf16_t*)(ws + OFF_WG), 256, nullptr);
    { bf16_t* wg = (bf16_t*)(ws + OFF_WG); for (int i = gtid; i < 1024 * 128; i += gn) wg[(size_t)(i >> 7) * 256 + 128 + (i & 127)] = 0; }
    { bf16_t* we = (bf16_t*)(ws + OFF_WEFF);
      for (int i = gtid; i < 512 * 1024; i += gn) { const int k = i >> 10, n = i & 1023, gI = k >> 7; const float* pw = p.pool_w + (size_t)k * 128; float acc = 0.f;
          for (int d = 0; d < 128; ++d) acc += pw[d] * p.pool_scale[gI * 128 + d] * p.w_pool_br[(size_t)(gI * 128 + d) * 1024 + n];
          we[(size_t)n * 512 + k] = (bf16_t)(pk_bf16(acc, 0.f) & 0xFFFFu); } }
    rmsnorm_rows(p, p.g_mix, (bf16_t*)(ws + OFF_R1));
}

#define LDS_BAR() do { asm volatile("s_waitcnt lgkmcnt(0)" ::: "memory"); __builtin_amdgcn_s_barrier(); asm volatile("" ::: "memory"); } while (0)
constexpr int N_SAMPLE_ITEMS = 128, N_ITEMS = N_SAMPLE_ITEMS + 1024;

template <int LPR, int RPL, int DIR>
__device__ __forceinline__ void scan_item(const Params& p, unsigned char* shm, const int tid, const int tbase, const int L, const int h, const int half) {
    constexpr int dir = DIR;
    constexpr int EC = 64 / LPR, RPW = RPL * (64 / LPR);
    float* sW = (float*)shm; float* sAV = sW + 2048; float* sBV = sW + 4096; float* sKD = sW + 6144; float* sWR = sW + 8192; float* sR = sW + 10240; float* sV = sW + 12288; float* sY = sW + 14336;
    float* sBK = sW + 16384;
    bf16_t* sTW = (bf16_t*)(sW + 16384 + 64);
    bf16_t* sZA = sTW + 32 * 72;
    const int lane = tid & 63, wv = tid >> 6;
    const bf16_t* zall = (const bf16_t*)(p.ws + OFF_Z);
    const int tokA = tid >> 4, q = tid & 15;
    const int rowS = half * 32 + wv * RPW + RPL * (lane / LPR), gS = lane % LPR;
    const int NC = L / 32;
    bf16_t* ybuf = (bf16_t*)p.out + (dir ? (size_t)T_TOK * 1024 : 0);
    float* bonus = (float*)(p.ws + OFF_BONUS) + (dir ? (size_t)T_TOK * 16 : 0);
    const float* w_up = dir ? p.w_up_b : p.w_up_f; const float* a_up = dir ? p.a_up_b : p.a_up_f;
    const float* w0 = dir ? p.w0_b : p.w0_f; const float* a0 = dir ? p.a0_b : p.a0_f;
    const int mat = wv >> 2, cbk = wv & 3, colB = cbk * 16 + (lane & 15), quad = lane >> 4;
    u32x4* sBF = (u32x4*)(shm + 84 * 1024);
    { const float* up = mat ? a_up : w_up;
#pragma unroll
      for (int kb = 0; kb < 2; ++kb) { float f[8];
#pragma unroll
          for (int j = 0; j < 8; ++j) f[j] = up[(size_t)(kb * 32 + quad * 8 + j) * 1024 + h * 64 + colB];
          u32x4 w; w.x = pk_bf16(f[0], f[1]); w.y = pk_bf16(f[2], f[3]); w.z = pk_bf16(f[4], f[5]); w.w = pk_bf16(f[6], f[7]); sBF[kb * 512 + tid] = w; } }
    const float c0B = (mat ? a0 : w0)[h * 64 + colB];
    const float kaB = p.k_a[h * 64 + colB];
    int colz[5];
    float* sM0 = (float*)(shm + 100 * 1024);
    float* sMU = (float*)(shm + 76 * 1024);
#pragma unroll
    for (int gi = 0; gi < 5; ++gi) colz[gi] = (gi == 0 ? COL_R + h * 64 : gi == 1 ? COL_K + h * 64 : gi == 2 ? COL_V + h * 64 : gi == 3 ? COL_W : COL_A) + 4 * q;
    if (tid < 320) { const int gi = tid >> 6, c = tid & 63; const int col = (gi == 0 ? COL_R + h * 64 : gi == 1 ? COL_K + h * 64 : gi == 2 ? COL_V + h * 64 : gi == 3 ? COL_W : COL_A) + c - COL_R;
        const float mpv_ = p.mu_prev[col], mnv_ = p.mu_next[col]; sMU[gi * 64 + c] = mpv_; sMU[320 + gi * 64 + c] = mnv_; sM0[gi * 64 + c] = 1.0f - mpv_ - mnv_; }
    else if (tid < 384) sMU[640 + (tid - 320)] = p.k_k[h * 64 + (tid - 320)];
    else if (tid < 448) sMU[704 + (tid - 384)] = p.r_k[h * 64 + (tid - 384)];
    __syncthreads();
    float s[RPL][EC];
#pragma unroll
    for (int r = 0; r < RPL; ++r)
#pragma unroll
        for (int j = 0; j < EC; ++j) s[r][j] = 0.f;
    u32x2 zc[5], zp[5], zn[5];
    auto load_chunk = [&](int ci) {
        const int t = tbase + 32 * (dir ? NC - 1 - ci : ci) + tokA; const bool hasPrev = t > tbase, hasNext = t < tbase + L - 1;
        const bf16_t* zr = zall + (size_t)t * ZLD;
#pragma unroll
        for (int gi = 0; gi < 5; ++gi) { zc[gi] = *(const u32x2*)(zr + colz[gi]); zp[gi] = (u32x2){0u, 0u}; zn[gi] = (u32x2){0u, 0u};
            if (hasPrev) zp[gi] = *(const u32x2*)(zr - ZLD + colz[gi]);
            if (hasNext) zn[gi] = *(const u32x2*)(zr + ZLD + colz[gi]); }
    };
    load_chunk(0);
    for (int ci = 0; ci < NC; ++ci) {
        const int t0 = tbase + 32 * (dir ? NC - 1 - ci : ci);
        { float zs[5][4];
#pragma unroll
          for (int gi = 0; gi < 5; ++gi) {
              const float c[4] = {bf_lo(zc[gi].x), bf_hi(zc[gi].x), bf_lo(zc[gi].y), bf_hi(zc[gi].y)}, pv[4] = {bf_lo(zp[gi].x), bf_hi(zp[gi].x), bf_lo(zp[gi].y), bf_hi(zp[gi].y)}, nx[4] = {bf_lo(zn[gi].x), bf_hi(zn[gi].x), bf_lo(zn[gi].y), bf_hi(zn[gi].y)};
              const f32x4 mp = *(const f32x4*)(sMU + gi * 64 + 4 * q), mn = *(const f32x4*)(sMU + 320 + gi * 64 + 4 * q), m0 = *(const f32x4*)(sM0 + gi * 64 + 4 * q);
              shift4(zs[gi], c, pv, nx, m0, mp, mn);
          }
          if (ci + 1 < NC) load_chunk(ci + 1);
          *(f32x4*)(sR + tokA * 64 + 4 * q) = (f32x4){zs[0][0], zs[0][1], zs[0][2], zs[0][3]};
          *(f32x4*)(sKD + tokA * 64 + 4 * q) = (f32x4){zs[1][0], zs[1][1], zs[1][2], zs[1][3]};
          *(f32x4*)(sV + tokA * 64 + 4 * q) = (f32x4){zs[2][0], zs[2][1], zs[2][2], zs[2][3]};
          float kk[4], ss; const f32x4 kk4c = *(const f32x4*)(sMU + 640 + 4 * q);
          kk4(kk, ss, zs[1], kk4c);
          ss = ss + 0.0f * kk[0];
          ss = red16(ss);
          const float inv = -__builtin_amdgcn_rsqf(fmaxf(ss, 1e-24f));
          *(f32x4*)(sAV + tokA * 64 + 4 * q) = (f32x4){kk[0] * inv, kk[1] * inv, kk[2] * inv, kk[3] * inv};
          float tw[4];
#pragma unroll
          for (int j = 0; j < 4; ++j) tw[j] = 1.0f - 2.0f * __builtin_amdgcn_rcpf(1.0f + fexp2_scaled(zs[3][j], 2.8853900818f));
          u32x2 w; w.x = pk_bf16(tw[0], tw[1]); w.y = pk_bf16(tw[2], tw[3]); *(u32x2*)(sTW + tokA * 72 + 4 * q) = w;
          w.x = pk_bf16(zs[4][0], zs[4][1]); w.y = pk_bf16(zs[4][2], zs[4][3]); *(u32x2*)(sZA + tokA * 72 + 4 * q) = w;
        }
        LDS_BAR();
        { const bf16_t* sX = mat ? sZA : sTW;
#pragma unroll
          for (int rb = 0; rb < 2; ++rb) {
              f32x4 acc = (f32x4){0.f, 0.f, 0.f, 0.f};
#pragma unroll
              for (int kb = 0; kb < 2; ++kb) { const bf16x8 af = *(const bf16x8*)(sX + (rb * 16 + (lane & 15)) * 72 + kb * 32 + quad * 8);
                  acc = __builtin_amdgcn_mfma_f32_16x16x32_bf16(af, __builtin_bit_cast(bf16x8, sBF[kb * 512 + tid]), acc, 0, 0, 0); }
#pragma unroll
              for (int j = 0; j < 4; ++j) { const int idx = (rb * 16 + quad * 4 + j) * 64 + colB; const float pre = c0B + acc[j];
                  if (mat == 0) { const float w = fexp2_scaled(sigmoidf_(pre), -0.6065306597f * 1.4426950409f); sW[idx] = w; sWR[idx] = w * sR[idx]; }
                  else { const float a = sigmoidf_(pre); const float k = sKD[idx]; sKD[idx] = k * (1.0f + (a - 1.0f) * kaB); sBV[idx] = -sAV[idx] * a; } }
          } }
        LDS_BAR();
        { const f32x4 r4 = *(const f32x4*)(sR + tokA * 64 + 4 * q), b4 = *(const f32x4*)(sBV + tokA * 64 + 4 * q), k4 = *(const f32x4*)(sKD + tokA * 64 + 4 * q);
          float br = 0.f, kr = 0.f, cb = 0.f; const f32x4 rk4 = *(const f32x4*)(sMU + 704 + 4 * q);
#pragma unroll
          for (int j = 0; j < 4; ++j) { br += b4[j] * r4[j]; kr += k4[j] * r4[j]; cb += r4[j] * k4[j] * rk4[j]; }
          br = red16(br); kr = red16(kr); cb = red16(cb);
          if (q == 0) { sBK[tokA * 2] = br; sBK[tokA * 2 + 1] = kr; if (half == 0) bonus[(size_t)(t0 + tokA) * 16 + h] = cb; } }
        LDS_BAR();
        {
            constexpr int NV = EC / 4;
            struct Ops { f32x4 w[NV], a[NV], b[NV], k[NV], q[NV]; float v[RPL]; f32x2 bk; };
            auto ld = [&](Ops& o, int i) { const int tk = DIR ? 31 - i : i; const int off = tk * 64 + 4 * gS;
#pragma unroll
                for (int c = 0; c < NV; ++c) { o.w[c] = *(const f32x4*)(sW + off + 32 * c); o.a[c] = *(const f32x4*)(sAV + off + 32 * c); o.b[c] = *(const f32x4*)(sBV + off + 32 * c);
                    o.k[c] = *(const f32x4*)(sKD + off + 32 * c); o.q[c] = *(const f32x4*)(sWR + off + 32 * c); }
                if constexpr (RPL == 2) { const f32x2 v2 = *(const f32x2*)(sV + tk * 64 + rowS); o.v[0] = v2.x; o.v[1] = v2.y; } else o.v[0] = sV[tk * 64 + rowS];
                o.bk = *(const f32x2*)(sBK + tk * 2); };
            auto step = [&](const Ops& cur, int i) {
                static_assert(EC == 4, "asm row helpers are written for 4 columns per lane");
                float sa[RPL], yp[RPL], y[RPL];
#pragma unroll
                for (int r = 0; r < RPL; ++r) row_dots(s[r], cur.a[0], cur.q[0], sa[r], yp[r]);
                if constexpr (RPL == 2) red16x4(sa[0], yp[0], sa[1], yp[1]); else red16x2(sa[0], yp[0]);
#pragma unroll
                for (int r = 0; r < RPL; ++r) row_update(s[r], cur.w[0], cur.b[0], cur.k[0], cur.v[r], sa[r], yp[r], cur.bk.x, cur.bk.y, y[r]);
                if (gS == 0) { if constexpr (RPL == 2) *(f32x2*)(sY + (DIR ? 31 - i : i) * 64 + rowS) = (f32x2){y[0], y[1]}; else sY[(DIR ? 31 - i : i) * 64 + rowS] = y[0]; }
            };
            {
                Ops o0, o1; ld(o0, 0);
#pragma unroll 1
                for (int i = 0; i < 32; i += 2) {
                    ld(o1, i + 1);
                    step(o0, i);
                    ld(o0, min(i + 2, 31));
                    step(o1, i + 1);
                }
            }
        }
        LDS_BAR();
        if (RPL == 2 || (q >> 3) == half) { const f32x4 y4 = *(const f32x4*)(sY + tokA * 64 + 4 * q); u32x2 w; w.x = pk_bf16(y4[0], y4[1]); w.y = pk_bf16(y4[2], y4[3]);
          *(u32x2*)(ybuf + (size_t)(t0 + tokA) * 1024 + h * 64 + 4 * q) = w; }
    }
}

__device__ void scan_phase(const Params& p, unsigned char* shm) {
    int* sItem = (int*)(shm + 80 * 1024);
    const int tid = opaque_tid();
    unsigned* queue = (unsigned*)(p.ws + OFF_QUEUE);
    for (;;) {
        if (tid == 0) *sItem = (int)atomicAdd(queue, 1u);
        __syncthreads();
        const int item = *sItem;
        __syncthreads();
        if (item >= N_ITEMS) break;
        int tid2 = tid; asm volatile("" : "+v"(tid2));
        if (item < N_SAMPLE_ITEMS) {
            const int half = item & 1, j = item >> 1;
            if (j & 1) scan_item<16, 1, 1>(p, shm, tid2, TP + (j >> 5) * 16384, 16384, (j >> 1) & 15, half); else scan_item<16, 1, 0>(p, shm, tid2, TP + (j >> 5) * 16384, 16384, (j >> 1) & 15, half);
        } else { const int j = item - N_SAMPLE_ITEMS;
            if (j & 1) scan_item<16, 2, 1>(p, shm, tid2, (j >> 5) * 2048, 2048, (j >> 1) & 15, 0); else scan_item<16, 2, 0>(p, shm, tid2, (j >> 5) * 2048, 2048, (j >> 1) & 15, 0); }
        __syncthreads();
    }
}

__device__ void mix_phase(const Params& p) {
    const int tidx = opaque_tid(); const int lane = tidx & 63, wave = (blockIdx.x * 512 + tidx) >> 6, nw = (gridDim.x * 512) >> 6;
    const bf16_t* zall = (const bf16_t*)(p.ws + OFF_Z);
    bf16_t* yf = (bf16_t*)p.out; const bf16_t* yb = (const bf16_t*)p.out + (size_t)T_TOK * 1024;
    const float* bonus_f = (const float*)(p.ws + OFF_BONUS); const float* bonus_b = bonus_f + (size_t)T_TOK * 16;
    bf16_t* pooled = (bf16_t*)(p.ws + OFF_POOLED); bf16_t* sg = (bf16_t*)(p.ws + OFF_SG);
    const int hL = lane >> 2;
    const int tpw = (T_TOK + nw - 1) / nw;
    for (int t = wave * tpw; t < min(T_TOK, (wave + 1) * tpw); ++t) {
        int tbase, L; seq_of(t, tbase, L); const int pos = t - tbase; const bool hasPrev = pos > 0, hasNext = pos < L - 1;
        const bf16_t* zr = zall + (size_t)t * ZLD;
        { const int c0 = lane * 16; float y[16];
          { const u32x4 a0 = *(const u32x4*)(yf + (size_t)t * 1024 + c0), a1 = *(const u32x4*)(yf + (size_t)t * 1024 + c0 + 8);
            const u32x4 b0 = *(const u32x4*)(yb + (size_t)t * 1024 + c0), b1 = *(const u32x4*)(yb + (size_t)t * 1024 + c0 + 8);
            f32x4 fa, fb, ga, gb; unpack8(a0, fa, fb); unpack8(b0, ga, gb);
#pragma unroll
            for (int j = 0; j < 4; ++j) { y[j] = fa[j] + ga[j]; y[4 + j] = fb[j] + gb[j]; }
            unpack8(a1, fa, fb); unpack8(b1, ga, gb);
#pragma unroll
            for (int j = 0; j < 4; ++j) { y[8 + j] = fa[j] + ga[j]; y[12 + j] = fb[j] + gb[j]; } }
          float sm = 0.f;
#pragma unroll
          for (int j = 0; j < 16; ++j) sm += y[j];
          const float mean = red4(sm) * (1.0f / 64.0f); float vs = 0.f;
#pragma unroll
          for (int j = 0; j < 16; ++j) { const float d = y[j] - mean; vs += d * d; }
          const float rstd = rsqrtf(red4(vs) * (1.0f / 64.0f) + 64e-5f);
          const float bon = bonus_f[(size_t)t * 16 + hL] + bonus_b[(size_t)t * 16 + hL];
          float vv[16];
          { const bf16_t* zc = zr + COL_V + c0;
            u32x4 c_[2], p_[2], n_[2];
#pragma unroll
            for (int i = 0; i < 2; ++i) { c_[i] = *(const u32x4*)(zc + 8 * i); p_[i] = hasPrev ? *(const u32x4*)(zc - ZLD + 8 * i) : (u32x4){0u, 0u, 0u, 0u}; n_[i] = hasNext ? *(const u32x4*)(zc + ZLD + 8 * i) : (u32x4){0u, 0u, 0u, 0u}; }
#pragma unroll
            for (int i = 0; i < 2; ++i) { f32x4 ca, cb, pa, pb, na, nb; unpack8(c_[i], ca, cb); unpack8(p_[i], pa, pb); unpack8(n_[i], na, nb);
                const float* mp = p.mu_prev + (COL_V - COL_R) + c0 + 8 * i; const float* mn = p.mu_next + (COL_V - COL_R) + c0 + 8 * i;
                const f32x4 mp0 = *(const f32x4*)mp, mp1 = *(const f32x4*)(mp + 4), mn0 = *(const f32x4*)mn, mn1 = *(const f32x4*)(mn + 4);
#pragma unroll
                for (int j = 0; j < 4; ++j) { vv[8 * i + j] = ca[j] + mp0[j] * (pa[j] - ca[j]) + mn0[j] * (na[j] - ca[j]); vv[8 * i + 4 + j] = cb[j] + mp1[j] * (pb[j] - cb[j]) + mn1[j] * (nb[j] - cb[j]); } } }
          float o[16];
#pragma unroll
          for (int i = 0; i < 4; ++i) { const f32x4 lw = *(const f32x4*)(p.ln_w + c0 + 4 * i), lb = *(const f32x4*)(p.ln_b + c0 + 4 * i);
#pragma unroll
              for (int j = 0; j < 4; ++j) o[4 * i + j] = (y[4 * i + j] - mean) * rstd * lw[j] + lb[j] + bon * vv[4 * i + j]; }
          u32x4 w0, w1; w0.x = pk_bf16(o[0], o[1]); w0.y = pk_bf16(o[2], o[3]); w0.z = pk_bf16(o[4], o[5]); w0.w = pk_bf16(o[6], o[7]);
          w1.x = pk_bf16(o[8], o[9]); w1.y = pk_bf16(o[10], o[11]); w1.z = pk_bf16(o[12], o[13]); w1.w = pk_bf16(o[14], o[15]);
          *(u32x4*)(yf + (size_t)t * 1024 + c0) = w0; *(u32x4*)(yf + (size_t)t * 1024 + c0 + 8) = w1; }
        { const int c = 2 * lane; const bf16_t* zc = zr + COL_G + c; const unsigned wc_ = *(const unsigned*)zc; const unsigned wp = hasPrev ? *(const unsigned*)(zc - ZLD) : 0u, wn = hasNext ? *(const unsigned*)(zc + ZLD) : 0u;
          const float mp0 = p.mu_prev[COL_G - COL_R + c], mp1 = p.mu_prev[COL_G - COL_R + c + 1], mn0 = p.mu_next[COL_G - COL_R + c], mn1 = p.mu_next[COL_G - COL_R + c + 1];
          const float c0v = bf_lo(wc_), c1v = bf_hi(wc_);
          const float z0 = c0v + mp0 * (bf_lo(wp) - c0v) + mn0 * (bf_lo(wn) - c0v), z1 = c1v + mp1 * (bf_hi(wp) - c1v) + mn1 * (bf_hi(wn) - c1v);
          *(unsigned*)(sg + (size_t)t * 256 + c) = pk_bf16(sigmoidf_(z0), sigmoidf_(z1)); *(unsigned*)(sg + (size_t)t * 256 + 128 + c) = 0u; }
        { const int c = lane * 8, gi = lane >> 4, w = 2 << gi; const int lo = max(pos - (w >> 1), 0), hi = min(pos + (w >> 1) - 1, L - 1);
          float sum[8];
#pragma unroll
          for (int j = 0; j < 8; ++j) sum[j] = 0.f;
          u32x4 wr_[16];
#pragma unroll
          for (int d = 0; d < 16; ++d) { const int r = pos - 8 + d; wr_[d] = (u32x4){0u, 0u, 0u, 0u}; if (r >= lo && r <= hi) wr_[d] = *(const u32x4*)(zall + (size_t)(tbase + r) * ZLD + c); }
#pragma unroll
          for (int d = 0; d < 16; ++d) { f32x4 a, b; unpack8(wr_[d], a, b);
#pragma unroll
              for (int j = 0; j < 4; ++j) { sum[j] += a[j]; sum[4 + j] += b[j]; } }
          const float icnt = 1.0f / (float)(hi - lo + 1); f32x4 a, b; unpack8(*(const u32x4*)(zr + c), a, b); f32x4 oa, ob;
#pragma unroll
          for (int j = 0; j < 4; ++j) { oa[j] = sum[j] * icnt - a[j]; ob[j] = sum[4 + j] * icnt - b[j]; }
          *(u32x4*)(pooled + (size_t)t * 512 + c) = pack8(oa, ob); }
    }
}

__device__ void final_phase(const Params& p) {
    const int tidx = opaque_tid(); const int lane = tidx & 63, wave = (blockIdx.x * 512 + tidx) >> 6, nw = (gridDim.x * 512) >> 6;
    const float* x2 = (const float*)(p.ws + OFF_X1); const float* rowsq2 = (const float*)(p.ws + OFF_ROWSQ2);
    f32x4 gv[4];
#pragma unroll
    for (int i = 0; i < 4; ++i) gv[i] = *(const f32x4*)(p.g_final + lane * 4 + 256 * i);
    for (int t = wave; t < T_TOK; t += nw) {
        const float rinv = rsqrtf(rowsq2[t] * (1.0f / 1024.0f) + 1e-6f);
#pragma unroll
        for (int i = 0; i < 4; ++i) { const f32x4 v = *(const f32x4*)(x2 + (size_t)t * 1024 + lane * 4 + 256 * i); *(f32x4*)(p.out + (size_t)t * 1024 + lane * 4 + 256 * i) = v * rinv * gv[i]; }
    }
}

__global__ void __launch_bounds__(512, 2) fwd_megakernel(Params p) {
    extern __shared__ __attribute__((aligned(16))) unsigned char shm[];
    unsigned char* ws = p.ws;
    prep_phase(p, shm);
    cg::this_grid().sync();
    { EpiStore E; E.O = (bf16_t*)(ws + OFF_Z); E.ldc = ZLD; run_gemm(shm, (const bf16_t*)(ws + OFF_R1), 1024, (const bf16_t*)(ws + OFF_WIN), 1024, 3840, 1024, E); }
    cg::this_grid().sync();
    scan_phase(p, shm);
    cg::this_grid().sync();
    mix_phase(p);
    cg::this_grid().sync();
    rmsnorm_rows(p, p.g_mix, (bf16_t*)(ws + OFF_XN2));
    { EpiMulInPlace E; E.Y = (bf16_t*)p.out; run_gemm(shm, (const bf16_t*)(ws + OFF_SG), 256, (const bf16_t*)(ws + OFF_WG), 256, 1024, 256, E); }
    cg::this_grid().sync();
    { EpiGates E; E.G = (bf16_t*)(ws + OFF_GATES); E.bias = p.b_gate; run_gemm(shm, (const bf16_t*)(ws + OFF_XN2), 1024, (const bf16_t*)(ws + OFF_WIN) + (size_t)3840 * 1024, 1024, 2048, 1024, E); }
    cg::this_grid().sync();
    { EpiPool E; E.P = (bf16_t*)(ws + OFF_MERGED); E.G = (const bf16_t*)(ws + OFF_GATES); run_gemm(shm, (const bf16_t*)(ws + OFF_POOLED), 512, (const bf16_t*)(ws + OFF_WEFF), 512, 1024, 512, E); }
    { EpiMerge E; E.P = (bf16_t*)(ws + OFF_MERGED); E.G = (const bf16_t*)(ws + OFF_GATES); run_gemm(shm, (const bf16_t*)p.out, 1024, (const bf16_t*)(ws + OFF_WRBR), 1024, 1024, 1024, E); }
    cg::this_grid().sync();
    { EpiOut E; E.xp = p.x_prompt; E.xs = p.x_sample; E.X1 = (float*)(ws + OFF_X1); E.X1B = (bf16_t*)(ws + OFF_X1B); E.rowsq = (float*)(ws + OFF_ROWSQ); run_gemm(shm, (const bf16_t*)(ws + OFF_MERGED), 1024, (const bf16_t*)(ws + OFF_WOUT), 1024, 1024, 1024, E); }
    cg::this_grid().sync();
    { EpiFF1 E; E.Hlo = (bf16_t*)(ws + OFF_HLO); E.Hhi = (bf16_t*)p.out; E.rowsq = (const float*)(ws + OFF_ROWSQ); run_gemm(shm, (const bf16_t*)(ws + OFF_X1B), 1024, (const bf16_t*)(ws + OFF_WFF1), 1024, 4096, 1024, E); }
    cg::this_grid().sync();
    { EpiFinal E; E.X = (float*)(ws + OFF_X1); E.rowsq = (float*)(ws + OFF_ROWSQ2);
      run_gemm(shm, (const bf16_t*)(ws + OFF_HLO), 2048, (const bf16_t*)(ws + OFF_WFF2), 4096, 1024, 4096, E, (const bf16_t*)p.out, 32); }
    cg::this_grid().sync();
    final_phase(p);
}

extern "C" void kernel_launch(void* const* d_in, const int* in_sizes, int n_in, void* d_out, int out_size, void* d_ws, size_t ws_size, hipStream_t stream) {
    constexpr size_t kDynLds = 131072;
    static int grid_blocks = 0;
    if (!grid_blocks) {
        hipFuncSetAttribute((const void*)fwd_megakernel, hipFuncAttributeMaxDynamicSharedMemorySize, (int)kDynLds);
        int dev = 0, cus = 0, per_cu = 0;
        hipGetDevice(&dev);
        hipDeviceGetAttribute(&cus, hipDeviceAttributeMultiprocessorCount, dev);
        hipOccupancyMaxActiveBlocksPerMultiprocessor(&per_cu, fwd_megakernel, 512, kDynLds);
        if (per_cu < 1) per_cu = 1;
        grid_blocks = cus;
    }
    Params p{};
    const float** pf = (const float**)&p;
    for (int i = 0; i < 30; ++i) pf[i] = (const float*)d_in[i];
    p.out = (float*)d_out; p.ws = (unsigned char*)d_ws;
    void* args[] = {&p};
    hipError_t e = hipLaunchCooperativeKernel((const void*)fwd_megakernel, dim3(grid_blocks), dim3(512), args, kDynLds, stream);
    if (e != hipSuccess) fprintf(stderr, "cooperative launch failed: %s (grid %d)\n", hipGetErrorString(e), grid_blocks);
}
```

```cpp
#include <hip/hip_runtime.h>
#include <hip/hip_cooperative_groups.h>
#include <cstdio>
namespace cg = cooperative_groups;

#define LAS __attribute__((address_space(3)))
typedef unsigned short bf16_t;
typedef short bf16x8 __attribute__((ext_vector_type(8)));
typedef float f32x4 __attribute__((ext_vector_type(4)));
typedef float f32x2 __attribute__((ext_vector_type(2)));
typedef unsigned u32x4 __attribute__((ext_vector_type(4)));
typedef unsigned u32x2 __attribute__((ext_vector_type(2)));

constexpr int T_TOK = 98304, DM = 1024, TP = 65536;
constexpr int ZLD = 3840;
constexpr int COL_R = 512, COL_K = 1536, COL_V = 2560, COL_W = 3584, COL_A = 3648, COL_G = 3712;
constexpr size_t MiB = 1ull << 20;
constexpr size_t OFF_WIN = 0, OFF_WEFF = 12 * MiB, OFF_WRBR = 13 * MiB, OFF_WOUT = 15 * MiB, OFF_WFF1 = 17 * MiB, OFF_WFF2 = 25 * MiB, OFF_WG = 33 * MiB;
constexpr size_t OFF_ROWSQ = 34 * MiB, OFF_ROWSQ2 = 34 * MiB + 512 * 1024, OFF_QUEUE = 35 * MiB, OFF_BONUS = 36 * MiB;
constexpr size_t OFF_R1 = 48 * MiB, OFF_Z = 240 * MiB;
constexpr size_t OFF_POOLED = OFF_R1, OFF_SG = OFF_R1 + 96 * MiB, OFF_XN2 = OFF_Z, OFF_GATES = OFF_Z + 192 * MiB, OFF_MERGED = OFF_Z + 576 * MiB;
constexpr size_t OFF_X1B = OFF_R1, OFF_X1 = OFF_Z, OFF_HLO = OFF_Z + 384 * MiB;
constexpr size_t U_BYTES = (size_t)T_TOK * 1024 * 2;

struct Params {
    const float *x_prompt, *x_sample, *g_mix, *w_in, *b_gate, *mu_prev, *mu_next, *pool_w, *pool_scale, *w_pool_br, *k_k, *k_a, *r_k,
        *w0_f, *w_up_f, *a0_f, *a_up_f, *w0_b, *w_up_b, *a0_b, *a_up_b, *g_up, *ln_w, *ln_b, *w_rwkv_br, *w_out, *g_ffn, *w_ff1, *w_ff2, *g_final;
    float* out; unsigned char* ws;
};

__device__ __forceinline__ float bf_lo(unsigned w) { return __uint_as_float(w << 16); }
__device__ __forceinline__ float bf_hi(unsigned w) { return __uint_as_float(w & 0xFFFF0000u); }
typedef __bf16 bf16x2_t __attribute__((ext_vector_type(2)));
__device__ __forceinline__ unsigned pk_bf16(float lo, float hi) { f32x2 v = {lo, hi}; bf16x2_t b = __builtin_convertvector(v, bf16x2_t); return __builtin_bit_cast(unsigned, b); }
__device__ __forceinline__ float fexp2_scaled(float x, float scale_log2e) { return __builtin_amdgcn_exp2f(x * scale_log2e); }
__device__ __forceinline__ float sigmoidf_(float x) { return __builtin_amdgcn_rcpf(1.0f + fexp2_scaled(x, -1.4426950409f)); }
__device__ __forceinline__ float fma_s(float a, float b, float c) { float d; asm("v_fma_f32 %0, %1, %2, %3" : "=v"(d) : "v"(a), "v"(b), "v"(c)); return d; }
__device__ __forceinline__ float mul_s(float a, float b) { float d; asm("v_mul_f32 %0, %1, %2" : "=v"(d) : "v"(a), "v"(b)); return d; }
__device__ __forceinline__ float add_s(float a, float b) { float d; asm("v_add_f32 %0, %1, %2" : "=v"(d) : "v"(a), "v"(b)); return d; }
#define DPPA(x, c) "v_add_f32_dpp " x ", " x ", " x " " c " row_mask:0xf bank_mask:0xf bound_ctrl:1\n"
#define DPP4(c) DPPA("%0", c) DPPA("%1", c) DPPA("%2", c) DPPA("%3", c)
#define DPP2(c) DPPA("%0", c) DPPA("%1", c) "s_nop 0\n"
__device__ __forceinline__ void red16x4(float& a, float& b, float& c, float& d) {
    asm("s_nop 1\n" DPP4("quad_perm:[1,0,3,2]") DPP4("quad_perm:[2,3,0,1]") DPP4("row_half_mirror") DPP4("row_mirror") : "+v"(a), "+v"(b), "+v"(c), "+v"(d)); }
__device__ __forceinline__ void red16x2(float& a, float& b) {
    asm("s_nop 1\n" DPP2("quad_perm:[1,0,3,2]") DPP2("quad_perm:[2,3,0,1]") DPP2("row_half_mirror") DPP2("row_mirror") : "+v"(a), "+v"(b)); }
__device__ __forceinline__ void row_dots(const float (&s)[4], const f32x4 a, const f32x4 q, float& sa, float& yp) {
    asm("v_mul_f32 %0, %2, %6\n v_mul_f32 %1, %2, %10\n v_fmac_f32 %0, %3, %7\n v_fmac_f32 %1, %3, %11\n v_fmac_f32 %0, %4, %8\n v_fmac_f32 %1, %4, %12\n v_fmac_f32 %0, %5, %9\n v_fmac_f32 %1, %5, %13"
        : "=&v"(sa), "=&v"(yp) : "v"(s[0]), "v"(s[1]), "v"(s[2]), "v"(s[3]), "v"(a[0]), "v"(a[1]), "v"(a[2]), "v"(a[3]), "v"(q[0]), "v"(q[1]), "v"(q[2]), "v"(q[3])); }
__device__ __forceinline__ void row_update(float (&s)[4], const f32x4 w, const f32x4 b, const f32x4 k, float v, float sa, float yp, float bkx, float bky, float& y) {
    float t0, t1, t2, t3;
    asm("v_mul_f32 %0, %6, %15\n v_mul_f32 %1, %6, %16\n v_mul_f32 %2, %6, %17\n v_mul_f32 %3, %6, %18\n"
        "v_fmac_f32 %4, %7, %5\n"
        "v_fmac_f32 %0, %7, %11\n v_fmac_f32 %1, %7, %12\n v_fmac_f32 %2, %7, %13\n v_fmac_f32 %3, %7, %14\n"
        "v_fmac_f32 %4, %6, %8\n"
        "v_fmac_f32 %0, %9, %19\n v_fmac_f32 %1, %10, %20\n v_fmac_f32 %2, %23, %21\n v_fmac_f32 %3, %24, %22"
        : "=&v"(t0), "=&v"(t1), "=&v"(t2), "=&v"(t3), "+v"(yp)
        : "v"(bkx), "v"(v), "v"(sa), "v"(bky), "v"(s[0]), "v"(s[1]), "v"(b[0]), "v"(b[1]), "v"(b[2]), "v"(b[3]), "v"(k[0]), "v"(k[1]), "v"(k[2]), "v"(k[3]), "v"(w[0]), "v"(w[1]), "v"(w[2]), "v"(w[3]), "v"(s[2]), "v"(s[3]));
    s[0] = t0; s[1] = t1; s[2] = t2; s[3] = t3; y = yp; }
__device__ __forceinline__ void shift4(float (&z)[4], const float (&c)[4], const float (&pv)[4], const float (&nx)[4], const f32x4 m0, const f32x4 mp, const f32x4 mn) {
    asm("v_mul_f32 %0, %4, %16\n v_mul_f32 %1, %5, %17\n v_mul_f32 %2, %6, %18\n v_mul_f32 %3, %7, %19\n"
        "v_fma_f32 %0, %8, %20, %0\n v_fma_f32 %1, %9, %21, %1\n v_fma_f32 %2, %10, %22, %2\n v_fma_f32 %3, %11, %23, %3\n"
        "v_fma_f32 %0, %12, %24, %0\n v_fma_f32 %1, %13, %25, %1\n v_fma_f32 %2, %14, %26, %2\n v_fma_f32 %3, %15, %27, %3"
        : "=&v"(z[0]), "=&v"(z[1]), "=&v"(z[2]), "=&v"(z[3])
        : "v"(c[0]), "v"(c[1]), "v"(c[2]), "v"(c[3]), "v"(pv[0]), "v"(pv[1]), "v"(pv[2]), "v"(pv[3]), "v"(nx[0]), "v"(nx[1]), "v"(nx[2]), "v"(nx[3]),
          "v"(m0[0]), "v"(m0[1]), "v"(m0[2]), "v"(m0[3]), "v"(mp[0]), "v"(mp[1]), "v"(mp[2]), "v"(mp[3]), "v"(mn[0]), "v"(mn[1]), "v"(mn[2]), "v"(mn[3])); }
__device__ __forceinline__ void kk4(float (&kk)[4], float& ss, const float (&k)[4], const f32x4 c) {
    asm("v_mul_f32 %0, %5, %9\n v_mul_f32 %1, %6, %10\n v_mul_f32 %2, %7, %11\n v_mul_f32 %3, %8, %12\n"
        "v_mul_f32 %4, %0, %0\n v_fma_f32 %4, %1, %1, %4\n v_fma_f32 %4, %2, %2, %4\n v_fma_f32 %4, %3, %3, %4"
        : "=&v"(kk[0]), "=&v"(kk[1]), "=&v"(kk[2]), "=&v"(kk[3]), "=&v"(ss) : "v"(k[0]), "v"(k[1]), "v"(k[2]), "v"(k[3]), "v"(c[0]), "v"(c[1]), "v"(c[2]), "v"(c[3])); }
template <int CTRL> __device__ __forceinline__ float dppf(float x) { return __int_as_float(__builtin_amdgcn_update_dpp(0, __float_as_int(x), CTRL, 0xF, 0xF, true)); }
__device__ __forceinline__ float red4(float x) { x += dppf<0xB1>(x); x += dppf<0x4E>(x); return x; }
__device__ __forceinline__ float red8(float x) { x = red4(x); x += dppf<0x141>(x); return x; }
__device__ __forceinline__ float red16(float x) { x = red8(x); x += dppf<0x140>(x); return x; }
__device__ __forceinline__ int opaque_tid() { int t = threadIdx.x; asm volatile("" : "+v"(t)); return t; }
__device__ __forceinline__ const float* xrow(const Params& p, int t) { return t < TP ? p.x_prompt + (size_t)t * DM : p.x_sample + (size_t)(t - TP) * DM; }
__device__ __forceinline__ void seq_of(int t, int& base, int& len) { if (t < TP) { base = t & ~2047; len = 2048; } else { base = TP + ((t - TP) & ~16383); len = 16384; } }

namespace pg8 {
constexpr int BM = 256, BK = 64, HALF = 128, HTB = HALF * BK * 2, STAGE_BYTES = 8 * HTB, NXCD = 8, WGM = 8;
__device__ __forceinline__ int lds_byte(int r, int c) { const int st = (r >> 4) * 2 + (c >> 5), rr = r & 15, cc = c & 31, ob = rr * 64 + cc * 2; return st * 1024 + (ob ^ (((ob >> 9) & 1) << 5)); }
__device__ __forceinline__ void stage_rc(int b, int& R, int& C) { const int st = b / 1024, sb = b % 1024, swz = sb ^ (((sb >> 9) & 1) << 5); R = (st >> 1) * 16 + swz / 64; C = (st & 1) * 32 + (swz % 64) / 2; }
__device__ __forceinline__ int perm32(int rho) { const int n = rho >> 4, i = rho & 15; return 8 * (i >> 2) + 4 * n + (i & 3); }
struct Unit { int pm, pn; };
struct Gemm { const bf16_t* A; const bf16_t* Bt; int M, N, K, lda, ldb; const bf16_t* A2; int ks; };
struct StaticOrder {
    int nM, nN, nwg, G, c;
    __device__ void init(int M, int N, int G_, int c_) { nM = M / BM; nN = N / BM; nwg = nM * nN; G = G_; c = c_; }
    __device__ bool next(int i, Unit& u) const {
        const long L = (long)i * G + c; if (L >= nwg) return false;
        int wgid = (int)L; { const int q = nwg / NXCD, r = nwg % NXCD, xcd = wgid % NXCD, off = wgid / NXCD; wgid = (xcd < r ? xcd * (q + 1) : r * (q + 1) + (xcd - r) * q) + off; }
        const int nig = WGM * nN, gid = wgid / nig, fm = gid * WGM, gsz = (nM - fm) < WGM ? (nM - fm) : WGM;
        u.pm = fm + ((wgid % nig) % gsz); u.pn = (wgid % nig) / gsz; return true;
    }
};

template <class Epi>
__device__ __forceinline__ void gemm_phase(LAS unsigned char* lds, const Gemm g, const StaticOrder& S, const Epi& E) {
    const int tid = opaque_tid();
    const int wid = __builtin_amdgcn_readfirstlane(tid >> 6), lane = tid & 63, wr = wid >> 2, wc = wid & 3, fr = lane & 15, fq = lane >> 4;
    const int K = g.K, nt = K / BK;
    unsigned voffA[2], voffB[2];
#pragma unroll
    for (int i = 0; i < 2; ++i) { int R, C; stage_rc(tid * 16 + i * 8192, R, C); const int Rb = (R & ~31) + perm32(R & 31);
        voffA[i] = (unsigned)(R * g.lda + C) * 2u; voffB[i] = (unsigned)(Rb * g.ldb + C) * 2u; }
    const size_t kstep = (size_t)(BK * 2);
    const size_t hstepA = (size_t)HALF * g.lda * 2, hstepB = (size_t)HALF * g.ldb * 2;
    const size_t tstepA = 2 * hstepA, tstepB = 2 * hstepB;
    const unsigned ldsw = (unsigned)wid * 1024u;
    const int aoff = lds_byte(wr * 64 + fr, fq * 8), boff = lds_byte(wc * 32 + fr, fq * 8);
#define PG8_SA(b, h) (((b) * 2 + (h)) * HTB)
#define PG8_SB(b, h) ((4 + (b) * 2 + (h)) * HTB)
#define PG8_STAGE(bufoff, gbase, voff) do { _Pragma("unroll") for (int _i = 0; _i < 2; ++_i) \
        __builtin_amdgcn_global_load_lds((const unsigned*)((const char*)(gbase) + (voff)[_i]), (LAS unsigned*)(lds + (bufoff) + ldsw + _i * 8192), 16, 0, 0); } while (0)
#define PG8_LDA(dst, b, h) do { _Pragma("unroll") for (int m = 0; m < 4; ++m) _Pragma("unroll") for (int k = 0; k < 2; ++k) dst[m][k] = *(const LAS bf16x8*)(lds + PG8_SA(b, h) + aoff + m * 2048 + k * 1024); } while (0)
#define PG8_LDB(dst, b, h) do { _Pragma("unroll") for (int n = 0; n < 2; ++n) _Pragma("unroll") for (int k = 0; k < 2; ++k) dst[n][k] = *(const LAS bf16x8*)(lds + PG8_SB(b, h) + boff + n * 2048 + k * 1024); } while (0)
#define PG8_MMA(ai, bj, At, Bt) do { __builtin_amdgcn_s_setprio(1); _Pragma("unroll") for (int m = 0; m < 4; ++m) _Pragma("unroll") for (int n = 0; n < 2; ++n) _Pragma("unroll") for (int k = 0; k < 2; ++k) \
        acc[ai][bj][m][n] = __builtin_amdgcn_mfma_f32_16x16x32_bf16(Bt[n][k], At[m][k], acc[ai][bj][m][n], 0, 0, 0); __builtin_amdgcn_s_setprio(0); } while (0)
#define PG8_WAIT_V(n) asm volatile("s_waitcnt vmcnt(" #n ")" ::: "memory")
#define PG8_WAIT_L(n) asm volatile("s_waitcnt lgkmcnt(" #n ")" ::: "memory")
#define PG8_BAR __builtin_amdgcn_s_barrier()
#define PG8_SCHED __builtin_amdgcn_sched_barrier(0)
    Unit cur, nxt; int ui = 0;
    if (!S.next(0, cur)) return;
    f32x4 acc[2][2][4][2];
#pragma unroll
    for (int a = 0; a < 2; ++a)
#pragma unroll
        for (int b = 0; b < 2; ++b)
#pragma unroll
            for (int m = 0; m < 4; ++m)
#pragma unroll
                for (int n = 0; n < 2; ++n) acc[a][b][m][n] = (f32x4){0.f, 0.f, 0.f, 0.f};
    bf16x8 At[4][2], B0[2][2], B1[2][2];
    const char* cA = (const char*)g.A + (size_t)cur.pm * tstepA; const char* cB = (const char*)g.Bt + (size_t)cur.pn * tstepB;
    const bool two = g.A2 != nullptr; const int ks = two ? g.ks : (1 << 30);
    const char* cA2 = two ? (const char*)g.A2 + (size_t)cur.pm * tstepA : cA;
    PG8_STAGE(PG8_SB(0, 0), cB, voffB); PG8_STAGE(PG8_SA(0, 0), cA, voffA); PG8_STAGE(PG8_SB(0, 1), cB + hstepB, voffB); PG8_STAGE(PG8_SA(0, 1), cA + hstepA, voffA);
    if (wr == 1) PG8_BAR;
    PG8_WAIT_V(4); PG8_BAR;
    PG8_STAGE(PG8_SB(1, 0), cB + kstep, voffB); PG8_STAGE(PG8_SA(1, 0), cA + kstep, voffA); PG8_STAGE(PG8_SB(1, 1), cB + hstepB + kstep, voffB);
    PG8_WAIT_V(6); PG8_BAR;
    for (;;) {
        const bool has_next = S.next(ui + 1, nxt);
        const char* nA = has_next ? (const char*)g.A + (size_t)nxt.pm * tstepA : cA; const char* nB = has_next ? (const char*)g.Bt + (size_t)nxt.pn * tstepB : cB;
        const char* nA2 = (two && has_next) ? (const char*)g.A2 + (size_t)nxt.pm * tstepA : cA2;
#pragma unroll 1
        for (int t = 0; t < nt; t += 2) {
            const bool last = (t == nt - 2);
            const char* a1 = (t + 1 < ks) ? cA + (size_t)(t + 1) * kstep : cA2 + (size_t)(t + 1 - ks) * kstep;
            const char* a2 = last ? nA : ((t + 2 < ks) ? cA + (size_t)(t + 2) * kstep : cA2 + (size_t)(t + 2 - ks) * kstep); const char* b2 = last ? nB : cB + (size_t)(t + 2) * kstep;
            const char* a3 = a2 + kstep; const char* b3 = b2 + kstep;
            PG8_LDB(B0, 0, 0); PG8_SCHED; PG8_LDA(At, 0, 0); PG8_STAGE(PG8_SA(1, 1), a1 + hstepA, voffA);
            PG8_WAIT_L(8); PG8_BAR; PG8_WAIT_L(0); PG8_MMA(0, 0, At, B0); PG8_BAR; PG8_SCHED;
            PG8_LDB(B1, 0, 1); PG8_STAGE(PG8_SB(0, 0), b2, voffB);
            PG8_BAR; PG8_WAIT_L(0); PG8_MMA(0, 1, At, B1); PG8_BAR;
            PG8_LDA(At, 0, 1); PG8_STAGE(PG8_SA(0, 0), a2, voffA);
            PG8_BAR; PG8_WAIT_L(0); PG8_MMA(1, 0, At, B0); PG8_BAR; PG8_SCHED;
            PG8_STAGE(PG8_SB(0, 1), b2 + hstepB, voffB);
            PG8_WAIT_V(6); PG8_BAR; PG8_MMA(1, 1, At, B1); PG8_BAR;
            PG8_LDB(B0, 1, 0); PG8_SCHED; PG8_LDA(At, 1, 0); PG8_STAGE(PG8_SA(0, 1), a2 + hstepA, voffA);
            PG8_WAIT_L(8); PG8_BAR; PG8_WAIT_L(0); PG8_MMA(0, 0, At, B0); PG8_BAR; PG8_SCHED;
            PG8_LDB(B1, 1, 1); PG8_STAGE(PG8_SB(1, 0), b3, voffB);
            PG8_BAR; PG8_WAIT_L(0); PG8_MMA(0, 1, At, B1); PG8_BAR;
            PG8_LDA(At, 1, 1); PG8_STAGE(PG8_SA(1, 0), a3, voffA);
            PG8_BAR; PG8_WAIT_L(0); PG8_MMA(1, 0, At, B0); PG8_BAR; PG8_SCHED;
            PG8_STAGE(PG8_SB(1, 1), b3 + hstepB, voffB);
            PG8_WAIT_V(6); PG8_BAR; PG8_MMA(1, 1, At, B1); PG8_BAR;
        }
        E(acc, cur, wr, wc, fr, fq);
        if (!has_next) break;
#pragma unroll
        for (int a = 0; a < 2; ++a)
#pragma unroll
            for (int b = 0; b < 2; ++b)
#pragma unroll
                for (int m = 0; m < 4; ++m)
#pragma unroll
                    for (int n = 0; n < 2; ++n) acc[a][b][m][n] = (f32x4){0.f, 0.f, 0.f, 0.f};
        cur = nxt; cA = nA; cA2 = nA2; cB = nB; ++ui;
    }
    PG8_WAIT_V(0);
    if (wr == 0) PG8_BAR;
    PG8_BAR;
#undef PG8_SA
#undef PG8_SB
#undef PG8_STAGE
#undef PG8_LDA
#undef PG8_LDB
#undef PG8_MMA
#undef PG8_WAIT_V
#undef PG8_WAIT_L
#undef PG8_BAR
#undef PG8_SCHED
}
}
using pg8::Unit;

#define EPI_LOOP_BEGIN const int row0 = u.pm * 256 + wr * 64 + fr, col0 = u.pn * 256 + wc * 32 + 8 * fq; \
    _Pragma("unroll") for (int ai = 0; ai < 2; ++ai) _Pragma("unroll") for (int m = 0; m < 4; ++m) { const int row = row0 + ai * 128 + m * 16;
#define EPI_BJ _Pragma("unroll") for (int bj = 0; bj < 2; ++bj) { const int col = col0 + bj * 128; const f32x4 v0 = acc[ai][bj][m][0], v1 = acc[ai][bj][m][1];
#define EPI_ACC const f32x4 (&acc)[2][2][4][2], const Unit& u, int wr, int wc, int fr, int fq

__device__ __forceinline__ u32x4 pack8(const f32x4 a, const f32x4 b) { u32x4 w; w.x = pk_bf16(a[0], a[1]); w.y = pk_bf16(a[2], a[3]); w.z = pk_bf16(b[0], b[1]); w.w = pk_bf16(b[2], b[3]); return w; }
__device__ __forceinline__ void unpack8(const u32x4 w, f32x4& a, f32x4& b) { a = (f32x4){bf_lo(w.x), bf_hi(w.x), bf_lo(w.y), bf_hi(w.y)}; b = (f32x4){bf_lo(w.z), bf_hi(w.z), bf_lo(w.w), bf_hi(w.w)}; }

struct EpiStore {
    bf16_t* O; int ldc;
    __device__ __forceinline__ void operator()(EPI_ACC) const { EPI_LOOP_BEGIN EPI_BJ *(u32x4*)(O + (size_t)row * ldc + col) = pack8(v0, v1); } } }
};
struct EpiMulInPlace {
    bf16_t* Y;
    __device__ __forceinline__ void operator()(EPI_ACC) const { EPI_LOOP_BEGIN if ((m & 1) == 0) __builtin_amdgcn_sched_barrier(0);
        EPI_BJ u32x4* ptr = (u32x4*)(Y + (size_t)row * 1024 + col); f32x4 a, b; unpack8(*ptr, a, b); *ptr = pack8(a * v0, b * v1); } } }
};
struct EpiGates {
    bf16_t* G; const float* bias;
    __device__ __forceinline__ void operator()(EPI_ACC) const { EPI_LOOP_BEGIN EPI_BJ
        const f32x4 b0 = *(const f32x4*)(bias + col), b1 = *(const f32x4*)(bias + col + 4); f32x4 a, b;
#pragma unroll
        for (int j = 0; j < 4; ++j) { a[j] = sigmoidf_(v0[j] + b0[j]); b[j] = sigmoidf_(v1[j] + b1[j]); }
        *(u32x4*)(G + (size_t)row * 2048 + col) = pack8(a, b); } } }
};
struct EpiPool {
    bf16_t* P; const bf16_t* G;
    __device__ __forceinline__ void operator()(EPI_ACC) const { EPI_LOOP_BEGIN EPI_BJ f32x4 a, b; unpack8(*(const u32x4*)(G + (size_t)row * 2048 + col), a, b);
        *(u32x4*)(P + (size_t)row * 1024 + col) = pack8(a * v0, b * v1); } } }
};
struct EpiMerge {
    bf16_t* P; const bf16_t* G;
    __device__ __forceinline__ void operator()(EPI_ACC) const { EPI_LOOP_BEGIN EPI_BJ f32x4 a, b, pa, pb; unpack8(*(const u32x4*)(G + (size_t)row * 2048 + 1024 + col), a, b);
        u32x4* ptr = (u32x4*)(P + (size_t)row * 1024 + col); unpack8(*ptr, pa, pb); *ptr = pack8(pa + a * v0, pb + b * v1); } } }
};
struct EpiOut {
    const float* xp; const float* xs; float* X1; bf16_t* X1B; float* rowsq;
    __device__ __forceinline__ void operator()(EPI_ACC) const { EPI_LOOP_BEGIN const float* xr = row < TP ? xp + (size_t)row * DM : xs + (size_t)(row - TP) * DM; float ss = 0.f; EPI_BJ
        f32x4 a = *(const f32x4*)(xr + col) + v0, b = *(const f32x4*)(xr + col + 4) + v1;
        *(f32x4*)(X1 + (size_t)row * 1024 + col) = a; *(f32x4*)(X1 + (size_t)row * 1024 + col + 4) = b; *(u32x4*)(X1B + (size_t)row * 1024 + col) = pack8(a, b);
#pragma unroll
        for (int j = 0; j < 4; ++j) ss += a[j] * a[j] + b[j] * b[j]; }
        ss += __shfl_xor(ss, 16); ss += __shfl_xor(ss, 32); if (fq == 0) atomicAdd(rowsq + row, ss); } }
};
struct EpiFF1 {
    bf16_t* Hlo; bf16_t* Hhi; const float* rowsq;
    __device__ __forceinline__ void operator()(EPI_ACC) const { bf16_t* H = u.pn < 8 ? Hlo : Hhi; const int cshift = u.pn < 8 ? 0 : 2048;
        EPI_LOOP_BEGIN const float rinv = rsqrtf(rowsq[row] * (1.0f / 1024.0f) + 1e-6f); EPI_BJ f32x4 a, b;
#pragma unroll
        for (int j = 0; j < 4; ++j) { float t0 = fmaxf(v0[j] * rinv, 0.f), t1 = fmaxf(v1[j] * rinv, 0.f); a[j] = t0 * t0; b[j] = t1 * t1; }
        *(u32x4*)(H + (size_t)row * 2048 + (col - cshift)) = pack8(a, b); } } }
};
struct EpiAddInPlace {
    float* X;
    __device__ __forceinline__ void operator()(EPI_ACC) const { EPI_LOOP_BEGIN EPI_BJ f32x4* ptr = (f32x4*)(X + (size_t)row * 1024 + col); ptr[0] = ptr[0] + v0; ptr[1] = ptr[1] + v1; } } }
};
struct EpiFinal {
    float* X; float* rowsq;
    __device__ __forceinline__ void operator()(EPI_ACC) const { EPI_LOOP_BEGIN float ss = 0.f; EPI_BJ f32x4* ptr = (f32x4*)(X + (size_t)row * 1024 + col); const f32x4 a = ptr[0] + v0, b = ptr[1] + v1; ptr[0] = a; ptr[1] = b;
#pragma unroll
        for (int j = 0; j < 4; ++j) ss += a[j] * a[j] + b[j] * b[j]; }
        ss += __shfl_xor(ss, 16); ss += __shfl_xor(ss, 32); if (fq == 0) atomicAdd(rowsq + row, ss); } }
};

template <class Epi>
__device__ __forceinline__ void run_gemm(unsigned char* shm, const bf16_t* A, int lda, const bf16_t* Bt, int ldb, int N, int K, const Epi& E, const bf16_t* A2 = nullptr, int ks = 0) {
    pg8::Gemm g; g.A = A; g.Bt = Bt; g.M = T_TOK; g.N = N; g.K = K; g.lda = lda; g.ldb = ldb; g.A2 = A2; g.ks = ks;
    pg8::StaticOrder S; S.init(T_TOK, N, (int)gridDim.x, (int)blockIdx.x);
    pg8::gemm_phase<Epi>((LAS unsigned char*)shm, g, S, E);
}

__device__ void transpose_cvt(unsigned char* shm, const float* src, int K, int N, bf16_t* dst, int ldd, const float* kscale) {
    float* tile = (float*)shm;
    const int tid = opaque_tid(), ntk = K / 64, ntn = N / 64;
    for (int t = blockIdx.x; t < ntk * ntn; t += gridDim.x) {
        const int tk = t / ntn, tn = t % ntn;
#pragma unroll
        for (int i = 0; i < 8; ++i) { const int kl = (tid >> 6) + 8 * i, nl = tid & 63; const int k = tk * 64 + kl;
            tile[kl * 65 + nl] = src[(size_t)k * N + tn * 64 + nl] * (kscale ? kscale[k] : 1.0f); }
        __syncthreads();
#pragma unroll
        for (int i = 0; i < 8; ++i) { const int nl = (tid >> 6) + 8 * i, kl = tid & 63;
            const unsigned w = pk_bf16(tile[kl * 65 + nl], 0.f); dst[(size_t)(tn * 64 + nl) * ldd + tk * 64 + kl] = (bf16_t)(w & 0xFFFFu); }
        __syncthreads();
    }
}

__device__ void rmsnorm_rows(const Params& p, const float* g, bf16_t* dst) {
    const int tidx = opaque_tid(); const int lane = tidx & 63, wave = (blockIdx.x * 512 + tidx) >> 6, nw = (gridDim.x * 512) >> 6;
    f32x4 gv[4];
#pragma unroll
    for (int i = 0; i < 4; ++i) gv[i] = *(const f32x4*)(g + lane * 4 + 256 * i);
    for (int t = wave; t < T_TOK; t += nw) {
        const float* xr = xrow(p, t); f32x4 v[4]; float ss = 0.f;
#pragma unroll
        for (int i = 0; i < 4; ++i) { v[i] = *(const f32x4*)(xr + lane * 4 + 256 * i); ss += v[i][0] * v[i][0] + v[i][1] * v[i][1] + v[i][2] * v[i][2] + v[i][3] * v[i][3]; }
#pragma unroll
        for (int o = 1; o < 64; o <<= 1) ss += __shfl_xor(ss, o);
        const float rinv = rsqrtf(ss * (1.0f / 1024.0f) + 1e-6f);
#pragma unroll
        for (int i = 0; i < 4; ++i) { u32x2 w; w.x = pk_bf16(v[i][0] * rinv * gv[i][0], v[i][1] * rinv * gv[i][1]); w.y = pk_bf16(v[i][2] * rinv * gv[i][2], v[i][3] * rinv * gv[i][3]);
            *(u32x2*)(dst + (size_t)t * 1024 + lane * 4 + 256 * i) = w; }
    }
}

__device__ void prep_phase(const Params& p, unsigned char* shm) {
    unsigned char* ws = p.ws;
    const int gtid = blockIdx.x * 512 + opaque_tid(), gn = gridDim.x * 512;
    for (int i = gtid; i < T_TOK; i += gn) { ((float*)(ws + OFF_ROWSQ))[i] = 0.f; ((float*)(ws + OFF_ROWSQ2))[i] = 0.f; }
    if (gtid < 64) ((unsigned*)(ws + OFF_QUEUE))[gtid] = 0u;
    transpose_cvt(shm, p.w_in, 1024, 5888, (bf16_t*)(ws + OFF_WIN), 1024, nullptr);
    transpose_cvt(shm, p.w_rwkv_br, 1024, 1024, (bf16_t*)(ws + OFF_WRBR), 1024, nullptr);
    transpose_cvt(shm, p.w_out, 1024, 1024, (bf16_t*)(ws + OFF_WOUT), 1024, nullptr);
    transpose_cvt(shm, p.w_ff1, 1024, 4096, (bf16_t*)(ws + OFF_WFF1), 1024, p.g_ffn);
    transpose_cvt(shm, p.w_ff2, 4096, 1024, (bf16_t*)(ws + OFF_WFF2), 4096, nullptr);
    transpose_cvt(shm, p.g_up, 128, 1024, (bf16_t*)(ws + OFF_WG), 256, nullptr);
    { bf16_t* wg = (bf16_t*)(ws + OFF_WG); for (int i = gtid; i < 1024 * 128; i += gn) wg[(size_t)(i >> 7) * 256 + 128 + (i & 127)] = 0; }
    { bf16_t* we = (bf16_t*)(ws + OFF_WEFF);
      for (int i = gtid; i < 512 * 1024; i += gn) { const int k = i >> 10, n = i & 1023, gI = k >> 7; const float* pw = p.pool_w + (size_t)k * 128; float acc = 0.f;
          for (int d = 0; d < 128; ++d) acc += pw[d] * p.pool_scale[gI * 128 + d] * p.w_pool_br[(size_t)(gI * 128 + d) * 1024 + n];
          we[(size_t)n * 512 + k] = (bf16_t)(pk_bf16(acc, 0.f) & 0xFFFFu); } }
    rmsnorm_rows(p, p.g_mix, (bf16_t*)(ws + OFF_R1));
}

#define LDS_BAR() do { asm volatile("s_waitcnt lgkmcnt(0)" ::: "memory"); __builtin_amdgcn_s_barrier(); asm volatile("" ::: "memory"); } while (0)
constexpr int N_SAMPLE_ITEMS = 128, N_ITEMS = N_SAMPLE_ITEMS + 1024;

template <int LPR, int RPL, int DIR>
__device__ __forceinline__ void scan_item(const Params& p, unsigned char* shm, const int tid, const int tbase, const int L, const int h, const int half) {
    constexpr int dir = DIR;
    constexpr int EC = 64 / LPR, RPW = RPL * (64 / LPR);
    float* sW = (float*)shm; float* sAV = sW + 2048; float* sBV = sW + 4096; float* sKD = sW + 6144; float* sWR = sW + 8192; float* sR = sW + 10240; float* sV = sW + 12288; float* sY = sW + 14336;
    float* sBK = sW + 16384;
    bf16_t* sTW = (bf16_t*)(sW + 16384 + 64);
    bf16_t* sZA = sTW + 32 * 72;
    const int lane = tid & 63, wv = tid >> 6;
    const bf16_t* zall = (const bf16_t*)(p.ws + OFF_Z);
    const int tokA = tid >> 4, q = tid & 15;
    const int rowS = half * 32 + wv * RPW + RPL * (lane / LPR), gS = lane % LPR;
    const int NC = L / 32;
    bf16_t* ybuf = (bf16_t*)p.out + (dir ? (size_t)T_TOK * 1024 : 0);
    float* bonus = (float*)(p.ws + OFF_BONUS) + (dir ? (size_t)T_TOK * 16 : 0);
    const float* w_up = dir ? p.w_up_b : p.w_up_f; const float* a_up = dir ? p.a_up_b : p.a_up_f;
    const float* w0 = dir ? p.w0_b : p.w0_f; const float* a0 = dir ? p.a0_b : p.a0_f;
    const int mat = wv >> 2, cbk = wv & 3, colB = cbk * 16 + (lane & 15), quad = lane >> 4;
    u32x4* sBF = (u32x4*)(shm + 84 * 1024);
    { const float* up = mat ? a_up : w_up;
#pragma unroll
      for (int kb = 0; kb < 2; ++kb) { float f[8];
#pragma unroll
          for (int j = 0; j < 8; ++j) f[j] = up[(size_t)(kb * 32 + quad * 8 + j) * 1024 + h * 64 + colB];
          u32x4 w; w.x = pk_bf16(f[0], f[1]); w.y = pk_bf16(f[2], f[3]); w.z = pk_bf16(f[4], f[5]); w.w = pk_bf16(f[6], f[7]); sBF[kb * 512 + tid] = w; } }
    const float c0B = (mat ? a0 : w0)[h * 64 + colB];
    const float kaB = p.k_a[h * 64 + colB];
    int colz[5];
    float* sM0 = (float*)(shm + 100 * 1024);
    float* sMU = (float*)(shm + 76 * 1024);
#pragma unroll
    for (int gi = 0; gi < 5; ++gi) colz[gi] = (gi == 0 ? COL_R + h * 64 : gi == 1 ? COL_K + h * 64 : gi == 2 ? COL_V + h * 64 : gi == 3 ? COL_W : COL_A) + 4 * q;
    if (tid < 320) { const int gi = tid >> 6, c = tid & 63; const int col = (gi == 0 ? COL_R + h * 64 : gi == 1 ? COL_K + h * 64 : gi == 2 ? COL_V + h * 64 : gi == 3 ? COL_W : COL_A) + c - COL_R;
        const float mpv_ = p.mu_prev[col], mnv_ = p.mu_next[col]; sMU[gi * 64 + c] = mpv_; sMU[320 + gi * 64 + c] = mnv_; sM0[gi * 64 + c] = 1.0f - mpv_ - mnv_; }
    else if (tid < 384) sMU[640 + (tid - 320)] = p.k_k[h * 64 + (tid - 320)];
    else if (tid < 448) sMU[704 + (tid - 384)] = p.r_k[h * 64 + (tid - 384)];
    __syncthreads();
    float s[RPL][EC];
#pragma unroll
    for (int r = 0; r < RPL; ++r)
#pragma unroll
        for (int j = 0; j < EC; ++j) s[r][j] = 0.f;
    u32x2 zc[5], zp[5], zn[5];
    auto load_chunk = [&](int ci) {
        const int t = tbase + 32 * (dir ? NC - 1 - ci : ci) + tokA; const bool hasPrev = t > tbase, hasNext = t < tbase + L - 1;
        const bf16_t* zr = zall + (size_t)t * ZLD;
#pragma unroll
        for (int gi = 0; gi < 5; ++gi) { zc[gi] = *(const u32x2*)(zr + colz[gi]); zp[gi] = (u32x2){0u, 0u}; zn[gi] = (u32x2){0u, 0u};
            if (hasPrev) zp[gi] = *(const u32x2*)(zr - ZLD + colz[gi]);
            if (hasNext) zn[gi] = *(const u32x2*)(zr + ZLD + colz[gi]); }
    };
    load_chunk(0);
    for (int ci = 0; ci < NC; ++ci) {
        const int t0 = tbase + 32 * (dir ? NC - 1 - ci : ci);
        { float zs[5][4];
#pragma unroll
          for (int gi = 0; gi < 5; ++gi) {
              const float c[4] = {bf_lo(zc[gi].x), bf_hi(zc[gi].x), bf_lo(zc[gi].y), bf_hi(zc[gi].y)}, pv[4] = {bf_lo(zp[gi].x), bf_hi(zp[gi].x), bf_lo(zp[gi].y), bf_hi(zp[gi].y)}, nx[4] = {bf_lo(zn[gi].x), bf_hi(zn[gi].x), bf_lo(zn[gi].y), bf_hi(zn[gi].y)};
              const f32x4 mp = *(const f32x4*)(sMU + gi * 64 + 4 * q), mn = *(const f32x4*)(sMU + 320 + gi * 64 + 4 * q), m0 = *(const f32x4*)(sM0 + gi * 64 + 4 * q);
              shift4(zs[gi], c, pv, nx, m0, mp, mn);
          }
          if (ci + 1 < NC) load_chunk(ci + 1);
          *(f32x4*)(sR + tokA * 64 + 4 * q) = (f32x4){zs[0][0], zs[0][1], zs[0][2], zs[0][3]};
          *(f32x4*)(sKD + tokA * 64 + 4 * q) = (f32x4){zs[1][0], zs[1][1], zs[1][2], zs[1][3]};
          *(f32x4*)(sV + tokA * 64 + 4 * q) = (f32x4){zs[2][0], zs[2][1], zs[2][2], zs[2][3]};
          float kk[4], ss; const f32x4 kk4c = *(const f32x4*)(sMU + 640 + 4 * q);
          kk4(kk, ss, zs[1], kk4c);
          ss = ss + 0.0f * kk[0];
          ss = red16(ss);
          const float inv = -__builtin_amdgcn_rsqf(fmaxf(ss, 1e-24f));
          *(f32x4*)(sAV + tokA * 64 + 4 * q) = (f32x4){kk[0] * inv, kk[1] * inv, kk[2] * inv, kk[3] * inv};
          float tw[4];
#pragma unroll
          for (int j = 0; j < 4; ++j) tw[j] = 1.0f - 2.0f * __builtin_amdgcn_rcpf(1.0f + fexp2_scaled(zs[3][j], 2.8853900818f));
          u32x2 w; w.x = pk_bf16(tw[0], tw[1]); w.y = pk_bf16(tw[2], tw[3]); *(u32x2*)(sTW + tokA * 72 + 4 * q) = w;
          w.x = pk_bf16(zs[4][0], zs[4][1]); w.y = pk_bf16(zs[4][2], zs[4][3]); *(u32x2*)(sZA + tokA * 72 + 4 * q) = w;
        }
        LDS_BAR();
        { const bf16_t* sX = mat ? sZA : sTW;
#pragma unroll
          for (int rb = 0; rb < 2; ++rb) {
              f32x4 acc = (f32x4){0.f, 0.f, 0.f, 0.f};
#pragma unroll
              for (int kb = 0; kb < 2; ++kb) { const bf16x8 af = *(const bf16x8*)(sX + (rb * 16 + (lane & 15)) * 72 + kb * 32 + quad * 8);
                  acc = __builtin_amdgcn_mfma_f32_16x16x32_bf16(af, __builtin_bit_cast(bf16x8, sBF[kb * 512 + tid]), acc, 0, 0, 0); }
#pragma unroll
              for (int j = 0; j < 4; ++j) { const int idx = (rb * 16 + quad * 4 + j) * 64 + colB; const float pre = c0B + acc[j];
                  if (mat == 0) { const float w = fexp2_scaled(sigmoidf_(pre), -0.6065306597f * 1.4426950409f); sW[idx] = w; sWR[idx] = w * sR[idx]; }
                  else { const float a = sigmoidf_(pre); const float k = sKD[idx]; sKD[idx] = k * (1.0f + (a - 1.0f) * kaB); sBV[idx] = -sAV[idx] * a; } }
          } }
        LDS_BAR();
        { const f32x4 r4 = *(const f32x4*)(sR + tokA * 64 + 4 * q), b4 = *(const f32x4*)(sBV + tokA * 64 + 4 * q), k4 = *(const f32x4*)(sKD + tokA * 64 + 4 * q);
          float br = 0.f, kr = 0.f, cb = 0.f; const f32x4 rk4 = *(const f32x4*)(sMU + 704 + 4 * q);
#pragma unroll
          for (int j = 0; j < 4; ++j) { br += b4[j] * r4[j]; kr += k4[j] * r4[j]; cb += r4[j] * k4[j] * rk4[j]; }
          br = red16(br); kr = red16(kr); cb = red16(cb);
          if (q == 0) { sBK[tokA * 2] = br; sBK[tokA * 2 + 1] = kr; if (half == 0) bonus[(size_t)(t0 + tokA) * 16 + h] = cb; } }
        LDS_BAR();
        {
            constexpr int NV = EC / 4;
            struct Ops { f32x4 w[NV], a[NV], b[NV], k[NV], q[NV]; float v[RPL]; f32x2 bk; };
            auto ld = [&](Ops& o, int i) { const int tk = DIR ? 31 - i : i; const int off = tk * 64 + 4 * gS;
#pragma unroll
                for (int c = 0; c < NV; ++c) { o.w[c] = *(const f32x4*)(sW + off + 32 * c); o.a[c] = *(const f32x4*)(sAV + off + 32 * c); o.b[c] = *(const f32x4*)(sBV + off + 32 * c);
                    o.k[c] = *(const f32x4*)(sKD + off + 32 * c); o.q[c] = *(const f32x4*)(sWR + off + 32 * c); }
                if constexpr (RPL == 2) { const f32x2 v2 = *(const f32x2*)(sV + tk * 64 + rowS); o.v[0] = v2.x; o.v[1] = v2.y; } else o.v[0] = sV[tk * 64 + rowS];
                o.bk = *(const f32x2*)(sBK + tk * 2); };
            auto step = [&](const Ops& cur, int i) {
                static_assert(EC == 4, "asm row helpers are written for 4 columns per lane");
                float sa[RPL], yp[RPL], y[RPL];
#pragma unroll
                for (int r = 0; r < RPL; ++r) row_dots(s[r], cur.a[0], cur.q[0], sa[r], yp[r]);
                if constexpr (RPL == 2) red16x4(sa[0], yp[0], sa[1], yp[1]); else red16x2(sa[0], yp[0]);
#pragma unroll
                for (int r = 0; r < RPL; ++r) row_update(s[r], cur.w[0], cur.b[0], cur.k[0], cur.v[r], sa[r], yp[r], cur.bk.x, cur.bk.y, y[r]);
                if (gS == 0) { if constexpr (RPL == 2) *(f32x2*)(sY + (DIR ? 31 - i : i) * 64 + rowS) = (f32x2){y[0], y[1]}; else sY[(DIR ? 31 - i : i) * 64 + rowS] = y[0]; }
            };
            {
                Ops o0, o1; ld(o0, 0);
#pragma unroll 1
                for (int i = 0; i < 32; i += 2) {
                    ld(o1, i + 1);
                    step(o0, i);
                    ld(o0, min(i + 2, 31));
                    step(o1, i + 1);
                }
            }
        }
        LDS_BAR();
        if (RPL == 2 || (q >> 3) == half) { const f32x4 y4 = *(const f32x4*)(sY + tokA * 64 + 4 * q); u32x2 w; w.x = pk_bf16(y4[0], y4[1]); w.y = pk_bf16(y4[2], y4[3]);
          *(u32x2*)(ybuf + (size_t)(t0 + tokA) * 1024 + h * 64 + 4 * q) = w; }
    }
}

__device__ void scan_phase(const Params& p, unsigned char* shm) {
    int* sItem = (int*)(shm + 80 * 1024);
    const int tid = opaque_tid();
    unsigned* queue = (unsigned*)(p.ws + OFF_QUEUE);
    for (;;) {
        if (tid == 0) *sItem = (int)atomicAdd(queue, 1u);
        __syncthreads();
        const int item = *sItem;
        __syncthreads();
        if (item >= N_ITEMS) break;
        int tid2 = tid; asm volatile("" : "+v"(tid2));
        if (item < N_SAMPLE_ITEMS) {
            const int half = item & 1, j = item >> 1;
            if (j & 1) scan_item<16, 1, 1>(p, shm, tid2, TP + (j >> 5) * 16384, 16384, (j >> 1) & 15, half); else scan_item<16, 1, 0>(p, shm, tid2, TP + (j >> 5) * 16384, 16384, (j >> 1) & 15, half);
        } else { const int j = item - N_SAMPLE_ITEMS;
            if (j & 1) scan_item<16, 2, 1>(p, shm, tid2, (j >> 5) * 2048, 2048, (j >> 1) & 15, 0); else scan_item<16, 2, 0>(p, shm, tid2, (j >> 5) * 2048, 2048, (j >> 1) & 15, 0); }
        __syncthreads();
    }
}

__device__ void mix_phase(const Params& p) {
    const int tidx = opaque_tid(); const int lane = tidx & 63, wave = (blockIdx.x * 512 + tidx) >> 6, nw = (gridDim.x * 512) >> 6;
    const bf16_t* zall = (const bf16_t*)(p.ws + OFF_Z);
    bf16_t* yf = (bf16_t*)p.out; const bf16_t* yb = (const bf16_t*)p.out + (size_t)T_TOK * 1024;
    const float* bonus_f = (const float*)(p.ws + OFF_BONUS); const float* bonus_b = bonus_f + (size_t)T_TOK * 16;
    bf16_t* pooled = (bf16_t*)(p.ws + OFF_POOLED); bf16_t* sg = (bf16_t*)(p.ws + OFF_SG);
    const int hL = lane >> 2;
    const int tpw = (T_TOK + nw - 1) / nw;
    for (int t = wave * tpw; t < min(T_TOK, (wave + 1) * tpw); ++t) {
        int tbase, L; seq_of(t, tbase, L); const int pos = t - tbase; const bool hasPrev = pos > 0, hasNext = pos < L - 1;
        const bf16_t* zr = zall + (size_t)t * ZLD;
        { const int c0 = lane * 16; float y[16];
          { const u32x4 a0 = *(const u32x4*)(yf + (size_t)t * 1024 + c0), a1 = *(const u32x4*)(yf + (size_t)t * 1024 + c0 + 8);
            const u32x4 b0 = *(const u32x4*)(yb + (size_t)t * 1024 + c0), b1 = *(const u32x4*)(yb + (size_t)t * 1024 + c0 + 8);
            f32x4 fa, fb, ga, gb; unpack8(a0, fa, fb); unpack8(b0, ga, gb);
#pragma unroll
            for (int j = 0; j < 4; ++j) { y[j] = fa[j] + ga[j]; y[4 + j] = fb[j] + gb[j]; }
            unpack8(a1, fa, fb); unpack8(b1, ga, gb);
#pragma unroll
            for (int j = 0; j < 4; ++j) { y[8 + j] = fa[j] + ga[j]; y[12 + j] = fb[j] + gb[j]; } }
          float sm = 0.f;
#pragma unroll
          for (int j = 0; j < 16; ++j) sm += y[j];
          const float mean = red4(sm) * (1.0f / 64.0f); float vs = 0.f;
#pragma unroll
          for (int j = 0; j < 16; ++j) { const float d = y[j] - mean; vs += d * d; }
          const float rstd = rsqrtf(red4(vs) * (1.0f / 64.0f) + 64e-5f);
          const float bon = bonus_f[(size_t)t * 16 + hL] + bonus_b[(size_t)t * 16 + hL];
          float vv[16];
          { const bf16_t* zc = zr + COL_V + c0;
            u32x4 c_[2], p_[2], n_[2];
#pragma unroll
            for (int i = 0; i < 2; ++i) { c_[i] = *(const u32x4*)(zc + 8 * i); p_[i] = hasPrev ? *(const u32x4*)(zc - ZLD + 8 * i) : (u32x4){0u, 0u, 0u, 0u}; n_[i] = hasNext ? *(const u32x4*)(zc + ZLD + 8 * i) : (u32x4){0u, 0u, 0u, 0u}; }
#pragma unroll
            for (int i = 0; i < 2; ++i) { f32x4 ca, cb, pa, pb, na, nb; unpack8(c_[i], ca, cb); unpack8(p_[i], pa, pb); unpack8(n_[i], na, nb);
                const float* mp = p.mu_prev + (COL_V - COL_R) + c0 + 8 * i; const float* mn = p.mu_next + (COL_V - COL_R) + c0 + 8 * i;
                const f32x4 mp0 = *(const f32x4*)mp, mp1 = *(const f32x4*)(mp + 4), mn0 = *(const f32x4*)mn, mn1 = *(const f32x4*)(mn + 4);
#pragma unroll
                for (int j = 0; j < 4; ++j) { vv[8 * i + j] = ca[j] + mp0[j] * (pa[j] - ca[j]) + mn0[j] * (na[j] - ca[j]); vv[8 * i + 4 + j] = cb[j] + mp1[j] * (pb[j] - cb[j]) + mn1[j] * (nb[j] - cb[j]); } } }
          float o[16];
#pragma unroll
          for (int i = 0; i < 4; ++i) { const f32x4 lw = *(const f32x4*)(p.ln_w + c0 + 4 * i), lb = *(const f32x4*)(p.ln_b + c0 + 4 * i);
#pragma unroll
              for (int j = 0; j < 4; ++j) o[4 * i + j] = (y[4 * i + j] - mean) * rstd * lw[j] + lb[j] + bon * vv[4 * i + j]; }
          u32x4 w0, w1; w0.x = pk_bf16(o[0], o[1]); w0.y = pk_bf16(o[2], o[3]); w0.z = pk_bf16(o[4], o[5]); w0.w = pk_bf16(o[6], o[7]);
          w1.x = pk_bf16(o[8], o[9]); w1.y = pk_bf16(o[10], o[11]); w1.z = pk_bf16(o[12], o[13]); w1.w = pk_bf16(o[14], o[15]);
          *(u32x4*)(yf + (size_t)t * 1024 + c0) = w0; *(u32x4*)(yf + (size_t)t * 1024 + c0 + 8) = w1; }
        { const int c = 2 * lane; const bf16_t* zc = zr + COL_G + c; const unsigned wc_ = *(const unsigned*)zc; const unsigned wp = hasPrev ? *(const unsigned*)(zc - ZLD) : 0u, wn = hasNext ? *(const unsigned*)(zc + ZLD) : 0u;
          const float mp0 = p.mu_prev[COL_G - COL_R + c], mp1 = p.mu_prev[COL_G - COL_R + c + 1], mn0 = p.mu_next[COL_G - COL_R + c], mn1 = p.mu_next[COL_G - COL_R + c + 1];
          const float c0v = bf_lo(wc_), c1v = bf_hi(wc_);
          const float z0 = c0v + mp0 * (bf_lo(wp) - c0v) + mn0 * (bf_lo(wn) - c0v), z1 = c1v + mp1 * (bf_hi(wp) - c1v) + mn1 * (bf_hi(wn) - c1v);
          *(unsigned*)(sg + (size_t)t * 256 + c) = pk_bf16(sigmoidf_(z0), sigmoidf_(z1)); *(unsigned*)(sg + (size_t)t * 256 + 128 + c) = 0u; }
        { const int c = lane * 8, gi = lane >> 4, w = 2 << gi; const int lo = max(pos - (w >> 1), 0), hi = min(pos + (w >> 1) - 1, L - 1);
          float sum[8];
#pragma unroll
          for (int j = 0; j < 8; ++j) sum[j] = 0.f;
          u32x4 wr_[16];
#pragma unroll
          for (int d = 0; d < 16; ++d) { const int r = pos - 8 + d; wr_[d] = (u32x4){0u, 0u, 0u, 0u}; if (r >= lo && r <= hi) wr_[d] = *(const u32x4*)(zall + (size_t)(tbase + r) * ZLD + c); }
#pragma unroll
          for (int d = 0; d < 16; ++d) { f32x4 a, b; unpack8(wr_[d], a, b);
#pragma unroll
              for (int j = 0; j < 4; ++j) { sum[j] += a[j]; sum[4 + j] += b[j]; } }
          const float icnt = 1.0f / (float)(hi - lo + 1); f32x4 a, b; unpack8(*(const u32x4*)(zr + c), a, b); f32x4 oa, ob;
#pragma unroll
          for (int j = 0; j < 4; ++j) { oa[j] = sum[j] * icnt - a[j]; ob[j] = sum[4 + j] * icnt - b[j]; }
          *(u32x4*)(pooled + (size_t)t * 512 + c) = pack8(oa, ob); }
    }
}

__device__ void final_phase(const Params& p) {
    const int tidx = opaque_tid(); const int lane = tidx & 63, wave = (blockIdx.x * 512 + tidx) >> 6, nw = (gridDim.x * 512) >> 6;
    const float* x2 = (const float*)(p.ws + OFF_X1); const float* rowsq2 = (const float*)(p.ws + OFF_ROWSQ2);
    f32x4 gv[4];
#pragma unroll
    for (int i = 0; i < 4; ++i) gv[i] = *(const f32x4*)(p.g_final + lane * 4 + 256 * i);
    for (int t = wave; t < T_TOK; t += nw) {
        const float rinv = rsqrtf(rowsq2[t] * (1.0f / 1024.0f) + 1e-6f);
#pragma unroll
        for (int i = 0; i < 4; ++i) { const f32x4 v = *(const f32x4*)(x2 + (size_t)t * 1024 + lane * 4 + 256 * i); *(f32x4*)(p.out + (size_t)t * 1024 + lane * 4 + 256 * i) = v * rinv * gv[i]; }
    }
}

__global__ void __launch_bounds__(512, 2) fwd_megakernel(Params p) {
    extern __shared__ __attribute__((aligned(16))) unsigned char shm[];
    unsigned char* ws = p.ws;
    prep_phase(p, shm);
    cg::this_grid().sync();
    { EpiStore E; E.O = (bf16_t*)(ws + OFF_Z); E.ldc = ZLD; run_gemm(shm, (const bf16_t*)(ws + OFF_R1), 1024, (const bf16_t*)(ws + OFF_WIN), 1024, 3840, 1024, E); }
    cg::this_grid().sync();
    scan_phase(p, shm);
    cg::this_grid().sync();
    mix_phase(p);
    cg::this_grid().sync();
    rmsnorm_rows(p, p.g_mix, (bf16_t*)(ws + OFF_XN2));
    { EpiMulInPlace E; E.Y = (bf16_t*)p.out; run_gemm(shm, (const bf16_t*)(ws + OFF_SG), 256, (const bf16_t*)(ws + OFF_WG), 256, 1024, 256, E); }
    cg::this_grid().sync();
    { EpiGates E; E.G = (bf16_t*)(ws + OFF_GATES); E.bias = p.b_gate; run_gemm(shm, (const bf16_t*)(ws + OFF_XN2), 1024, (const bf16_t*)(ws + OFF_WIN) + (size_t)3840 * 1024, 1024, 2048, 1024, E); }
    cg::this_grid().sync();
    { EpiPool E; E.P = (bf16_t*)(ws + OFF_MERGED); E.G = (const bf16_t*)(ws + OFF_GATES); run_gemm(shm, (const bf16_t*)(ws + OFF_POOLED), 512, (const bf16_t*)(ws + OFF_WEFF), 512, 1024, 512, E); }
    { EpiMerge E; E.P = (bf16_t*)(ws + OFF_MERGED); E.G = (const bf16_t*)(ws + OFF_GATES); run_gemm(shm, (const bf16_t*)p.out, 1024, (const bf16_t*)(ws + OFF_WRBR), 1024, 1024, 1024, E); }
    cg::this_grid().sync();
    { EpiOut E; E.xp = p.x_prompt; E.xs = p.x_sample; E.X1 = (float*)(ws + OFF_X1); E.X1B = (bf16_t*)(ws + OFF_X1B); E.rowsq = (float*)(ws + OFF_ROWSQ); run_gemm(shm, (const bf16_t*)(ws + OFF_MERGED), 1024, (const bf16_t*)(ws + OFF_WOUT), 1024, 1024, 1024, E); }
    cg::this_grid().sync();
    { EpiFF1 E; E.Hlo = (bf16_t*)(ws + OFF_HLO); E.Hhi = (bf16_t*)p.out; E.rowsq = (const float*)(ws + OFF_ROWSQ); run_gemm(shm, (const bf16_t*)(ws + OFF_X1B), 1024, (const bf16_t*)(ws + OFF_WFF1), 1024, 4096, 1024, E); }
    cg::this_grid().sync();
    { EpiFinal E; E.X = (float*)(ws + OFF_X1); E.rowsq = (float*)(ws + OFF_ROWSQ2);
      run_gemm(shm, (const bf16_t*)(ws + OFF_HLO), 2048, (const bf16_t*)(ws + OFF_WFF2), 4096, 1024, 4096, E, (const bf16_t*)p.out, 32); }
    cg::this_grid().sync();
    final_phase(p);
}

extern "C" void kernel_launch(void* const* d_in, const int* in_sizes, int n_in, void* d_out, int out_size, void* d_ws, size_t ws_size, hipStream_t stream) {
    constexpr size_t kDynLds = 131072;
    static int grid_blocks = 0;
    if (!grid_blocks) {
        hipFuncSetAttribute((const void*)fwd_megakernel, hipFuncAttributeMaxDynamicSharedMemorySize, (int)kDynLds);
        int dev = 0, cus = 0, per_cu = 0;
        hipGetDevice(&dev);
        hipDeviceGetAttribute(&cus, hipDeviceAttributeMultiprocessorCount, dev);
        hipOccupancyMaxActiveBlocksPerMultiprocessor(&per_cu, fwd_megakernel, 512, kDynLds);
        if (per_cu < 1) per_cu = 1;
        grid_blocks = cus;
    }
    Params p{};
    const float** pf = (const float**)&p;
    for (int i = 0; i < 30; ++i) pf[i] = (const float*)d_in[i];
    p.out = (float*)d_out; p.ws = (unsigned char*)d_ws;
    void* args[] = {&p};
    hipError_t e = hipLaunchCooperativeKernel((const void*)fwd_megakernel, dim3(grid_blocks), dim3(512), args, kDynLds, stream);
    if (e != hipSuccess) fprintf(stderr, "cooperative launch failed: %s (grid %d)\n", hipGetErrorString(e), grid_blocks);
}
```

```cpp
#include <hip/hip_runtime.h>
#include <hip/hip_cooperative_groups.h>
#include <cstdio>
namespace cg = cooperative_groups;

#define LAS __attribute__((address_space(3)))
typedef unsigned short bf16_t;
typedef short bf16x8 __attribute__((ext_vector_type(8)));
typedef float f32x4 __attribute__((ext_vector_type(4)));
typedef float f32x2 __attribute__((ext_vector_type(2)));
typedef unsigned u32x4 __attribute__((ext_vector_type(4)));
typedef unsigned u32x2 __attribute__((ext_vector_type(2)));

constexpr int T_TOK = 98304, DM = 1024, TP = 65536;
constexpr int ZLD = 3840;
constexpr int COL_R = 512, COL_K = 1536, COL_V = 2560, COL_W = 3584, COL_A = 3648, COL_G = 3712;
constexpr size_t MiB = 1ull << 20;
constexpr size_t OFF_WIN = 0, OFF_WEFF = 12 * MiB, OFF_WRBR = 13 * MiB, OFF_WOUT = 15 * MiB, OFF_WFF1 = 17 * MiB, OFF_WFF2 = 25 * MiB, OFF_WG = 33 * MiB;
constexpr size_t OFF_ROWSQ = 34 * MiB, OFF_ROWSQ2 = 34 * MiB + 512 * 1024, OFF_QUEUE = 35 * MiB, OFF_BONUS = 36 * MiB;
constexpr size_t OFF_R1 = 48 * MiB, OFF_Z = 240 * MiB;
constexpr size_t OFF_POOLED = OFF_R1, OFF_SG = OFF_R1 + 96 * MiB, OFF_XN2 = OFF_Z, OFF_GATES = OFF_Z + 192 * MiB, OFF_MERGED = OFF_Z + 576 * MiB;
constexpr size_t OFF_X1B = OFF_R1, OFF_X1 = OFF_Z, OFF_HLO = OFF_Z + 384 * MiB;
constexpr size_t U_BYTES = (size_t)T_TOK * 1024 * 2;

struct Params {
    const float *x_prompt, *x_sample, *g_mix, *w_in, *b_gate, *mu_prev, *mu_next, *pool_w, *pool_scale, *w_pool_br, *k_k, *k_a, *r_k,
        *w0_f, *w_up_f, *a0_f, *a_up_f, *w0_b, *w_up_b, *a0_b, *a_up_b, *g_up, *ln_w, *ln_b, *w_rwkv_br, *w_out, *g_ffn, *w_ff1, *w_ff2, *g_final;
    float* out; unsigned char* ws;
};

__device__ __forceinline__ float bf_lo(unsigned w) { return __uint_as_float(w << 16); }
__device__ __forceinline__ float bf_hi(unsigned w) { return __uint_as_float(w & 0xFFFF0000u); }
typedef __bf16 bf16x2_t __attribute__((ext_vector_type(2)));
__device__ __forceinline__ unsigned pk_bf16(float lo, float hi) { f32x2 v = {lo, hi}; bf16x2_t b = __builtin_convertvector(v, bf16x2_t); return __builtin_bit_cast(unsigned, b); }
__device__ __forceinline__ float fexp2_scaled(float x, float scale_log2e) { return __builtin_amdgcn_exp2f(x * scale_log2e); }
__device__ __forceinline__ float sigmoidf_(float x) { return __builtin_amdgcn_rcpf(1.0f + fexp2_scaled(x, -1.4426950409f)); }
__device__ __forceinline__ float fma_s(float a, float b, float c) { float d; asm("v_fma_f32 %0, %1, %2, %3" : "=v"(d) : "v"(a), "v"(b), "v"(c)); return d; }
__device__ __forceinline__ float mul_s(float a, float b) { float d; asm("v_mul_f32 %0, %1, %2" : "=v"(d) : "v"(a), "v"(b)); return d; }
__device__ __forceinline__ float add_s(float a, float b) { float d; asm("v_add_f32 %0, %1, %2" : "=v"(d) : "v"(a), "v"(b)); return d; }
#define DPPA(x, c) "v_add_f32_dpp " x ", " x ", " x " " c " row_mask:0xf bank_mask:0xf bound_ctrl:1\n"
#define DPP4(c) DPPA("%0", c) DPPA("%1", c) DPPA("%2", c) DPPA("%3", c)
#define DPP2(c) DPPA("%0", c) DPPA("%1", c) "s_nop 0\n"
__device__ __forceinline__ void red16x4(float& a, float& b, float& c, float& d) {
    asm("s_nop 1\n" DPP4("quad_perm:[1,0,3,2]") DPP4("quad_perm:[2,3,0,1]") DPP4("row_half_mirror") DPP4("row_mirror") : "+v"(a), "+v"(b), "+v"(c), "+v"(d)); }
__device__ __forceinline__ void red16x2(float& a, float& b) {
    asm("s_nop 1\n" DPP2("quad_perm:[1,0,3,2]") DPP2("quad_perm:[2,3,0,1]") DPP2("row_half_mirror") DPP2("row_mirror") : "+v"(a), "+v"(b)); }
__device__ __forceinline__ void row_dots(const float (&s)[4], const f32x4 a, const f32x4 q, float& sa, float& yp) {
    asm("v_mul_f32 %0, %2, %6\n v_mul_f32 %1, %2, %10\n v_fmac_f32 %0, %3, %7\n v_fmac_f32 %1, %3, %11\n v_fmac_f32 %0, %4, %8\n v_fmac_f32 %1, %4, %12\n v_fmac_f32 %0, %5, %9\n v_fmac_f32 %1, %5, %13"
        : "=&v"(sa), "=&v"(yp) : "v"(s[0]), "v"(s[1]), "v"(s[2]), "v"(s[3]), "v"(a[0]), "v"(a[1]), "v"(a[2]), "v"(a[3]), "v"(q[0]), "v"(q[1]), "v"(q[2]), "v"(q[3])); }
__device__ __forceinline__ void row_update(float (&s)[4], const f32x4 w, const f32x4 b, const f32x4 k, float v, float sa, float yp, float bkx, float bky, float& y) {
    float t0, t1, t2, t3;
    asm("v_mul_f32 %0, %6, %15\n v_mul_f32 %1, %6, %16\n v_mul_f32 %2, %6, %17\n v_mul_f32 %3, %6, %18\n"
        "v_fmac_f32 %4, %7, %5\n"
        "v_fmac_f32 %0, %7, %11\n v_fmac_f32 %1, %7, %12\n v_fmac_f32 %2, %7, %13\n v_fmac_f32 %3, %7, %14\n"
        "v_fmac_f32 %4, %6, %8\n"
        "v_fmac_f32 %0, %9, %19\n v_fmac_f32 %1, %10, %20\n v_fmac_f32 %2, %23, %21\n v_fmac_f32 %3, %24, %22"
        : "=&v"(t0), "=&v"(t1), "=&v"(t2), "=&v"(t3), "+v"(yp)
        : "v"(bkx), "v"(v), "v"(sa), "v"(bky), "v"(s[0]), "v"(s[1]), "v"(b[0]), "v"(b[1]), "v"(b[2]), "v"(b[3]), "v"(k[0]), "v"(k[1]), "v"(k[2]), "v"(k[3]), "v"(w[0]), "v"(w[1]), "v"(w[2]), "v"(w[3]), "v"(s[2]), "v"(s[3]));
    s[0] = t0; s[1] = t1; s[2] = t2; s[3] = t3; y = yp; }
__device__ __forceinline__ void shift4(float (&z)[4], const float (&c)[4], const float (&pv)[4], const float (&nx)[4], const f32x4 m0, const f32x4 mp, const f32x4 mn) {
    asm("v_mul_f32 %0, %4, %16\n v_mul_f32 %1, %5, %17\n v_mul_f32 %2, %6, %18\n v_mul_f32 %3, %7, %19\n"
        "v_fma_f32 %0, %8, %20, %0\n v_fma_f32 %1, %9, %21, %1\n v_fma_f32 %2, %10, %22, %2\n v_fma_f32 %3, %11, %23, %3\n"
        "v_fma_f32 %0, %12, %24, %0\n v_fma_f32 %1, %13, %25, %1\n v_fma_f32 %2, %14, %26, %2\n v_fma_f32 %3, %15, %27, %3"
        : "=&v"(z[0]), "=&v"(z[1]), "=&v"(z[2]), "=&v"(z[3])
        : "v"(c[0]), "v"(c[1]), "v"(c[2]), "v"(c[3]), "v"(pv[0]), "v"(pv[1]), "v"(pv[2]), "v"(pv[3]), "v"(nx[0]), "v"(nx[1]), "v"(nx[2]), "v"(nx[3]),
          "v"(m0[0]), "v"(m0[1]), "v"(m0[2]), "v"(m0[3]), "v"(mp[0]), "v"(mp[1]), "v"(mp[2]), "v"(mp[3]), "v"(mn[0]), "v"(mn[1]), "v"(mn[2]), "v"(mn[3])); }
__device__ __forceinline__ void kk4(float (&kk)[4], float& ss, const float (&k)[4], const f32x4 c) {
    asm("v_mul_f32 %0, %5, %9\n v_mul_f32 %1, %6, %10\n v_mul_f32 %2, %7, %11\n v_mul_f32 %3, %8, %12\n"
        "v_mul_f32 %4, %0, %0\n v_fma_f32 %4, %1, %1, %4\n v_fma_f32 %4, %2, %2, %4\n v_fma_f32 %4, %3, %3, %4"
        : "=&v"(kk[0]), "=&v"(kk[1]), "=&v"(kk[2]), "=&v"(kk[3]), "=&v"(ss) : "v"(k[0]), "v"(k[1]), "v"(k[2]), "v"(k[3]), "v"(c[0]), "v"(c[1]), "v"(c[2]), "v"(c[3])); }
template <int CTRL> __device__ __forceinline__ float dppf(float x) { return __int_as_float(__builtin_amdgcn_update_dpp(0, __float_as_int(x), CTRL, 0xF, 0xF, true)); }
__device__ __forceinline__ float red4(float x) { x += dppf<0xB1>(x); x += dppf<0x4E>(x); return x; }
__device__ __forceinline__ float red8(float x) { x = red4(x); x += dppf<0x141>(x); return x; }
__device__ __forceinline__ float red16(float x) { x = red8(x); x += dppf<0x140>(x); return x; }
__device__ __forceinline__ int opaque_tid() { int t = threadIdx.x; asm volatile("" : "+v"(t)); return t; }
__device__ __forceinline__ const float* xrow(const Params& p, int t) { return t < TP ? p.x_prompt + (size_t)t * DM : p.x_sample + (size_t)(t - TP) * DM; }
__device__ __forceinline__ void seq_of(int t, int& base, int& len) { if (t < TP) { base = t & ~2047; len = 2048; } else { base = TP + ((t - TP) & ~16383); len = 16384; } }

namespace pg8 {
constexpr int BM = 256, BK = 64, HALF = 128, HTB = HALF * BK * 2, STAGE_BYTES = 8 * HTB, NXCD = 8, WGM = 8;
__device__ __forceinline__ int lds_byte(int r, int c) { const int st = (r >> 4) * 2 + (c >> 5), rr = r & 15, cc = c & 31, ob = rr * 64 + cc * 2; return st * 1024 + (ob ^ (((ob >> 9) & 1) << 5)); }
__device__ __forceinline__ void stage_rc(int b, int& R, int& C) { const int st = b / 1024, sb = b % 1024, swz = sb ^ (((sb >> 9) & 1) << 5); R = (st >> 1) * 16 + swz / 64; C = (st & 1) * 32 + (swz % 64) / 2; }
__device__ __forceinline__ int perm32(int rho) { const int n = rho >> 4, i = rho & 15; return 8 * (i >> 2) + 4 * n + (i & 3); }
struct Unit { int pm, pn; };
struct Gemm { const bf16_t* A; const bf16_t* Bt; int M, N, K, lda, ldb; const bf16_t* A2; int ks; };
struct StaticOrder {
    int nM, nN, nwg, G, c;
    __device__ void init(int M, int N, int G_, int c_) { nM = M / BM; nN = N / BM; nwg = nM * nN; G = G_; c = c_; }
    __device__ bool next(int i, Unit& u) const {
        const long L = (long)i * G + c; if (L >= nwg) return false;
        int wgid = (int)L; { const int q = nwg / NXCD, r = nwg % NXCD, xcd = wgid % NXCD, off = wgid / NXCD; wgid = (xcd < r ? xcd * (q + 1) : r * (q + 1) + (xcd - r) * q) + off; }
        const int nig = WGM * nN, gid = wgid / nig, fm = gid * WGM, gsz = (nM - fm) < WGM ? (nM - fm) : WGM;
        u.pm = fm + ((wgid % nig) % gsz); u.pn = (wgid % nig) / gsz; return true;
    }
};

template <class Epi>
__device__ __forceinline__ void gemm_phase(LAS unsigned char* lds, const Gemm g, const StaticOrder& S, const Epi& E) {
    const int tid = opaque_tid();
    const int wid = __builtin_amdgcn_readfirstlane(tid >> 6), lane = tid & 63, wr = wid >> 2, wc = wid & 3, fr = lane & 15, fq = lane >> 4;
    const int K = g.K, nt = K / BK;
    unsigned voffA[2], voffB[2];
#pragma unroll
    for (int i = 0; i < 2; ++i) { int R, C; stage_rc(tid * 16 + i * 8192, R, C); const int Rb = (R & ~31) + perm32(R & 31);
        voffA[i] = (unsigned)(R * g.lda + C) * 2u; voffB[i] = (unsigned)(Rb * g.ldb + C) * 2u; }
    const size_t kstep = (size_t)(BK * 2);
    const size_t hstepA = (size_t)HALF * g.lda * 2, hstepB = (size_t)HALF * g.ldb * 2;
    const size_t tstepA = 2 * hstepA, tstepB = 2 * hstepB;
    const unsigned ldsw = (unsigned)wid * 1024u;
    const int aoff = lds_byte(wr * 64 + fr, fq * 8), boff = lds_byte(wc * 32 + fr, fq * 8);
#define PG8_SA(b, h) (((b) * 2 + (h)) * HTB)
#define PG8_SB(b, h) ((4 + (b) * 2 + (h)) * HTB)
#define PG8_STAGE(bufoff, gbase, voff) do { _Pragma("unroll") for (int _i = 0; _i < 2; ++_i) \
        __builtin_amdgcn_global_load_lds((const unsigned*)((const char*)(gbase) + (voff)[_i]), (LAS unsigned*)(lds + (bufoff) + ldsw + _i * 8192), 16, 0, 0); } while (0)
#define PG8_LDA(dst, b, h) do { _Pragma("unroll") for (int m = 0; m < 4; ++m) _Pragma("unroll") for (int k = 0; k < 2; ++k) dst[m][k] = *(const LAS bf16x8*)(lds + PG8_SA(b, h) + aoff + m * 2048 + k * 1024); } while (0)
#define PG8_LDB(dst, b, h) do { _Pragma("unroll") for (int n = 0; n < 2; ++n) _Pragma("unroll") for (int k = 0; k < 2; ++k) dst[n][k] = *(const LAS bf16x8*)(lds + PG8_SB(b, h) + boff + n * 2048 + k * 1024); } while (0)
#define PG8_MMA(ai, bj, At, Bt) do { __builtin_amdgcn_s_setprio(1); _Pragma("unroll") for (int m = 0; m < 4; ++m) _Pragma("unroll") for (int n = 0; n < 2; ++n) _Pragma("unroll") for (int k = 0; k < 2; ++k) \
        acc[ai][bj][m][n] = __builtin_amdgcn_mfma_f32_16x16x32_bf16(Bt[n][k], At[m][k], acc[ai][bj][m][n], 0, 0, 0); __builtin_amdgcn_s_setprio(0); } while (0)
#define PG8_WAIT_V(n) asm volatile("s_waitcnt vmcnt(" #n ")" ::: "memory")
#define PG8_WAIT_L(n) asm volatile("s_waitcnt lgkmcnt(" #n ")" ::: "memory")
#define PG8_BAR __builtin_amdgcn_s_barrier()
#define PG8_SCHED __builtin_amdgcn_sched_barrier(0)
    Unit cur, nxt; int ui = 0;
    if (!S.next(0, cur)) return;
    f32x4 acc[2][2][4][2];
#pragma unroll
    for (int a = 0; a < 2; ++a)
#pragma unroll
        for (int b = 0; b < 2; ++b)
#pragma unroll
            for (int m = 0; m < 4; ++m)
#pragma unroll
                for (int n = 0; n < 2; ++n) acc[a][b][m][n] = (f32x4){0.f, 0.f, 0.f, 0.f};
    bf16x8 At[4][2], B0[2][2], B1[2][2];
    const char* cA = (const char*)g.A + (size_t)cur.pm * tstepA; const char* cB = (const char*)g.Bt + (size_t)cur.pn * tstepB;
    const bool two = g.A2 != nullptr; const int ks = two ? g.ks : (1 << 30);
    const char* cA2 = two ? (const char*)g.A2 + (size_t)cur.pm * tstepA : cA;
    PG8_STAGE(PG8_SB(0, 0), cB, voffB); PG8_STAGE(PG8_SA(0, 0), cA, voffA); PG8_STAGE(PG8_SB(0, 1), cB + hstepB, voffB); PG8_STAGE(PG8_SA(0, 1), cA + hstepA, voffA);
    if (wr == 1) PG8_BAR;
    PG8_WAIT_V(4); PG8_BAR;
    PG8_STAGE(PG8_SB(1, 0), cB + kstep, voffB); PG8_STAGE(PG8_SA(1, 0), cA + kstep, voffA); PG8_STAGE(PG8_SB(1, 1), cB + hstepB + kstep, voffB);
    PG8_WAIT_V(6); PG8_BAR;
    for (;;) {
        const bool has_next = S.next(ui + 1, nxt);
        const char* nA = has_next ? (const char*)g.A + (size_t)nxt.pm * tstepA : cA; const char* nB = has_next ? (const char*)g.Bt + (size_t)nxt.pn * tstepB : cB;
        const char* nA2 = (two && has_next) ? (const char*)g.A2 + (size_t)nxt.pm * tstepA : cA2;
#pragma unroll 1
        for (int t = 0; t < nt; t += 2) {
            const bool last = (t == nt - 2);
            const char* a1 = (t + 1 < ks) ? cA + (size_t)(t + 1) * kstep : cA2 + (size_t)(t + 1 - ks) * kstep;
            const char* a2 = last ? nA : ((t + 2 < ks) ? cA + (size_t)(t + 2) * kstep : cA2 + (size_t)(t + 2 - ks) * kstep); const char* b2 = last ? nB : cB + (size_t)(t + 2) * kstep;
            const char* a3 = a2 + kstep; const char* b3 = b2 + kstep;
            PG8_LDB(B0, 0, 0); PG8_SCHED; PG8_LDA(At, 0, 0); PG8_STAGE(PG8_SA(1, 1), a1 + hstepA, voffA);
            PG8_WAIT_L(8); PG8_BAR; PG8_WAIT_L(0); PG8_MMA(0, 0, At, B0); PG8_BAR; PG8_SCHED;
            PG8_LDB(B1, 0, 1); PG8_STAGE(PG8_SB(0, 0), b2, voffB);
            PG8_BAR; PG8_WAIT_L(0); PG8_MMA(0, 1, At, B1); PG8_BAR;
            PG8_LDA(At, 0, 1); PG8_STAGE(PG8_SA(0, 0), a2, voffA);
            PG8_BAR; PG8_WAIT_L(0); PG8_MMA(1, 0, At, B0); PG8_BAR; PG8_SCHED;
            PG8_STAGE(PG8_SB(0, 1), b2 + hstepB, voffB);
            PG8_WAIT_V(6); PG8_BAR; PG8_MMA(1, 1, At, B1); PG8_BAR;
            PG8_LDB(B0, 1, 0); PG8_SCHED; PG8_LDA(At, 1, 0); PG8_STAGE(PG8_SA(0, 1), a2 + hstepA, voffA);
            PG8_WAIT_L(8); PG8_BAR; PG8_WAIT_L(0); PG8_MMA(0, 0, At, B0); PG8_BAR; PG8_SCHED;
            PG8_LDB(B1, 1, 1); PG8_STAGE(PG8_SB(1, 0), b3, voffB);
            PG8_BAR; PG8_WAIT_L(0); PG8_MMA(0, 1, At, B1); PG8_BAR;
            PG8_LDA(At, 1, 1); PG8_STAGE(PG8_SA(1, 0), a3, voffA);
            PG8_BAR; PG8_WAIT_L(0); PG8_MMA(1, 0, At, B0); PG8_BAR; PG8_SCHED;
            PG8_STAGE(PG8_SB(1, 1), b3 + hstepB, voffB);
            PG8_WAIT_V(6); PG8_BAR; PG8_MMA(1, 1, At, B1); PG8_BAR;
        }
        E(acc, cur, wr, wc, fr, fq);
        if (!has_next) break;
#pragma unroll
        for (int a = 0; a < 2; ++a)
#pragma unroll
            for (int b = 0; b < 2; ++b)
#pragma unroll
                for (int m = 0; m < 4; ++m)
#pragma unroll
                    for (int n = 0; n < 2; ++n) acc[a][b][m][n] = (f32x4){0.f, 0.f, 0.f, 0.f};
        cur = nxt; cA = nA; cA2 = nA2; cB = nB; ++ui;
    }
    PG8_WAIT_V(0);
    if (wr == 0) PG8_BAR;
    PG8_BAR;
#undef PG8_SA
#undef PG8_SB
#undef PG8_STAGE
#undef PG8_LDA
#undef PG8_LDB
#undef PG8_MMA
#undef PG8_WAIT_V
#undef PG8_WAIT_L
#undef PG8_BAR
#undef PG8_SCHED
}
}
using pg8::Unit;

#define EPI_LOOP_BEGIN const int row0 = u.pm * 256 + wr * 64 + fr, col0 = u.pn * 256 + wc * 32 + 8 * fq; \
    _Pragma("unroll") for (int ai = 0; ai < 2; ++ai) _Pragma("unroll") for (int m = 0; m < 4; ++m) { const int row = row0 + ai * 128 + m * 16;
#define EPI_BJ _Pragma("unroll") for (int bj = 0; bj < 2; ++bj) { const int col = col0 + bj * 128; const f32x4 v0 = acc[ai][bj][m][0], v1 = acc[ai][bj][m][1];
#define EPI_ACC const f32x4 (&acc)[2][2][4][2], const Unit& u, int wr, int wc, int fr, int fq

__device__ __forceinline__ u32x4 pack8(const f32x4 a, const f32x4 b) { u32x4 w; w.x = pk_bf16(a[0], a[1]); w.y = pk_bf16(a[2], a[3]); w.z = pk_bf16(b[0], b[1]); w.w = pk_bf16(b[2], b[3]); return w; }
__device__ __forceinline__ void unpack8(const u32x4 w, f32x4& a, f32x4& b) { a = (f32x4){bf_lo(w.x), bf_hi(w.x), bf_lo(w.y), bf_hi(w.y)}; b = (f32x4){bf_lo(w.z), bf_hi(w.z), bf_lo(w.w), bf_hi(w.w)}; }

struct EpiStore {
    bf16_t* O; int ldc;
    __device__ __forceinline__ void operator()(EPI_ACC) const { EPI_LOOP_BEGIN EPI_BJ *(u32x4*)(O + (size_t)row * ldc + col) = pack8(v0, v1); } } }
};
struct EpiMulInPlace {
    bf16_t* Y;
    __device__ __forceinline__ void operator()(EPI_ACC) const { EPI_LOOP_BEGIN if ((m & 1) == 0) __builtin_amdgcn_sched_barrier(0);
        EPI_BJ u32x4* ptr = (u32x4*)(Y + (size_t)row * 1024 + col); f32x4 a, b; unpack8(*ptr, a, b); *ptr = pack8(a * v0, b * v1); } } }
};
struct EpiGates {
    bf16_t* G; const float* bias;
    __device__ __forceinline__ void operator()(EPI_ACC) const { EPI_LOOP_BEGIN EPI_BJ
        const f32x4 b0 = *(const f32x4*)(bias + col), b1 = *(const f32x4*)(bias + col + 4); f32x4 a, b;
#pragma unroll
        for (int j = 0; j < 4; ++j) { a[j] = sigmoidf_(v0[j] + b0[j]); b[j] = sigmoidf_(v1[j] + b1[j]); }
        *(u32x4*)(G + (size_t)row * 2048 + col) = pack8(a, b); } } }
};
struct EpiPool {
    bf16_t* P; const bf16_t* G;
    __device__ __forceinline__ void operator()(EPI_ACC) const { EPI_LOOP_BEGIN EPI_BJ f32x4 a, b; unpack8(*(const u32x4*)(G + (size_t)row * 2048 + col), a, b);
        *(u32x4*)(P + (size_t)row * 1024 + col) = pack8(a * v0, b * v1); } } }
};
struct EpiMerge {
    bf16_t* P; const bf16_t* G;
    __device__ __forceinline__ void operator()(EPI_ACC) const { EPI_LOOP_BEGIN EPI_BJ f32x4 a, b, pa, pb; unpack8(*(const u32x4*)(G + (size_t)row * 2048 + 1024 + col), a, b);
        u32x4* ptr = (u32x4*)(P + (size_t)row * 1024 + col); unpack8(*ptr, pa, pb); *ptr = pack8(pa + a * v0, pb + b * v1); } } }
};
struct EpiOut {
    const float* xp; const float* xs; float* X1; bf16_t* X1B; float* rowsq;
    __device__ __forceinline__ void operator()(EPI_ACC) const { EPI_LOOP_BEGIN const float* xr = row < TP ? xp + (size_t)row * DM : xs + (size_t)(row - TP) * DM; float ss = 0.f; EPI_BJ
        f32x4 a = *(const f32x4*)(xr + col) + v0, b = *(const f32x4*)(xr + col + 4) + v1;
        *(f32x4*)(X1 + (size_t)row * 1024 + col) = a; *(f32x4*)(X1 + (size_t)row * 1024 + col + 4) = b; *(u32x4*)(X1B + (size_t)row * 1024 + col) = pack8(a, b);
#pragma unroll
        for (int j = 0; j < 4; ++j) ss += a[j] * a[j] + b[j] * b[j]; }
        ss += __shfl_xor(ss, 16); ss += __shfl_xor(ss, 32); if (fq == 0) atomicAdd(rowsq + row, ss); } }
};
struct EpiFF1 {
    bf16_t* Hlo; bf16_t* Hhi; const float* rowsq;
    __device__ __forceinline__ void operator()(EPI_ACC) const { bf16_t* H = u.pn < 8 ? Hlo : Hhi; const int cshift = u.pn < 8 ? 0 : 2048;
        EPI_LOOP_BEGIN const float rinv = rsqrtf(rowsq[row] * (1.0f / 1024.0f) + 1e-6f); EPI_BJ f32x4 a, b;
#pragma unroll
        for (int j = 0; j < 4; ++j) { float t0 = fmaxf(v0[j] * rinv, 0.f), t1 = fmaxf(v1[j] * rinv, 0.f); a[j] = t0 * t0; b[j] = t1 * t1; }
        *(u32x4*)(H + (size_t)row * 2048 + (col - cshift)) = pack8(a, b); } } }
};
struct EpiAddInPlace {
    float* X;
    __device__ __forceinline__ void operator()(EPI_ACC) const { EPI_LOOP_BEGIN EPI_BJ f32x4* ptr = (f32x4*)(X + (size_t)row * 1024 + col); ptr[0] = ptr[0] + v0; ptr[1] = ptr[1] + v1; } } }
};
struct EpiFinal {
    float* X; float* rowsq;
    __device__ __forceinline__ void operator()(EPI_ACC) const { EPI_LOOP_BEGIN float ss = 0.f; EPI_BJ f32x4* ptr = (f32x4*)(X + (size_t)row * 1024 + col); const f32x4 a = ptr[0] + v0, b = ptr[1] + v1; ptr[0] = a; ptr[1] = b;
#pragma unroll
        for (int j = 0; j < 4; ++j) ss += a[j] * a[j] + b[j] * b[j]; }
        ss += __shfl_xor(ss, 16); ss += __shfl_xor(ss, 32); if (fq == 0) atomicAdd(rowsq + row, ss); } }
};

template <class Epi>
__device__ __forceinline__ void run_gemm(unsigned char* shm, const bf16_t* A, int lda, const bf16_t* Bt, int ldb, int N, int K, const Epi& E, const bf16_t* A2 = nullptr, int ks = 0) {
    pg8::Gemm g; g.A = A; g.Bt = Bt; g.M = T_TOK; g.N = N; g.K = K; g.lda = lda; g.ldb = ldb; g.A2 = A2; g.ks = ks;
    pg8::StaticOrder S; S.init(T_TOK, N, (int)gridDim.x, (int)blockIdx.x);
    pg8::gemm_phase<Epi>((LAS unsigned char*)shm, g, S, E);
}

__device__ void transpose_cvt(unsigned char* shm, const float* src, int K, int N, bf16_t* dst, int ldd, const float* kscale) {
    float* tile = (float*)shm;
    const int tid = opaque_tid(), ntk = K / 64, ntn = N / 64;
    for (int t = blockIdx.x; t < ntk * ntn; t += gridDim.x) {
        const int tk = t / ntn, tn = t % ntn;
#pragma unroll
        for (int i = 0; i < 8; ++i) { const int kl = (tid >> 6) + 8 * i, nl = tid & 63; const int k = tk * 64 + kl;
            tile[kl * 65 + nl] = src[(size_t)k * N + tn * 64 + nl] * (kscale ? kscale[k] : 1.0f); }
        __syncthreads();
#pragma unroll
        for (int i = 0; i < 8; ++i) { const int nl = (tid >> 6) + 8 * i, kl = tid & 63;
            const unsigned w = pk_bf16(tile[kl * 65 + nl], 0.f); dst[(size_t)(tn * 64 + nl) * ldd + tk * 64 + kl] = (bf16_t)(w & 0xFFFFu); }
        __syncthreads();
    }
}

__device__ void rmsnorm_rows(const Params& p, const float* g, bf16_t* dst) {
    const int tidx = opaque_tid(); const int lane = tidx & 63, wave = (blockIdx.x * 512 + tidx) >> 6, nw = (gridDim.x * 512) >> 6;
    f32x4 gv[4];
#pragma unroll
    for (int i = 0; i < 4; ++i) gv[i] = *(const f32x4*)(g + lane * 4 + 256 * i);
    for (int t0 = wave; t0 < T_TOK; t0 += 2 * nw) {
        const int t1 = t0 + nw; const bool has1 = t1 < T_TOK;
        const float* xr0 = xrow(p, t0); const float* xr1 = xrow(p, has1 ? t1 : t0); f32x4 v0[4], v1[4]; float ss0 = 0.f, ss1 = 0.f;
#pragma unroll
        for (int i = 0; i < 4; ++i) { v0[i] = *(const f32x4*)(xr0 + lane * 4 + 256 * i); v1[i] = *(const f32x4*)(xr1 + lane * 4 + 256 * i); }
#pragma unroll
        for (int i = 0; i < 4; ++i) { ss0 += v0[i][0] * v0[i][0] + v0[i][1] * v0[i][1] + v0[i][2] * v0[i][2] + v0[i][3] * v0[i][3]; ss1 += v1[i][0] * v1[i][0] + v1[i][1] * v1[i][1] + v1[i][2] * v1[i][2] + v1[i][3] * v1[i][3]; }
#pragma unroll
        for (int o = 1; o < 64; o <<= 1) { ss0 += __shfl_xor(ss0, o); ss1 += __shfl_xor(ss1, o); }
        const float r0 = rsqrtf(ss0 * (1.0f / 1024.0f) + 1e-6f), r1 = rsqrtf(ss1 * (1.0f / 1024.0f) + 1e-6f);
#pragma unroll
        for (int i = 0; i < 4; ++i) { u32x2 w; w.x = pk_bf16(v0[i][0] * r0 * gv[i][0], v0[i][1] * r0 * gv[i][1]); w.y = pk_bf16(v0[i][2] * r0 * gv[i][2], v0[i][3] * r0 * gv[i][3]);
            *(u32x2*)(dst + (size_t)t0 * 1024 + lane * 4 + 256 * i) = w; }
        if (has1) {
#pragma unroll
            for (int i = 0; i < 4; ++i) { u32x2 w; w.x = pk_bf16(v1[i][0] * r1 * gv[i][0], v1[i][1] * r1 * gv[i][1]); w.y = pk_bf16(v1[i][2] * r1 * gv[i][2], v1[i][3] * r1 * gv[i][3]);
                *(u32x2*)(dst + (size_t)t1 * 1024 + lane * 4 + 256 * i) = w; } }
    }
}

__device__ void prep_phase(const Params& p, unsigned char* shm) {
    unsigned char* ws = p.ws;
    const int gtid = blockIdx.x * 512 + opaque_tid(), gn = gridDim.x * 512;
    for (int i = gtid; i < T_TOK; i += gn) { ((float*)(ws + OFF_ROWSQ))[i] = 0.f; ((float*)(ws + OFF_ROWSQ2))[i] = 0.f; }
    if (gtid < 64) ((unsigned*)(ws + OFF_QUEUE))[gtid] = 0u;
    transpose_cvt(shm, p.w_in, 1024, 5888, (bf16_t*)(ws + OFF_WIN), 1024, nullptr);
    transpose_cvt(shm, p.w_rwkv_br, 1024, 1024, (bf16_t*)(ws + OFF_WRBR), 1024, nullptr);
    transpose_cvt(shm, p.w_out, 1024, 1024, (bf16_t*)(ws + OFF_WOUT), 1024, nullptr);
    transpose_cvt(shm, p.w_ff1, 1024, 4096, (bf16_t*)(ws + OFF_WFF1), 1024, p.g_ffn);
    transpose_cvt(shm, p.w_ff2, 4096, 1024, (bf16_t*)(ws + OFF_WFF2), 4096, nullptr);
    transpose_cvt(shm, p.g_up, 128, 1024, (bf16_t*)(ws + OFF_WG), 256, nullptr);
    { bf16_t* wg = (bf16_t*)(ws + OFF_WG); for (int i = gtid; i < 1024 * 128; i += gn) wg[(size_t)(i >> 7) * 256 + 128 + (i & 127)] = 0; }
    { bf16_t* we = (bf16_t*)(ws + OFF_WEFF);
      for (int i = gtid; i < 512 * 1024; i += gn) { const int k = i >> 10, n = i & 1023, gI = k >> 7; const float* pw = p.pool_w + (size_t)k * 128; float acc = 0.f;
          for (int d = 0; d < 128; ++d) acc += pw[d] * p.pool_scale[gI * 128 + d] * p.w_pool_br[(size_t)(gI * 128 + d) * 1024 + n];
          we[(size_t)n * 512 + k] = (bf16_t)(pk_bf16(acc, 0.f) & 0xFFFFu); } }
    rmsnorm_rows(p, p.g_mix, (bf16_t*)(ws + OFF_R1));
}

#define LDS_BAR() do { asm volatile("s_waitcnt lgkmcnt(0)" ::: "memory"); __builtin_amdgcn_s_barrier(); asm volatile("" ::: "memory"); } while (0)
constexpr int N_SAMPLE_ITEMS = 128, N_ITEMS = N_SAMPLE_ITEMS + 1024;

template <int LPR, int RPL, int DIR>
__device__ __forceinline__ void scan_item(const Params& p, unsigned char* shm, const int tid, const int tbase, const int L, const int h, const int half) {
    constexpr int dir = DIR;
    constexpr int EC = 64 / LPR, RPW = RPL * (64 / LPR);
    float* sW = (float*)shm; float* sAV = sW + 2048; float* sBV = sW + 4096; float* sKD = sW + 6144; float* sWR = sW + 8192; float* sR = sW + 10240; float* sV = sW + 12288; float* sY = sW + 14336;
    float* sBK = sW + 16384;
    bf16_t* sTW = (bf16_t*)(sW + 16384 + 64);
    bf16_t* sZA = sTW + 32 * 72;
    const int lane = tid & 63, wv = tid >> 6;
    const bf16_t* zall = (const bf16_t*)(p.ws + OFF_Z);
    const int tokA = tid >> 4, q = tid & 15;
    const int rowS = half * 32 + wv * RPW + RPL * (lane / LPR), gS = lane % LPR;
    const int NC = L / 32;
    bf16_t* ybuf = (bf16_t*)p.out + (dir ? (size_t)T_TOK * 1024 : 0);
    float* bonus = (float*)(p.ws + OFF_BONUS) + (dir ? (size_t)T_TOK * 16 : 0);
    const float* w_up = dir ? p.w_up_b : p.w_up_f; const float* a_up = dir ? p.a_up_b : p.a_up_f;
    const float* w0 = dir ? p.w0_b : p.w0_f; const float* a0 = dir ? p.a0_b : p.a0_f;
    const int mat = wv >> 2, cbk = wv & 3, colB = cbk * 16 + (lane & 15), quad = lane >> 4;
    u32x4* sBF = (u32x4*)(shm + 84 * 1024);
    { const float* up = mat ? a_up : w_up;
#pragma unroll
      for (int kb = 0; kb < 2; ++kb) { float f[8];
#pragma unroll
          for (int j = 0; j < 8; ++j) f[j] = up[(size_t)(kb * 32 + quad * 8 + j) * 1024 + h * 64 + colB];
          u32x4 w; w.x = pk_bf16(f[0], f[1]); w.y = pk_bf16(f[2], f[3]); w.z = pk_bf16(f[4], f[5]); w.w = pk_bf16(f[6], f[7]); sBF[kb * 512 + tid] = w; } }
    const float c0B = (mat ? a0 : w0)[h * 64 + colB];
    const float kaB = p.k_a[h * 64 + colB];
    int colz[5];
    float* sM0 = (float*)(shm + 100 * 1024);
    float* sMU = (float*)(shm + 76 * 1024);
#pragma unroll
    for (int gi = 0; gi < 5; ++gi) colz[gi] = (gi == 0 ? COL_R + h * 64 : gi == 1 ? COL_K + h * 64 : gi == 2 ? COL_V + h * 64 : gi == 3 ? COL_W : COL_A) + 4 * q;
    if (tid < 320) { const int gi = tid >> 6, c = tid & 63; const int col = (gi == 0 ? COL_R + h * 64 : gi == 1 ? COL_K + h * 64 : gi == 2 ? COL_V + h * 64 : gi == 3 ? COL_W : COL_A) + c - COL_R;
        const float mpv_ = p.mu_prev[col], mnv_ = p.mu_next[col]; sMU[gi * 64 + c] = mpv_; sMU[320 + gi * 64 + c] = mnv_; sM0[gi * 64 + c] = 1.0f - mpv_ - mnv_; }
    else if (tid < 384) sMU[640 + (tid - 320)] = p.k_k[h * 64 + (tid - 320)];
    else if (tid < 448) sMU[704 + (tid - 384)] = p.r_k[h * 64 + (tid - 384)];
    __syncthreads();
    float s[RPL][EC];
#pragma unroll
    for (int r = 0; r < RPL; ++r)
#pragma unroll
        for (int j = 0; j < EC; ++j) s[r][j] = 0.f;
    u32x2 zc[5], zp[5], zn[5];
    auto load_chunk = [&](int ci) {
        const int t = tbase + 32 * (dir ? NC - 1 - ci : ci) + tokA; const bool hasPrev = t > tbase, hasNext = t < tbase + L - 1;
        const bf16_t* zr = zall + (size_t)t * ZLD;
#pragma unroll
        for (int gi = 0; gi < 5; ++gi) { zc[gi] = *(const u32x2*)(zr + colz[gi]); zp[gi] = (u32x2){0u, 0u}; zn[gi] = (u32x2){0u, 0u};
            if (hasPrev) zp[gi] = *(const u32x2*)(zr - ZLD + colz[gi]);
            if (hasNext) zn[gi] = *(const u32x2*)(zr + ZLD + colz[gi]); }
    };
    load_chunk(0);
    for (int ci = 0; ci < NC; ++ci) {
        const int t0 = tbase + 32 * (dir ? NC - 1 - ci : ci);
        { float zs[5][4];
#pragma unroll
          for (int gi = 0; gi < 5; ++gi) {
              const float c[4] = {bf_lo(zc[gi].x), bf_hi(zc[gi].x), bf_lo(zc[gi].y), bf_hi(zc[gi].y)}, pv[4] = {bf_lo(zp[gi].x), bf_hi(zp[gi].x), bf_lo(zp[gi].y), bf_hi(zp[gi].y)}, nx[4] = {bf_lo(zn[gi].x), bf_hi(zn[gi].x), bf_lo(zn[gi].y), bf_hi(zn[gi].y)};
              const f32x4 mp = *(const f32x4*)(sMU + gi * 64 + 4 * q), mn = *(const f32x4*)(sMU + 320 + gi * 64 + 4 * q), m0 = *(const f32x4*)(sM0 + gi * 64 + 4 * q);
              shift4(zs[gi], c, pv, nx, m0, mp, mn);
          }
          if (ci + 1 < NC) load_chunk(ci + 1);
          *(f32x4*)(sR + tokA * 64 + 4 * q) = (f32x4){zs[0][0], zs[0][1], zs[0][2], zs[0][3]};
          *(f32x4*)(sKD + tokA * 64 + 4 * q) = (f32x4){zs[1][0], zs[1][1], zs[1][2], zs[1][3]};
          *(f32x4*)(sV + tokA * 64 + 4 * q) = (f32x4){zs[2][0], zs[2][1], zs[2][2], zs[2][3]};
          float kk[4], ss; const f32x4 kk4c = *(const f32x4*)(sMU + 640 + 4 * q);
          kk4(kk, ss, zs[1], kk4c);
          ss = ss + 0.0f * kk[0];
          ss = red16(ss);
          const float inv = -__builtin_amdgcn_rsqf(fmaxf(ss, 1e-24f));
          *(f32x4*)(sAV + tokA * 64 + 4 * q) = (f32x4){kk[0] * inv, kk[1] * inv, kk[2] * inv, kk[3] * inv};
          float tw[4];
#pragma unroll
          for (int j = 0; j < 4; ++j) tw[j] = 1.0f - 2.0f * __builtin_amdgcn_rcpf(1.0f + fexp2_scaled(zs[3][j], 2.8853900818f));
          u32x2 w; w.x = pk_bf16(tw[0], tw[1]); w.y = pk_bf16(tw[2], tw[3]); *(u32x2*)(sTW + tokA * 72 + 4 * q) = w;
          w.x = pk_bf16(zs[4][0], zs[4][1]); w.y = pk_bf16(zs[4][2], zs[4][3]); *(u32x2*)(sZA + tokA * 72 + 4 * q) = w;
        }
        LDS_BAR();
        { const bf16_t* sX = mat ? sZA : sTW;
#pragma unroll
          for (int rb = 0; rb < 2; ++rb) {
              f32x4 acc = (f32x4){0.f, 0.f, 0.f, 0.f};
#pragma unroll
              for (int kb = 0; kb < 2; ++kb) { const bf16x8 af = *(const bf16x8*)(sX + (rb * 16 + (lane & 15)) * 72 + kb * 32 + quad * 8);
                  acc = __builtin_amdgcn_mfma_f32_16x16x32_bf16(af, __builtin_bit_cast(bf16x8, sBF[kb * 512 + tid]), acc, 0, 0, 0); }
#pragma unroll
              for (int j = 0; j < 4; ++j) { const int idx = (rb * 16 + quad * 4 + j) * 64 + colB; const float pre = c0B + acc[j];
                  if (mat == 0) { const float w = fexp2_scaled(sigmoidf_(pre), -0.6065306597f * 1.4426950409f); sW[idx] = w; sWR[idx] = w * sR[idx]; }
                  else { const float a = sigmoidf_(pre); const float k = sKD[idx]; sKD[idx] = k * (1.0f + (a - 1.0f) * kaB); sBV[idx] = -sAV[idx] * a; } }
          } }
        LDS_BAR();
        { const f32x4 r4 = *(const f32x4*)(sR + tokA * 64 + 4 * q), b4 = *(const f32x4*)(sBV + tokA * 64 + 4 * q), k4 = *(const f32x4*)(sKD + tokA * 64 + 4 * q);
          float br = 0.f, kr = 0.f, cb = 0.f; const f32x4 rk4 = *(const f32x4*)(sMU + 704 + 4 * q);
#pragma unroll
          for (int j = 0; j < 4; ++j) { br += b4[j] * r4[j]; kr += k4[j] * r4[j]; cb += r4[j] * k4[j] * rk4[j]; }
          br = red16(br); kr = red16(kr); cb = red16(cb);
          if (q == 0) { sBK[tokA * 2] = br; sBK[tokA * 2 + 1] = kr; if (half == 0) bonus[(size_t)(t0 + tokA) * 16 + h] = cb; } }
        LDS_BAR();
        {
            constexpr int NV = EC / 4;
            struct Ops { f32x4 w[NV], a[NV], b[NV], k[NV], q[NV]; float v[RPL]; f32x2 bk; };
            auto ld = [&](Ops& o, int i) { const int tk = DIR ? 31 - i : i; const int off = tk * 64 + 4 * gS;
#pragma unroll
                for (int c = 0; c < NV; ++c) { o.w[c] = *(const f32x4*)(sW + off + 32 * c); o.a[c] = *(const f32x4*)(sAV + off + 32 * c); o.b[c] = *(const f32x4*)(sBV + off + 32 * c);
                    o.k[c] = *(const f32x4*)(sKD + off + 32 * c); o.q[c] = *(const f32x4*)(sWR + off + 32 * c); }
                if constexpr (RPL == 2) { const f32x2 v2 = *(const f32x2*)(sV + tk * 64 + rowS); o.v[0] = v2.x; o.v[1] = v2.y; } else o.v[0] = sV[tk * 64 + rowS];
                o.bk = *(const f32x2*)(sBK + tk * 2); };
            auto step = [&](const Ops& cur, int i) {
                static_assert(EC == 4, "asm row helpers are written for 4 columns per lane");
                float sa[RPL], yp[RPL], y[RPL];
#pragma unroll
                for (int r = 0; r < RPL; ++r) row_dots(s[r], cur.a[0], cur.q[0], sa[r], yp[r]);
                if constexpr (RPL == 2) red16x4(sa[0], yp[0], sa[1], yp[1]); else red16x2(sa[0], yp[0]);
#pragma unroll
                for (int r = 0; r < RPL; ++r) row_update(s[r], cur.w[0], cur.b[0], cur.k[0], cur.v[r], sa[r], yp[r], cur.bk.x, cur.bk.y, y[r]);
                if (gS == 0) { if constexpr (RPL == 2) *(f32x2*)(sY + (DIR ? 31 - i : i) * 64 + rowS) = (f32x2){y[0], y[1]}; else sY[(DIR ? 31 - i : i) * 64 + rowS] = y[0]; }
            };
            {
                Ops o0, o1, o2; ld(o0, 0); ld(o1, 1);
#pragma unroll 1
                for (int i = 0; i < 30; i += 3) {
                    ld(o2, i + 2);
                    step(o0, i);
                    ld(o0, i + 3);
                    step(o1, i + 1);
                    ld(o1, min(i + 4, 31));
                    step(o2, i + 2);
                }
                step(o0, 30);
                step(o1, 31);
            }
        }
        LDS_BAR();
        if (RPL == 2 || (q >> 3) == half) { const f32x4 y4 = *(const f32x4*)(sY + tokA * 64 + 4 * q); u32x2 w; w.x = pk_bf16(y4[0], y4[1]); w.y = pk_bf16(y4[2], y4[3]);
          *(u32x2*)(ybuf + (size_t)(t0 + tokA) * 1024 + h * 64 + 4 * q) = w; }
    }
}

__device__ void scan_phase(const Params& p, unsigned char* shm) {
    int* sItem = (int*)(shm + 80 * 1024);
    const int tid = opaque_tid();
    unsigned* queue = (unsigned*)(p.ws + OFF_QUEUE);
    for (;;) {
        if (tid == 0) *sItem = (int)atomicAdd(queue, 1u);
        __syncthreads();
        const int item = *sItem;
        __syncthreads();
        if (item >= N_ITEMS) break;
        int tid2 = tid; asm volatile("" : "+v"(tid2));
        if (item < N_SAMPLE_ITEMS) {
            const int half = item & 1, j = item >> 1;
            if (j & 1) scan_item<16, 1, 1>(p, shm, tid2, TP + (j >> 5) * 16384, 16384, (j >> 1) & 15, half); else scan_item<16, 1, 0>(p, shm, tid2, TP + (j >> 5) * 16384, 16384, (j >> 1) & 15, half);
        } else { const int j = item - N_SAMPLE_ITEMS;
            if (j & 1) scan_item<16, 2, 1>(p, shm, tid2, (j >> 5) * 2048, 2048, (j >> 1) & 15, 0); else scan_item<16, 2, 0>(p, shm, tid2, (j >> 5) * 2048, 2048, (j >> 1) & 15, 0); }
        __syncthreads();
    }
}

__device__ void mix_phase(const Params& p) {
    const int tidx = opaque_tid(); const int lane = tidx & 63, wave = (blockIdx.x * 512 + tidx) >> 6, nw = (gridDim.x * 512) >> 6;
    const bf16_t* zall = (const bf16_t*)(p.ws + OFF_Z);
    bf16_t* yf = (bf16_t*)p.out; const bf16_t* yb = (const bf16_t*)p.out + (size_t)T_TOK * 1024;
    const float* bonus_f = (const float*)(p.ws + OFF_BONUS); const float* bonus_b = bonus_f + (size_t)T_TOK * 16;
    bf16_t* pooled = (bf16_t*)(p.ws + OFF_POOLED); bf16_t* sg = (bf16_t*)(p.ws + OFF_SG);
    const int hL = lane >> 2;
    const int tpw = (T_TOK + nw - 1) / nw;
    for (int t = wave * tpw; t < min(T_TOK, (wave + 1) * tpw); ++t) {
        int tbase, L; seq_of(t, tbase, L); const int pos = t - tbase; const bool hasPrev = pos > 0, hasNext = pos < L - 1;
        const bf16_t* zr = zall + (size_t)t * ZLD;
        { const int c0 = lane * 16; float y[16];
          { const u32x4 a0 = *(const u32x4*)(yf + (size_t)t * 1024 + c0), a1 = *(const u32x4*)(yf + (size_t)t * 1024 + c0 + 8);
            const u32x4 b0 = *(const u32x4*)(yb + (size_t)t * 1024 + c0), b1 = *(const u32x4*)(yb + (size_t)t * 1024 + c0 + 8);
            f32x4 fa, fb, ga, gb; unpack8(a0, fa, fb); unpack8(b0, ga, gb);
#pragma unroll
            for (int j = 0; j < 4; ++j) { y[j] = fa[j] + ga[j]; y[4 + j] = fb[j] + gb[j]; }
            unpack8(a1, fa, fb); unpack8(b1, ga, gb);
#pragma unroll
            for (int j = 0; j < 4; ++j) { y[8 + j] = fa[j] + ga[j]; y[12 + j] = fb[j] + gb[j]; } }
          float sm = 0.f;
#pragma unroll
          for (int j = 0; j < 16; ++j) sm += y[j];
          const float mean = red4(sm) * (1.0f / 64.0f); float vs = 0.f;
#pragma unroll
          for (int j = 0; j < 16; ++j) { const float d = y[j] - mean; vs += d * d; }
          const float rstd = rsqrtf(red4(vs) * (1.0f / 64.0f) + 64e-5f);
          const float bon = bonus_f[(size_t)t * 16 + hL] + bonus_b[(size_t)t * 16 + hL];
          float vv[16];
          { const bf16_t* zc = zr + COL_V + c0;
            u32x4 c_[2], p_[2], n_[2];
#pragma unroll
            for (int i = 0; i < 2; ++i) { c_[i] = *(const u32x4*)(zc + 8 * i); p_[i] = hasPrev ? *(const u32x4*)(zc - ZLD + 8 * i) : (u32x4){0u, 0u, 0u, 0u}; n_[i] = hasNext ? *(const u32x4*)(zc + ZLD + 8 * i) : (u32x4){0u, 0u, 0u, 0u}; }
#pragma unroll
            for (int i = 0; i < 2; ++i) { f32x4 ca, cb, pa, pb, na, nb; unpack8(c_[i], ca, cb); unpack8(p_[i], pa, pb); unpack8(n_[i], na, nb);
                const float* mp = p.mu_prev + (COL_V - COL_R) + c0 + 8 * i; const float* mn = p.mu_next + (COL_V - COL_R) + c0 + 8 * i;
                const f32x4 mp0 = *(const f32x4*)mp, mp1 = *(const f32x4*)(mp + 4), mn0 = *(const f32x4*)mn, mn1 = *(const f32x4*)(mn + 4);
#pragma unroll
                for (int j = 0; j < 4; ++j) { vv[8 * i + j] = ca[j] + mp0[j] * (pa[j] - ca[j]) + mn0[j] * (na[j] - ca[j]); vv[8 * i + 4 + j] = cb[j] + mp1[j] * (pb[j] - cb[j]) + mn1[j] * (nb[j] - cb[j]); } } }
          float o[16];
#pragma unroll
          for (int i = 0; i < 4; ++i) { const f32x4 lw = *(const f32x4*)(p.ln_w + c0 + 4 * i), lb = *(const f32x4*)(p.ln_b + c0 + 4 * i);
#pragma unroll
              for (int j = 0; j < 4; ++j) o[4 * i + j] = (y[4 * i + j] - mean) * rstd * lw[j] + lb[j] + bon * vv[4 * i + j]; }
          u32x4 w0, w1; w0.x = pk_bf16(o[0], o[1]); w0.y = pk_bf16(o[2], o[3]); w0.z = pk_bf16(o[4], o[5]); w0.w = pk_bf16(o[6], o[7]);
          w1.x = pk_bf16(o[8], o[9]); w1.y = pk_bf16(o[10], o[11]); w1.z = pk_bf16(o[12], o[13]); w1.w = pk_bf16(o[14], o[15]);
          *(u32x4*)(yf + (size_t)t * 1024 + c0) = w0; *(u32x4*)(yf + (size_t)t * 1024 + c0 + 8) = w1; }
        { const int c = 2 * lane; const bf16_t* zc = zr + COL_G + c; const unsigned wc_ = *(const unsigned*)zc; const unsigned wp = hasPrev ? *(const unsigned*)(zc - ZLD) : 0u, wn = hasNext ? *(const unsigned*)(zc + ZLD) : 0u;
          const float mp0 = p.mu_prev[COL_G - COL_R + c], mp1 = p.mu_prev[COL_G - COL_R + c + 1], mn0 = p.mu_next[COL_G - COL_R + c], mn1 = p.mu_next[COL_G - COL_R + c + 1];
          const float c0v = bf_lo(wc_), c1v = bf_hi(wc_);
          const float z0 = c0v + mp0 * (bf_lo(wp) - c0v) + mn0 * (bf_lo(wn) - c0v), z1 = c1v + mp1 * (bf_hi(wp) - c1v) + mn1 * (bf_hi(wn) - c1v);
          *(unsigned*)(sg + (size_t)t * 256 + c) = pk_bf16(sigmoidf_(z0), sigmoidf_(z1)); *(unsigned*)(sg + (size_t)t * 256 + 128 + c) = 0u; }
        { const int c = lane * 8, gi = lane >> 4, w = 2 << gi; const int lo = max(pos - (w >> 1), 0), hi = min(pos + (w >> 1) - 1, L - 1);
          float sum[8];
#pragma unroll
          for (int j = 0; j < 8; ++j) sum[j] = 0.f;
          u32x4 wr_[16];
#pragma unroll
          for (int d = 0; d < 16; ++d) { const int r = pos - 8 + d; wr_[d] = (u32x4){0u, 0u, 0u, 0u}; if (r >= lo && r <= hi) wr_[d] = *(const u32x4*)(zall + (size_t)(tbase + r) * ZLD + c); }
#pragma unroll
          for (int d = 0; d < 16; ++d) { f32x4 a, b; unpack8(wr_[d], a, b);
#pragma unroll
              for (int j = 0; j < 4; ++j) { sum[j] += a[j]; sum[4 + j] += b[j]; } }
          const float icnt = 1.0f / (float)(hi - lo + 1); f32x4 a, b; unpack8(*(const u32x4*)(zr + c), a, b); f32x4 oa, ob;
#pragma unroll
          for (int j = 0; j < 4; ++j) { oa[j] = sum[j] * icnt - a[j]; ob[j] = sum[4 + j] * icnt - b[j]; }
          *(u32x4*)(pooled + (size_t)t * 512 + c) = pack8(oa, ob); }
    }
}

__device__ void final_phase(const Params& p) {
    const int tidx = opaque_tid(); const int lane = tidx & 63, wave = (blockIdx.x * 512 + tidx) >> 6, nw = (gridDim.x * 512) >> 6;
    const float* x2 = (const float*)(p.ws + OFF_X1); const float* rowsq2 = (const float*)(p.ws + OFF_ROWSQ2);
    f32x4 gv[4];
#pragma unroll
    for (int i = 0; i < 4; ++i) gv[i] = *(const f32x4*)(p.g_final + lane * 4 + 256 * i);
    for (int t0 = wave; t0 < T_TOK; t0 += 2 * nw) {
        const int t1 = t0 + nw < T_TOK ? t0 + nw : t0;
        const float r0 = rsqrtf(rowsq2[t0] * (1.0f / 1024.0f) + 1e-6f), r1 = rsqrtf(rowsq2[t1] * (1.0f / 1024.0f) + 1e-6f);
        f32x4 a[4], b[4];
#pragma unroll
        for (int i = 0; i < 4; ++i) { a[i] = *(const f32x4*)(x2 + (size_t)t0 * 1024 + lane * 4 + 256 * i); b[i] = *(const f32x4*)(x2 + (size_t)t1 * 1024 + lane * 4 + 256 * i); }
#pragma unroll
        for (int i = 0; i < 4; ++i) { *(f32x4*)(p.out + (size_t)t0 * 1024 + lane * 4 + 256 * i) = a[i] * r0 * gv[i]; *(f32x4*)(p.out + (size_t)t1 * 1024 + lane * 4 + 256 * i) = b[i] * r1 * gv[i]; }
    }
}

__global__ void __launch_bounds__(512, 2) fwd_megakernel(Params p) {
    extern __shared__ __attribute__((aligned(16))) unsigned char shm[];
    unsigned char* ws = p.ws;
    prep_phase(p, shm);
    cg::this_grid().sync();
    { EpiStore E; E.O = (bf16_t*)(ws + OFF_Z); E.ldc = ZLD; run_gemm(shm, (const bf16_t*)(ws + OFF_R1), 1024, (const bf16_t*)(ws + OFF_WIN), 1024, 3840, 1024, E); }
    cg::this_grid().sync();
    scan_phase(p, shm);
    cg::this_grid().sync();
    mix_phase(p);
    cg::this_grid().sync();
    rmsnorm_rows(p, p.g_mix, (bf16_t*)(ws + OFF_XN2));
    { EpiMulInPlace E; E.Y = (bf16_t*)p.out; run_gemm(shm, (const bf16_t*)(ws + OFF_SG), 256, (const bf16_t*)(ws + OFF_WG), 256, 1024, 256, E); }
    cg::this_grid().sync();
    { EpiGates E; E.G = (bf16_t*)(ws + OFF_GATES); E.bias = p.b_gate; run_gemm(shm, (const bf16_t*)(ws + OFF_XN2), 1024, (const bf16_t*)(ws + OFF_WIN) + (size_t)3840 * 1024, 1024, 2048, 1024, E); }
    cg::this_grid().sync();
    { EpiPool E; E.P = (bf16_t*)(ws + OFF_MERGED); E.G = (const bf16_t*)(ws + OFF_GATES); run_gemm(shm, (const bf16_t*)(ws + OFF_POOLED), 512, (const bf16_t*)(ws + OFF_WEFF), 512, 1024, 512, E); }
    { EpiMerge E; E.P = (bf16_t*)(ws + OFF_MERGED); E.G = (const bf16_t*)(ws + OFF_GATES); run_gemm(shm, (const bf16_t*)p.out, 1024, (const bf16_t*)(ws + OFF_WRBR), 1024, 1024, 1024, E); }
    cg::this_grid().sync();
    { EpiOut E; E.xp = p.x_prompt; E.xs = p.x_sample; E.X1 = (float*)(ws + OFF_X1); E.X1B = (bf16_t*)(ws + OFF_X1B); E.rowsq = (float*)(ws + OFF_ROWSQ); run_gemm(shm, (const bf16_t*)(ws + OFF_MERGED), 1024, (const bf16_t*)(ws + OFF_WOUT), 1024, 1024, 1024, E); }
    cg::this_grid().sync();
    { EpiFF1 E; E.Hlo = (bf16_t*)(ws + OFF_HLO); E.Hhi = (bf16_t*)p.out; E.rowsq = (const float*)(ws + OFF_ROWSQ); run_gemm(shm, (const bf16_t*)(ws + OFF_X1B), 1024, (const bf16_t*)(ws + OFF_WFF1), 1024, 4096, 1024, E); }
    cg::this_grid().sync();
    { EpiFinal E; E.X = (float*)(ws + OFF_X1); E.rowsq = (float*)(ws + OFF_ROWSQ2);
      run_gemm(shm, (const bf16_t*)(ws + OFF_HLO), 2048, (const bf16_t*)(ws + OFF_WFF2), 4096, 1024, 4096, E, (const bf16_t*)p.out, 32); }
    cg::this_grid().sync();
    final_phase(p);
}

extern "C" void kernel_launch(void* const* d_in, const int* in_sizes, int n_in, void* d_out, int out_size, void* d_ws, size_t ws_size, hipStream_t stream) {
    constexpr size_t kDynLds = 131072;
    static int grid_blocks = 0;
    if (!grid_blocks) {
        hipFuncSetAttribute((const void*)fwd_megakernel, hipFuncAttributeMaxDynamicSharedMemorySize, (int)kDynLds);
        int dev = 0, cus = 0, per_cu = 0;
        hipGetDevice(&dev);
        hipDeviceGetAttribute(&cus, hipDeviceAttributeMultiprocessorCount, dev);
        hipOccupancyMaxActiveBlocksPerMultiprocessor(&per_cu, fwd_megakernel, 512, kDynLds);
        if (per_cu < 1) per_cu = 1;
        grid_blocks = cus;
    }
    Params p{};
    const float** pf = (const float**)&p;
    for (int i = 0; i < 30; ++i) pf[i] = (const float*)d_in[i];
    p.out = (float*)d_out; p.ws = (unsigned char*)d_ws;
    void* args[] = {&p};
    hipError_t e = hipLaunchCooperativeKernel((const void*)fwd_megakernel, dim3(grid_blocks), dim3(512), args, kDynLds, stream);
    if (e != hipSuccess) fprintf(stderr, "cooperative launch failed: %s (grid %d)\n", hipGetErrorString(e), grid_blocks);
}
```

```cpp
#include <hip/hip_runtime.h>
#include <hip/hip_cooperative_groups.h>
#include <cstdio>
namespace cg = cooperative_groups;

#define LAS __attribute__((address_space(3)))
typedef unsigned short bf16_t;
typedef short bf16x8 __attribute__((ext_vector_type(8)));
typedef float f32x4 __attribute__((ext_vector_type(4)));
typedef float f32x2 __attribute__((ext_vector_type(2)));
typedef unsigned u32x4 __attribute__((ext_vector_type(4)));
typedef unsigned u32x2 __attribute__((ext_vector_type(2)));

constexpr int T_TOK = 98304, DM = 1024, TP = 65536;
constexpr int ZLD = 3840;
constexpr int COL_R = 512, COL_K = 1536, COL_V = 2560, COL_W = 3584, COL_A = 3648, COL_G = 3712;
constexpr size_t MiB = 1ull << 20;
constexpr size_t OFF_WIN = 0, OFF_WEFF = 12 * MiB, OFF_WRBR = 13 * MiB, OFF_WOUT = 15 * MiB, OFF_WFF1 = 17 * MiB, OFF_WFF2 = 25 * MiB, OFF_WG = 33 * MiB;
constexpr size_t OFF_ROWSQ = 34 * MiB, OFF_ROWSQ2 = 34 * MiB + 512 * 1024, OFF_QUEUE = 35 * MiB, OFF_BONUS = 36 * MiB;
constexpr size_t OFF_R1 = 48 * MiB, OFF_Z = 240 * MiB;
constexpr size_t OFF_POOLED = OFF_R1, OFF_SG = OFF_R1 + 96 * MiB, OFF_XN2 = OFF_Z, OFF_GATES = OFF_Z + 192 * MiB, OFF_MERGED = OFF_Z + 576 * MiB;
constexpr size_t OFF_X1B = OFF_R1, OFF_X1 = OFF_Z, OFF_HLO = OFF_Z + 384 * MiB;
constexpr size_t U_BYTES = (size_t)T_TOK * 1024 * 2;

struct Params {
    const float *x_prompt, *x_sample, *g_mix, *w_in, *b_gate, *mu_prev, *mu_next, *pool_w, *pool_scale, *w_pool_br, *k_k, *k_a, *r_k,
        *w0_f, *w_up_f, *a0_f, *a_up_f, *w0_b, *w_up_b, *a0_b, *a_up_b, *g_up, *ln_w, *ln_b, *w_rwkv_br, *w_out, *g_ffn, *w_ff1, *w_ff2, *g_final;
    float* out; unsigned char* ws;
};

__device__ __forceinline__ float bf_lo(unsigned w) { return __uint_as_float(w << 16); }
__device__ __forceinline__ float bf_hi(unsigned w) { return __uint_as_float(w & 0xFFFF0000u); }
typedef __bf16 bf16x2_t __attribute__((ext_vector_type(2)));
__device__ __forceinline__ unsigned pk_bf16(float lo, float hi) { f32x2 v = {lo, hi}; bf16x2_t b = __builtin_convertvector(v, bf16x2_t); return __builtin_bit_cast(unsigned, b); }
__device__ __forceinline__ float fexp2_scaled(float x, float scale_log2e) { return __builtin_amdgcn_exp2f(x * scale_log2e); }
__device__ __forceinline__ float sigmoidf_(float x) { return __builtin_amdgcn_rcpf(1.0f + fexp2_scaled(x, -1.4426950409f)); }
__device__ __forceinline__ float fma_s(float a, float b, float c) { float d; asm("v_fma_f32 %0, %1, %2, %3" : "=v"(d) : "v"(a), "v"(b), "v"(c)); return d; }
__device__ __forceinline__ float mul_s(float a, float b) { float d; asm("v_mul_f32 %0, %1, %2" : "=v"(d) : "v"(a), "v"(b)); return d; }
__device__ __forceinline__ float add_s(float a, float b) { float d; asm("v_add_f32 %0, %1, %2" : "=v"(d) : "v"(a), "v"(b)); return d; }
#define DPPA(x, c) "v_add_f32_dpp " x ", " x ", " x " " c " row_mask:0xf bank_mask:0xf bound_ctrl:1\n"
#define DPP4(c) DPPA("%0", c) DPPA("%1", c) DPPA("%2", c) DPPA("%3", c)
#define DPP2(c) DPPA("%0", c) DPPA("%1", c) "s_nop 0\n"
__device__ __forceinline__ void red16x4(float& a, float& b, float& c, float& d) {
    asm("s_nop 1\n" DPP4("quad_perm:[1,0,3,2]") DPP4("quad_perm:[2,3,0,1]") DPP4("row_half_mirror") DPP4("row_mirror") : "+v"(a), "+v"(b), "+v"(c), "+v"(d)); }
__device__ __forceinline__ void red16x2(float& a, float& b) {
    asm("s_nop 1\n" DPP2("quad_perm:[1,0,3,2]") DPP2("quad_perm:[2,3,0,1]") DPP2("row_half_mirror") DPP2("row_mirror") : "+v"(a), "+v"(b)); }
__device__ __forceinline__ void row_dots(const float (&s)[4], const f32x4 a, const f32x4 q, float& sa, float& yp) {
    asm("v_mul_f32 %0, %2, %6\n v_mul_f32 %1, %2, %10\n v_fmac_f32 %0, %3, %7\n v_fmac_f32 %1, %3, %11\n v_fmac_f32 %0, %4, %8\n v_fmac_f32 %1, %4, %12\n v_fmac_f32 %0, %5, %9\n v_fmac_f32 %1, %5, %13"
        : "=&v"(sa), "=&v"(yp) : "v"(s[0]), "v"(s[1]), "v"(s[2]), "v"(s[3]), "v"(a[0]), "v"(a[1]), "v"(a[2]), "v"(a[3]), "v"(q[0]), "v"(q[1]), "v"(q[2]), "v"(q[3])); }
__device__ __forceinline__ void row_update(float (&s)[4], const f32x4 w, const f32x4 b, const f32x4 k, float v, float sa, float yp, float bkx, float bky, float& y) {
    float t0, t1, t2, t3;
    asm("v_mul_f32 %0, %6, %15\n v_mul_f32 %1, %6, %16\n v_mul_f32 %2, %6, %17\n v_mul_f32 %3, %6, %18\n"
        "v_fmac_f32 %4, %7, %5\n"
        "v_fmac_f32 %0, %7, %11\n v_fmac_f32 %1, %7, %12\n v_fmac_f32 %2, %7, %13\n v_fmac_f32 %3, %7, %14\n"
        "v_fmac_f32 %4, %6, %8\n"
        "v_fmac_f32 %0, %9, %19\n v_fmac_f32 %1, %10, %20\n v_fmac_f32 %2, %23, %21\n v_fmac_f32 %3, %24, %22"
        : "=&v"(t0), "=&v"(t1), "=&v"(t2), "=&v"(t3), "+v"(yp)
        : "v"(bkx), "v"(v), "v"(sa), "v"(bky), "v"(s[0]), "v"(s[1]), "v"(b[0]), "v"(b[1]), "v"(b[2]), "v"(b[3]), "v"(k[0]), "v"(k[1]), "v"(k[2]), "v"(k[3]), "v"(w[0]), "v"(w[1]), "v"(w[2]), "v"(w[3]), "v"(s[2]), "v"(s[3]));
    s[0] = t0; s[1] = t1; s[2] = t2; s[3] = t3; y = yp; }
__device__ __forceinline__ void shift4(float (&z)[4], const float (&c)[4], const float (&pv)[4], const float (&nx)[4], const f32x4 m0, const f32x4 mp, const f32x4 mn) {
    asm("v_mul_f32 %0, %4, %16\n v_mul_f32 %1, %5, %17\n v_mul_f32 %2, %6, %18\n v_mul_f32 %3, %7, %19\n"
        "v_fma_f32 %0, %8, %20, %0\n v_fma_f32 %1, %9, %21, %1\n v_fma_f32 %2, %10, %22, %2\n v_fma_f32 %3, %11, %23, %3\n"
        "v_fma_f32 %0, %12, %24, %0\n v_fma_f32 %1, %13, %25, %1\n v_fma_f32 %2, %14, %26, %2\n v_fma_f32 %3, %15, %27, %3"
        : "=&v"(z[0]), "=&v"(z[1]), "=&v"(z[2]), "=&v"(z[3])
        : "v"(c[0]), "v"(c[1]), "v"(c[2]), "v"(c[3]), "v"(pv[0]), "v"(pv[1]), "v"(pv[2]), "v"(pv[3]), "v"(nx[0]), "v"(nx[1]), "v"(nx[2]), "v"(nx[3]),
          "v"(m0[0]), "v"(m0[1]), "v"(m0[2]), "v"(m0[3]), "v"(mp[0]), "v"(mp[1]), "v"(mp[2]), "v"(mp[3]), "v"(mn[0]), "v"(mn[1]), "v"(mn[2]), "v"(mn[3])); }
__device__ __forceinline__ void kk4(float (&kk)[4], float& ss, const float (&k)[4], const f32x4 c) {
    asm("v_mul_f32 %0, %5, %9\n v_mul_f32 %1, %6, %10\n v_mul_f32 %2, %7, %11\n v_mul_f32 %3, %8, %12\n"
        "v_mul_f32 %4, %0, %0\n v_fma_f32 %4, %1, %1, %4\n v_fma_f32 %4, %2, %2, %4\n v_fma_f32 %4, %3, %3, %4"
        : "=&v"(kk[0]), "=&v"(kk[1]), "=&v"(kk[2]), "=&v"(kk[3]), "=&v"(ss) : "v"(k[0]), "v"(k[1]), "v"(k[2]), "v"(k[3]), "v"(c[0]), "v"(c[1]), "v"(c[2]), "v"(c[3])); }
template <int CTRL> __device__ __forceinline__ float dppf(float x) { return __int_as_float(__builtin_amdgcn_update_dpp(0, __float_as_int(x), CTRL, 0xF, 0xF, true)); }
__device__ __forceinline__ float red4(float x) { x += dppf<0xB1>(x); x += dppf<0x4E>(x); return x; }
__device__ __forceinline__ float red8(float x) { x = red4(x); x += dppf<0x141>(x); return x; }
__device__ __forceinline__ float red16(float x) { x = red8(x); x += dppf<0x140>(x); return x; }
__device__ __forceinline__ int opaque_tid() { int t = threadIdx.x; asm volatile("" : "+v"(t)); return t; }
__device__ __forceinline__ const float* xrow(const Params& p, int t) { return t < TP ? p.x_prompt + (size_t)t * DM : p.x_sample + (size_t)(t - TP) * DM; }
__device__ __forceinline__ void seq_of(int t, int& base, int& len) { if (t < TP) { base = t & ~2047; len = 2048; } else { base = TP + ((t - TP) & ~16383); len = 16384; } }

namespace pg8 {
constexpr int BM = 256, BK = 64, HALF = 128, HTB = HALF * BK * 2, STAGE_BYTES = 8 * HTB, NXCD = 8, WGM = 8;
__device__ __forceinline__ int lds_byte(int r, int c) { const int st = (r >> 4) * 2 + (c >> 5), rr = r & 15, cc = c & 31, ob = rr * 64 + cc * 2; return st * 1024 + (ob ^ (((ob >> 9) & 1) << 5)); }
__device__ __forceinline__ void stage_rc(int b, int& R, int& C) { const int st = b / 1024, sb = b % 1024, swz = sb ^ (((sb >> 9) & 1) << 5); R = (st >> 1) * 16 + swz / 64; C = (st & 1) * 32 + (swz % 64) / 2; }
__device__ __forceinline__ int perm32(int rho) { const int n = rho >> 4, i = rho & 15; return 8 * (i >> 2) + 4 * n + (i & 3); }
struct Unit { int pm, pn; };
struct Gemm { const bf16_t* A; const bf16_t* Bt; int M, N, K, lda, ldb; const bf16_t* A2; int ks; };
struct StaticOrder {
    int nM, nN, nwg, G, c;
    __device__ void init(int M, int N, int G_, int c_) { nM = M / BM; nN = N / BM; nwg = nM * nN; G = G_; c = c_; }
    __device__ bool next(int i, Unit& u) const {
        const long L = (long)i * G + c; if (L >= nwg) return false;
        int wgid = (int)L; { const int q = nwg / NXCD, r = nwg % NXCD, xcd = wgid % NXCD, off = wgid / NXCD; wgid = (xcd < r ? xcd * (q + 1) : r * (q + 1) + (xcd - r) * q) + off; }
        const int nig = WGM * nN, gid = wgid / nig, fm = gid * WGM, gsz = (nM - fm) < WGM ? (nM - fm) : WGM;
        u.pm = fm + ((wgid % nig) % gsz); u.pn = (wgid % nig) / gsz; return true;
    }
};

template <class Epi>
__device__ __forceinline__ void gemm_phase(LAS unsigned char* lds, const Gemm g, const StaticOrder& S, const Epi& E) {
    const int tid = opaque_tid();
    const int wid = __builtin_amdgcn_readfirstlane(tid >> 6), lane = tid & 63, wr = wid >> 2, wc = wid & 3, fr = lane & 15, fq = lane >> 4;
    const int K = g.K, nt = K / BK;
    unsigned voffA[2], voffB[2];
#pragma unroll
    for (int i = 0; i < 2; ++i) { int R, C; stage_rc(tid * 16 + i * 8192, R, C); const int Rb = (R & ~31) + perm32(R & 31);
        voffA[i] = (unsigned)(R * g.lda + C) * 2u; voffB[i] = (unsigned)(Rb * g.ldb + C) * 2u; }
    const size_t kstep = (size_t)(BK * 2);
    const size_t hstepA = (size_t)HALF * g.lda * 2, hstepB = (size_t)HALF * g.ldb * 2;
    const size_t tstepA = 2 * hstepA, tstepB = 2 * hstepB;
    const unsigned ldsw = (unsigned)wid * 1024u;
    const int aoff = lds_byte(wr * 64 + fr, fq * 8), boff = lds_byte(wc * 32 + fr, fq * 8);
#define PG8_SA(b, h) (((b) * 2 + (h)) * HTB)
#define PG8_SB(b, h) ((4 + (b) * 2 + (h)) * HTB)
#define PG8_STAGE(bufoff, gbase, voff) do { _Pragma("unroll") for (int _i = 0; _i < 2; ++_i) \
        __builtin_amdgcn_global_load_lds((const unsigned*)((const char*)(gbase) + (voff)[_i]), (LAS unsigned*)(lds + (bufoff) + ldsw + _i * 8192), 16, 0, 0); } while (0)
#define PG8_LDA(dst, b, h) do { _Pragma("unroll") for (int m = 0; m < 4; ++m) _Pragma("unroll") for (int k = 0; k < 2; ++k) dst[m][k] = *(const LAS bf16x8*)(lds + PG8_SA(b, h) + aoff + m * 2048 + k * 1024); } while (0)
#define PG8_LDB(dst, b, h) do { _Pragma("unroll") for (int n = 0; n < 2; ++n) _Pragma("unroll") for (int k = 0; k < 2; ++k) dst[n][k] = *(const LAS bf16x8*)(lds + PG8_SB(b, h) + boff + n * 2048 + k * 1024); } while (0)
#define PG8_MMA(ai, bj, At, Bt) do { __builtin_amdgcn_s_setprio(1); _Pragma("unroll") for (int m = 0; m < 4; ++m) _Pragma("unroll") for (int n = 0; n < 2; ++n) _Pragma("unroll") for (int k = 0; k < 2; ++k) \
        acc[ai][bj][m][n] = __builtin_amdgcn_mfma_f32_16x16x32_bf16(Bt[n][k], At[m][k], acc[ai][bj][m][n], 0, 0, 0); __builtin_amdgcn_s_setprio(0); } while (0)
#define PG8_WAIT_V(n) asm volatile("s_waitcnt vmcnt(" #n ")" ::: "memory")
#define PG8_WAIT_L(n) asm volatile("s_waitcnt lgkmcnt(" #n ")" ::: "memory")
#define PG8_BAR __builtin_amdgcn_s_barrier()
#define PG8_SCHED __builtin_amdgcn_sched_barrier(0)
    Unit cur, nxt; int ui = 0;
    if (!S.next(0, cur)) return;
    f32x4 acc[2][2][4][2];
#pragma unroll
    for (int a = 0; a < 2; ++a)
#pragma unroll
        for (int b = 0; b < 2; ++b)
#pragma unroll
            for (int m = 0; m < 4; ++m)
#pragma unroll
                for (int n = 0; n < 2; ++n) acc[a][b][m][n] = (f32x4){0.f, 0.f, 0.f, 0.f};
    bf16x8 At[4][2], B0[2][2], B1[2][2];
    const char* cA = (const char*)g.A + (size_t)cur.pm * tstepA; const char* cB = (const char*)g.Bt + (size_t)cur.pn * tstepB;
    const bool two = g.A2 != nullptr; const int ks = two ? g.ks : (1 << 30);
    const char* cA2 = two ? (const char*)g.A2 + (size_t)cur.pm * tstepA : cA;
    PG8_STAGE(PG8_SB(0, 0), cB, voffB); PG8_STAGE(PG8_SA(0, 0), cA, voffA); PG8_STAGE(PG8_SB(0, 1), cB + hstepB, voffB); PG8_STAGE(PG8_SA(0, 1), cA + hstepA, voffA);
    if (wr == 1) PG8_BAR;
    PG8_WAIT_V(4); PG8_BAR;
    PG8_STAGE(PG8_SB(1, 0), cB + kstep, voffB); PG8_STAGE(PG8_SA(1, 0), cA + kstep, voffA); PG8_STAGE(PG8_SB(1, 1), cB + hstepB + kstep, voffB);
    PG8_WAIT_V(6); PG8_BAR;
    for (;;) {
        const bool has_next = S.next(ui + 1, nxt);
        const char* nA = has_next ? (const char*)g.A + (size_t)nxt.pm * tstepA : cA; const char* nB = has_next ? (const char*)g.Bt + (size_t)nxt.pn * tstepB : cB;
        const char* nA2 = (two && has_next) ? (const char*)g.A2 + (size_t)nxt.pm * tstepA : cA2;
#pragma unroll 1
        for (int t = 0; t < nt; t += 2) {
            const bool last = (t == nt - 2);
            const char* a1 = (t + 1 < ks) ? cA + (size_t)(t + 1) * kstep : cA2 + (size_t)(t + 1 - ks) * kstep;
            const char* a2 = last ? nA : ((t + 2 < ks) ? cA + (size_t)(t + 2) * kstep : cA2 + (size_t)(t + 2 - ks) * kstep); const char* b2 = last ? nB : cB + (size_t)(t + 2) * kstep;
            const char* a3 = a2 + kstep; const char* b3 = b2 + kstep;
            PG8_LDB(B0, 0, 0); PG8_SCHED; PG8_LDA(At, 0, 0); PG8_STAGE(PG8_SA(1, 1), a1 + hstepA, voffA);
            PG8_WAIT_L(8); PG8_BAR; PG8_WAIT_L(0); PG8_MMA(0, 0, At, B0); PG8_BAR; PG8_SCHED;
            PG8_LDB(B1, 0, 1); PG8_STAGE(PG8_SB(0, 0), b2, voffB);
            PG8_BAR; PG8_WAIT_L(0); PG8_MMA(0, 1, At, B1); PG8_BAR;
            PG8_LDA(At, 0, 1); PG8_STAGE(PG8_SA(0, 0), a2, voffA);
            PG8_BAR; PG8_WAIT_L(0); PG8_MMA(1, 0, At, B0); PG8_BAR; PG8_SCHED;
            PG8_STAGE(PG8_SB(0, 1), b2 + hstepB, voffB);
            PG8_WAIT_V(6); PG8_BAR; PG8_MMA(1, 1, At, B1); PG8_BAR;
            PG8_LDB(B0, 1, 0); PG8_SCHED; PG8_LDA(At, 1, 0); PG8_STAGE(PG8_SA(0, 1), a2 + hstepA, voffA);
            PG8_WAIT_L(8); PG8_BAR; PG8_WAIT_L(0); PG8_MMA(0, 0, At, B0); PG8_BAR; PG8_SCHED;
            PG8_LDB(B1, 1, 1); PG8_STAGE(PG8_SB(1, 0), b3, voffB);
            PG8_BAR; PG8_WAIT_L(0); PG8_MMA(0, 1, At, B1); PG8_BAR;
            PG8_LDA(At, 1, 1); PG8_STAGE(PG8_SA(1, 0), a3, voffA);
            PG8_BAR; PG8_WAIT_L(0); PG8_MMA(1, 0, At, B0); PG8_BAR; PG8_SCHED;
            PG8_STAGE(PG8_SB(1, 1), b3 + hstepB, voffB);
            PG8_WAIT_V(6); PG8_BAR; PG8_MMA(1, 1, At, B1); PG8_BAR;
        }
        E(acc, cur, wr, wc, fr, fq);
        if (!has_next) break;
#pragma unroll
        for (int a = 0; a < 2; ++a)
#pragma unroll
            for (int b = 0; b < 2; ++b)
#pragma unroll
                for (int m = 0; m < 4; ++m)
#pragma unroll
                    for (int n = 0; n < 2; ++n) acc[a][b][m][n] = (f32x4){0.f, 0.f, 0.f, 0.f};
        cur = nxt; cA = nA; cA2 = nA2; cB = nB; ++ui;
    }
    PG8_WAIT_V(0);
    if (wr == 0) PG8_BAR;
    PG8_BAR;
#undef PG8_SA
#undef PG8_SB
#undef PG8_STAGE
#undef PG8_LDA
#undef PG8_LDB
#undef PG8_MMA
#undef PG8_WAIT_V
#undef PG8_WAIT_L
#undef PG8_BAR
#undef PG8_SCHED
}
}
using pg8::Unit;

#define EPI_LOOP_BEGIN const int row0 = u.pm * 256 + wr * 64 + fr, col0 = u.pn * 256 + wc * 32 + 8 * fq; \
    _Pragma("unroll") for (int ai = 0; ai < 2; ++ai) _Pragma("unroll") for (int m = 0; m < 4; ++m) { const int row = row0 + ai * 128 + m * 16;
#define EPI_BJ _Pragma("unroll") for (int bj = 0; bj < 2; ++bj) { const int col = col0 + bj * 128; const f32x4 v0 = acc[ai][bj][m][0], v1 = acc[ai][bj][m][1];
#define EPI_ACC const f32x4 (&acc)[2][2][4][2], const Unit& u, int wr, int wc, int fr, int fq

__device__ __forceinline__ u32x4 pack8(const f32x4 a, const f32x4 b) { u32x4 w; w.x = pk_bf16(a[0], a[1]); w.y = pk_bf16(a[2], a[3]); w.z = pk_bf16(b[0], b[1]); w.w = pk_bf16(b[2], b[3]); return w; }
__device__ __forceinline__ void unpack8(const u32x4 w, f32x4& a, f32x4& b) { a = (f32x4){bf_lo(w.x), bf_hi(w.x), bf_lo(w.y), bf_hi(w.y)}; b = (f32x4){bf_lo(w.z), bf_hi(w.z), bf_lo(w.w), bf_hi(w.w)}; }

struct EpiStore {
    bf16_t* O; int ldc;
    __device__ __forceinline__ void operator()(EPI_ACC) const { EPI_LOOP_BEGIN EPI_BJ *(u32x4*)(O + (size_t)row * ldc + col) = pack8(v0, v1); } } }
};
struct EpiMulInPlace {
    bf16_t* Y;
    __device__ __forceinline__ void operator()(EPI_ACC) const { EPI_LOOP_BEGIN if ((m & 1) == 0) __builtin_amdgcn_sched_barrier(0);
        EPI_BJ u32x4* ptr = (u32x4*)(Y + (size_t)row * 1024 + col); f32x4 a, b; unpack8(*ptr, a, b); *ptr = pack8(a * v0, b * v1); } } }
};
struct EpiGates {
    bf16_t* G; const float* bias;
    __device__ __forceinline__ void operator()(EPI_ACC) const { EPI_LOOP_BEGIN EPI_BJ
        const f32x4 b0 = *(const f32x4*)(bias + col), b1 = *(const f32x4*)(bias + col + 4); f32x4 a, b;
#pragma unroll
        for (int j = 0; j < 4; ++j) { a[j] = sigmoidf_(v0[j] + b0[j]); b[j] = sigmoidf_(v1[j] + b1[j]); }
        *(u32x4*)(G + (size_t)row * 2048 + col) = pack8(a, b); } } }
};
struct EpiPool {
    bf16_t* P; const bf16_t* G;
    __device__ __forceinline__ void operator()(EPI_ACC) const { EPI_LOOP_BEGIN EPI_BJ f32x4 a, b; unpack8(*(const u32x4*)(G + (size_t)row * 2048 + col), a, b);
        *(u32x4*)(P + (size_t)row * 1024 + col) = pack8(a * v0, b * v1); } } }
};
struct EpiMerge {
    bf16_t* P; const bf16_t* G;
    __device__ __forceinline__ void operator()(EPI_ACC) const { EPI_LOOP_BEGIN EPI_BJ f32x4 a, b, pa, pb; unpack8(*(const u32x4*)(G + (size_t)row * 2048 + 1024 + col), a, b);
        u32x4* ptr = (u32x4*)(P + (size_t)row * 1024 + col); unpack8(*ptr, pa, pb); *ptr = pack8(pa + a * v0, pb + b * v1); } } }
};
struct EpiOut {
    const float* xp; const float* xs; float* X1; bf16_t* X1B; float* rowsq;
    __device__ __forceinline__ void operator()(EPI_ACC) const { EPI_LOOP_BEGIN const float* xr = row < TP ? xp + (size_t)row * DM : xs + (size_t)(row - TP) * DM; float ss = 0.f; EPI_BJ
        f32x4 a = *(const f32x4*)(xr + col) + v0, b = *(const f32x4*)(xr + col + 4) + v1;
        *(f32x4*)(X1 + (size_t)row * 1024 + col) = a; *(f32x4*)(X1 + (size_t)row * 1024 + col + 4) = b; *(u32x4*)(X1B + (size_t)row * 1024 + col) = pack8(a, b);
#pragma unroll
        for (int j = 0; j < 4; ++j) ss += a[j] * a[j] + b[j] * b[j]; }
        ss += __shfl_xor(ss, 16); ss += __shfl_xor(ss, 32); if (fq == 0) atomicAdd(rowsq + row, ss); } }
};
struct EpiFF1 {
    bf16_t* Hlo; bf16_t* Hhi; const float* rowsq;
    __device__ __forceinline__ void operator()(EPI_ACC) const { bf16_t* H = u.pn < 8 ? Hlo : Hhi; const int cshift = u.pn < 8 ? 0 : 2048;
        EPI_LOOP_BEGIN const float rinv = rsqrtf(rowsq[row] * (1.0f / 1024.0f) + 1e-6f); EPI_BJ f32x4 a, b;
#pragma unroll
        for (int j = 0; j < 4; ++j) { float t0 = fmaxf(v0[j] * rinv, 0.f), t1 = fmaxf(v1[j] * rinv, 0.f); a[j] = t0 * t0; b[j] = t1 * t1; }
        *(u32x4*)(H + (size_t)row * 2048 + (col - cshift)) = pack8(a, b); } } }
};
struct EpiAddInPlace {
    float* X;
    __device__ __forceinline__ void operator()(EPI_ACC) const { EPI_LOOP_BEGIN EPI_BJ f32x4* ptr = (f32x4*)(X + (size_t)row * 1024 + col); ptr[0] = ptr[0] + v0; ptr[1] = ptr[1] + v1; } } }
};
struct EpiFinal {
    float* X; float* rowsq;
    __device__ __forceinline__ void operator()(EPI_ACC) const { EPI_LOOP_BEGIN float ss = 0.f; EPI_BJ f32x4* ptr = (f32x4*)(X + (size_t)row * 1024 + col); const f32x4 a = ptr[0] + v0, b = ptr[1] + v1; ptr[0] = a; ptr[1] = b;
#pragma unroll
        for (int j = 0; j < 4; ++j) ss += a[j] * a[j] + b[j] * b[j]; }
        ss += __shfl_xor(ss, 16); ss += __shfl_xor(ss, 32); if (fq == 0) atomicAdd(rowsq + row, ss); } }
};

template <class Epi>
__device__ __forceinline__ void run_gemm(unsigned char* shm, const bf16_t* A, int lda, const bf16_t* Bt, int ldb, int N, int K, const Epi& E, const bf16_t* A2 = nullptr, int ks = 0) {
    pg8::Gemm g; g.A = A; g.Bt = Bt; g.M = T_TOK; g.N = N; g.K = K; g.lda = lda; g.ldb = ldb; g.A2 = A2; g.ks = ks;
    pg8::StaticOrder S; S.init(T_TOK, N, (int)gridDim.x, (int)blockIdx.x);
    pg8::gemm_phase<Epi>((LAS unsigned char*)shm, g, S, E);
}

__device__ void transpose_cvt(unsigned char* shm, const float* src, int K, int N, bf16_t* dst, int ldd, const float* kscale) {
    float* tile = (float*)shm;
    const int tid = opaque_tid(), ntk = K / 64, ntn = N / 64;
    for (int t = blockIdx.x; t < ntk * ntn; t += gridDim.x) {
        const int tk = t / ntn, tn = t % ntn;
#pragma unroll
        for (int i = 0; i < 8; ++i) { const int kl = (tid >> 6) + 8 * i, nl = tid & 63; const int k = tk * 64 + kl;
            tile[kl * 65 + nl] = src[(size_t)k * N + tn * 64 + nl] * (kscale ? kscale[k] : 1.0f); }
        __syncthreads();
#pragma unroll
        for (int i = 0; i < 8; ++i) { const int nl = (tid >> 6) + 8 * i, kl = tid & 63;
            const unsigned w = pk_bf16(tile[kl * 65 + nl], 0.f); dst[(size_t)(tn * 64 + nl) * ldd + tk * 64 + kl] = (bf16_t)(w & 0xFFFFu); }
        __syncthreads();
    }
}

__device__ void rmsnorm_rows(const Params& p, const float* g, bf16_t* dst) {
    const int tidx = opaque_tid(); const int lane = tidx & 63, wave = (blockIdx.x * 512 + tidx) >> 6, nw = (gridDim.x * 512) >> 6;
    f32x4 gv[4];
#pragma unroll
    for (int i = 0; i < 4; ++i) gv[i] = *(const f32x4*)(g + lane * 4 + 256 * i);
    for (int t0 = wave; t0 < T_TOK; t0 += 2 * nw) {
        const int t1 = t0 + nw; const bool has1 = t1 < T_TOK;
        const float* xr0 = xrow(p, t0); const float* xr1 = xrow(p, has1 ? t1 : t0); f32x4 v0[4], v1[4]; float ss0 = 0.f, ss1 = 0.f;
#pragma unroll
        for (int i = 0; i < 4; ++i) { v0[i] = *(const f32x4*)(xr0 + lane * 4 + 256 * i); v1[i] = *(const f32x4*)(xr1 + lane * 4 + 256 * i); }
#pragma unroll
        for (int i = 0; i < 4; ++i) { ss0 += v0[i][0] * v0[i][0] + v0[i][1] * v0[i][1] + v0[i][2] * v0[i][2] + v0[i][3] * v0[i][3]; ss1 += v1[i][0] * v1[i][0] + v1[i][1] * v1[i][1] + v1[i][2] * v1[i][2] + v1[i][3] * v1[i][3]; }
#pragma unroll
        for (int o = 1; o < 64; o <<= 1) { ss0 += __shfl_xor(ss0, o); ss1 += __shfl_xor(ss1, o); }
        const float r0 = rsqrtf(ss0 * (1.0f / 1024.0f) + 1e-6f), r1 = rsqrtf(ss1 * (1.0f / 1024.0f) + 1e-6f);
#pragma unroll
        for (int i = 0; i < 4; ++i) { u32x2 w; w.x = pk_bf16(v0[i][0] * r0 * gv[i][0], v0[i][1] * r0 * gv[i][1]); w.y = pk_bf16(v0[i][2] * r0 * gv[i][2], v0[i][3] * r0 * gv[i][3]);
            *(u32x2*)(dst + (size_t)t0 * 1024 + lane * 4 + 256 * i) = w; }
        if (has1) {
#pragma unroll
            for (int i = 0; i < 4; ++i) { u32x2 w; w.x = pk_bf16(v1[i][0] * r1 * gv[i][0], v1[i][1] * r1 * gv[i][1]); w.y = pk_bf16(v1[i][2] * r1 * gv[i][2], v1[i][3] * r1 * gv[i][3]);
                *(u32x2*)(dst + (size_t)t1 * 1024 + lane * 4 + 256 * i) = w; } }
    }
}

__device__ void prep_phase(const Params& p, unsigned char* shm) {
    unsigned char* ws = p.ws;
    const int gtid = blockIdx.x * 512 + opaque_tid(), gn = gridDim.x * 512;
    for (int i = gtid; i < T_TOK; i += gn) { ((float*)(ws + OFF_ROWSQ))[i] = 0.f; ((float*)(ws + OFF_ROWSQ2))[i] = 0.f; }
    if (gtid < 64) ((unsigned*)(ws + OFF_QUEUE))[gtid] = 0u;
    transpose_cvt(shm, p.w_in, 1024, 5888, (bf16_t*)(ws + OFF_WIN), 1024, nullptr);
    transpose_cvt(shm, p.w_rwkv_br, 1024, 1024, (bf16_t*)(ws + OFF_WRBR), 1024, nullptr);
    transpose_cvt(shm, p.w_out, 1024, 1024, (bf16_t*)(ws + OFF_WOUT), 1024, nullptr);
    transpose_cvt(shm, p.w_ff1, 1024, 4096, (bf16_t*)(ws + OFF_WFF1), 1024, p.g_ffn);
    transpose_cvt(shm, p.w_ff2, 4096, 1024, (bf16_t*)(ws + OFF_WFF2), 4096, nullptr);
    transpose_cvt(shm, p.g_up, 128, 1024, (bf16_t*)(ws + OFF_WG), 256, nullptr);
    { bf16_t* wg = (bf16_t*)(ws + OFF_WG); for (int i = gtid; i < 1024 * 128; i += gn) wg[(size_t)(i >> 7) * 256 + 128 + (i & 127)] = 0; }
    { bf16_t* we = (bf16_t*)(ws + OFF_WEFF);
      for (int i = gtid; i < 512 * 1024; i += gn) { const int k = i >> 10, n = i & 1023, gI = k >> 7; const float* pw = p.pool_w + (size_t)k * 128; float acc = 0.f;
          for (int d = 0; d < 128; ++d) acc += pw[d] * p.pool_scale[gI * 128 + d] * p.w_pool_br[(size_t)(gI * 128 + d) * 1024 + n];
          we[(size_t)n * 512 + k] = (bf16_t)(pk_bf16(acc, 0.f) & 0xFFFFu); } }
    rmsnorm_rows(p, p.g_mix, (bf16_t*)(ws + OFF_R1));
}

#define LDS_BAR() do { asm volatile("s_waitcnt lgkmcnt(0)" ::: "memory"); __builtin_amdgcn_s_barrier(); asm volatile("" ::: "memory"); } while (0)
constexpr int N_SAMPLE_ITEMS = 128, N_ITEMS = N_SAMPLE_ITEMS + 1024;

template <int LPR, int RPL, int DIR>
__device__ __forceinline__ void scan_item(const Params& p, unsigned char* shm, const int tid, const int tbase, const int L, const int h, const int half) {
    constexpr int dir = DIR;
    constexpr int EC = 64 / LPR, RPW = RPL * (64 / LPR);
    float* sW = (float*)shm; float* sAV = sW + 2048; float* sBV = sW + 4096; float* sKD = sW + 6144; float* sWR = sW + 8192; float* sR = sW + 10240; float* sV = sW + 12288; float* sY = sW + 14336;
    float* sBK = sW + 16384;
    bf16_t* sTW = (bf16_t*)(sW + 16384 + 64);
    bf16_t* sZA = sTW + 32 * 72;
    const int lane = tid & 63, wv = tid >> 6;
    const bf16_t* zall = (const bf16_t*)(p.ws + OFF_Z);
    const int tokA = tid >> 4, q = tid & 15;
    const int rowS = half * 32 + wv * RPW + RPL * (lane / LPR), gS = lane % LPR;
    const int NC = L / 32;
    bf16_t* ybuf = (bf16_t*)p.out + (dir ? (size_t)T_TOK * 1024 : 0);
    float* bonus = (float*)(p.ws + OFF_BONUS) + (dir ? (size_t)T_TOK * 16 : 0);
    const float* w_up = dir ? p.w_up_b : p.w_up_f; const float* a_up = dir ? p.a_up_b : p.a_up_f;
    const float* w0 = dir ? p.w0_b : p.w0_f; const float* a0 = dir ? p.a0_b : p.a0_f;
    const int mat = wv >> 2, cbk = wv & 3, colB = cbk * 16 + (lane & 15), quad = lane >> 4;
    u32x4* sBF = (u32x4*)(shm + 84 * 1024);
    { const float* up = mat ? a_up : w_up;
#pragma unroll
      for (int kb = 0; kb < 2; ++kb) { float f[8];
#pragma unroll
          for (int j = 0; j < 8; ++j) f[j] = up[(size_t)(kb * 32 + quad * 8 + j) * 1024 + h * 64 + colB];
          u32x4 w; w.x = pk_bf16(f[0], f[1]); w.y = pk_bf16(f[2], f[3]); w.z = pk_bf16(f[4], f[5]); w.w = pk_bf16(f[6], f[7]); sBF[kb * 512 + tid] = w; } }
    const float c0B = (mat ? a0 : w0)[h * 64 + colB];
    const float kaB = p.k_a[h * 64 + colB];
    int colz[5];
    float* sM0 = (float*)(shm + 100 * 1024);
    float* sMU = (float*)(shm + 76 * 1024);
#pragma unroll
    for (int gi = 0; gi < 5; ++gi) colz[gi] = (gi == 0 ? COL_R + h * 64 : gi == 1 ? COL_K + h * 64 : gi == 2 ? COL_V + h * 64 : gi == 3 ? COL_W : COL_A) + 4 * q;
    if (tid < 320) { const int gi = tid >> 6, c = tid & 63; const int col = (gi == 0 ? COL_R + h * 64 : gi == 1 ? COL_K + h * 64 : gi == 2 ? COL_V + h * 64 : gi == 3 ? COL_W : COL_A) + c - COL_R;
        const float mpv_ = p.mu_prev[col], mnv_ = p.mu_next[col]; sMU[gi * 64 + c] = mpv_; sMU[320 + gi * 64 + c] = mnv_; sM0[gi * 64 + c] = 1.0f - mpv_ - mnv_; }
    else if (tid < 384) sMU[640 + (tid - 320)] = p.k_k[h * 64 + (tid - 320)];
    else if (tid < 448) sMU[704 + (tid - 384)] = p.r_k[h * 64 + (tid - 384)];
    __syncthreads();
    float s[RPL][EC];
#pragma unroll
    for (int r = 0; r < RPL; ++r)
#pragma unroll
        for (int j = 0; j < EC; ++j) s[r][j] = 0.f;
    u32x2 zc[5], zp[5], zn[5];
    auto load_chunk = [&](int ci) {
        const int t = tbase + 32 * (dir ? NC - 1 - ci : ci) + tokA; const bool hasPrev = t > tbase, hasNext = t < tbase + L - 1;
        const bf16_t* zr = zall + (size_t)t * ZLD;
#pragma unroll
        for (int gi = 0; gi < 5; ++gi) { zc[gi] = *(const u32x2*)(zr + colz[gi]); zp[gi] = (u32x2){0u, 0u}; zn[gi] = (u32x2){0u, 0u};
            if (hasPrev) zp[gi] = *(const u32x2*)(zr - ZLD + colz[gi]);
            if (hasNext) zn[gi] = *(const u32x2*)(zr + ZLD + colz[gi]); }
    };
    load_chunk(0);
    for (int ci = 0; ci < NC; ++ci) {
        const int t0 = tbase + 32 * (dir ? NC - 1 - ci : ci);
        { float zs[5][4];
          f32x4 MP[5], MN[5], M0[5];
#pragma unroll
          for (int gi = 0; gi < 5; ++gi) { MP[gi] = *(const f32x4*)(sMU + gi * 64 + 4 * q); MN[gi] = *(const f32x4*)(sMU + 320 + gi * 64 + 4 * q); M0[gi] = *(const f32x4*)(sM0 + gi * 64 + 4 * q); }
          const f32x4 kk4c = *(const f32x4*)(sMU + 640 + 4 * q);
#pragma unroll
          for (int gi = 0; gi < 5; ++gi) {
              const float c[4] = {bf_lo(zc[gi].x), bf_hi(zc[gi].x), bf_lo(zc[gi].y), bf_hi(zc[gi].y)}, pv[4] = {bf_lo(zp[gi].x), bf_hi(zp[gi].x), bf_lo(zp[gi].y), bf_hi(zp[gi].y)}, nx[4] = {bf_lo(zn[gi].x), bf_hi(zn[gi].x), bf_lo(zn[gi].y), bf_hi(zn[gi].y)};
              shift4(zs[gi], c, pv, nx, M0[gi], MP[gi], MN[gi]);
          }
          if (ci + 1 < NC) load_chunk(ci + 1);
          *(f32x4*)(sR + tokA * 64 + 4 * q) = (f32x4){zs[0][0], zs[0][1], zs[0][2], zs[0][3]};
          *(f32x4*)(sKD + tokA * 64 + 4 * q) = (f32x4){zs[1][0], zs[1][1], zs[1][2], zs[1][3]};
          *(f32x4*)(sV + tokA * 64 + 4 * q) = (f32x4){zs[2][0], zs[2][1], zs[2][2], zs[2][3]};
          float kk[4], ss;
          kk4(kk, ss, zs[1], kk4c);
          ss = ss + 0.0f * kk[0];
          ss = red16(ss);
          const float inv = -__builtin_amdgcn_rsqf(fmaxf(ss, 1e-24f));
          *(f32x4*)(sAV + tokA * 64 + 4 * q) = (f32x4){kk[0] * inv, kk[1] * inv, kk[2] * inv, kk[3] * inv};
          float tw[4];
#pragma unroll
          for (int j = 0; j < 4; ++j) tw[j] = 1.0f - 2.0f * __builtin_amdgcn_rcpf(1.0f + fexp2_scaled(zs[3][j], 2.8853900818f));
          u32x2 w; w.x = pk_bf16(tw[0], tw[1]); w.y = pk_bf16(tw[2], tw[3]); *(u32x2*)(sTW + tokA * 72 + 4 * q) = w;
          w.x = pk_bf16(zs[4][0], zs[4][1]); w.y = pk_bf16(zs[4][2], zs[4][3]); *(u32x2*)(sZA + tokA * 72 + 4 * q) = w;
        }
        LDS_BAR();
        { const int matu = __builtin_amdgcn_readfirstlane(mat);
          const bf16_t* sX = matu ? sZA : sTW;
          const bf16x8 b0 = __builtin_bit_cast(bf16x8, sBF[tid]), b1 = __builtin_bit_cast(bf16x8, sBF[512 + tid]);
          const bf16_t* ap = sX + (lane & 15) * 72 + quad * 8;
          const bf16x8 a00 = *(const bf16x8*)(ap), a01 = *(const bf16x8*)(ap + 32), a10 = *(const bf16x8*)(ap + 16 * 72), a11 = *(const bf16x8*)(ap + 16 * 72 + 32);
          const int idx0 = (quad * 4) * 64 + colB;
          float o1[8], o2[8];
          if (matu == 0) {
#pragma unroll
              for (int i = 0; i < 8; ++i) o1[i] = sR[idx0 + ((i >> 2) * 16 + (i & 3)) * 64];
          } else {
#pragma unroll
              for (int i = 0; i < 8; ++i) { o1[i] = sKD[idx0 + ((i >> 2) * 16 + (i & 3)) * 64]; o2[i] = sAV[idx0 + ((i >> 2) * 16 + (i & 3)) * 64]; }
          }
          f32x4 acc0 = (f32x4){c0B, c0B, c0B, c0B}, acc1 = acc0;
          acc0 = __builtin_amdgcn_mfma_f32_16x16x32_bf16(a00, b0, acc0, 0, 0, 0); acc1 = __builtin_amdgcn_mfma_f32_16x16x32_bf16(a10, b0, acc1, 0, 0, 0);
          acc0 = __builtin_amdgcn_mfma_f32_16x16x32_bf16(a01, b1, acc0, 0, 0, 0); acc1 = __builtin_amdgcn_mfma_f32_16x16x32_bf16(a11, b1, acc1, 0, 0, 0);
          float sg[8];
#pragma unroll
          for (int i = 0; i < 8; ++i) sg[i] = sigmoidf_(i < 4 ? acc0[i & 3] : acc1[i & 3]);
          if (matu == 0) {
              float wv_[8];
#pragma unroll
              for (int i = 0; i < 8; ++i) wv_[i] = fexp2_scaled(sg[i], -0.6065306597f * 1.4426950409f);
#pragma unroll
              for (int i = 0; i < 8; ++i) { const int idx = idx0 + ((i >> 2) * 16 + (i & 3)) * 64; sW[idx] = wv_[i]; sWR[idx] = wv_[i] * o1[i]; }
          } else {
#pragma unroll
              for (int i = 0; i < 8; ++i) { const int idx = idx0 + ((i >> 2) * 16 + (i & 3)) * 64; sKD[idx] = o1[i] * (1.0f + (sg[i] - 1.0f) * kaB); sBV[idx] = -o2[i] * sg[i]; }
          } }
        LDS_BAR();
        { const f32x4 r4 = *(const f32x4*)(sR + tokA * 64 + 4 * q), b4 = *(const f32x4*)(sBV + tokA * 64 + 4 * q), k4 = *(const f32x4*)(sKD + tokA * 64 + 4 * q);
          float br = 0.f, kr = 0.f, cb = 0.f; const f32x4 rk4 = *(const f32x4*)(sMU + 704 + 4 * q);
#pragma unroll
          for (int j = 0; j < 4; ++j) { br += b4[j] * r4[j]; kr += k4[j] * r4[j]; cb += r4[j] * k4[j] * rk4[j]; }
          br = red16(br); kr = red16(kr); cb = red16(cb);
          if (q == 0) { sBK[tokA * 2] = br; sBK[tokA * 2 + 1] = kr; if (half == 0) bonus[(size_t)(t0 + tokA) * 16 + h] = cb; } }
        LDS_BAR();
        {
            constexpr int NV = EC / 4;
            struct Ops { f32x4 w[NV], a[NV], b[NV], k[NV], q[NV]; float v[RPL]; f32x2 bk; };
            auto ld = [&](Ops& o, int i) { const int tk = DIR ? 31 - i : i; const int off = tk * 64 + 4 * gS;
#pragma unroll
                for (int c = 0; c < NV; ++c) { o.w[c] = *(const f32x4*)(sW + off + 32 * c); o.a[c] = *(const f32x4*)(sAV + off + 32 * c); o.b[c] = *(const f32x4*)(sBV + off + 32 * c);
                    o.k[c] = *(const f32x4*)(sKD + off + 32 * c); o.q[c] = *(const f32x4*)(sWR + off + 32 * c); }
                if constexpr (RPL == 2) { const f32x2 v2 = *(const f32x2*)(sV + tk * 64 + rowS); o.v[0] = v2.x; o.v[1] = v2.y; } else o.v[0] = sV[tk * 64 + rowS];
                o.bk = *(const f32x2*)(sBK + tk * 2); };
            auto step = [&](const Ops& cur, int i) {
                static_assert(EC == 4, "asm row helpers are written for 4 columns per lane");
                float sa[RPL], yp[RPL], y[RPL];
#pragma unroll
                for (int r = 0; r < RPL; ++r) row_dots(s[r], cur.a[0], cur.q[0], sa[r], yp[r]);
                if constexpr (RPL == 2) red16x4(sa[0], yp[0], sa[1], yp[1]); else red16x2(sa[0], yp[0]);
#pragma unroll
                for (int r = 0; r < RPL; ++r) row_update(s[r], cur.w[0], cur.b[0], cur.k[0], cur.v[r], sa[r], yp[r], cur.bk.x, cur.bk.y, y[r]);
                if (gS == 0) { if constexpr (RPL == 2) *(f32x2*)(sY + (DIR ? 31 - i : i) * 64 + rowS) = (f32x2){y[0], y[1]}; else sY[(DIR ? 31 - i : i) * 64 + rowS] = y[0]; }
            };
            {
                Ops o0, o1, o2; ld(o0, 0); ld(o1, 1);
#pragma unroll 1
                for (int i = 0; i < 30; i += 3) {
                    ld(o2, i + 2);
                    step(o0, i);
                    ld(o0, i + 3);
                    step(o1, i + 1);
                    ld(o1, min(i + 4, 31));
                    step(o2, i + 2);
                }
                step(o0, 30);
                step(o1, 31);
            }
        }
        LDS_BAR();
        if (RPL == 2 || (q >> 3) == half) { const f32x4 y4 = *(const f32x4*)(sY + tokA * 64 + 4 * q); u32x2 w; w.x = pk_bf16(y4[0], y4[1]); w.y = pk_bf16(y4[2], y4[3]);
          *(u32x2*)(ybuf + (size_t)(t0 + tokA) * 1024 + h * 64 + 4 * q) = w; }
    }
}

__device__ void scan_phase(const Params& p, unsigned char* shm) {
    int* sItem = (int*)(shm + 80 * 1024);
    const int tid = opaque_tid();
    unsigned* queue = (unsigned*)(p.ws + OFF_QUEUE);
    for (;;) {
        if (tid == 0) *sItem = (int)atomicAdd(queue, 1u);
        __syncthreads();
        const int item = *sItem;
        __syncthreads();
        if (item >= N_ITEMS) break;
        int tid2 = tid; asm volatile("" : "+v"(tid2));
        if (item < N_SAMPLE_ITEMS) {
            const int half = item & 1, j = item >> 1;
            if (j & 1) scan_item<16, 1, 1>(p, shm, tid2, TP + (j >> 5) * 16384, 16384, (j >> 1) & 15, half); else scan_item<16, 1, 0>(p, shm, tid2, TP + (j >> 5) * 16384, 16384, (j >> 1) & 15, half);
        } else { const int j = item - N_SAMPLE_ITEMS;
            if (j & 1) scan_item<16, 2, 1>(p, shm, tid2, (j >> 5) * 2048, 2048, (j >> 1) & 15, 0); else scan_item<16, 2, 0>(p, shm, tid2, (j >> 5) * 2048, 2048, (j >> 1) & 15, 0); }
        __syncthreads();
    }
}

__device__ void mix_phase(const Params& p) {
    const int tidx = opaque_tid(); const int lane = tidx & 63, wave = (blockIdx.x * 512 + tidx) >> 6, nw = (gridDim.x * 512) >> 6;
    const bf16_t* zall = (const bf16_t*)(p.ws + OFF_Z);
    bf16_t* yf = (bf16_t*)p.out; const bf16_t* yb = (const bf16_t*)p.out + (size_t)T_TOK * 1024;
    const float* bonus_f = (const float*)(p.ws + OFF_BONUS); const float* bonus_b = bonus_f + (size_t)T_TOK * 16;
    bf16_t* pooled = (bf16_t*)(p.ws + OFF_POOLED); bf16_t* sg = (bf16_t*)(p.ws + OFF_SG);
    const int hL = lane >> 2;
    const int tpw = (T_TOK + nw - 1) / nw;
    for (int t = wave * tpw; t < min(T_TOK, (wave + 1) * tpw); ++t) {
        int tbase, L; seq_of(t, tbase, L); const int pos = t - tbase; const bool hasPrev = pos > 0, hasNext = pos < L - 1;
        const bf16_t* zr = zall + (size_t)t * ZLD;
        { const int c0 = lane * 16; float y[16];
          { const u32x4 a0 = *(const u32x4*)(yf + (size_t)t * 1024 + c0), a1 = *(const u32x4*)(yf + (size_t)t * 1024 + c0 + 8);
            const u32x4 b0 = *(const u32x4*)(yb + (size_t)t * 1024 + c0), b1 = *(const u32x4*)(yb + (size_t)t * 1024 + c0 + 8);
            f32x4 fa, fb, ga, gb; unpack8(a0, fa, fb); unpack8(b0, ga, gb);
#pragma unroll
            for (int j = 0; j < 4; ++j) { y[j] = fa[j] + ga[j]; y[4 + j] = fb[j] + gb[j]; }
            unpack8(a1, fa, fb); unpack8(b1, ga, gb);
#pragma unroll
            for (int j = 0; j < 4; ++j) { y[8 + j] = fa[j] + ga[j]; y[12 + j] = fb[j] + gb[j]; } }
          float sm = 0.f;
#pragma unroll
          for (int j = 0; j < 16; ++j) sm += y[j];
          const float mean = red4(sm) * (1.0f / 64.0f); float vs = 0.f;
#pragma unroll
          for (int j = 0; j < 16; ++j) { const float d = y[j] - mean; vs += d * d; }
          const float rstd = rsqrtf(red4(vs) * (1.0f / 64.0f) + 64e-5f);
          const float bon = bonus_f[(size_t)t * 16 + hL] + bonus_b[(size_t)t * 16 + hL];
          float vv[16];
          { const bf16_t* zc = zr + COL_V + c0;
            u32x4 c_[2], p_[2], n_[2];
#pragma unroll
            for (int i = 0; i < 2; ++i) { c_[i] = *(const u32x4*)(zc + 8 * i); p_[i] = hasPrev ? *(const u32x4*)(zc - ZLD + 8 * i) : (u32x4){0u, 0u, 0u, 0u}; n_[i] = hasNext ? *(const u32x4*)(zc + ZLD + 8 * i) : (u32x4){0u, 0u, 0u, 0u}; }
#pragma unroll
            for (int i = 0; i < 2; ++i) { f32x4 ca, cb, pa, pb, na, nb; unpack8(c_[i], ca, cb); unpack8(p_[i], pa, pb); unpack8(n_[i], na, nb);
                const float* mp = p.mu_prev + (COL_V - COL_R) + c0 + 8 * i; const float* mn = p.mu_next + (COL_V - COL_R) + c0 + 8 * i;
                const f32x4 mp0 = *(const f32x4*)mp, mp1 = *(const f32x4*)(mp + 4), mn0 = *(const f32x4*)mn, mn1 = *(const f32x4*)(mn + 4);
#pragma unroll
                for (int j = 0; j < 4; ++j) { vv[8 * i + j] = ca[j] + mp0[j] * (pa[j] - ca[j]) + mn0[j] * (na[j] - ca[j]); vv[8 * i + 4 + j] = cb[j] + mp1[j] * (pb[j] - cb[j]) + mn1[j] * (nb[j] - cb[j]); } } }
          float o[16];
#pragma unroll
          for (int i = 0; i < 4; ++i) { const f32x4 lw = *(const f32x4*)(p.ln_w + c0 + 4 * i), lb = *(const f32x4*)(p.ln_b + c0 + 4 * i);
#pragma unroll
              for (int j = 0; j < 4; ++j) o[4 * i + j] = (y[4 * i + j] - mean) * rstd * lw[j] + lb[j] + bon * vv[4 * i + j]; }
          u32x4 w0, w1; w0.x = pk_bf16(o[0], o[1]); w0.y = pk_bf16(o[2], o[3]); w0.z = pk_bf16(o[4], o[5]); w0.w = pk_bf16(o[6], o[7]);
          w1.x = pk_bf16(o[8], o[9]); w1.y = pk_bf16(o[10], o[11]); w1.z = pk_bf16(o[12], o[13]); w1.w = pk_bf16(o[14], o[15]);
          *(u32x4*)(yf + (size_t)t * 1024 + c0) = w0; *(u32x4*)(yf + (size_t)t * 1024 + c0 + 8) = w1; }
        { const int c = 2 * lane; const bf16_t* zc = zr + COL_G + c; const unsigned wc_ = *(const unsigned*)zc; const unsigned wp = hasPrev ? *(const unsigned*)(zc - ZLD) : 0u, wn = hasNext ? *(const unsigned*)(zc + ZLD) : 0u;
          const float mp0 = p.mu_prev[COL_G - COL_R + c], mp1 = p.mu_prev[COL_G - COL_R + c + 1], mn0 = p.mu_next[COL_G - COL_R + c], mn1 = p.mu_next[COL_G - COL_R + c + 1];
          const float c0v = bf_lo(wc_), c1v = bf_hi(wc_);
          const float z0 = c0v + mp0 * (bf_lo(wp) - c0v) + mn0 * (bf_lo(wn) - c0v), z1 = c1v + mp1 * (bf_hi(wp) - c1v) + mn1 * (bf_hi(wn) - c1v);
          *(unsigned*)(sg + (size_t)t * 256 + c) = pk_bf16(sigmoidf_(z0), sigmoidf_(z1)); *(unsigned*)(sg + (size_t)t * 256 + 128 + c) = 0u; }
        { const int c = lane * 8, gi = lane >> 4, w = 2 << gi; const int lo = max(pos - (w >> 1), 0), hi = min(pos + (w >> 1) - 1, L - 1);
          float sum[8];
#pragma unroll
          for (int j = 0; j < 8; ++j) sum[j] = 0.f;
          u32x4 wr_[16];
#pragma unroll
          for (int d = 0; d < 16; ++d) { const int r = pos - 8 + d; wr_[d] = (u32x4){0u, 0u, 0u, 0u}; if (r >= lo && r <= hi) wr_[d] = *(const u32x4*)(zall + (size_t)(tbase + r) * ZLD + c); }
#pragma unroll
          for (int d = 0; d < 16; ++d) { f32x4 a, b; unpack8(wr_[d], a, b);
#pragma unroll
              for (int j = 0; j < 4; ++j) { sum[j] += a[j]; sum[4 + j] += b[j]; } }
          const float icnt = 1.0f / (float)(hi - lo + 1); f32x4 a, b; unpack8(*(const u32x4*)(zr + c), a, b); f32x4 oa, ob;
#pragma unroll
          for (int j = 0; j < 4; ++j) { oa[j] = sum[j] * icnt - a[j]; ob[j] = sum[4 + j] * icnt - b[j]; }
          *(u32x4*)(pooled + (size_t)t * 512 + c) = pack8(oa, ob); }
    }
}

__device__ void final_phase(const Params& p) {
    const int tidx = opaque_tid(); const int lane = tidx & 63, wave = (blockIdx.x * 512 + tidx) >> 6, nw = (gridDim.x * 512) >> 6;
    const float* x2 = (const float*)(p.ws + OFF_X1); const float* rowsq2 = (const float*)(p.ws + OFF_ROWSQ2);
    f32x4 gv[4];
#pragma unroll
    for (int i = 0; i < 4; ++i) gv[i] = *(const f32x4*)(p.g_final + lane * 4 + 256 * i);
    for (int t0 = wave; t0 < T_TOK; t0 += 2 * nw) {
        const int t1 = t0 + nw < T_TOK ? t0 + nw : t0;
        const float r0 = rsqrtf(rowsq2[t0] * (1.0f / 1024.0f) + 1e-6f), r1 = rsqrtf(rowsq2[t1] * (1.0f / 1024.0f) + 1e-6f);
        f32x4 a[4], b[4];
#pragma unroll
        for (int i = 0; i < 4; ++i) { a[i] = *(const f32x4*)(x2 + (size_t)t0 * 1024 + lane * 4 + 256 * i); b[i] = *(const f32x4*)(x2 + (size_t)t1 * 1024 + lane * 4 + 256 * i); }
#pragma unroll
        for (int i = 0; i < 4; ++i) { *(f32x4*)(p.out + (size_t)t0 * 1024 + lane * 4 + 256 * i) = a[i] * r0 * gv[i]; *(f32x4*)(p.out + (size_t)t1 * 1024 + lane * 4 + 256 * i) = b[i] * r1 * gv[i]; }
    }
}

__global__ void __launch_bounds__(512, 2) fwd_megakernel(Params p) {
    extern __shared__ __attribute__((aligned(16))) unsigned char shm[];
    unsigned char* ws = p.ws;
    prep_phase(p, shm);
    cg::this_grid().sync();
    { EpiStore E; E.O = (bf16_t*)(ws + OFF_Z); E.ldc = ZLD; run_gemm(shm, (const bf16_t*)(ws + OFF_R1), 1024, (const bf16_t*)(ws + OFF_WIN), 1024, 3840, 1024, E); }
    cg::this_grid().sync();
    scan_phase(p, shm);
    cg::this_grid().sync();
    mix_phase(p);
    cg::this_grid().sync();
    rmsnorm_rows(p, p.g_mix, (bf16_t*)(ws + OFF_XN2));
    { EpiMulInPlace E; E.Y = (bf16_t*)p.out; run_gemm(shm, (const bf16_t*)(ws + OFF_SG), 256, (const bf16_t*)(ws + OFF_WG), 256, 1024, 256, E); }
    cg::this_grid().sync();
    { EpiGates E; E.G = (bf16_t*)(ws + OFF_GATES); E.bias = p.b_gate; run_gemm(shm, (const bf16_t*)(ws + OFF_XN2), 1024, (const bf16_t*)(ws + OFF_WIN) + (size_t)3840 * 1024, 1024, 2048, 1024, E); }
    cg::this_grid().sync();
    { EpiPool E; E.P = (bf16_t*)(ws + OFF_MERGED); E.G = (const bf16_t*)(ws + OFF_GATES); run_gemm(shm, (const bf16_t*)(ws + OFF_POOLED), 512, (const bf16_t*)(ws + OFF_WEFF), 512, 1024, 512, E); }
    { EpiMerge E; E.P = (bf16_t*)(ws + OFF_MERGED); E.G = (const bf16_t*)(ws + OFF_GATES); run_gemm(shm, (const bf16_t*)p.out, 1024, (const bf16_t*)(ws + OFF_WRBR), 1024, 1024, 1024, E); }
    cg::this_grid().sync();
    { EpiOut E; E.xp = p.x_prompt; E.xs = p.x_sample; E.X1 = (float*)(ws + OFF_X1); E.X1B = (bf16_t*)(ws + OFF_X1B); E.rowsq = (float*)(ws + OFF_ROWSQ); run_gemm(shm, (const bf16_t*)(ws + OFF_MERGED), 1024, (const bf16_t*)(ws + OFF_WOUT), 1024, 1024, 1024, E); }
    cg::this_grid().sync();
    { EpiFF1 E; E.Hlo = (bf16_t*)(ws + OFF_HLO); E.Hhi = (bf16_t*)p.out; E.rowsq = (const float*)(ws + OFF_ROWSQ); run_gemm(shm, (const bf16_t*)(ws + OFF_X1B), 1024, (const bf16_t*)(ws + OFF_WFF1), 1024, 4096, 1024, E); }
    cg::this_grid().sync();
    { EpiFinal E; E.X = (float*)(ws + OFF_X1); E.rowsq = (float*)(ws + OFF_ROWSQ2);
      run_gemm(shm, (const bf16_t*)(ws + OFF_HLO), 2048, (const bf16_t*)(ws + OFF_WFF2), 4096, 1024, 4096, E, (const bf16_t*)p.out, 32); }
    cg::this_grid().sync();
    final_phase(p);
}

extern "C" void kernel_launch(void* const* d_in, const int* in_sizes, int n_in, void* d_out, int out_size, void* d_ws, size_t ws_size, hipStream_t stream) {
    constexpr size_t kDynLds = 131072;
    static int grid_blocks = 0;
    if (!grid_blocks) {
        hipFuncSetAttribute((const void*)fwd_megakernel, hipFuncAttributeMaxDynamicSharedMemorySize, (int)kDynLds);
        int dev = 0, cus = 0, per_cu = 0;
        hipGetDevice(&dev);
        hipDeviceGetAttribute(&cus, hipDeviceAttributeMultiprocessorCount, dev);
        hipOccupancyMaxActiveBlocksPerMultiprocessor(&per_cu, fwd_megakernel, 512, kDynLds);
        if (per_cu < 1) per_cu = 1;
        grid_blocks = cus;
    }
    Params p{};
    const float** pf = (const float**)&p;
    for (int i = 0; i < 30; ++i) pf[i] = (const float*)d_in[i];
    p.out = (float*)d_out; p.ws = (unsigned char*)d_ws;
    void* args[] = {&p};
    hipError_t e = hipLaunchCooperativeKernel((const void*)fwd_megakernel, dim3(grid_blocks), dim3(512), args, kDynLds, stream);
    if (e != hipSuccess) fprintf(stderr, "cooperative launch failed: %s (grid %d)\n", hipGetErrorString(e), grid_blocks);
}
```

```cpp
#include <hip/hip_runtime.h>
#include <hip/hip_cooperative_groups.h>
#include <cstdio>
namespace cg = cooperative_groups;

#define LAS __attribute__((address_space(3)))
typedef unsigned short bf16_t;
typedef short bf16x8 __attribute__((ext_vector_type(8)));
typedef float f32x4 __attribute__((ext_vector_type(4)));
typedef float f32x2 __attribute__((ext_vector_type(2)));
typedef unsigned u32x4 __attribute__((ext_vector_type(4)));
typedef unsigned u32x2 __attribute__((ext_vector_type(2)));

constexpr int T_TOK = 98304, DM = 1024, TP = 65536;
constexpr int ZLD = 3840;
constexpr int COL_R = 512, COL_K = 1536, COL_V = 2560, COL_W = 3584, COL_A = 3648, COL_G = 3712;
constexpr size_t MiB = 1ull << 20;
constexpr size_t OFF_WIN = 0, OFF_WEFF = 12 * MiB, OFF_WRBR = 13 * MiB, OFF_WOUT = 15 * MiB, OFF_WFF1 = 17 * MiB, OFF_WFF2 = 25 * MiB, OFF_WG = 33 * MiB;
constexpr size_t OFF_ROWSQ = 34 * MiB, OFF_ROWSQ2 = 34 * MiB + 512 * 1024, OFF_QUEUE = 35 * MiB, OFF_BONUS = 36 * MiB;
constexpr size_t OFF_R1 = 48 * MiB, OFF_Z = 240 * MiB;
constexpr size_t OFF_POOLED = OFF_R1, OFF_SG = OFF_R1 + 96 * MiB, OFF_XN2 = OFF_Z, OFF_GATES = OFF_Z + 192 * MiB, OFF_MERGED = OFF_Z + 576 * MiB;
constexpr size_t OFF_X1B = OFF_R1, OFF_X1 = OFF_Z, OFF_HLO = OFF_Z + 384 * MiB;
constexpr size_t U_BYTES = (size_t)T_TOK * 1024 * 2;

struct Params {
    const float *x_prompt, *x_sample, *g_mix, *w_in, *b_gate, *mu_prev, *mu_next, *pool_w, *pool_scale, *w_pool_br, *k_k, *k_a, *r_k,
        *w0_f, *w_up_f, *a0_f, *a_up_f, *w0_b, *w_up_b, *a0_b, *a_up_b, *g_up, *ln_w, *ln_b, *w_rwkv_br, *w_out, *g_ffn, *w_ff1, *w_ff2, *g_final;
    float* out; unsigned char* ws;
};

__device__ __forceinline__ float bf_lo(unsigned w) { return __uint_as_float(w << 16); }
__device__ __forceinline__ float bf_hi(unsigned w) { return __uint_as_float(w & 0xFFFF0000u); }
typedef __bf16 bf16x2_t __attribute__((ext_vector_type(2)));
__device__ __forceinline__ unsigned pk_bf16(float lo, float hi) { f32x2 v = {lo, hi}; bf16x2_t b = __builtin_convertvector(v, bf16x2_t); return __builtin_bit_cast(unsigned, b); }
__device__ __forceinline__ float fexp2_scaled(float x, float scale_log2e) { return __builtin_amdgcn_exp2f(x * scale_log2e); }
__device__ __forceinline__ float sigmoidf_(float x) { return __builtin_amdgcn_rcpf(1.0f + fexp2_scaled(x, -1.4426950409f)); }
__device__ __forceinline__ float fma_s(float a, float b, float c) { float d; asm("v_fma_f32 %0, %1, %2, %3" : "=v"(d) : "v"(a), "v"(b), "v"(c)); return d; }
__device__ __forceinline__ float mul_s(float a, float b) { float d; asm("v_mul_f32 %0, %1, %2" : "=v"(d) : "v"(a), "v"(b)); return d; }
__device__ __forceinline__ float add_s(float a, float b) { float d; asm("v_add_f32 %0, %1, %2" : "=v"(d) : "v"(a), "v"(b)); return d; }
#define DPPA(x, c) "v_add_f32_dpp " x ", " x ", " x " " c " row_mask:0xf bank_mask:0xf bound_ctrl:1\n"
#define DPP4(c) DPPA("%0", c) DPPA("%1", c) DPPA("%2", c) DPPA("%3", c)
#define DPP2(c) DPPA("%0", c) DPPA("%1", c) "s_nop 0\n"
__device__ __forceinline__ void red16x4(float& a, float& b, float& c, float& d) {
    asm("s_nop 1\n" DPP4("quad_perm:[1,0,3,2]") DPP4("quad_perm:[2,3,0,1]") DPP4("row_half_mirror") DPP4("row_mirror") : "+v"(a), "+v"(b), "+v"(c), "+v"(d)); }
__device__ __forceinline__ void red16x2(float& a, float& b) {
    asm("s_nop 1\n" DPP2("quad_perm:[1,0,3,2]") DPP2("quad_perm:[2,3,0,1]") DPP2("row_half_mirror") DPP2("row_mirror") : "+v"(a), "+v"(b)); }
__device__ __forceinline__ void row_dots(const float (&s)[4], const f32x4 a, const f32x4 q, float& sa, float& yp) {
    asm("v_mul_f32 %0, %2, %6\n v_mul_f32 %1, %2, %10\n v_fmac_f32 %0, %3, %7\n v_fmac_f32 %1, %3, %11\n v_fmac_f32 %0, %4, %8\n v_fmac_f32 %1, %4, %12\n v_fmac_f32 %0, %5, %9\n v_fmac_f32 %1, %5, %13"
        : "=&v"(sa), "=&v"(yp) : "v"(s[0]), "v"(s[1]), "v"(s[2]), "v"(s[3]), "v"(a[0]), "v"(a[1]), "v"(a[2]), "v"(a[3]), "v"(q[0]), "v"(q[1]), "v"(q[2]), "v"(q[3])); }
__device__ __forceinline__ void row_update(float (&s)[4], const f32x4 w, const f32x4 b, const f32x4 k, float v, float sa, float yp, float bkx, float bky, float& y) {
    float t0, t1, t2, t3;
    asm("v_mul_f32 %0, %6, %15\n v_mul_f32 %1, %6, %16\n v_mul_f32 %2, %6, %17\n v_mul_f32 %3, %6, %18\n"
        "v_fmac_f32 %4, %7, %5\n"
        "v_fmac_f32 %0, %7, %11\n v_fmac_f32 %1, %7, %12\n v_fmac_f32 %2, %7, %13\n v_fmac_f32 %3, %7, %14\n"
        "v_fmac_f32 %4, %6, %8\n"
        "v_fmac_f32 %0, %9, %19\n v_fmac_f32 %1, %10, %20\n v_fmac_f32 %2, %23, %21\n v_fmac_f32 %3, %24, %22"
        : "=&v"(t0), "=&v"(t1), "=&v"(t2), "=&v"(t3), "+v"(yp)
        : "v"(bkx), "v"(v), "v"(sa), "v"(bky), "v"(s[0]), "v"(s[1]), "v"(b[0]), "v"(b[1]), "v"(b[2]), "v"(b[3]), "v"(k[0]), "v"(k[1]), "v"(k[2]), "v"(k[3]), "v"(w[0]), "v"(w[1]), "v"(w[2]), "v"(w[3]), "v"(s[2]), "v"(s[3]));
    s[0] = t0; s[1] = t1; s[2] = t2; s[3] = t3; y = yp; }
__device__ __forceinline__ void shift4(float (&z)[4], const float (&c)[4], const float (&pv)[4], const float (&nx)[4], const f32x4 m0, const f32x4 mp, const f32x4 mn) {
    asm("v_mul_f32 %0, %4, %16\n v_mul_f32 %1, %5, %17\n v_mul_f32 %2, %6, %18\n v_mul_f32 %3, %7, %19\n"
        "v_fma_f32 %0, %8, %20, %0\n v_fma_f32 %1, %9, %21, %1\n v_fma_f32 %2, %10, %22, %2\n v_fma_f32 %3, %11, %23, %3\n"
        "v_fma_f32 %0, %12, %24, %0\n v_fma_f32 %1, %13, %25, %1\n v_fma_f32 %2, %14, %26, %2\n v_fma_f32 %3, %15, %27, %3"
        : "=&v"(z[0]), "=&v"(z[1]), "=&v"(z[2]), "=&v"(z[3])
        : "v"(c[0]), "v"(c[1]), "v"(c[2]), "v"(c[3]), "v"(pv[0]), "v"(pv[1]), "v"(pv[2]), "v"(pv[3]), "v"(nx[0]), "v"(nx[1]), "v"(nx[2]), "v"(nx[3]),
          "v"(m0[0]), "v"(m0[1]), "v"(m0[2]), "v"(m0[3]), "v"(mp[0]), "v"(mp[1]), "v"(mp[2]), "v"(mp[3]), "v"(mn[0]), "v"(mn[1]), "v"(mn[2]), "v"(mn[3])); }
__device__ __forceinline__ void kk4(float (&kk)[4], float& ss, const float (&k)[4], const f32x4 c) {
    asm("v_mul_f32 %0, %5, %9\n v_mul_f32 %1, %6, %10\n v_mul_f32 %2, %7, %11\n v_mul_f32 %3, %8, %12\n"
        "v_mul_f32 %4, %0, %0\n v_fma_f32 %4, %1, %1, %4\n v_fma_f32 %4, %2, %2, %4\n v_fma_f32 %4, %3, %3, %4"
        : "=&v"(kk[0]), "=&v"(kk[1]), "=&v"(kk[2]), "=&v"(kk[3]), "=&v"(ss) : "v"(k[0]), "v"(k[1]), "v"(k[2]), "v"(k[3]), "v"(c[0]), "v"(c[1]), "v"(c[2]), "v"(c[3])); }
template <int CTRL> __device__ __forceinline__ float dppf(float x) { return __int_as_float(__builtin_amdgcn_update_dpp(0, __float_as_int(x), CTRL, 0xF, 0xF, true)); }
__device__ __forceinline__ float red4(float x) { x += dppf<0xB1>(x); x += dppf<0x4E>(x); return x; }
__device__ __forceinline__ float red8(float x) { x = red4(x); x += dppf<0x141>(x); return x; }
__device__ __forceinline__ float red16(float x) { x = red8(x); x += dppf<0x140>(x); return x; }
__device__ __forceinline__ int opaque_tid() { int t = threadIdx.x; asm volatile("" : "+v"(t)); return t; }
__device__ __forceinline__ const float* xrow(const Params& p, int t) { return t < TP ? p.x_prompt + (size_t)t * DM : p.x_sample + (size_t)(t - TP) * DM; }
__device__ __forceinline__ void seq_of(int t, int& base, int& len) { if (t < TP) { base = t & ~2047; len = 2048; } else { base = TP + ((t - TP) & ~16383); len = 16384; } }

namespace pg8 {
constexpr int BM = 256, BK = 64, HALF = 128, HTB = HALF * BK * 2, STAGE_BYTES = 8 * HTB, NXCD = 8, WGM = 8;
__device__ __forceinline__ int lds_byte(int r, int c) { const int st = (r >> 4) * 2 + (c >> 5), rr = r & 15, cc = c & 31, ob = rr * 64 + cc * 2; return st * 1024 + (ob ^ (((ob >> 9) & 1) << 5)); }
__device__ __forceinline__ void stage_rc(int b, int& R, int& C) { const int st = b / 1024, sb = b % 1024, swz = sb ^ (((sb >> 9) & 1) << 5); R = (st >> 1) * 16 + swz / 64; C = (st & 1) * 32 + (swz % 64) / 2; }
__device__ __forceinline__ int perm32(int rho) { const int n = rho >> 4, i = rho & 15; return 8 * (i >> 2) + 4 * n + (i & 3); }
struct Unit { int pm, pn; };
struct Gemm { const bf16_t* A; const bf16_t* Bt; int M, N, K, lda, ldb; const bf16_t* A2; int ks; };
struct StaticOrder {
    int nM, nN, nwg, G, c;
    __device__ void init(int M, int N, int G_, int c_) { nM = M / BM; nN = N / BM; nwg = nM * nN; G = G_; c = c_; }
    __device__ bool next(int i, Unit& u) const {
        const long L = (long)i * G + c; if (L >= nwg) return false;
        int wgid = (int)L; { const int q = nwg / NXCD, r = nwg % NXCD, xcd = wgid % NXCD, off = wgid / NXCD; wgid = (xcd < r ? xcd * (q + 1) : r * (q + 1) + (xcd - r) * q) + off; }
        const int nig = WGM * nN, gid = wgid / nig, fm = gid * WGM, gsz = (nM - fm) < WGM ? (nM - fm) : WGM;
        u.pm = fm + ((wgid % nig) % gsz); u.pn = (wgid % nig) / gsz; return true;
    }
};

template <class Epi>
__device__ __forceinline__ void gemm_phase(LAS unsigned char* lds, const Gemm g, const StaticOrder& S, const Epi& E) {
    const int tid = opaque_tid();
    const int wid = __builtin_amdgcn_readfirstlane(tid >> 6), lane = tid & 63, wr = wid >> 2, wc = wid & 3, fr = lane & 15, fq = lane >> 4;
    const int K = g.K, nt = K / BK;
    unsigned voffA[2], voffB[2];
#pragma unroll
    for (int i = 0; i < 2; ++i) { int R, C; stage_rc(tid * 16 + i * 8192, R, C); const int Rb = (R & ~31) + perm32(R & 31);
        voffA[i] = (unsigned)(R * g.lda + C) * 2u; voffB[i] = (unsigned)(Rb * g.ldb + C) * 2u; }
    const size_t kstep = (size_t)(BK * 2);
    const size_t hstepA = (size_t)HALF * g.lda * 2, hstepB = (size_t)HALF * g.ldb * 2;
    const size_t tstepA = 2 * hstepA, tstepB = 2 * hstepB;
    const unsigned ldsw = (unsigned)wid * 1024u;
    const int aoff = lds_byte(wr * 64 + fr, fq * 8), boff = lds_byte(wc * 32 + fr, fq * 8);
#define PG8_SA(b, h) (((b) * 2 + (h)) * HTB)
#define PG8_SB(b, h) ((4 + (b) * 2 + (h)) * HTB)
#define PG8_STAGE(bufoff, gbase, voff) do { _Pragma("unroll") for (int _i = 0; _i < 2; ++_i) \
        __builtin_amdgcn_global_load_lds((const unsigned*)((const char*)(gbase) + (voff)[_i]), (LAS unsigned*)(lds + (bufoff) + ldsw + _i * 8192), 16, 0, 0); } while (0)
#define PG8_LDA(dst, b, h) do { _Pragma("unroll") for (int m = 0; m < 4; ++m) _Pragma("unroll") for (int k = 0; k < 2; ++k) dst[m][k] = *(const LAS bf16x8*)(lds + PG8_SA(b, h) + aoff + m * 2048 + k * 1024); } while (0)
#define PG8_LDB(dst, b, h) do { _Pragma("unroll") for (int n = 0; n < 2; ++n) _Pragma("unroll") for (int k = 0; k < 2; ++k) dst[n][k] = *(const LAS bf16x8*)(lds + PG8_SB(b, h) + boff + n * 2048 + k * 1024); } while (0)
#define PG8_MMA(ai, bj, At, Bt) do { __builtin_amdgcn_s_setprio(1); _Pragma("unroll") for (int m = 0; m < 4; ++m) _Pragma("unroll") for (int n = 0; n < 2; ++n) _Pragma("unroll") for (int k = 0; k < 2; ++k) \
        acc[ai][bj][m][n] = __builtin_amdgcn_mfma_f32_16x16x32_bf16(Bt[n][k], At[m][k], acc[ai][bj][m][n], 0, 0, 0); __builtin_amdgcn_s_setprio(0); } while (0)
#define PG8_WAIT_V(n) asm volatile("s_waitcnt vmcnt(" #n ")" ::: "memory")
#define PG8_WAIT_L(n) asm volatile("s_waitcnt lgkmcnt(" #n ")" ::: "memory")
#define PG8_BAR __builtin_amdgcn_s_barrier()
#define PG8_SCHED __builtin_amdgcn_sched_barrier(0)
    Unit cur, nxt; int ui = 0;
    if (!S.next(0, cur)) return;
    f32x4 acc[2][2][4][2];
#pragma unroll
    for (int a = 0; a < 2; ++a)
#pragma unroll
        for (int b = 0; b < 2; ++b)
#pragma unroll
            for (int m = 0; m < 4; ++m)
#pragma unroll
                for (int n = 0; n < 2; ++n) acc[a][b][m][n] = (f32x4){0.f, 0.f, 0.f, 0.f};
    bf16x8 At[4][2], B0[2][2], B1[2][2];
    const char* cA = (const char*)g.A + (size_t)cur.pm * tstepA; const char* cB = (const char*)g.Bt + (size_t)cur.pn * tstepB;
    const bool two = g.A2 != nullptr; const int ks = two ? g.ks : (1 << 30);
    const char* cA2 = two ? (const char*)g.A2 + (size_t)cur.pm * tstepA : cA;
    PG8_STAGE(PG8_SB(0, 0), cB, voffB); PG8_STAGE(PG8_SA(0, 0), cA, voffA); PG8_STAGE(PG8_SB(0, 1), cB + hstepB, voffB); PG8_STAGE(PG8_SA(0, 1), cA + hstepA, voffA);
    if (wr == 1) PG8_BAR;
    PG8_WAIT_V(4); PG8_BAR;
    PG8_STAGE(PG8_SB(1, 0), cB + kstep, voffB); PG8_STAGE(PG8_SA(1, 0), cA + kstep, voffA); PG8_STAGE(PG8_SB(1, 1), cB + hstepB + kstep, voffB);
    PG8_WAIT_V(6); PG8_BAR;
    for (;;) {
        const bool has_next = S.next(ui + 1, nxt);
        const char* nA = has_next ? (const char*)g.A + (size_t)nxt.pm * tstepA : cA; const char* nB = has_next ? (const char*)g.Bt + (size_t)nxt.pn * tstepB : cB;
        const char* nA2 = (two && has_next) ? (const char*)g.A2 + (size_t)nxt.pm * tstepA : cA2;
#pragma unroll 1
        for (int t = 0; t < nt; t += 2) {
            const bool last = (t == nt - 2);
            const char* a1 = (t + 1 < ks) ? cA + (size_t)(t + 1) * kstep : cA2 + (size_t)(t + 1 - ks) * kstep;
            const char* a2 = last ? nA : ((t + 2 < ks) ? cA + (size_t)(t + 2) * kstep : cA2 + (size_t)(t + 2 - ks) * kstep); const char* b2 = last ? nB : cB + (size_t)(t + 2) * kstep;
            const char* a3 = a2 + kstep; const char* b3 = b2 + kstep;
            PG8_LDB(B0, 0, 0); PG8_SCHED; PG8_LDA(At, 0, 0); PG8_STAGE(PG8_SA(1, 1), a1 + hstepA, voffA);
            PG8_WAIT_L(8); PG8_BAR; PG8_WAIT_L(0); PG8_MMA(0, 0, At, B0); PG8_BAR; PG8_SCHED;
            PG8_LDB(B1, 0, 1); PG8_STAGE(PG8_SB(0, 0), b2, voffB);
            PG8_BAR; PG8_WAIT_L(0); PG8_MMA(0, 1, At, B1); PG8_BAR;
            PG8_LDA(At, 0, 1); PG8_STAGE(PG8_SA(0, 0), a2, voffA);
            PG8_BAR; PG8_WAIT_L(0); PG8_MMA(1, 0, At, B0); PG8_BAR; PG8_SCHED;
            PG8_STAGE(PG8_SB(0, 1), b2 + hstepB, voffB);
            PG8_WAIT_V(6); PG8_BAR; PG8_MMA(1, 1, At, B1); PG8_BAR;
            PG8_LDB(B0, 1, 0); PG8_SCHED; PG8_LDA(At, 1, 0); PG8_STAGE(PG8_SA(0, 1), a2 + hstepA, voffA);
            PG8_WAIT_L(8); PG8_BAR; PG8_WAIT_L(0); PG8_MMA(0, 0, At, B0); PG8_BAR; PG8_SCHED;
            PG8_LDB(B1, 1, 1); PG8_STAGE(PG8_SB(1, 0), b3, voffB);
            PG8_BAR; PG8_WAIT_L(0); PG8_MMA(0, 1, At, B1); PG8_BAR;
            PG8_LDA(At, 1, 1); PG8_STAGE(PG8_SA(1, 0), a3, voffA);
            PG8_BAR; PG8_WAIT_L(0); PG8_MMA(1, 0, At, B0); PG8_BAR; PG8_SCHED;
            PG8_STAGE(PG8_SB(1, 1), b3 + hstepB, voffB);
            PG8_WAIT_V(6); PG8_BAR; PG8_MMA(1, 1, At, B1); PG8_BAR;
        }
        E(acc, cur, wr, wc, fr, fq);
        if (!has_next) break;
#pragma unroll
        for (int a = 0; a < 2; ++a)
#pragma unroll
            for (int b = 0; b < 2; ++b)
#pragma unroll
                for (int m = 0; m < 4; ++m)
#pragma unroll
                    for (int n = 0; n < 2; ++n) acc[a][b][m][n] = (f32x4){0.f, 0.f, 0.f, 0.f};
        cur = nxt; cA = nA; cA2 = nA2; cB = nB; ++ui;
    }
    PG8_WAIT_V(0);
    if (wr == 0) PG8_BAR;
    PG8_BAR;
#undef PG8_SA
#undef PG8_SB
#undef PG8_STAGE
#undef PG8_LDA
#undef PG8_LDB
#undef PG8_MMA
#undef PG8_WAIT_V
#undef PG8_WAIT_L
#undef PG8_BAR
#undef PG8_SCHED
}
}
using pg8::Unit;

#define EPI_LOOP_BEGIN const int row0 = u.pm * 256 + wr * 64 + fr, col0 = u.pn * 256 + wc * 32 + 8 * fq; \
    _Pragma("unroll") for (int ai = 0; ai < 2; ++ai) _Pragma("unroll") for (int m = 0; m < 4; ++m) { const int row = row0 + ai * 128 + m * 16;
#define EPI_BJ _Pragma("unroll") for (int bj = 0; bj < 2; ++bj) { const int col = col0 + bj * 128; const f32x4 v0 = acc[ai][bj][m][0], v1 = acc[ai][bj][m][1];
#define EPI_ACC const f32x4 (&acc)[2][2][4][2], const Unit& u, int wr, int wc, int fr, int fq

__device__ __forceinline__ u32x4 pack8(const f32x4 a, const f32x4 b) { u32x4 w; w.x = pk_bf16(a[0], a[1]); w.y = pk_bf16(a[2], a[3]); w.z = pk_bf16(b[0], b[1]); w.w = pk_bf16(b[2], b[3]); return w; }
__device__ __forceinline__ void unpack8(const u32x4 w, f32x4& a, f32x4& b) { a = (f32x4){bf_lo(w.x), bf_hi(w.x), bf_lo(w.y), bf_hi(w.y)}; b = (f32x4){bf_lo(w.z), bf_hi(w.z), bf_lo(w.w), bf_hi(w.w)}; }

struct EpiStore {
    bf16_t* O; int ldc;
    __device__ __forceinline__ void operator()(EPI_ACC) const { EPI_LOOP_BEGIN EPI_BJ *(u32x4*)(O + (size_t)row * ldc + col) = pack8(v0, v1); } } }
};
struct EpiMulInPlace {
    bf16_t* Y;
    __device__ __forceinline__ void operator()(EPI_ACC) const { EPI_LOOP_BEGIN if ((m & 1) == 0) __builtin_amdgcn_sched_barrier(0);
        EPI_BJ u32x4* ptr = (u32x4*)(Y + (size_t)row * 1024 + col); f32x4 a, b; unpack8(*ptr, a, b); *ptr = pack8(a * v0, b * v1); } } }
};
struct EpiGates {
    bf16_t* G; const float* bias;
    __device__ __forceinline__ void operator()(EPI_ACC) const { EPI_LOOP_BEGIN EPI_BJ
        const f32x4 b0 = *(const f32x4*)(bias + col), b1 = *(const f32x4*)(bias + col + 4); f32x4 a, b;
#pragma unroll
        for (int j = 0; j < 4; ++j) { a[j] = sigmoidf_(v0[j] + b0[j]); b[j] = sigmoidf_(v1[j] + b1[j]); }
        *(u32x4*)(G + (size_t)row * 2048 + col) = pack8(a, b); } } }
};
struct EpiPool {
    bf16_t* P; const bf16_t* G;
    __device__ __forceinline__ void operator()(EPI_ACC) const { EPI_LOOP_BEGIN EPI_BJ f32x4 a, b; unpack8(*(const u32x4*)(G + (size_t)row * 2048 + col), a, b);
        *(u32x4*)(P + (size_t)row * 1024 + col) = pack8(a * v0, b * v1); } } }
};
struct EpiMerge {
    bf16_t* P; const bf16_t* G;
    __device__ __forceinline__ void operator()(EPI_ACC) const { EPI_LOOP_BEGIN EPI_BJ f32x4 a, b, pa, pb; unpack8(*(const u32x4*)(G + (size_t)row * 2048 + 1024 + col), a, b);
        u32x4* ptr = (u32x4*)(P + (size_t)row * 1024 + col); unpack8(*ptr, pa, pb); *ptr = pack8(pa + a * v0, pb + b * v1); } } }
};
struct EpiOut {
    const float* xp; const float* xs; float* X1; bf16_t* X1B; float* rowsq;
    __device__ __forceinline__ void operator()(EPI_ACC) const { EPI_LOOP_BEGIN const float* xr = row < TP ? xp + (size_t)row * DM : xs + (size_t)(row - TP) * DM; float ss = 0.f; EPI_BJ
        f32x4 a = *(const f32x4*)(xr + col) + v0, b = *(const f32x4*)(xr + col + 4) + v1;
        *(f32x4*)(X1 + (size_t)row * 1024 + col) = a; *(f32x4*)(X1 + (size_t)row * 1024 + col + 4) = b; *(u32x4*)(X1B + (size_t)row * 1024 + col) = pack8(a, b);
#pragma unroll
        for (int j = 0; j < 4; ++j) ss += a[j] * a[j] + b[j] * b[j]; }
        ss += __shfl_xor(ss, 16); ss += __shfl_xor(ss, 32); if (fq == 0) atomicAdd(rowsq + row, ss); } }
};
struct EpiFF1 {
    bf16_t* Hlo; bf16_t* Hhi; const float* rowsq;
    __device__ __forceinline__ void operator()(EPI_ACC) const { bf16_t* H = u.pn < 8 ? Hlo : Hhi; const int cshift = u.pn < 8 ? 0 : 2048;
        EPI_LOOP_BEGIN const float rinv = rsqrtf(rowsq[row] * (1.0f / 1024.0f) + 1e-6f); EPI_BJ f32x4 a, b;
#pragma unroll
        for (int j = 0; j < 4; ++j) { float t0 = fmaxf(v0[j] * rinv, 0.f), t1 = fmaxf(v1[j] * rinv, 0.f); a[j] = t0 * t0; b[j] = t1 * t1; }
        *(u32x4*)(H + (size_t)row * 2048 + (col - cshift)) = pack8(a, b); } } }
};
struct EpiAddInPlace {
    float* X;
    __device__ __forceinline__ void operator()(EPI_ACC) const { EPI_LOOP_BEGIN EPI_BJ f32x4* ptr = (f32x4*)(X + (size_t)row * 1024 + col); ptr[0] = ptr[0] + v0; ptr[1] = ptr[1] + v1; } } }
};
struct EpiFinal {
    float* X; float* rowsq;
    __device__ __forceinline__ void operator()(EPI_ACC) const { EPI_LOOP_BEGIN float ss = 0.f; EPI_BJ f32x4* ptr = (f32x4*)(X + (size_t)row * 1024 + col); const f32x4 a = ptr[0] + v0, b = ptr[1] + v1; ptr[0] = a; ptr[1] = b;
#pragma unroll
        for (int j = 0; j < 4; ++j) ss += a[j] * a[j] + b[j] * b[j]; }
        ss += __shfl_xor(ss, 16); ss += __shfl_xor(ss, 32); if (fq == 0) atomicAdd(rowsq + row, ss); } }
};

template <class Epi>
__device__ __forceinline__ void run_gemm(unsigned char* shm, const bf16_t* A, int lda, const bf16_t* Bt, int ldb, int N, int K, const Epi& E, const bf16_t* A2 = nullptr, int ks = 0) {
    pg8::Gemm g; g.A = A; g.Bt = Bt; g.M = T_TOK; g.N = N; g.K = K; g.lda = lda; g.ldb = ldb; g.A2 = A2; g.ks = ks;
    pg8::StaticOrder S; S.init(T_TOK, N, (int)gridDim.x, (int)blockIdx.x);
    pg8::gemm_phase<Epi>((LAS unsigned char*)shm, g, S, E);
}

__device__ __forceinline__ void transpose_tile(float* tile, int tid, const float* src, int N, bf16_t* dst, int ldd, const float* kscale, int t) {
    const int ntn = N / 64, tk = t / ntn, tn = t % ntn;
#pragma unroll
    for (int i = 0; i < 8; ++i) { const int kl = (tid >> 6) + 8 * i, nl = tid & 63; const int k = tk * 64 + kl;
        tile[kl * 65 + nl] = src[(size_t)k * N + tn * 64 + nl] * (kscale ? kscale[k] : 1.0f); }
    __syncthreads();
#pragma unroll
    for (int i = 0; i < 8; ++i) { const int nl = (tid >> 6) + 8 * i, kl = tid & 63;
        const unsigned w = pk_bf16(tile[kl * 65 + nl], 0.f); dst[(size_t)(tn * 64 + nl) * ldd + tk * 64 + kl] = (bf16_t)(w & 0xFFFFu); }
    __syncthreads();
}
__device__ void transpose_cvt(unsigned char* shm, const float* src, int K, int N, bf16_t* dst, int ldd, const float* kscale) {
    float* tile = (float*)shm;
    const int tid = opaque_tid(), ntk = K / 64, ntn = N / 64;
    for (int t = blockIdx.x; t < ntk * ntn; t += gridDim.x) transpose_tile(tile, tid, src, N, dst, ldd, kscale, t);
}
constexpr int DU_RBR = 256, DU_OUT = 512, DU_FF1 = 1536, DU_FF2 = 2560, DU_G = 2592, DU_GZ = 2624, N_DEFER = 2624 + 256;
__device__ void deferred_unit(const Params& p, unsigned char* shm, int tid, int u) {
    unsigned char* ws = p.ws; float* tile = (float*)shm;
    if (u < DU_RBR) transpose_tile(tile, tid, p.w_rwkv_br, 1024, (bf16_t*)(ws + OFF_WRBR), 1024, nullptr, u);
    else if (u < DU_OUT) transpose_tile(tile, tid, p.w_out, 1024, (bf16_t*)(ws + OFF_WOUT), 1024, nullptr, u - DU_RBR);
    else if (u < DU_FF1) transpose_tile(tile, tid, p.w_ff1, 4096, (bf16_t*)(ws + OFF_WFF1), 1024, p.g_ffn, u - DU_OUT);
    else if (u < DU_FF2) transpose_tile(tile, tid, p.w_ff2, 1024, (bf16_t*)(ws + OFF_WFF2), 4096, nullptr, u - DU_FF1);
    else if (u < DU_G) transpose_tile(tile, tid, p.g_up, 1024, (bf16_t*)(ws + OFF_WG), 256, nullptr, u - DU_FF2);
    else if (u < DU_GZ) { bf16_t* wg = (bf16_t*)(ws + OFF_WG);
#pragma unroll
        for (int m = 0; m < 8; ++m) { const int i = (u - DU_G) * 4096 + m * 512 + tid; wg[(size_t)(i >> 7) * 256 + 128 + (i & 127)] = 0; } }
    else {
        bf16_t* we = (bf16_t*)(ws + OFF_WEFF); const int base = (u - DU_GZ) * 2048; float acc[4] = {0.f, 0.f, 0.f, 0.f};
        const int gI = (base >> 10) >> 7;
        for (int d = 0; d < 128; ++d) { const float sc = p.pool_scale[gI * 128 + d];
#pragma unroll
            for (int m = 0; m < 4; ++m) { const int i = base + m * 512 + tid, k = i >> 10, n = i & 1023;
                acc[m] += p.pool_w[(size_t)k * 128 + d] * sc * p.w_pool_br[(size_t)(gI * 128 + d) * 1024 + n]; } }
#pragma unroll
        for (int m = 0; m < 4; ++m) { const int i = base + m * 512 + tid, k = i >> 10, n = i & 1023; we[(size_t)n * 512 + k] = (bf16_t)(pk_bf16(acc[m], 0.f) & 0xFFFFu); } }
}
__device__ void rmsnorm_rows(const Params& p, const float* g, bf16_t* dst) {
    const int tidx = opaque_tid(); const int lane = tidx & 63, wave = (blockIdx.x * 512 + tidx) >> 6, nw = (gridDim.x * 512) >> 6;
    f32x4 gv[4];
#pragma unroll
    for (int i = 0; i < 4; ++i) gv[i] = *(const f32x4*)(g + lane * 4 + 256 * i);
    for (int t0 = wave; t0 < T_TOK; t0 += 2 * nw) {
        const int t1 = t0 + nw; const bool has1 = t1 < T_TOK;
        const float* xr0 = xrow(p, t0); const float* xr1 = xrow(p, has1 ? t1 : t0); f32x4 v0[4], v1[4]; float ss0 = 0.f, ss1 = 0.f;
#pragma unroll
        for (int i = 0; i < 4; ++i) { v0[i] = *(const f32x4*)(xr0 + lane * 4 + 256 * i); v1[i] = *(const f32x4*)(xr1 + lane * 4 + 256 * i); }
#pragma unroll
        for (int i = 0; i < 4; ++i) { ss0 += v0[i][0] * v0[i][0] + v0[i][1] * v0[i][1] + v0[i][2] * v0[i][2] + v0[i][3] * v0[i][3]; ss1 += v1[i][0] * v1[i][0] + v1[i][1] * v1[i][1] + v1[i][2] * v1[i][2] + v1[i][3] * v1[i][3]; }
#pragma unroll
        for (int o = 1; o < 64; o <<= 1) { ss0 += __shfl_xor(ss0, o); ss1 += __shfl_xor(ss1, o); }
        const float r0 = rsqrtf(ss0 * (1.0f / 1024.0f) + 1e-6f), r1 = rsqrtf(ss1 * (1.0f / 1024.0f) + 1e-6f);
#pragma unroll
        for (int i = 0; i < 4; ++i) { u32x2 w; w.x = pk_bf16(v0[i][0] * r0 * gv[i][0], v0[i][1] * r0 * gv[i][1]); w.y = pk_bf16(v0[i][2] * r0 * gv[i][2], v0[i][3] * r0 * gv[i][3]);
            *(u32x2*)(dst + (size_t)t0 * 1024 + lane * 4 + 256 * i) = w; }
        if (has1) {
#pragma unroll
            for (int i = 0; i < 4; ++i) { u32x2 w; w.x = pk_bf16(v1[i][0] * r1 * gv[i][0], v1[i][1] * r1 * gv[i][1]); w.y = pk_bf16(v1[i][2] * r1 * gv[i][2], v1[i][3] * r1 * gv[i][3]);
                *(u32x2*)(dst + (size_t)t1 * 1024 + lane * 4 + 256 * i) = w; } }
    }
}

__device__ void prep_phase(const Params& p, unsigned char* shm) {
    unsigned char* ws = p.ws;
    const int gtid = blockIdx.x * 512 + opaque_tid(), gn = gridDim.x * 512;
    for (int i = gtid; i < T_TOK; i += gn) { ((float*)(ws + OFF_ROWSQ))[i] = 0.f; ((float*)(ws + OFF_ROWSQ2))[i] = 0.f; }
    if (gtid < 64) ((unsigned*)(ws + OFF_QUEUE))[gtid] = 0u;
    transpose_cvt(shm, p.w_in, 1024, 5888, (bf16_t*)(ws + OFF_WIN), 1024, nullptr);
    rmsnorm_rows(p, p.g_mix, (bf16_t*)(ws + OFF_R1));
}

#define LDS_BAR() do { asm volatile("s_waitcnt lgkmcnt(0)" ::: "memory"); __builtin_amdgcn_s_barrier(); asm volatile("" ::: "memory"); } while (0)
constexpr int N_SAMPLE_ITEMS = 128, N_ITEMS = N_SAMPLE_ITEMS + 1024;

template <int LPR, int RPL, int DIR>
__device__ __forceinline__ void scan_item(const Params& p, unsigned char* shm, const int tid, const int tbase, const int L, const int h, const int half) {
    constexpr int dir = DIR;
    constexpr int EC = 64 / LPR, RPW = RPL * (64 / LPR);
    float* sW = (float*)shm; float* sAV = sW + 2048; float* sBV = sW + 4096; float* sKD = sW + 6144; float* sWR = sW + 8192; float* sR = sW + 10240; float* sV = sW + 12288; float* sY = sW + 14336;
    float* sBK = sW + 16384;
    bf16_t* sTW = (bf16_t*)(sW + 16384 + 64);
    bf16_t* sZA = sTW + 32 * 72;
    const int lane = tid & 63, wv = tid >> 6;
    const bf16_t* zall = (const bf16_t*)(p.ws + OFF_Z);
    const int tokA = tid >> 4, q = tid & 15;
    const int rowS = half * 32 + wv * RPW + RPL * (lane / LPR), gS = lane % LPR;
    const int NC = L / 32;
    bf16_t* ybuf = (bf16_t*)p.out + (dir ? (size_t)T_TOK * 1024 : 0);
    float* bonus = (float*)(p.ws + OFF_BONUS) + (dir ? (size_t)T_TOK * 16 : 0);
    const float* w_up = dir ? p.w_up_b : p.w_up_f; const float* a_up = dir ? p.a_up_b : p.a_up_f;
    const float* w0 = dir ? p.w0_b : p.w0_f; const float* a0 = dir ? p.a0_b : p.a0_f;
    const int mat = wv >> 2, cbk = wv & 3, colB = cbk * 16 + (lane & 15), quad = lane >> 4;
    u32x4* sBF = (u32x4*)(shm + 84 * 1024);
    { const float* up = mat ? a_up : w_up;
#pragma unroll
      for (int kb = 0; kb < 2; ++kb) { float f[8];
#pragma unroll
          for (int j = 0; j < 8; ++j) f[j] = up[(size_t)(kb * 32 + quad * 8 + j) * 1024 + h * 64 + colB];
          u32x4 w; w.x = pk_bf16(f[0], f[1]); w.y = pk_bf16(f[2], f[3]); w.z = pk_bf16(f[4], f[5]); w.w = pk_bf16(f[6], f[7]); sBF[kb * 512 + tid] = w; } }
    const float c0B = (mat ? a0 : w0)[h * 64 + colB];
    const float kaB = p.k_a[h * 64 + colB];
    int colz[5];
    float* sM0 = (float*)(shm + 100 * 1024);
    float* sMU = (float*)(shm + 76 * 1024);
#pragma unroll
    for (int gi = 0; gi < 5; ++gi) colz[gi] = (gi == 0 ? COL_R + h * 64 : gi == 1 ? COL_K + h * 64 : gi == 2 ? COL_V + h * 64 : gi == 3 ? COL_W : COL_A) + 4 * q;
    if (tid < 320) { const int gi = tid >> 6, c = tid & 63; const int col = (gi == 0 ? COL_R + h * 64 : gi == 1 ? COL_K + h * 64 : gi == 2 ? COL_V + h * 64 : gi == 3 ? COL_W : COL_A) + c - COL_R;
        const float mpv_ = p.mu_prev[col], mnv_ = p.mu_next[col]; sMU[gi * 64 + c] = mpv_; sMU[320 + gi * 64 + c] = mnv_; sM0[gi * 64 + c] = 1.0f - mpv_ - mnv_; }
    else if (tid < 384) sMU[640 + (tid - 320)] = p.k_k[h * 64 + (tid - 320)];
    else if (tid < 448) sMU[704 + (tid - 384)] = p.r_k[h * 64 + (tid - 384)];
    __syncthreads();
    float s[RPL][EC];
#pragma unroll
    for (int r = 0; r < RPL; ++r)
#pragma unroll
        for (int j = 0; j < EC; ++j) s[r][j] = 0.f;
    u32x2 zc[5], zp[5], zn[5];
    auto load_chunk = [&](int ci) {
        const int t = tbase + 32 * (dir ? NC - 1 - ci : ci) + tokA; const bool hasPrev = t > tbase, hasNext = t < tbase + L - 1;
        const bf16_t* zr = zall + (size_t)t * ZLD;
#pragma unroll
        for (int gi = 0; gi < 5; ++gi) { zc[gi] = *(const u32x2*)(zr + colz[gi]); zp[gi] = (u32x2){0u, 0u}; zn[gi] = (u32x2){0u, 0u};
            if (hasPrev) zp[gi] = *(const u32x2*)(zr - ZLD + colz[gi]);
            if (hasNext) zn[gi] = *(const u32x2*)(zr + ZLD + colz[gi]); }
    };
    load_chunk(0);
    for (int ci = 0; ci < NC; ++ci) {
        const int t0 = tbase + 32 * (dir ? NC - 1 - ci : ci);
        { float zs[5][4];
          f32x4 MP[5], MN[5], M0[5];
#pragma unroll
          for (int gi = 0; gi < 5; ++gi) { MP[gi] = *(const f32x4*)(sMU + gi * 64 + 4 * q); MN[gi] = *(const f32x4*)(sMU + 320 + gi * 64 + 4 * q); M0[gi] = *(const f32x4*)(sM0 + gi * 64 + 4 * q); }
          const f32x4 kk4c = *(const f32x4*)(sMU + 640 + 4 * q);
#pragma unroll
          for (int gi = 0; gi < 5; ++gi) {
              const float c[4] = {bf_lo(zc[gi].x), bf_hi(zc[gi].x), bf_lo(zc[gi].y), bf_hi(zc[gi].y)}, pv[4] = {bf_lo(zp[gi].x), bf_hi(zp[gi].x), bf_lo(zp[gi].y), bf_hi(zp[gi].y)}, nx[4] = {bf_lo(zn[gi].x), bf_hi(zn[gi].x), bf_lo(zn[gi].y), bf_hi(zn[gi].y)};
              shift4(zs[gi], c, pv, nx, M0[gi], MP[gi], MN[gi]);
          }
          if (ci + 1 < NC) load_chunk(ci + 1);
          *(f32x4*)(sR + tokA * 64 + 4 * q) = (f32x4){zs[0][0], zs[0][1], zs[0][2], zs[0][3]};
          *(f32x4*)(sKD + tokA * 64 + 4 * q) = (f32x4){zs[1][0], zs[1][1], zs[1][2], zs[1][3]};
          *(f32x4*)(sV + tokA * 64 + 4 * q) = (f32x4){zs[2][0], zs[2][1], zs[2][2], zs[2][3]};
          float kk[4], ss;
          kk4(kk, ss, zs[1], kk4c);
          ss = ss + 0.0f * kk[0];
          ss = red16(ss);
          const float inv = -__builtin_amdgcn_rsqf(fmaxf(ss, 1e-24f));
          *(f32x4*)(sAV + tokA * 64 + 4 * q) = (f32x4){kk[0] * inv, kk[1] * inv, kk[2] * inv, kk[3] * inv};
          float tw[4];
#pragma unroll
          for (int j = 0; j < 4; ++j) tw[j] = 1.0f - 2.0f * __builtin_amdgcn_rcpf(1.0f + fexp2_scaled(zs[3][j], 2.8853900818f));
          u32x2 w; w.x = pk_bf16(tw[0], tw[1]); w.y = pk_bf16(tw[2], tw[3]); *(u32x2*)(sTW + tokA * 72 + 4 * q) = w;
          w.x = pk_bf16(zs[4][0], zs[4][1]); w.y = pk_bf16(zs[4][2], zs[4][3]); *(u32x2*)(sZA + tokA * 72 + 4 * q) = w;
        }
        LDS_BAR();
        { const int matu = __builtin_amdgcn_readfirstlane(mat);
          const bf16_t* sX = matu ? sZA : sTW;
          const bf16x8 b0 = __builtin_bit_cast(bf16x8, sBF[tid]), b1 = __builtin_bit_cast(bf16x8, sBF[512 + tid]);
          const bf16_t* ap = sX + (lane & 15) * 72 + quad * 8;
          const bf16x8 a00 = *(const bf16x8*)(ap), a01 = *(const bf16x8*)(ap + 32), a10 = *(const bf16x8*)(ap + 16 * 72), a11 = *(const bf16x8*)(ap + 16 * 72 + 32);
          const int idx0 = (quad * 4) * 64 + colB;
          float o1[8], o2[8];
          if (matu == 0) {
#pragma unroll
              for (int i = 0; i < 8; ++i) o1[i] = sR[idx0 + ((i >> 2) * 16 + (i & 3)) * 64];
          } else {
#pragma unroll
              for (int i = 0; i < 8; ++i) { o1[i] = sKD[idx0 + ((i >> 2) * 16 + (i & 3)) * 64]; o2[i] = sAV[idx0 + ((i >> 2) * 16 + (i & 3)) * 64]; }
          }
          f32x4 acc0 = (f32x4){c0B, c0B, c0B, c0B}, acc1 = acc0;
          acc0 = __builtin_amdgcn_mfma_f32_16x16x32_bf16(a00, b0, acc0, 0, 0, 0); acc1 = __builtin_amdgcn_mfma_f32_16x16x32_bf16(a10, b0, acc1, 0, 0, 0);
          acc0 = __builtin_amdgcn_mfma_f32_16x16x32_bf16(a01, b1, acc0, 0, 0, 0); acc1 = __builtin_amdgcn_mfma_f32_16x16x32_bf16(a11, b1, acc1, 0, 0, 0);
          float sg[8];
#pragma unroll
          for (int i = 0; i < 8; ++i) sg[i] = sigmoidf_(i < 4 ? acc0[i & 3] : acc1[i & 3]);
          if (matu == 0) {
              float wv_[8];
#pragma unroll
              for (int i = 0; i < 8; ++i) wv_[i] = fexp2_scaled(sg[i], -0.6065306597f * 1.4426950409f);
#pragma unroll
              for (int i = 0; i < 8; ++i) { const int idx = idx0 + ((i >> 2) * 16 + (i & 3)) * 64; sW[idx] = wv_[i]; sWR[idx] = wv_[i] * o1[i]; }
          } else {
#pragma unroll
              for (int i = 0; i < 8; ++i) { const int idx = idx0 + ((i >> 2) * 16 + (i & 3)) * 64; sKD[idx] = o1[i] * (1.0f + (sg[i] - 1.0f) * kaB); sBV[idx] = -o2[i] * sg[i]; }
          } }
        LDS_BAR();
        { const f32x4 r4 = *(const f32x4*)(sR + tokA * 64 + 4 * q), b4 = *(const f32x4*)(sBV + tokA * 64 + 4 * q), k4 = *(const f32x4*)(sKD + tokA * 64 + 4 * q);
          float br = 0.f, kr = 0.f, cb = 0.f; const f32x4 rk4 = *(const f32x4*)(sMU + 704 + 4 * q);
#pragma unroll
          for (int j = 0; j < 4; ++j) { br += b4[j] * r4[j]; kr += k4[j] * r4[j]; cb += r4[j] * k4[j] * rk4[j]; }
          br = red16(br); kr = red16(kr); cb = red16(cb);
          if (q == 0) { sBK[tokA * 2] = br; sBK[tokA * 2 + 1] = kr; if (half == 0) bonus[(size_t)(t0 + tokA) * 16 + h] = cb; } }
        LDS_BAR();
        {
            constexpr int NV = EC / 4;
            struct Ops { f32x4 w[NV], a[NV], b[NV], k[NV], q[NV]; float v[RPL]; f32x2 bk; };
            auto ld = [&](Ops& o, int i) { const int tk = DIR ? 31 - i : i; const int off = tk * 64 + 4 * gS;
#pragma unroll
                for (int c = 0; c < NV; ++c) { o.w[c] = *(const f32x4*)(sW + off + 32 * c); o.a[c] = *(const f32x4*)(sAV + off + 32 * c); o.b[c] = *(const f32x4*)(sBV + off + 32 * c);
                    o.k[c] = *(const f32x4*)(sKD + off + 32 * c); o.q[c] = *(const f32x4*)(sWR + off + 32 * c); }
                if constexpr (RPL == 2) { const f32x2 v2 = *(const f32x2*)(sV + tk * 64 + rowS); o.v[0] = v2.x; o.v[1] = v2.y; } else o.v[0] = sV[tk * 64 + rowS];
                o.bk = *(const f32x2*)(sBK + tk * 2); };
            auto step = [&](const Ops& cur, int i) {
                static_assert(EC == 4, "asm row helpers are written for 4 columns per lane");
                float sa[RPL], yp[RPL], y[RPL];
#pragma unroll
                for (int r = 0; r < RPL; ++r) row_dots(s[r], cur.a[0], cur.q[0], sa[r], yp[r]);
                if constexpr (RPL == 2) red16x4(sa[0], yp[0], sa[1], yp[1]); else red16x2(sa[0], yp[0]);
#pragma unroll
                for (int r = 0; r < RPL; ++r) row_update(s[r], cur.w[0], cur.b[0], cur.k[0], cur.v[r], sa[r], yp[r], cur.bk.x, cur.bk.y, y[r]);
                if (gS == 0) { if constexpr (RPL == 2) *(f32x2*)(sY + (DIR ? 31 - i : i) * 64 + rowS) = (f32x2){y[0], y[1]}; else sY[(DIR ? 31 - i : i) * 64 + rowS] = y[0]; }
            };
            {
                Ops o0, o1, o2; ld(o0, 0); ld(o1, 1);
#pragma unroll 1
                for (int i = 0; i < 30; i += 3) {
                    ld(o2, i + 2);
                    step(o0, i);
                    ld(o0, i + 3);
                    step(o1, i + 1);
                    ld(o1, min(i + 4, 31));
                    step(o2, i + 2);
                }
                step(o0, 30);
                step(o1, 31);
            }
        }
        LDS_BAR();
        if (RPL == 2 || (q >> 3) == half) { const f32x4 y4 = *(const f32x4*)(sY + tokA * 64 + 4 * q); u32x2 w; w.x = pk_bf16(y4[0], y4[1]); w.y = pk_bf16(y4[2], y4[3]);
          *(u32x2*)(ybuf + (size_t)(t0 + tokA) * 1024 + h * 64 + 4 * q) = w; }
    }
}

__device__ void scan_phase(const Params& p, unsigned char* shm) {
    int* sItem = (int*)(shm + 80 * 1024);
    const int tid = opaque_tid();
    unsigned* queue = (unsigned*)(p.ws + OFF_QUEUE);
    for (;;) {
        if (tid == 0) *sItem = (int)atomicAdd(queue, 1u);
        __syncthreads();
        const int item = *sItem;
        __syncthreads();
        if (item >= N_ITEMS) break;
        int tid2 = tid; asm volatile("" : "+v"(tid2));
        if (item < N_SAMPLE_ITEMS) {
            const int half = item & 1, j = item >> 1;
            if (j & 1) scan_item<16, 1, 1>(p, shm, tid2, TP + (j >> 5) * 16384, 16384, (j >> 1) & 15, half); else scan_item<16, 1, 0>(p, shm, tid2, TP + (j >> 5) * 16384, 16384, (j >> 1) & 15, half);
        } else { const int j = item - N_SAMPLE_ITEMS;
            if (j & 1) scan_item<16, 2, 1>(p, shm, tid2, (j >> 5) * 2048, 2048, (j >> 1) & 15, 0); else scan_item<16, 2, 0>(p, shm, tid2, (j >> 5) * 2048, 2048, (j >> 1) & 15, 0); }
        __syncthreads();
    }
    for (;;) {
        if (tid == 0) *sItem = (int)atomicAdd(queue + 1, 1u);
        __syncthreads();
        const int u = *sItem;
        __syncthreads();
        if (u >= N_DEFER) break;
        deferred_unit(p, shm, tid, u);
    }
}


__device__ void mix_phase(const Params& p) {
    const int tidx = opaque_tid(); const int lane = tidx & 63, wave = (blockIdx.x * 512 + tidx) >> 6, nw = (gridDim.x * 512) >> 6;
    const bf16_t* zall = (const bf16_t*)(p.ws + OFF_Z);
    bf16_t* yf = (bf16_t*)p.out; const bf16_t* yb = (const bf16_t*)p.out + (size_t)T_TOK * 1024;
    const float* bonus_f = (const float*)(p.ws + OFF_BONUS); const float* bonus_b = bonus_f + (size_t)T_TOK * 16;
    bf16_t* pooled = (bf16_t*)(p.ws + OFF_POOLED); bf16_t* sg = (bf16_t*)(p.ws + OFF_SG);
    const int hL = lane >> 2;
    const int tpw = (T_TOK + nw - 1) / nw;
    for (int t = wave * tpw; t < min(T_TOK, (wave + 1) * tpw); ++t) {
        int tbase, L; seq_of(t, tbase, L); const int pos = t - tbase; const bool hasPrev = pos > 0, hasNext = pos < L - 1;
        const bf16_t* zr = zall + (size_t)t * ZLD;
        { const int c0 = lane * 16; float y[16];
          { const u32x4 a0 = *(const u32x4*)(yf + (size_t)t * 1024 + c0), a1 = *(const u32x4*)(yf + (size_t)t * 1024 + c0 + 8);
            const u32x4 b0 = *(const u32x4*)(yb + (size_t)t * 1024 + c0), b1 = *(const u32x4*)(yb + (size_t)t * 1024 + c0 + 8);
            f32x4 fa, fb, ga, gb; unpack8(a0, fa, fb); unpack8(b0, ga, gb);
#pragma unroll
            for (int j = 0; j < 4; ++j) { y[j] = fa[j] + ga[j]; y[4 + j] = fb[j] + gb[j]; }
            unpack8(a1, fa, fb); unpack8(b1, ga, gb);
#pragma unroll
            for (int j = 0; j < 4; ++j) { y[8 + j] = fa[j] + ga[j]; y[12 + j] = fb[j] + gb[j]; } }
          float sm = 0.f;
#pragma unroll
          for (int j = 0; j < 16; ++j) sm += y[j];
          const float mean = red4(sm) * (1.0f / 64.0f); float vs = 0.f;
#pragma unroll
          for (int j = 0; j < 16; ++j) { const float d = y[j] - mean; vs += d * d; }
          const float rstd = rsqrtf(red4(vs) * (1.0f / 64.0f) + 64e-5f);
          const float bon = bonus_f[(size_t)t * 16 + hL] + bonus_b[(size_t)t * 16 + hL];
          float vv[16];
          { const bf16_t* zc = zr + COL_V + c0;
            u32x4 c_[2], p_[2], n_[2];
#pragma unroll
            for (int i = 0; i < 2; ++i) { c_[i] = *(const u32x4*)(zc + 8 * i); p_[i] = hasPrev ? *(const u32x4*)(zc - ZLD + 8 * i) : (u32x4){0u, 0u, 0u, 0u}; n_[i] = hasNext ? *(const u32x4*)(zc + ZLD + 8 * i) : (u32x4){0u, 0u, 0u, 0u}; }
#pragma unroll
            for (int i = 0; i < 2; ++i) { f32x4 ca, cb, pa, pb, na, nb; unpack8(c_[i], ca, cb); unpack8(p_[i], pa, pb); unpack8(n_[i], na, nb);
                const float* mp = p.mu_prev + (COL_V - COL_R) + c0 + 8 * i; const float* mn = p.mu_next + (COL_V - COL_R) + c0 + 8 * i;
                const f32x4 mp0 = *(const f32x4*)mp, mp1 = *(const f32x4*)(mp + 4), mn0 = *(const f32x4*)mn, mn1 = *(const f32x4*)(mn + 4);
#pragma unroll
                for (int j = 0; j < 4; ++j) { vv[8 * i + j] = ca[j] + mp0[j] * (pa[j] - ca[j]) + mn0[j] * (na[j] - ca[j]); vv[8 * i + 4 + j] = cb[j] + mp1[j] * (pb[j] - cb[j]) + mn1[j] * (nb[j] - cb[j]); } } }
          float o[16];
#pragma unroll
          for (int i = 0; i < 4; ++i) { const f32x4 lw = *(const f32x4*)(p.ln_w + c0 + 4 * i), lb = *(const f32x4*)(p.ln_b + c0 + 4 * i);
#pragma unroll
              for (int j = 0; j < 4; ++j) o[4 * i + j] = (y[4 * i + j] - mean) * rstd * lw[j] + lb[j] + bon * vv[4 * i + j]; }
          u32x4 w0, w1; w0.x = pk_bf16(o[0], o[1]); w0.y = pk_bf16(o[2], o[3]); w0.z = pk_bf16(o[4], o[5]); w0.w = pk_bf16(o[6], o[7]);
          w1.x = pk_bf16(o[8], o[9]); w1.y = pk_bf16(o[10], o[11]); w1.z = pk_bf16(o[12], o[13]); w1.w = pk_bf16(o[14], o[15]);
          *(u32x4*)(yf + (size_t)t * 1024 + c0) = w0; *(u32x4*)(yf + (size_t)t * 1024 + c0 + 8) = w1; }
        { const int c = 2 * lane; const bf16_t* zc = zr + COL_G + c; const unsigned wc_ = *(const unsigned*)zc; const unsigned wp = hasPrev ? *(const unsigned*)(zc - ZLD) : 0u, wn = hasNext ? *(const unsigned*)(zc + ZLD) : 0u;
          const float mp0 = p.mu_prev[COL_G - COL_R + c], mp1 = p.mu_prev[COL_G - COL_R + c + 1], mn0 = p.mu_next[COL_G - COL_R + c], mn1 = p.mu_next[COL_G - COL_R + c + 1];
          const float c0v = bf_lo(wc_), c1v = bf_hi(wc_);
          const float z0 = c0v + mp0 * (bf_lo(wp) - c0v) + mn0 * (bf_lo(wn) - c0v), z1 = c1v + mp1 * (bf_hi(wp) - c1v) + mn1 * (bf_hi(wn) - c1v);
          *(unsigned*)(sg + (size_t)t * 256 + c) = pk_bf16(sigmoidf_(z0), sigmoidf_(z1)); *(unsigned*)(sg + (size_t)t * 256 + 128 + c) = 0u; }
        { const int c = lane * 8, gi = lane >> 4, w = 2 << gi; const int lo = max(pos - (w >> 1), 0), hi = min(pos + (w >> 1) - 1, L - 1);
          float sum[8];
#pragma unroll
          for (int j = 0; j < 8; ++j) sum[j] = 0.f;
          u32x4 wr_[16];
#pragma unroll
          for (int d = 0; d < 16; ++d) { const int r = pos - 8 + d; wr_[d] = (u32x4){0u, 0u, 0u, 0u}; if (r >= lo && r <= hi) wr_[d] = *(const u32x4*)(zall + (size_t)(tbase + r) * ZLD + c); }
#pragma unroll
          for (int d = 0; d < 16; ++d) { f32x4 a, b; unpack8(wr_[d], a, b);
#pragma unroll
              for (int j = 0; j < 4; ++j) { sum[j] += a[j]; sum[4 + j] += b[j]; } }
          const float icnt = 1.0f / (float)(hi - lo + 1); f32x4 a, b; unpack8(*(const u32x4*)(zr + c), a, b); f32x4 oa, ob;
#pragma unroll
          for (int j = 0; j < 4; ++j) { oa[j] = sum[j] * icnt - a[j]; ob[j] = sum[4 + j] * icnt - b[j]; }
          *(u32x4*)(pooled + (size_t)t * 512 + c) = pack8(oa, ob); }
    }
}

__device__ void final_phase(const Params& p) {
    const int tidx = opaque_tid(); const int lane = tidx & 63, wave = (blockIdx.x * 512 + tidx) >> 6, nw = (gridDim.x * 512) >> 6;
    const float* x2 = (const float*)(p.ws + OFF_X1); const float* rowsq2 = (const float*)(p.ws + OFF_ROWSQ2);
    f32x4 gv[4];
#pragma unroll
    for (int i = 0; i < 4; ++i) gv[i] = *(const f32x4*)(p.g_final + lane * 4 + 256 * i);
    for (int t0 = wave; t0 < T_TOK; t0 += 2 * nw) {
        const int t1 = t0 + nw < T_TOK ? t0 + nw : t0;
        const float r0 = rsqrtf(rowsq2[t0] * (1.0f / 1024.0f) + 1e-6f), r1 = rsqrtf(rowsq2[t1] * (1.0f / 1024.0f) + 1e-6f);
        f32x4 a[4], b[4];
#pragma unroll
        for (int i = 0; i < 4; ++i) { a[i] = *(const f32x4*)(x2 + (size_t)t0 * 1024 + lane * 4 + 256 * i); b[i] = *(const f32x4*)(x2 + (size_t)t1 * 1024 + lane * 4 + 256 * i); }
#pragma unroll
        for (int i = 0; i < 4; ++i) { *(f32x4*)(p.out + (size_t)t0 * 1024 + lane * 4 + 256 * i) = a[i] * r0 * gv[i]; *(f32x4*)(p.out + (size_t)t1 * 1024 + lane * 4 + 256 * i) = b[i] * r1 * gv[i]; }
    }
}

__global__ void __launch_bounds__(512, 2) fwd_megakernel(Params p) {
    extern __shared__ __attribute__((aligned(16))) unsigned char shm[];
    unsigned char* ws = p.ws;
    prep_phase(p, shm);
    cg::this_grid().sync();
    { EpiStore E; E.O = (bf16_t*)(ws + OFF_Z); E.ldc = ZLD; run_gemm(shm, (const bf16_t*)(ws + OFF_R1), 1024, (const bf16_t*)(ws + OFF_WIN), 1024, 3840, 1024, E); }
    cg::this_grid().sync();
    scan_phase(p, shm);
    cg::this_grid().sync();
    mix_phase(p);
    cg::this_grid().sync();
    rmsnorm_rows(p, p.g_mix, (bf16_t*)(ws + OFF_XN2));
    { EpiMulInPlace E; E.Y = (bf16_t*)p.out; run_gemm(shm, (const bf16_t*)(ws + OFF_SG), 256, (const bf16_t*)(ws + OFF_WG), 256, 1024, 256, E); }
    cg::this_grid().sync();
    { EpiGates E; E.G = (bf16_t*)(ws + OFF_GATES); E.bias = p.b_gate; run_gemm(shm, (const bf16_t*)(ws + OFF_XN2), 1024, (const bf16_t*)(ws + OFF_WIN) + (size_t)3840 * 1024, 1024, 2048, 1024, E); }
    cg::this_grid().sync();
    { EpiPool E; E.P = (bf16_t*)(ws + OFF_MERGED); E.G = (const bf16_t*)(ws + OFF_GATES); run_gemm(shm, (const bf16_t*)(ws + OFF_POOLED), 512, (const bf16_t*)(ws + OFF_WEFF), 512, 1024, 512, E); }
    { EpiMerge E; E.P = (bf16_t*)(ws + OFF_MERGED); E.G = (const bf16_t*)(ws + OFF_GATES); run_gemm(shm, (const bf16_t*)p.out, 1024, (const bf16_t*)(ws + OFF_WRBR), 1024, 1024, 1024, E); }
    cg::this_grid().sync();
    { EpiOut E; E.xp = p.x_prompt; E.xs = p.x_sample; E.X1 = (float*)(ws + OFF_X1); E.X1B = (bf16_t*)(ws + OFF_X1B); E.rowsq = (float*)(ws + OFF_ROWSQ); run_gemm(shm, (const bf16_t*)(ws + OFF_MERGED), 1024, (const bf16_t*)(ws + OFF_WOUT), 1024, 1024, 1024, E); }
    cg::this_grid().sync();
    { EpiFF1 E; E.Hlo = (bf16_t*)(ws + OFF_HLO); E.Hhi = (bf16_t*)p.out; E.rowsq = (const float*)(ws + OFF_ROWSQ); run_gemm(shm, (const bf16_t*)(ws + OFF_X1B), 1024, (const bf16_t*)(ws + OFF_WFF1), 1024, 4096, 1024, E); }
    cg::this_grid().sync();
    { EpiFinal E; E.X = (float*)(ws + OFF_X1); E.rowsq = (float*)(ws + OFF_ROWSQ2);
      run_gemm(shm, (const bf16_t*)(ws + OFF_HLO), 2048, (const bf16_t*)(ws + OFF_WFF2), 4096, 1024, 4096, E, (const bf16_t*)p.out, 32); }
    cg::this_grid().sync();
    final_phase(p);
}

extern "C" void kernel_launch(void* const* d_in, const int* in_sizes, int n_in, void* d_out, int out_size, void* d_ws, size_t ws_size, hipStream_t stream) {
    constexpr size_t kDynLds = 131072;
    static int grid_blocks = 0;
    if (!grid_blocks) {
        hipFuncSetAttribute((const void*)fwd_megakernel, hipFuncAttributeMaxDynamicSharedMemorySize, (int)kDynLds);
        int dev = 0, cus = 0, per_cu = 0;
        hipGetDevice(&dev);
        hipDeviceGetAttribute(&cus, hipDeviceAttributeMultiprocessorCount, dev);
        hipOccupancyMaxActiveBlocksPerMultiprocessor(&per_cu, fwd_megakernel, 512, kDynLds);
        if (per_cu < 1) per_cu = 1;
        grid_blocks = cus;
    }
    Params p{};
    const float** pf = (const float**)&p;
    for (int i = 0; i < 30; ++i) pf[i] = (const float*)d_in[i];
    p.out = (float*)d_out; p.ws = (unsigned char*)d_ws;
    void* args[] = {&p};
    hipError_t e = hipLaunchCooperativeKernel((const void*)fwd_megakernel, dim3(grid_blocks), dim3(512), args, kDynLds, stream);
    if (e != hipSuccess) fprintf(stderr, "cooperative launch failed: %s (grid %d)\n", hipGetErrorString(e), grid_blocks);
}
```

```cpp
#include <hip/hip_runtime.h>
#include <hip/hip_cooperative_groups.h>
#include <cstdio>
namespace cg = cooperative_groups;

#define LAS __attribute__((address_space(3)))
typedef unsigned short bf16_t;
typedef short bf16x8 __attribute__((ext_vector_type(8)));
typedef float f32x4 __attribute__((ext_vector_type(4)));
typedef float f32x2 __attribute__((ext_vector_type(2)));
typedef unsigned u32x4 __attribute__((ext_vector_type(4)));
typedef unsigned u32x2 __attribute__((ext_vector_type(2)));

constexpr int T_TOK = 98304, DM = 1024, TP = 65536;
constexpr int ZLD = 3840;
constexpr int COL_R = 512, COL_K = 1536, COL_V = 2560, COL_W = 3584, COL_A = 3648, COL_G = 3712;
constexpr size_t MiB = 1ull << 20;
constexpr size_t OFF_WIN = 0, OFF_WEFF = 12 * MiB, OFF_WRBR = 13 * MiB, OFF_WOUT = 15 * MiB, OFF_WFF1 = 17 * MiB, OFF_WFF2 = 25 * MiB, OFF_WG = 33 * MiB;
constexpr size_t OFF_ROWSQ = 34 * MiB, OFF_ROWSQ2 = 34 * MiB + 512 * 1024, OFF_QUEUE = 35 * MiB, OFF_BONUS = 36 * MiB;
constexpr size_t OFF_R1 = 48 * MiB, OFF_Z = 240 * MiB;
constexpr size_t OFF_POOLED = OFF_R1, OFF_SG = OFF_R1 + 96 * MiB, OFF_XN2 = OFF_Z, OFF_GATES = OFF_Z + 192 * MiB, OFF_MERGED = OFF_Z + 576 * MiB;
constexpr size_t OFF_X1B = OFF_R1, OFF_X1 = OFF_Z, OFF_HLO = OFF_Z + 384 * MiB;
constexpr size_t U_BYTES = (size_t)T_TOK * 1024 * 2;

struct Params {
    const float *x_prompt, *x_sample, *g_mix, *w_in, *b_gate, *mu_prev, *mu_next, *pool_w, *pool_scale, *w_pool_br, *k_k, *k_a, *r_k,
        *w0_f, *w_up_f, *a0_f, *a_up_f, *w0_b, *w_up_b, *a0_b, *a_up_b, *g_up, *ln_w, *ln_b, *w_rwkv_br, *w_out, *g_ffn, *w_ff1, *w_ff2, *g_final;
    float* out; unsigned char* ws;
};

__device__ __forceinline__ float bf_lo(unsigned w) { return __uint_as_float(w << 16); }
__device__ __forceinline__ float bf_hi(unsigned w) { return __uint_as_float(w & 0xFFFF0000u); }
typedef __bf16 bf16x2_t __attribute__((ext_vector_type(2)));
__device__ __forceinline__ unsigned pk_bf16(float lo, float hi) { f32x2 v = {lo, hi}; bf16x2_t b = __builtin_convertvector(v, bf16x2_t); return __builtin_bit_cast(unsigned, b); }
__device__ __forceinline__ float fexp2_scaled(float x, float scale_log2e) { return __builtin_amdgcn_exp2f(x * scale_log2e); }
__device__ __forceinline__ float sigmoidf_(float x) { return __builtin_amdgcn_rcpf(1.0f + fexp2_scaled(x, -1.4426950409f)); }
__device__ __forceinline__ float fma_s(float a, float b, float c) { float d; asm("v_fma_f32 %0, %1, %2, %3" : "=v"(d) : "v"(a), "v"(b), "v"(c)); return d; }
__device__ __forceinline__ float mul_s(float a, float b) { float d; asm("v_mul_f32 %0, %1, %2" : "=v"(d) : "v"(a), "v"(b)); return d; }
__device__ __forceinline__ float add_s(float a, float b) { float d; asm("v_add_f32 %0, %1, %2" : "=v"(d) : "v"(a), "v"(b)); return d; }
#define DPPA(x, c) "v_add_f32_dpp " x ", " x ", " x " " c " row_mask:0xf bank_mask:0xf bound_ctrl:1\n"
#define DPP4(c) DPPA("%0", c) DPPA("%1", c) DPPA("%2", c) DPPA("%3", c)
#define DPP2(c) DPPA("%0", c) DPPA("%1", c) "s_nop 0\n"
__device__ __forceinline__ void red16x4(float& a, float& b, float& c, float& d) {
    asm("s_nop 1\n" DPP4("quad_perm:[1,0,3,2]") DPP4("quad_perm:[2,3,0,1]") DPP4("row_half_mirror") DPP4("row_mirror") : "+v"(a), "+v"(b), "+v"(c), "+v"(d)); }
__device__ __forceinline__ void red16x2(float& a, float& b) {
    asm("s_nop 1\n" DPP2("quad_perm:[1,0,3,2]") DPP2("quad_perm:[2,3,0,1]") DPP2("row_half_mirror") DPP2("row_mirror") : "+v"(a), "+v"(b)); }
__device__ __forceinline__ void row_dots(const float (&s)[4], const f32x4 a, const f32x4 q, float& sa, float& yp) {
    asm("v_mul_f32 %0, %2, %6\n v_mul_f32 %1, %2, %10\n v_fmac_f32 %0, %3, %7\n v_fmac_f32 %1, %3, %11\n v_fmac_f32 %0, %4, %8\n v_fmac_f32 %1, %4, %12\n v_fmac_f32 %0, %5, %9\n v_fmac_f32 %1, %5, %13"
        : "=&v"(sa), "=&v"(yp) : "v"(s[0]), "v"(s[1]), "v"(s[2]), "v"(s[3]), "v"(a[0]), "v"(a[1]), "v"(a[2]), "v"(a[3]), "v"(q[0]), "v"(q[1]), "v"(q[2]), "v"(q[3])); }
__device__ __forceinline__ void row_update(float (&s)[4], const f32x4 w, const f32x4 b, const f32x4 k, float v, float sa, float yp, float bkx, float bky, float& y) {
    float t0, t1, t2, t3;
    asm("v_mul_f32 %0, %6, %15\n v_mul_f32 %1, %6, %16\n v_mul_f32 %2, %6, %17\n v_mul_f32 %3, %6, %18\n"
        "v_fmac_f32 %4, %7, %5\n"
        "v_fmac_f32 %0, %7, %11\n v_fmac_f32 %1, %7, %12\n v_fmac_f32 %2, %7, %13\n v_fmac_f32 %3, %7, %14\n"
        "v_fmac_f32 %4, %6, %8\n"
        "v_fmac_f32 %0, %9, %19\n v_fmac_f32 %1, %10, %20\n v_fmac_f32 %2, %23, %21\n v_fmac_f32 %3, %24, %22"
        : "=&v"(t0), "=&v"(t1), "=&v"(t2), "=&v"(t3), "+v"(yp)
        : "v"(bkx), "v"(v), "v"(sa), "v"(bky), "v"(s[0]), "v"(s[1]), "v"(b[0]), "v"(b[1]), "v"(b[2]), "v"(b[3]), "v"(k[0]), "v"(k[1]), "v"(k[2]), "v"(k[3]), "v"(w[0]), "v"(w[1]), "v"(w[2]), "v"(w[3]), "v"(s[2]), "v"(s[3]));
    s[0] = t0; s[1] = t1; s[2] = t2; s[3] = t3; y = yp; }
__device__ __forceinline__ void shift4(float (&z)[4], const float (&c)[4], const float (&pv)[4], const float (&nx)[4], const f32x4 m0, const f32x4 mp, const f32x4 mn) {
    asm("v_mul_f32 %0, %4, %16\n v_mul_f32 %1, %5, %17\n v_mul_f32 %2, %6, %18\n v_mul_f32 %3, %7, %19\n"
        "v_fma_f32 %0, %8, %20, %0\n v_fma_f32 %1, %9, %21, %1\n v_fma_f32 %2, %10, %22, %2\n v_fma_f32 %3, %11, %23, %3\n"
        "v_fma_f32 %0, %12, %24, %0\n v_fma_f32 %1, %13, %25, %1\n v_fma_f32 %2, %14, %26, %2\n v_fma_f32 %3, %15, %27, %3"
        : "=&v"(z[0]), "=&v"(z[1]), "=&v"(z[2]), "=&v"(z[3])
        : "v"(c[0]), "v"(c[1]), "v"(c[2]), "v"(c[3]), "v"(pv[0]), "v"(pv[1]), "v"(pv[2]), "v"(pv[3]), "v"(nx[0]), "v"(nx[1]), "v"(nx[2]), "v"(nx[3]),
          "v"(m0[0]), "v"(m0[1]), "v"(m0[2]), "v"(m0[3]), "v"(mp[0]), "v"(mp[1]), "v"(mp[2]), "v"(mp[3]), "v"(mn[0]), "v"(mn[1]), "v"(mn[2]), "v"(mn[3])); }
__device__ __forceinline__ void kk4(float (&kk)[4], float& ss, const float (&k)[4], const f32x4 c) {
    asm("v_mul_f32 %0, %5, %9\n v_mul_f32 %1, %6, %10\n v_mul_f32 %2, %7, %11\n v_mul_f32 %3, %8, %12\n"
        "v_mul_f32 %4, %0, %0\n v_fma_f32 %4, %1, %1, %4\n v_fma_f32 %4, %2, %2, %4\n v_fma_f32 %4, %3, %3, %4"
        : "=&v"(kk[0]), "=&v"(kk[1]), "=&v"(kk[2]), "=&v"(kk[3]), "=&v"(ss) : "v"(k[0]), "v"(k[1]), "v"(k[2]), "v"(k[3]), "v"(c[0]), "v"(c[1]), "v"(c[2]), "v"(c[3])); }
__device__ __forceinline__ void row_update2(float (&s)[4], const f32x4 w, const f32x4 b, const f32x4 k, float v, float vkr, float sa, float yp, float& y) {
    float t0, t1, t2, t3;
    asm("v_mul_f32 %0, %6, %14\n v_mul_f32 %1, %6, %15\n v_mul_f32 %2, %6, %16\n v_mul_f32 %3, %6, %17\n"
        "v_add_f32 %4, %4, %5\n"
        "v_fmac_f32 %0, %7, %10\n v_fmac_f32 %1, %7, %11\n v_fmac_f32 %2, %7, %12\n v_fmac_f32 %3, %7, %13\n"
        "v_fmac_f32 %0, %8, %18\n v_fmac_f32 %1, %9, %19\n v_fmac_f32 %2, %22, %20\n v_fmac_f32 %3, %23, %21"
        : "=&v"(t0), "=&v"(t1), "=&v"(t2), "=&v"(t3), "+v"(yp)
        : "v"(vkr), "v"(v), "v"(sa), "v"(s[0]), "v"(s[1]), "v"(b[0]), "v"(b[1]), "v"(b[2]), "v"(b[3]), "v"(k[0]), "v"(k[1]), "v"(k[2]), "v"(k[3]), "v"(w[0]), "v"(w[1]), "v"(w[2]), "v"(w[3]), "v"(s[2]), "v"(s[3]));
    s[0] = t0; s[1] = t1; s[2] = t2; s[3] = t3; y = yp; }
template <int CTRL> __device__ __forceinline__ float dppf(float x) { return __int_as_float(__builtin_amdgcn_update_dpp(0, __float_as_int(x), CTRL, 0xF, 0xF, true)); }
__device__ __forceinline__ float red4(float x) { x += dppf<0xB1>(x); x += dppf<0x4E>(x); return x; }
__device__ __forceinline__ float red8(float x) { x = red4(x); x += dppf<0x141>(x); return x; }
__device__ __forceinline__ float red16(float x) { x = red8(x); x += dppf<0x140>(x); return x; }
__device__ __forceinline__ int opaque_tid() { int t = threadIdx.x; asm volatile("" : "+v"(t)); return t; }
__device__ __forceinline__ const float* xrow(const Params& p, int t) { return t < TP ? p.x_prompt + (size_t)t * DM : p.x_sample + (size_t)(t - TP) * DM; }
__device__ __forceinline__ void seq_of(int t, int& base, int& len) { if (t < TP) { base = t & ~2047; len = 2048; } else { base = TP + ((t - TP) & ~16383); len = 16384; } }

namespace pg8 {
constexpr int BM = 256, BK = 64, HALF = 128, HTB = HALF * BK * 2, STAGE_BYTES = 8 * HTB, NXCD = 8, WGM = 8;
__device__ __forceinline__ int lds_byte(int r, int c) { const int st = (r >> 4) * 2 + (c >> 5), rr = r & 15, cc = c & 31, ob = rr * 64 + cc * 2; return st * 1024 + (ob ^ (((ob >> 9) & 1) << 5)); }
__device__ __forceinline__ void stage_rc(int b, int& R, int& C) { const int st = b / 1024, sb = b % 1024, swz = sb ^ (((sb >> 9) & 1) << 5); R = (st >> 1) * 16 + swz / 64; C = (st & 1) * 32 + (swz % 64) / 2; }
__device__ __forceinline__ int perm32(int rho) { const int n = rho >> 4, i = rho & 15; return 8 * (i >> 2) + 4 * n + (i & 3); }
struct Unit { int pm, pn; };
struct Gemm { const bf16_t* A; const bf16_t* Bt; int M, N, K, lda, ldb; const bf16_t* A2; int ks; };
struct StaticOrder {
    int nM, nN, nwg, G, c;
    __device__ void init(int M, int N, int G_, int c_) { nM = M / BM; nN = N / BM; nwg = nM * nN; G = G_; c = c_; }
    __device__ bool next(int i, Unit& u) const {
        const long L = (long)i * G + c; if (L >= nwg) return false;
        int wgid = (int)L; { const int q = nwg / NXCD, r = nwg % NXCD, xcd = wgid % NXCD, off = wgid / NXCD; wgid = (xcd < r ? xcd * (q + 1) : r * (q + 1) + (xcd - r) * q) + off; }
        const int nig = WGM * nN, gid = wgid / nig, fm = gid * WGM, gsz = (nM - fm) < WGM ? (nM - fm) : WGM;
        u.pm = fm + ((wgid % nig) % gsz); u.pn = (wgid % nig) / gsz; return true;
    }
};

template <class Epi>
__device__ __forceinline__ void gemm_phase(LAS unsigned char* lds, const Gemm g, const StaticOrder& S, const Epi& E) {
    const int tid = opaque_tid();
    const int wid = __builtin_amdgcn_readfirstlane(tid >> 6), lane = tid & 63, wr = wid >> 2, wc = wid & 3, fr = lane & 15, fq = lane >> 4;
    const int K = g.K, nt = K / BK;
    unsigned voffA[2], voffB[2];
#pragma unroll
    for (int i = 0; i < 2; ++i) { int R, C; stage_rc(tid * 16 + i * 8192, R, C); const int Rb = (R & ~31) + perm32(R & 31);
        voffA[i] = (unsigned)(R * g.lda + C) * 2u; voffB[i] = (unsigned)(Rb * g.ldb + C) * 2u; }
    const size_t kstep = (size_t)(BK * 2);
    const size_t hstepA = (size_t)HALF * g.lda * 2, hstepB = (size_t)HALF * g.ldb * 2;
    const size_t tstepA = 2 * hstepA, tstepB = 2 * hstepB;
    const unsigned ldsw = (unsigned)wid * 1024u;
    const int aoff = lds_byte(wr * 64 + fr, fq * 8), boff = lds_byte(wc * 32 + fr, fq * 8);
#define PG8_SA(b, h) (((b) * 2 + (h)) * HTB)
#define PG8_SB(b, h) ((4 + (b) * 2 + (h)) * HTB)
#define PG8_STAGE(bufoff, gbase, voff) do { _Pragma("unroll") for (int _i = 0; _i < 2; ++_i) \
        __builtin_amdgcn_global_load_lds((const unsigned*)((const char*)(gbase) + (voff)[_i]), (LAS unsigned*)(lds + (bufoff) + ldsw + _i * 8192), 16, 0, 0); } while (0)
#define PG8_LDA(dst, b, h) do { _Pragma("unroll") for (int m = 0; m < 4; ++m) _Pragma("unroll") for (int k = 0; k < 2; ++k) dst[m][k] = *(const LAS bf16x8*)(lds + PG8_SA(b, h) + aoff + m * 2048 + k * 1024); } while (0)
#define PG8_LDB(dst, b, h) do { _Pragma("unroll") for (int n = 0; n < 2; ++n) _Pragma("unroll") for (int k = 0; k < 2; ++k) dst[n][k] = *(const LAS bf16x8*)(lds + PG8_SB(b, h) + boff + n * 2048 + k * 1024); } while (0)
#define PG8_MMA(ai, bj, At, Bt) do { __builtin_amdgcn_s_setprio(1); _Pragma("unroll") for (int m = 0; m < 4; ++m) _Pragma("unroll") for (int n = 0; n < 2; ++n) _Pragma("unroll") for (int k = 0; k < 2; ++k) \
        acc[ai][bj][m][n] = __builtin_amdgcn_mfma_f32_16x16x32_bf16(Bt[n][k], At[m][k], acc[ai][bj][m][n], 0, 0, 0); __builtin_amdgcn_s_setprio(0); } while (0)
#define PG8_WAIT_V(n) asm volatile("s_waitcnt vmcnt(" #n ")" ::: "memory")
#define PG8_WAIT_L(n) asm volatile("s_waitcnt lgkmcnt(" #n ")" ::: "memory")
#define PG8_BAR __builtin_amdgcn_s_barrier()
#define PG8_SCHED __builtin_amdgcn_sched_barrier(0)
    Unit cur, nxt; int ui = 0;
    if (!S.next(0, cur)) return;
    f32x4 acc[2][2][4][2];
#pragma unroll
    for (int a = 0; a < 2; ++a)
#pragma unroll
        for (int b = 0; b < 2; ++b)
#pragma unroll
            for (int m = 0; m < 4; ++m)
#pragma unroll
                for (int n = 0; n < 2; ++n) acc[a][b][m][n] = (f32x4){0.f, 0.f, 0.f, 0.f};
    bf16x8 At[4][2], B0[2][2], B1[2][2];
    const char* cA = (const char*)g.A + (size_t)cur.pm * tstepA; const char* cB = (const char*)g.Bt + (size_t)cur.pn * tstepB;
    const bool two = g.A2 != nullptr; const int ks = two ? g.ks : (1 << 30);
    const char* cA2 = two ? (const char*)g.A2 + (size_t)cur.pm * tstepA : cA;
    PG8_STAGE(PG8_SB(0, 0), cB, voffB); PG8_STAGE(PG8_SA(0, 0), cA, voffA); PG8_STAGE(PG8_SB(0, 1), cB + hstepB, voffB); PG8_STAGE(PG8_SA(0, 1), cA + hstepA, voffA);
    if (wr == 1) PG8_BAR;
    PG8_WAIT_V(4); PG8_BAR;
    PG8_STAGE(PG8_SB(1, 0), cB + kstep, voffB); PG8_STAGE(PG8_SA(1, 0), cA + kstep, voffA); PG8_STAGE(PG8_SB(1, 1), cB + hstepB + kstep, voffB);
    PG8_WAIT_V(6); PG8_BAR;
    for (;;) {
        const bool has_next = S.next(ui + 1, nxt);
        const char* nA = has_next ? (const char*)g.A + (size_t)nxt.pm * tstepA : cA; const char* nB = has_next ? (const char*)g.Bt + (size_t)nxt.pn * tstepB : cB;
        const char* nA2 = (two && has_next) ? (const char*)g.A2 + (size_t)nxt.pm * tstepA : cA2;
#pragma unroll 1
        for (int t = 0; t < nt; t += 2) {
            const bool last = (t == nt - 2);
            const char* a1 = (t + 1 < ks) ? cA + (size_t)(t + 1) * kstep : cA2 + (size_t)(t + 1 - ks) * kstep;
            const char* a2 = last ? nA : ((t + 2 < ks) ? cA + (size_t)(t + 2) * kstep : cA2 + (size_t)(t + 2 - ks) * kstep); const char* b2 = last ? nB : cB + (size_t)(t + 2) * kstep;
            const char* a3 = a2 + kstep; const char* b3 = b2 + kstep;
            PG8_LDB(B0, 0, 0); PG8_SCHED; PG8_LDA(At, 0, 0); PG8_STAGE(PG8_SA(1, 1), a1 + hstepA, voffA);
            PG8_WAIT_L(8); PG8_BAR; PG8_WAIT_L(0); PG8_MMA(0, 0, At, B0); PG8_BAR; PG8_SCHED;
            PG8_LDB(B1, 0, 1); PG8_STAGE(PG8_SB(0, 0), b2, voffB);
            PG8_BAR; PG8_WAIT_L(0); PG8_MMA(0, 1, At, B1); PG8_BAR;
            PG8_LDA(At, 0, 1); PG8_STAGE(PG8_SA(0, 0), a2, voffA);
            PG8_BAR; PG8_WAIT_L(0); PG8_MMA(1, 0, At, B0); PG8_BAR; PG8_SCHED;
            PG8_STAGE(PG8_SB(0, 1), b2 + hstepB, voffB);
            PG8_WAIT_V(6); PG8_BAR; PG8_MMA(1, 1, At, B1); PG8_BAR;
            PG8_LDB(B0, 1, 0); PG8_SCHED; PG8_LDA(At, 1, 0); PG8_STAGE(PG8_SA(0, 1), a2 + hstepA, voffA);
            PG8_WAIT_L(8); PG8_BAR; PG8_WAIT_L(0); PG8_MMA(0, 0, At, B0); PG8_BAR; PG8_SCHED;
            PG8_LDB(B1, 1, 1); PG8_STAGE(PG8_SB(1, 0), b3, voffB);
            PG8_BAR; PG8_WAIT_L(0); PG8_MMA(0, 1, At, B1); PG8_BAR;
            PG8_LDA(At, 1, 1); PG8_STAGE(PG8_SA(1, 0), a3, voffA);
            PG8_BAR; PG8_WAIT_L(0); PG8_MMA(1, 0, At, B0); PG8_BAR; PG8_SCHED;
            PG8_STAGE(PG8_SB(1, 1), b3 + hstepB, voffB);
            PG8_WAIT_V(6); PG8_BAR; PG8_MMA(1, 1, At, B1); PG8_BAR;
        }
        E(acc, cur, wr, wc, fr, fq);
        if (!has_next) break;
#pragma unroll
        for (int a = 0; a < 2; ++a)
#pragma unroll
            for (int b = 0; b < 2; ++b)
#pragma unroll
                for (int m = 0; m < 4; ++m)
#pragma unroll
                    for (int n = 0; n < 2; ++n) acc[a][b][m][n] = (f32x4){0.f, 0.f, 0.f, 0.f};
        cur = nxt; cA = nA; cA2 = nA2; cB = nB; ++ui;
    }
    PG8_WAIT_V(0);
    if (wr == 0) PG8_BAR;
    PG8_BAR;
#undef PG8_SA
#undef PG8_SB
#undef PG8_STAGE
#undef PG8_LDA
#undef PG8_LDB
#undef PG8_MMA
#undef PG8_WAIT_V
#undef PG8_WAIT_L
#undef PG8_BAR
#undef PG8_SCHED
}
}
using pg8::Unit;

#define EPI_LOOP_BEGIN const int row0 = u.pm * 256 + wr * 64 + fr, col0 = u.pn * 256 + wc * 32 + 8 * fq; \
    _Pragma("unroll") for (int ai = 0; ai < 2; ++ai) _Pragma("unroll") for (int m = 0; m < 4; ++m) { const int row = row0 + ai * 128 + m * 16;
#define EPI_BJ _Pragma("unroll") for (int bj = 0; bj < 2; ++bj) { const int col = col0 + bj * 128; const f32x4 v0 = acc[ai][bj][m][0], v1 = acc[ai][bj][m][1];
#define EPI_ACC const f32x4 (&acc)[2][2][4][2], const Unit& u, int wr, int wc, int fr, int fq

__device__ __forceinline__ u32x4 pack8(const f32x4 a, const f32x4 b) { u32x4 w; w.x = pk_bf16(a[0], a[1]); w.y = pk_bf16(a[2], a[3]); w.z = pk_bf16(b[0], b[1]); w.w = pk_bf16(b[2], b[3]); return w; }
__device__ __forceinline__ void unpack8(const u32x4 w, f32x4& a, f32x4& b) { a = (f32x4){bf_lo(w.x), bf_hi(w.x), bf_lo(w.y), bf_hi(w.y)}; b = (f32x4){bf_lo(w.z), bf_hi(w.z), bf_lo(w.w), bf_hi(w.w)}; }

struct EpiStore {
    bf16_t* O; int ldc;
    __device__ __forceinline__ void operator()(EPI_ACC) const { EPI_LOOP_BEGIN EPI_BJ *(u32x4*)(O + (size_t)row * ldc + col) = pack8(v0, v1); } } }
};
struct EpiMulInPlace {
    bf16_t* Y;
    __device__ __forceinline__ void operator()(EPI_ACC) const { EPI_LOOP_BEGIN if ((m & 1) == 0) __builtin_amdgcn_sched_barrier(0);
        EPI_BJ u32x4* ptr = (u32x4*)(Y + (size_t)row * 1024 + col); f32x4 a, b; unpack8(*ptr, a, b); *ptr = pack8(a * v0, b * v1); } } }
};
struct EpiGates {
    bf16_t* G; const float* bias;
    __device__ __forceinline__ void operator()(EPI_ACC) const { EPI_LOOP_BEGIN EPI_BJ
        const f32x4 b0 = *(const f32x4*)(bias + col), b1 = *(const f32x4*)(bias + col + 4); f32x4 a, b;
#pragma unroll
        for (int j = 0; j < 4; ++j) { a[j] = sigmoidf_(v0[j] + b0[j]); b[j] = sigmoidf_(v1[j] + b1[j]); }
        *(u32x4*)(G + (size_t)row * 2048 + col) = pack8(a, b); } } }
};
struct EpiPool {
    bf16_t* P; const bf16_t* G;
    __device__ __forceinline__ void operator()(EPI_ACC) const { EPI_LOOP_BEGIN EPI_BJ f32x4 a, b; unpack8(*(const u32x4*)(G + (size_t)row * 2048 + col), a, b);
        *(u32x4*)(P + (size_t)row * 1024 + col) = pack8(a * v0, b * v1); } } }
};
struct EpiMerge {
    bf16_t* P; const bf16_t* G;
    __device__ __forceinline__ void operator()(EPI_ACC) const { EPI_LOOP_BEGIN EPI_BJ f32x4 a, b, pa, pb; unpack8(*(const u32x4*)(G + (size_t)row * 2048 + 1024 + col), a, b);
        u32x4* ptr = (u32x4*)(P + (size_t)row * 1024 + col); unpack8(*ptr, pa, pb); *ptr = pack8(pa + a * v0, pb + b * v1); } } }
};
struct EpiOut {
    const float* xp; const float* xs; float* X1; bf16_t* X1B; float* rowsq;
    __device__ __forceinline__ void operator()(EPI_ACC) const { EPI_LOOP_BEGIN const float* xr = row < TP ? xp + (size_t)row * DM : xs + (size_t)(row - TP) * DM; float ss = 0.f; EPI_BJ
        f32x4 a = *(const f32x4*)(xr + col) + v0, b = *(const f32x4*)(xr + col + 4) + v1;
        *(f32x4*)(X1 + (size_t)row * 1024 + col) = a; *(f32x4*)(X1 + (size_t)row * 1024 + col + 4) = b; *(u32x4*)(X1B + (size_t)row * 1024 + col) = pack8(a, b);
#pragma unroll
        for (int j = 0; j < 4; ++j) ss += a[j] * a[j] + b[j] * b[j]; }
        ss += __shfl_xor(ss, 16); ss += __shfl_xor(ss, 32); if (fq == 0) atomicAdd(rowsq + row, ss); } }
};
struct EpiFF1 {
    bf16_t* Hlo; bf16_t* Hhi; const float* rowsq;
    __device__ __forceinline__ void operator()(EPI_ACC) const { bf16_t* H = u.pn < 8 ? Hlo : Hhi; const int cshift = u.pn < 8 ? 0 : 2048;
        EPI_LOOP_BEGIN const float rinv = rsqrtf(rowsq[row] * (1.0f / 1024.0f) + 1e-6f); EPI_BJ f32x4 a, b;
#pragma unroll
        for (int j = 0; j < 4; ++j) { float t0 = fmaxf(v0[j] * rinv, 0.f), t1 = fmaxf(v1[j] * rinv, 0.f); a[j] = t0 * t0; b[j] = t1 * t1; }
        *(u32x4*)(H + (size_t)row * 2048 + (col - cshift)) = pack8(a, b); } } }
};
struct EpiAddInPlace {
    float* X;
    __device__ __forceinline__ void operator()(EPI_ACC) const { EPI_LOOP_BEGIN EPI_BJ f32x4* ptr = (f32x4*)(X + (size_t)row * 1024 + col); ptr[0] = ptr[0] + v0; ptr[1] = ptr[1] + v1; } } }
};
struct EpiFinal {
    float* X; float* rowsq;
    __device__ __forceinline__ void operator()(EPI_ACC) const { EPI_LOOP_BEGIN float ss = 0.f; EPI_BJ f32x4* ptr = (f32x4*)(X + (size_t)row * 1024 + col); const f32x4 a = ptr[0] + v0, b = ptr[1] + v1; ptr[0] = a; ptr[1] = b;
#pragma unroll
        for (int j = 0; j < 4; ++j) ss += a[j] * a[j] + b[j] * b[j]; }
        ss += __shfl_xor(ss, 16); ss += __shfl_xor(ss, 32); if (fq == 0) atomicAdd(rowsq + row, ss); } }
};

template <class Epi>
__device__ __forceinline__ void run_gemm(unsigned char* shm, const bf16_t* A, int lda, const bf16_t* Bt, int ldb, int N, int K, const Epi& E, const bf16_t* A2 = nullptr, int ks = 0) {
    pg8::Gemm g; g.A = A; g.Bt = Bt; g.M = T_TOK; g.N = N; g.K = K; g.lda = lda; g.ldb = ldb; g.A2 = A2; g.ks = ks;
    pg8::StaticOrder S; S.init(T_TOK, N, (int)gridDim.x, (int)blockIdx.x);
    pg8::gemm_phase<Epi>((LAS unsigned char*)shm, g, S, E);
}

__device__ __forceinline__ void transpose_tile(float* tile, int tid, const float* src, int N, bf16_t* dst, int ldd, const float* kscale, int t) {
    const int ntn = N / 64, tk = t / ntn, tn = t % ntn;
#pragma unroll
    for (int i = 0; i < 8; ++i) { const int kl = (tid >> 6) + 8 * i, nl = tid & 63; const int k = tk * 64 + kl;
        tile[kl * 65 + nl] = src[(size_t)k * N + tn * 64 + nl] * (kscale ? kscale[k] : 1.0f); }
    __syncthreads();
#pragma unroll
    for (int i = 0; i < 8; ++i) { const int nl = (tid >> 6) + 8 * i, kl = tid & 63;
        const unsigned w = pk_bf16(tile[kl * 65 + nl], 0.f); dst[(size_t)(tn * 64 + nl) * ldd + tk * 64 + kl] = (bf16_t)(w & 0xFFFFu); }
    __syncthreads();
}
__device__ void transpose_cvt(unsigned char* shm, const float* src, int K, int N, bf16_t* dst, int ldd, const float* kscale) {
    float* tile = (float*)shm;
    const int tid = opaque_tid(), ntk = K / 64, ntn = N / 64;
    for (int t = blockIdx.x; t < ntk * ntn; t += gridDim.x) transpose_tile(tile, tid, src, N, dst, ldd, kscale, t);
}
constexpr int DU_RBR = 256, DU_OUT = 512, DU_FF1 = 1536, DU_FF2 = 2560, DU_G = 2592, DU_GZ = 2624, N_DEFER = 2624 + 256;
__device__ void deferred_unit(const Params& p, unsigned char* shm, int tid, int u) {
    unsigned char* ws = p.ws; float* tile = (float*)shm;
    if (u < DU_RBR) transpose_tile(tile, tid, p.w_rwkv_br, 1024, (bf16_t*)(ws + OFF_WRBR), 1024, nullptr, u);
    else if (u < DU_OUT) transpose_tile(tile, tid, p.w_out, 1024, (bf16_t*)(ws + OFF_WOUT), 1024, nullptr, u - DU_RBR);
    else if (u < DU_FF1) transpose_tile(tile, tid, p.w_ff1, 4096, (bf16_t*)(ws + OFF_WFF1), 1024, p.g_ffn, u - DU_OUT);
    else if (u < DU_FF2) transpose_tile(tile, tid, p.w_ff2, 1024, (bf16_t*)(ws + OFF_WFF2), 4096, nullptr, u - DU_FF1);
    else if (u < DU_G) transpose_tile(tile, tid, p.g_up, 1024, (bf16_t*)(ws + OFF_WG), 256, nullptr, u - DU_FF2);
    else if (u < DU_GZ) { bf16_t* wg = (bf16_t*)(ws + OFF_WG);
#pragma unroll
        for (int m = 0; m < 8; ++m) { const int i = (u - DU_G) * 4096 + m * 512 + tid; wg[(size_t)(i >> 7) * 256 + 128 + (i & 127)] = 0; } }
    else {
        bf16_t* we = (bf16_t*)(ws + OFF_WEFF); const int base = (u - DU_GZ) * 2048; float acc[4] = {0.f, 0.f, 0.f, 0.f};
        const int gI = (base >> 10) >> 7;
        for (int d = 0; d < 128; ++d) { const float sc = p.pool_scale[gI * 128 + d];
#pragma unroll
            for (int m = 0; m < 4; ++m) { const int i = base + m * 512 + tid, k = i >> 10, n = i & 1023;
                acc[m] += p.pool_w[(size_t)k * 128 + d] * sc * p.w_pool_br[(size_t)(gI * 128 + d) * 1024 + n]; } }
#pragma unroll
        for (int m = 0; m < 4; ++m) { const int i = base + m * 512 + tid, k = i >> 10, n = i & 1023; we[(size_t)n * 512 + k] = (bf16_t)(pk_bf16(acc[m], 0.f) & 0xFFFFu); } }
}
__device__ void rmsnorm_rows(const Params& p, const float* g, bf16_t* dst) {
    const int tidx = opaque_tid(); const int lane = tidx & 63, wave = (blockIdx.x * 512 + tidx) >> 6, nw = (gridDim.x * 512) >> 6;
    f32x4 gv[4];
#pragma unroll
    for (int i = 0; i < 4; ++i) gv[i] = *(const f32x4*)(g + lane * 4 + 256 * i);
    for (int t0 = wave; t0 < T_TOK; t0 += 2 * nw) {
        const int t1 = t0 + nw; const bool has1 = t1 < T_TOK;
        const float* xr0 = xrow(p, t0); const float* xr1 = xrow(p, has1 ? t1 : t0); f32x4 v0[4], v1[4]; float ss0 = 0.f, ss1 = 0.f;
#pragma unroll
        for (int i = 0; i < 4; ++i) { v0[i] = *(const f32x4*)(xr0 + lane * 4 + 256 * i); v1[i] = *(const f32x4*)(xr1 + lane * 4 + 256 * i); }
#pragma unroll
        for (int i = 0; i < 4; ++i) { ss0 += v0[i][0] * v0[i][0] + v0[i][1] * v0[i][1] + v0[i][2] * v0[i][2] + v0[i][3] * v0[i][3]; ss1 += v1[i][0] * v1[i][0] + v1[i][1] * v1[i][1] + v1[i][2] * v1[i][2] + v1[i][3] * v1[i][3]; }
#pragma unroll
        for (int o = 1; o < 64; o <<= 1) { ss0 += __shfl_xor(ss0, o); ss1 += __shfl_xor(ss1, o); }
        const float r0 = rsqrtf(ss0 * (1.0f / 1024.0f) + 1e-6f), r1 = rsqrtf(ss1 * (1.0f / 1024.0f) + 1e-6f);
#pragma unroll
        for (int i = 0; i < 4; ++i) { u32x2 w; w.x = pk_bf16(v0[i][0] * r0 * gv[i][0], v0[i][1] * r0 * gv[i][1]); w.y = pk_bf16(v0[i][2] * r0 * gv[i][2], v0[i][3] * r0 * gv[i][3]);
            *(u32x2*)(dst + (size_t)t0 * 1024 + lane * 4 + 256 * i) = w; }
        if (has1) {
#pragma unroll
            for (int i = 0; i < 4; ++i) { u32x2 w; w.x = pk_bf16(v1[i][0] * r1 * gv[i][0], v1[i][1] * r1 * gv[i][1]); w.y = pk_bf16(v1[i][2] * r1 * gv[i][2], v1[i][3] * r1 * gv[i][3]);
                *(u32x2*)(dst + (size_t)t1 * 1024 + lane * 4 + 256 * i) = w; } }
    }
}

__device__ void prep_phase(const Params& p, unsigned char* shm) {
    unsigned char* ws = p.ws;
    const int gtid = blockIdx.x * 512 + opaque_tid(), gn = gridDim.x * 512;
    for (int i = gtid; i < T_TOK; i += gn) { ((float*)(ws + OFF_ROWSQ))[i] = 0.f; ((float*)(ws + OFF_ROWSQ2))[i] = 0.f; }
    if (gtid < 64) ((unsigned*)(ws + OFF_QUEUE))[gtid] = 0u;
    transpose_cvt(shm, p.w_in, 1024, 5888, (bf16_t*)(ws + OFF_WIN), 1024, nullptr);
    rmsnorm_rows(p, p.g_mix, (bf16_t*)(ws + OFF_R1));
}

#define LDS_BAR() do { asm volatile("s_waitcnt lgkmcnt(0)" ::: "memory"); __builtin_amdgcn_s_barrier(); asm volatile("" ::: "memory"); } while (0)
constexpr int N_SAMPLE_ITEMS = 128, N_ITEMS = N_SAMPLE_ITEMS + 1024;

template <int LPR, int RPL, int DIR>
__device__ __forceinline__ void scan_item(const Params& p, unsigned char* shm, const int tid, const int tbase, const int L, const int h, const int half) {
    constexpr int dir = DIR;
    constexpr int EC = 64 / LPR, RPW = RPL * (64 / LPR);
    float* sW = (float*)shm; float* sAV = sW + 2048; float* sBV = sW + 4096; float* sKD = sW + 6144; float* sWR = sW + 8192; float* sR = sW + 10240; float* sV = sW + 12288; float* sY = sW + 14336;
    float* sBK = sW + 16384;
    bf16_t* sTW = (bf16_t*)(sW + 16384 + 64);
    bf16_t* sZA = sTW + 32 * 72;
    const int lane = tid & 63, wv = tid >> 6;
    const bf16_t* zall = (const bf16_t*)(p.ws + OFF_Z);
    const int tokA = tid >> 4, q = tid & 15;
    const int rowS = half * 32 + wv * RPW + RPL * (lane / LPR), gS = lane % LPR;
    const int NC = L / 32;
    bf16_t* ybuf = (bf16_t*)p.out + (dir ? (size_t)T_TOK * 1024 : 0);
    float* bonus = (float*)(p.ws + OFF_BONUS) + (dir ? (size_t)T_TOK * 16 : 0);
    const float* w_up = dir ? p.w_up_b : p.w_up_f; const float* a_up = dir ? p.a_up_b : p.a_up_f;
    const float* w0 = dir ? p.w0_b : p.w0_f; const float* a0 = dir ? p.a0_b : p.a0_f;
    const int mat = wv >> 2, cbk = wv & 3, colB = cbk * 16 + (lane & 15), quad = lane >> 4;
    u32x4* sBF = (u32x4*)(shm + 84 * 1024);
    { const float* up = mat ? a_up : w_up;
#pragma unroll
      for (int kb = 0; kb < 2; ++kb) { float f[8];
#pragma unroll
          for (int j = 0; j < 8; ++j) f[j] = up[(size_t)(kb * 32 + quad * 8 + j) * 1024 + h * 64 + colB];
          u32x4 w; w.x = pk_bf16(f[0], f[1]); w.y = pk_bf16(f[2], f[3]); w.z = pk_bf16(f[4], f[5]); w.w = pk_bf16(f[6], f[7]); sBF[kb * 512 + tid] = w; } }
    const float c0B = (mat ? a0 : w0)[h * 64 + colB];
    const float kaB = p.k_a[h * 64 + colB];
    int colz[5];
    float* sV2 = (float*)(shm + 104 * 1024);
    float* sM0 = (float*)(shm + 100 * 1024);
    float* sMU = (float*)(shm + 76 * 1024);
#pragma unroll
    for (int gi = 0; gi < 5; ++gi) colz[gi] = (gi == 0 ? COL_R + h * 64 : gi == 1 ? COL_K + h * 64 : gi == 2 ? COL_V + h * 64 : gi == 3 ? COL_W : COL_A) + 4 * q;
    if (tid < 320) { const int gi = tid >> 6, c = tid & 63; const int col = (gi == 0 ? COL_R + h * 64 : gi == 1 ? COL_K + h * 64 : gi == 2 ? COL_V + h * 64 : gi == 3 ? COL_W : COL_A) + c - COL_R;
        const float mpv_ = p.mu_prev[col], mnv_ = p.mu_next[col]; sMU[gi * 64 + c] = mpv_; sMU[320 + gi * 64 + c] = mnv_; sM0[gi * 64 + c] = 1.0f - mpv_ - mnv_; }
    else if (tid < 384) sMU[640 + (tid - 320)] = p.k_k[h * 64 + (tid - 320)];
    else if (tid < 448) sMU[704 + (tid - 384)] = p.r_k[h * 64 + (tid - 384)];
    __syncthreads();
    float s[RPL][EC];
#pragma unroll
    for (int r = 0; r < RPL; ++r)
#pragma unroll
        for (int j = 0; j < EC; ++j) s[r][j] = 0.f;
    u32x2 zc[5], zp[5], zn[5];
    auto load_chunk = [&](int ci) {
        const int t = tbase + 32 * (dir ? NC - 1 - ci : ci) + tokA; const bool hasPrev = t > tbase, hasNext = t < tbase + L - 1;
        const bf16_t* zr = zall + (size_t)t * ZLD;
#pragma unroll
        for (int gi = 0; gi < 5; ++gi) { zc[gi] = *(const u32x2*)(zr + colz[gi]); zp[gi] = (u32x2){0u, 0u}; zn[gi] = (u32x2){0u, 0u};
            if (hasPrev) zp[gi] = *(const u32x2*)(zr - ZLD + colz[gi]);
            if (hasNext) zn[gi] = *(const u32x2*)(zr + ZLD + colz[gi]); }
    };
    load_chunk(0);
    for (int ci = 0; ci < NC; ++ci) {
        const int t0 = tbase + 32 * (dir ? NC - 1 - ci : ci);
        { float zs[5][4];
          f32x4 MP[5], MN[5], M0[5];
#pragma unroll
          for (int gi = 0; gi < 5; ++gi) { MP[gi] = *(const f32x4*)(sMU + gi * 64 + 4 * q); MN[gi] = *(const f32x4*)(sMU + 320 + gi * 64 + 4 * q); M0[gi] = *(const f32x4*)(sM0 + gi * 64 + 4 * q); }
          const f32x4 kk4c = *(const f32x4*)(sMU + 640 + 4 * q);
#pragma unroll
          for (int gi = 0; gi < 5; ++gi) {
              const float c[4] = {bf_lo(zc[gi].x), bf_hi(zc[gi].x), bf_lo(zc[gi].y), bf_hi(zc[gi].y)}, pv[4] = {bf_lo(zp[gi].x), bf_hi(zp[gi].x), bf_lo(zp[gi].y), bf_hi(zp[gi].y)}, nx[4] = {bf_lo(zn[gi].x), bf_hi(zn[gi].x), bf_lo(zn[gi].y), bf_hi(zn[gi].y)};
              shift4(zs[gi], c, pv, nx, M0[gi], MP[gi], MN[gi]);
          }
          if (ci + 1 < NC) load_chunk(ci + 1);
          *(f32x4*)(sR + tokA * 64 + 4 * q) = (f32x4){zs[0][0], zs[0][1], zs[0][2], zs[0][3]};
          *(f32x4*)(sKD + tokA * 64 + 4 * q) = (f32x4){zs[1][0], zs[1][1], zs[1][2], zs[1][3]};
          *(f32x4*)(sV + tokA * 64 + 4 * q) = (f32x4){zs[2][0], zs[2][1], zs[2][2], zs[2][3]};
          float kk[4], ss;
          kk4(kk, ss, zs[1], kk4c);
          ss = ss + 0.0f * kk[0];
          ss = red16(ss);
          const float inv = -__builtin_amdgcn_rsqf(fmaxf(ss, 1e-24f));
          *(f32x4*)(sAV + tokA * 64 + 4 * q) = (f32x4){kk[0] * inv, kk[1] * inv, kk[2] * inv, kk[3] * inv};
          float tw[4];
#pragma unroll
          for (int j = 0; j < 4; ++j) tw[j] = 1.0f - 2.0f * __builtin_amdgcn_rcpf(1.0f + fexp2_scaled(zs[3][j], 2.8853900818f));
          u32x2 w; w.x = pk_bf16(tw[0], tw[1]); w.y = pk_bf16(tw[2], tw[3]); *(u32x2*)(sTW + tokA * 72 + 4 * q) = w;
          w.x = pk_bf16(zs[4][0], zs[4][1]); w.y = pk_bf16(zs[4][2], zs[4][3]); *(u32x2*)(sZA + tokA * 72 + 4 * q) = w;
        }
        LDS_BAR();
        { const int matu = __builtin_amdgcn_readfirstlane(mat);
          const bf16_t* sX = matu ? sZA : sTW;
          const bf16x8 b0 = __builtin_bit_cast(bf16x8, sBF[tid]), b1 = __builtin_bit_cast(bf16x8, sBF[512 + tid]);
          const bf16_t* ap = sX + (lane & 15) * 72 + quad * 8;
          const bf16x8 a00 = *(const bf16x8*)(ap), a01 = *(const bf16x8*)(ap + 32), a10 = *(const bf16x8*)(ap + 16 * 72), a11 = *(const bf16x8*)(ap + 16 * 72 + 32);
          const int idx0 = (quad * 4) * 64 + colB;
          float o1[8], o2[8];
          if (matu == 0) {
#pragma unroll
              for (int i = 0; i < 8; ++i) o1[i] = sR[idx0 + ((i >> 2) * 16 + (i & 3)) * 64];
          } else {
#pragma unroll
              for (int i = 0; i < 8; ++i) { o1[i] = sKD[idx0 + ((i >> 2) * 16 + (i & 3)) * 64]; o2[i] = sAV[idx0 + ((i >> 2) * 16 + (i & 3)) * 64]; }
          }
          f32x4 acc0 = (f32x4){c0B, c0B, c0B, c0B}, acc1 = acc0;
          acc0 = __builtin_amdgcn_mfma_f32_16x16x32_bf16(a00, b0, acc0, 0, 0, 0); acc1 = __builtin_amdgcn_mfma_f32_16x16x32_bf16(a10, b0, acc1, 0, 0, 0);
          acc0 = __builtin_amdgcn_mfma_f32_16x16x32_bf16(a01, b1, acc0, 0, 0, 0); acc1 = __builtin_amdgcn_mfma_f32_16x16x32_bf16(a11, b1, acc1, 0, 0, 0);
          float sg[8];
#pragma unroll
          for (int i = 0; i < 8; ++i) sg[i] = sigmoidf_(i < 4 ? acc0[i & 3] : acc1[i & 3]);
          if (matu == 0) {
              float wv_[8];
#pragma unroll
              for (int i = 0; i < 8; ++i) wv_[i] = fexp2_scaled(sg[i], -0.6065306597f * 1.4426950409f);
#pragma unroll
              for (int i = 0; i < 8; ++i) { const int idx = idx0 + ((i >> 2) * 16 + (i & 3)) * 64; sW[idx] = wv_[i]; sWR[idx] = wv_[i] * o1[i]; }
          } else {
#pragma unroll
              for (int i = 0; i < 8; ++i) { const int idx = idx0 + ((i >> 2) * 16 + (i & 3)) * 64; sKD[idx] = o1[i] * (1.0f + (sg[i] - 1.0f) * kaB); sBV[idx] = -o2[i] * sg[i]; }
          } }
        LDS_BAR();
        { const f32x4 r4 = *(const f32x4*)(sR + tokA * 64 + 4 * q), b4 = *(const f32x4*)(sBV + tokA * 64 + 4 * q), k4 = *(const f32x4*)(sKD + tokA * 64 + 4 * q);
          float br = 0.f, kr = 0.f, cb = 0.f; const f32x4 rk4 = *(const f32x4*)(sMU + 704 + 4 * q);
#pragma unroll
          for (int j = 0; j < 4; ++j) { br += b4[j] * r4[j]; kr += k4[j] * r4[j]; cb += r4[j] * k4[j] * rk4[j]; }
          br = red16(br); kr = red16(kr); cb = red16(cb);
          { f32x4* qp = (f32x4*)(sWR + tokA * 64 + 4 * q); const f32x4 a4 = *(const f32x4*)(sAV + tokA * 64 + 4 * q); *qp = *qp + a4 * br; }
          { const f32x4 v4 = *(const f32x4*)(sV + tokA * 64 + 4 * q); f32x4* vp = (f32x4*)(sV2 + (tokA * 64 + 4 * q) * 2);
            vp[0] = (f32x4){v4[0], v4[0] * kr, v4[1], v4[1] * kr}; vp[1] = (f32x4){v4[2], v4[2] * kr, v4[3], v4[3] * kr}; }
          if (q == 0 && half == 0) bonus[(size_t)(t0 + tokA) * 16 + h] = cb; }
        LDS_BAR();
        {
            constexpr int NV = EC / 4;
            struct Ops { f32x4 w[NV], a[NV], b[NV], k[NV], q[NV]; float v[RPL], vkr[RPL]; };
            auto ld = [&](Ops& o, int i) { const int tk = DIR ? 31 - i : i; const int off = tk * 64 + 4 * gS;
#pragma unroll
                for (int c = 0; c < NV; ++c) { o.w[c] = *(const f32x4*)(sW + off + 32 * c); o.a[c] = *(const f32x4*)(sAV + off + 32 * c); o.b[c] = *(const f32x4*)(sBV + off + 32 * c);
                    o.k[c] = *(const f32x4*)(sKD + off + 32 * c); o.q[c] = *(const f32x4*)(sWR + off + 32 * c); }
                if constexpr (RPL == 2) { const f32x4 v2 = *(const f32x4*)(sV2 + (tk * 64 + rowS) * 2); o.v[0] = v2[0]; o.vkr[0] = v2[1]; o.v[1] = v2[2]; o.vkr[1] = v2[3]; }
                else { const f32x2 v2 = *(const f32x2*)(sV2 + (tk * 64 + rowS) * 2); o.v[0] = v2.x; o.vkr[0] = v2.y; } };
            auto step = [&](const Ops& cur, int i) {
                static_assert(EC == 4, "asm row helpers are written for 4 columns per lane");
                float sa[RPL], yp[RPL], y[RPL];
#pragma unroll
                for (int r = 0; r < RPL; ++r) row_dots(s[r], cur.a[0], cur.q[0], sa[r], yp[r]);
                if constexpr (RPL == 2) red16x4(sa[0], yp[0], sa[1], yp[1]); else red16x2(sa[0], yp[0]);
#pragma unroll
                for (int r = 0; r < RPL; ++r) row_update2(s[r], cur.w[0], cur.b[0], cur.k[0], cur.v[r], cur.vkr[r], sa[r], yp[r], y[r]);
                if (gS == 0) { if constexpr (RPL == 2) *(f32x2*)(sY + (DIR ? 31 - i : i) * 64 + rowS) = (f32x2){y[0], y[1]}; else sY[(DIR ? 31 - i : i) * 64 + rowS] = y[0]; }
            };
            {
                Ops o0, o1, o2; ld(o0, 0); ld(o1, 1);
#pragma unroll 1
                for (int i = 0; i < 30; i += 3) {
                    ld(o2, i + 2);
                    step(o0, i);
                    ld(o0, i + 3);
                    step(o1, i + 1);
                    ld(o1, min(i + 4, 31));
                    step(o2, i + 2);
                }
                step(o0, 30);
                step(o1, 31);
            }
        }
        LDS_BAR();
        if (RPL == 2 || (q >> 3) == half) { const f32x4 y4 = *(const f32x4*)(sY + tokA * 64 + 4 * q); u32x2 w; w.x = pk_bf16(y4[0], y4[1]); w.y = pk_bf16(y4[2], y4[3]);
          *(u32x2*)(ybuf + (size_t)(t0 + tokA) * 1024 + h * 64 + 4 * q) = w; }
    }
}

__device__ void scan_phase(const Params& p, unsigned char* shm) {
    int* sItem = (int*)(shm + 80 * 1024);
    const int tid = opaque_tid();
    unsigned* queue = (unsigned*)(p.ws + OFF_QUEUE);
    for (;;) {
        if (tid == 0) *sItem = (int)atomicAdd(queue, 1u);
        __syncthreads();
        const int item = *sItem;
        __syncthreads();
        if (item >= N_ITEMS) break;
        int tid2 = tid; asm volatile("" : "+v"(tid2));
        if (item < N_SAMPLE_ITEMS) {
            const int half = item & 1, j = item >> 1;
            if (j & 1) scan_item<16, 1, 1>(p, shm, tid2, TP + (j >> 5) * 16384, 16384, (j >> 1) & 15, half); else scan_item<16, 1, 0>(p, shm, tid2, TP + (j >> 5) * 16384, 16384, (j >> 1) & 15, half);
        } else { const int j = item - N_SAMPLE_ITEMS;
            if (j & 1) scan_item<16, 2, 1>(p, shm, tid2, (j >> 5) * 2048, 2048, (j >> 1) & 15, 0); else scan_item<16, 2, 0>(p, shm, tid2, (j >> 5) * 2048, 2048, (j >> 1) & 15, 0); }
        __syncthreads();
    }
    for (;;) {
        if (tid == 0) *sItem = (int)atomicAdd(queue + 1, 1u);
        __syncthreads();
        const int u = *sItem;
        __syncthreads();
        if (u >= N_DEFER) break;
        deferred_unit(p, shm, tid, u);
    }
}


__device__ void mix_phase(const Params& p) {
    const int tidx = opaque_tid(); const int lane = tidx & 63, wave = (blockIdx.x * 512 + tidx) >> 6, nw = (gridDim.x * 512) >> 6;
    const bf16_t* zall = (const bf16_t*)(p.ws + OFF_Z);
    bf16_t* yf = (bf16_t*)p.out; const bf16_t* yb = (const bf16_t*)p.out + (size_t)T_TOK * 1024;
    const float* bonus_f = (const float*)(p.ws + OFF_BONUS); const float* bonus_b = bonus_f + (size_t)T_TOK * 16;
    bf16_t* pooled = (bf16_t*)(p.ws + OFF_POOLED); bf16_t* sg = (bf16_t*)(p.ws + OFF_SG);
    const int hL = lane >> 2;
    const int tpw = (T_TOK + nw - 1) / nw;
    for (int t = wave * tpw; t < min(T_TOK, (wave + 1) * tpw); ++t) {
        int tbase, L; seq_of(t, tbase, L); const int pos = t - tbase; const bool hasPrev = pos > 0, hasNext = pos < L - 1;
        const bf16_t* zr = zall + (size_t)t * ZLD;
        { const int c0 = lane * 16; float y[16];
          { const u32x4 a0 = *(const u32x4*)(yf + (size_t)t * 1024 + c0), a1 = *(const u32x4*)(yf + (size_t)t * 1024 + c0 + 8);
            const u32x4 b0 = *(const u32x4*)(yb + (size_t)t * 1024 + c0), b1 = *(const u32x4*)(yb + (size_t)t * 1024 + c0 + 8);
            f32x4 fa, fb, ga, gb; unpack8(a0, fa, fb); unpack8(b0, ga, gb);
#pragma unroll
            for (int j = 0; j < 4; ++j) { y[j] = fa[j] + ga[j]; y[4 + j] = fb[j] + gb[j]; }
            unpack8(a1, fa, fb); unpack8(b1, ga, gb);
#pragma unroll
            for (int j = 0; j < 4; ++j) { y[8 + j] = fa[j] + ga[j]; y[12 + j] = fb[j] + gb[j]; } }
          float sm = 0.f;
#pragma unroll
          for (int j = 0; j < 16; ++j) sm += y[j];
          const float mean = red4(sm) * (1.0f / 64.0f); float vs = 0.f;
#pragma unroll
          for (int j = 0; j < 16; ++j) { const float d = y[j] - mean; vs += d * d; }
          const float rstd = rsqrtf(red4(vs) * (1.0f / 64.0f) + 64e-5f);
          const float bon = bonus_f[(size_t)t * 16 + hL] + bonus_b[(size_t)t * 16 + hL];
          float vv[16];
          { const bf16_t* zc = zr + COL_V + c0;
            u32x4 c_[2], p_[2], n_[2];
#pragma unroll
            for (int i = 0; i < 2; ++i) { c_[i] = *(const u32x4*)(zc + 8 * i); p_[i] = hasPrev ? *(const u32x4*)(zc - ZLD + 8 * i) : (u32x4){0u, 0u, 0u, 0u}; n_[i] = hasNext ? *(const u32x4*)(zc + ZLD + 8 * i) : (u32x4){0u, 0u, 0u, 0u}; }
#pragma unroll
            for (int i = 0; i < 2; ++i) { f32x4 ca, cb, pa, pb, na, nb; unpack8(c_[i], ca, cb); unpack8(p_[i], pa, pb); unpack8(n_[i], na, nb);
                const float* mp = p.mu_prev + (COL_V - COL_R) + c0 + 8 * i; const float* mn = p.mu_next + (COL_V - COL_R) + c0 + 8 * i;
                const f32x4 mp0 = *(const f32x4*)mp, mp1 = *(const f32x4*)(mp + 4), mn0 = *(const f32x4*)mn, mn1 = *(const f32x4*)(mn + 4);
#pragma unroll
                for (int j = 0; j < 4; ++j) { vv[8 * i + j] = ca[j] + mp0[j] * (pa[j] - ca[j]) + mn0[j] * (na[j] - ca[j]); vv[8 * i + 4 + j] = cb[j] + mp1[j] * (pb[j] - cb[j]) + mn1[j] * (nb[j] - cb[j]); } } }
          float o[16];
#pragma unroll
          for (int i = 0; i < 4; ++i) { const f32x4 lw = *(const f32x4*)(p.ln_w + c0 + 4 * i), lb = *(const f32x4*)(p.ln_b + c0 + 4 * i);
#pragma unroll
              for (int j = 0; j < 4; ++j) o[4 * i + j] = (y[4 * i + j] - mean) * rstd * lw[j] + lb[j] + bon * vv[4 * i + j]; }
          u32x4 w0, w1; w0.x = pk_bf16(o[0], o[1]); w0.y = pk_bf16(o[2], o[3]); w0.z = pk_bf16(o[4], o[5]); w0.w = pk_bf16(o[6], o[7]);
          w1.x = pk_bf16(o[8], o[9]); w1.y = pk_bf16(o[10], o[11]); w1.z = pk_bf16(o[12], o[13]); w1.w = pk_bf16(o[14], o[15]);
          *(u32x4*)(yf + (size_t)t * 1024 + c0) = w0; *(u32x4*)(yf + (size_t)t * 1024 + c0 + 8) = w1; }
        { const int c = 2 * lane; const bf16_t* zc = zr + COL_G + c; const unsigned wc_ = *(const unsigned*)zc; const unsigned wp = hasPrev ? *(const unsigned*)(zc - ZLD) : 0u, wn = hasNext ? *(const unsigned*)(zc + ZLD) : 0u;
          const float mp0 = p.mu_prev[COL_G - COL_R + c], mp1 = p.mu_prev[COL_G - COL_R + c + 1], mn0 = p.mu_next[COL_G - COL_R + c], mn1 = p.mu_next[COL_G - COL_R + c + 1];
          const float c0v = bf_lo(wc_), c1v = bf_hi(wc_);
          const float z0 = c0v + mp0 * (bf_lo(wp) - c0v) + mn0 * (bf_lo(wn) - c0v), z1 = c1v + mp1 * (bf_hi(wp) - c1v) + mn1 * (bf_hi(wn) - c1v);
          *(unsigned*)(sg + (size_t)t * 256 + c) = pk_bf16(sigmoidf_(z0), sigmoidf_(z1)); *(unsigned*)(sg + (size_t)t * 256 + 128 + c) = 0u; }
        { const int c = lane * 8, gi = lane >> 4, w = 2 << gi; const int lo = max(pos - (w >> 1), 0), hi = min(pos + (w >> 1) - 1, L - 1);
          float sum[8];
#pragma unroll
          for (int j = 0; j < 8; ++j) sum[j] = 0.f;
          u32x4 wr_[16];
#pragma unroll
          for (int d = 0; d < 16; ++d) { const int r = pos - 8 + d; wr_[d] = (u32x4){0u, 0u, 0u, 0u}; if (r >= lo && r <= hi) wr_[d] = *(const u32x4*)(zall + (size_t)(tbase + r) * ZLD + c); }
#pragma unroll
          for (int d = 0; d < 16; ++d) { f32x4 a, b; unpack8(wr_[d], a, b);
#pragma unroll
              for (int j = 0; j < 4; ++j) { sum[j] += a[j]; sum[4 + j] += b[j]; } }
          const float icnt = 1.0f / (float)(hi - lo + 1); f32x4 a, b; unpack8(*(const u32x4*)(zr + c), a, b); f32x4 oa, ob;
#pragma unroll
          for (int j = 0; j < 4; ++j) { oa[j] = sum[j] * icnt - a[j]; ob[j] = sum[4 + j] * icnt - b[j]; }
          *(u32x4*)(pooled + (size_t)t * 512 + c) = pack8(oa, ob); }
    }
}

__device__ void final_phase(const Params& p) {
    const int tidx = opaque_tid(); const int lane = tidx & 63, wave = (blockIdx.x * 512 + tidx) >> 6, nw = (gridDim.x * 512) >> 6;
    const float* x2 = (const float*)(p.ws + OFF_X1); const float* rowsq2 = (const float*)(p.ws + OFF_ROWSQ2);
    f32x4 gv[4];
#pragma unroll
    for (int i = 0; i < 4; ++i) gv[i] = *(const f32x4*)(p.g_final + lane * 4 + 256 * i);
    for (int t0 = wave; t0 < T_TOK; t0 += 2 * nw) {
        const int t1 = t0 + nw < T_TOK ? t0 + nw : t0;
        const float r0 = rsqrtf(rowsq2[t0] * (1.0f / 1024.0f) + 1e-6f), r1 = rsqrtf(rowsq2[t1] * (1.0f / 1024.0f) + 1e-6f);
        f32x4 a[4], b[4];
#pragma unroll
        for (int i = 0; i < 4; ++i) { a[i] = *(const f32x4*)(x2 + (size_t)t0 * 1024 + lane * 4 + 256 * i); b[i] = *(const f32x4*)(x2 + (size_t)t1 * 1024 + lane * 4 + 256 * i); }
#pragma unroll
        for (int i = 0; i < 4; ++i) { *(f32x4*)(p.out + (size_t)t0 * 1024 + lane * 4 + 256 * i) = a[i] * r0 * gv[i]; *(f32x4*)(p.out + (size_t)t1 * 1024 + lane * 4 + 256 * i) = b[i] * r1 * gv[i]; }
    }
}

__global__ void __launch_bounds__(512, 2) fwd_megakernel(Params p) {
    extern __shared__ __attribute__((aligned(16))) unsigned char shm[];
    unsigned char* ws = p.ws;
    prep_phase(p, shm);
    cg::this_grid().sync();
    { EpiStore E; E.O = (bf16_t*)(ws + OFF_Z); E.ldc = ZLD; run_gemm(shm, (const bf16_t*)(ws + OFF_R1), 1024, (const bf16_t*)(ws + OFF_WIN), 1024, 3840, 1024, E); }
    cg::this_grid().sync();
    scan_phase(p, shm);
    cg::this_grid().sync();
    mix_phase(p);
    cg::this_grid().sync();
    rmsnorm_rows(p, p.g_mix, (bf16_t*)(ws + OFF_XN2));
    { EpiMulInPlace E; E.Y = (bf16_t*)p.out; run_gemm(shm, (const bf16_t*)(ws + OFF_SG), 256, (const bf16_t*)(ws + OFF_WG), 256, 1024, 256, E); }
    cg::this_grid().sync();
    { EpiGates E; E.G = (bf16_t*)(ws + OFF_GATES); E.bias = p.b_gate; run_gemm(shm, (const bf16_t*)(ws + OFF_XN2), 1024, (const bf16_t*)(ws + OFF_WIN) + (size_t)3840 * 1024, 1024, 2048, 1024, E); }
    cg::this_grid().sync();
    { EpiPool E; E.P = (bf16_t*)(ws + OFF_MERGED); E.G = (const bf16_t*)(ws + OFF_GATES); run_gemm(shm, (const bf16_t*)(ws + OFF_POOLED), 512, (const bf16_t*)(ws + OFF_WEFF), 512, 1024, 512, E); }
    { EpiMerge E; E.P = (bf16_t*)(ws + OFF_MERGED); E.G = (const bf16_t*)(ws + OFF_GATES); run_gemm(shm, (const bf16_t*)p.out, 1024, (const bf16_t*)(ws + OFF_WRBR), 1024, 1024, 1024, E); }
    cg::this_grid().sync();
    { EpiOut E; E.xp = p.x_prompt; E.xs = p.x_sample; E.X1 = (float*)(ws + OFF_X1); E.X1B = (bf16_t*)(ws + OFF_X1B); E.rowsq = (float*)(ws + OFF_ROWSQ); run_gemm(shm, (const bf16_t*)(ws + OFF_MERGED), 1024, (const bf16_t*)(ws + OFF_WOUT), 1024, 1024, 1024, E); }
    cg::this_grid().sync();
    { EpiFF1 E; E.Hlo = (bf16_t*)(ws + OFF_HLO); E.Hhi = (bf16_t*)p.out; E.rowsq = (const float*)(ws + OFF_ROWSQ); run_gemm(shm, (const bf16_t*)(ws + OFF_X1B), 1024, (const bf16_t*)(ws + OFF_WFF1), 1024, 4096, 1024, E); }
    cg::this_grid().sync();
    { EpiFinal E; E.X = (float*)(ws + OFF_X1); E.rowsq = (float*)(ws + OFF_ROWSQ2);
      run_gemm(shm, (const bf16_t*)(ws + OFF_HLO), 2048, (const bf16_t*)(ws + OFF_WFF2), 4096, 1024, 4096, E, (const bf16_t*)p.out, 32); }
    cg::this_grid().sync();
    final_phase(p);
}

extern "C" void kernel_launch(void* const* d_in, const int* in_sizes, int n_in, void* d_out, int out_size, void* d_ws, size_t ws_size, hipStream_t stream) {
    constexpr size_t kDynLds = 131072;
    static int grid_blocks = 0;
    if (!grid_blocks) {
        hipFuncSetAttribute((const void*)fwd_megakernel, hipFuncAttributeMaxDynamicSharedMemorySize, (int)kDynLds);
        int dev = 0, cus = 0, per_cu = 0;
        hipGetDevice(&dev);
        hipDeviceGetAttribute(&cus, hipDeviceAttributeMultiprocessorCount, dev);
        hipOccupancyMaxActiveBlocksPerMultiprocessor(&per_cu, fwd_megakernel, 512, kDynLds);
        if (per_cu < 1) per_cu = 1;
        grid_blocks = cus;
    }
    Params p{};
    const float** pf = (const float**)&p;
    for (int i = 0; i < 30; ++i) pf[i] = (const float*)d_in[i];
    p.out = (float*)d_out; p.ws = (unsigned char*)d_ws;
    void* args[] = {&p};
    hipError_t e = hipLaunchCooperativeKernel((const void*)fwd_megakernel, dim3(grid_blocks), dim3(512), args, kDynLds, stream);
    if (e != hipSuccess) fprintf(stderr, "cooperative launch failed: %s (grid %d)\n", hipGetErrorString(e), grid_blocks);
}
```

```cpp
#include <hip/hip_runtime.h>
#include <hip/hip_cooperative_groups.h>
#include <cstdio>
namespace cg = cooperative_groups;

#define LAS __attribute__((address_space(3)))
typedef unsigned short bf16_t;
typedef short bf16x8 __attribute__((ext_vector_type(8)));
typedef float f32x4 __attribute__((ext_vector_type(4)));
typedef float f32x2 __attribute__((ext_vector_type(2)));
typedef unsigned u32x4 __attribute__((ext_vector_type(4)));
typedef unsigned u32x2 __attribute__((ext_vector_type(2)));

constexpr int T_TOK = 98304, DM = 1024, TP = 65536;
constexpr int ZLD = 3840;
constexpr int COL_R = 512, COL_K = 1536, COL_V = 2560, COL_W = 3584, COL_A = 3648, COL_G = 3712;
constexpr size_t MiB = 1ull << 20;
constexpr size_t OFF_WIN = 0, OFF_WEFF = 12 * MiB, OFF_WRBR = 13 * MiB, OFF_WOUT = 15 * MiB, OFF_WFF1 = 17 * MiB, OFF_WFF2 = 25 * MiB, OFF_WG = 33 * MiB;
constexpr size_t OFF_ROWSQ = 34 * MiB, OFF_ROWSQ2 = 34 * MiB + 512 * 1024, OFF_QUEUE = 35 * MiB, OFF_BONUS = 36 * MiB;
constexpr size_t OFF_R1 = 48 * MiB, OFF_Z = 240 * MiB;
constexpr size_t OFF_POOLED = OFF_R1, OFF_SG = OFF_R1 + 96 * MiB, OFF_XN2 = OFF_Z, OFF_GATES = OFF_Z + 192 * MiB, OFF_MERGED = OFF_Z + 576 * MiB;
constexpr size_t OFF_X1B = OFF_R1, OFF_X1 = OFF_Z, OFF_HLO = OFF_Z + 384 * MiB;
constexpr size_t U_BYTES = (size_t)T_TOK * 1024 * 2;

struct Params {
    const float *x_prompt, *x_sample, *g_mix, *w_in, *b_gate, *mu_prev, *mu_next, *pool_w, *pool_scale, *w_pool_br, *k_k, *k_a, *r_k,
        *w0_f, *w_up_f, *a0_f, *a_up_f, *w0_b, *w_up_b, *a0_b, *a_up_b, *g_up, *ln_w, *ln_b, *w_rwkv_br, *w_out, *g_ffn, *w_ff1, *w_ff2, *g_final;
    float* out; unsigned char* ws;
};

__device__ __forceinline__ float bf_lo(unsigned w) { return __uint_as_float(w << 16); }
__device__ __forceinline__ float bf_hi(unsigned w) { return __uint_as_float(w & 0xFFFF0000u); }
typedef __bf16 bf16x2_t __attribute__((ext_vector_type(2)));
__device__ __forceinline__ unsigned pk_bf16(float lo, float hi) { f32x2 v = {lo, hi}; bf16x2_t b = __builtin_convertvector(v, bf16x2_t); return __builtin_bit_cast(unsigned, b); }
__device__ __forceinline__ float fexp2_scaled(float x, float scale_log2e) { return __builtin_amdgcn_exp2f(x * scale_log2e); }
__device__ __forceinline__ float sigmoidf_(float x) { return __builtin_amdgcn_rcpf(1.0f + fexp2_scaled(x, -1.4426950409f)); }
__device__ __forceinline__ float fma_s(float a, float b, float c) { float d; asm("v_fma_f32 %0, %1, %2, %3" : "=v"(d) : "v"(a), "v"(b), "v"(c)); return d; }
__device__ __forceinline__ float mul_s(float a, float b) { float d; asm("v_mul_f32 %0, %1, %2" : "=v"(d) : "v"(a), "v"(b)); return d; }
__device__ __forceinline__ float add_s(float a, float b) { float d; asm("v_add_f32 %0, %1, %2" : "=v"(d) : "v"(a), "v"(b)); return d; }
#define DPPA(x, c) "v_add_f32_dpp " x ", " x ", " x " " c " row_mask:0xf bank_mask:0xf bound_ctrl:1\n"
#define DPP4(c) DPPA("%0", c) DPPA("%1", c) DPPA("%2", c) DPPA("%3", c)
#define DPP2(c) DPPA("%0", c) DPPA("%1", c) "s_nop 0\n"
__device__ __forceinline__ void red16x4(float& a, float& b, float& c, float& d) {
    asm("s_nop 1\n" DPP4("quad_perm:[1,0,3,2]") DPP4("quad_perm:[2,3,0,1]") DPP4("row_half_mirror") DPP4("row_mirror") : "+v"(a), "+v"(b), "+v"(c), "+v"(d)); }
__device__ __forceinline__ void red16x2(float& a, float& b) {
    asm("s_nop 1\n" DPP2("quad_perm:[1,0,3,2]") DPP2("quad_perm:[2,3,0,1]") DPP2("row_half_mirror") DPP2("row_mirror") : "+v"(a), "+v"(b)); }
__device__ __forceinline__ void row_dots(const float (&s)[4], const f32x4 a, const f32x4 q, float& sa, float& yp) {
    asm("v_mul_f32 %0, %2, %6\n v_mul_f32 %1, %2, %10\n v_fmac_f32 %0, %3, %7\n v_fmac_f32 %1, %3, %11\n v_fmac_f32 %0, %4, %8\n v_fmac_f32 %1, %4, %12\n v_fmac_f32 %0, %5, %9\n v_fmac_f32 %1, %5, %13"
        : "=&v"(sa), "=&v"(yp) : "v"(s[0]), "v"(s[1]), "v"(s[2]), "v"(s[3]), "v"(a[0]), "v"(a[1]), "v"(a[2]), "v"(a[3]), "v"(q[0]), "v"(q[1]), "v"(q[2]), "v"(q[3])); }
__device__ __forceinline__ void row_update(float (&s)[4], const f32x4 w, const f32x4 b, const f32x4 k, float v, float sa, float yp, float bkx, float bky, float& y) {
    float t0, t1, t2, t3;
    asm("v_mul_f32 %0, %6, %15\n v_mul_f32 %1, %6, %16\n v_mul_f32 %2, %6, %17\n v_mul_f32 %3, %6, %18\n"
        "v_fmac_f32 %4, %7, %5\n"
        "v_fmac_f32 %0, %7, %11\n v_fmac_f32 %1, %7, %12\n v_fmac_f32 %2, %7, %13\n v_fmac_f32 %3, %7, %14\n"
        "v_fmac_f32 %4, %6, %8\n"
        "v_fmac_f32 %0, %9, %19\n v_fmac_f32 %1, %10, %20\n v_fmac_f32 %2, %23, %21\n v_fmac_f32 %3, %24, %22"
        : "=&v"(t0), "=&v"(t1), "=&v"(t2), "=&v"(t3), "+v"(yp)
        : "v"(bkx), "v"(v), "v"(sa), "v"(bky), "v"(s[0]), "v"(s[1]), "v"(b[0]), "v"(b[1]), "v"(b[2]), "v"(b[3]), "v"(k[0]), "v"(k[1]), "v"(k[2]), "v"(k[3]), "v"(w[0]), "v"(w[1]), "v"(w[2]), "v"(w[3]), "v"(s[2]), "v"(s[3]));
    s[0] = t0; s[1] = t1; s[2] = t2; s[3] = t3; y = yp; }
__device__ __forceinline__ void shift4(float (&z)[4], const float (&c)[4], const float (&pv)[4], const float (&nx)[4], const f32x4 m0, const f32x4 mp, const f32x4 mn) {
    asm("v_mul_f32 %0, %4, %16\n v_mul_f32 %1, %5, %17\n v_mul_f32 %2, %6, %18\n v_mul_f32 %3, %7, %19\n"
        "v_fma_f32 %0, %8, %20, %0\n v_fma_f32 %1, %9, %21, %1\n v_fma_f32 %2, %10, %22, %2\n v_fma_f32 %3, %11, %23, %3\n"
        "v_fma_f32 %0, %12, %24, %0\n v_fma_f32 %1, %13, %25, %1\n v_fma_f32 %2, %14, %26, %2\n v_fma_f32 %3, %15, %27, %3"
        : "=&v"(z[0]), "=&v"(z[1]), "=&v"(z[2]), "=&v"(z[3])
        : "v"(c[0]), "v"(c[1]), "v"(c[2]), "v"(c[3]), "v"(pv[0]), "v"(pv[1]), "v"(pv[2]), "v"(pv[3]), "v"(nx[0]), "v"(nx[1]), "v"(nx[2]), "v"(nx[3]),
          "v"(m0[0]), "v"(m0[1]), "v"(m0[2]), "v"(m0[3]), "v"(mp[0]), "v"(mp[1]), "v"(mp[2]), "v"(mp[3]), "v"(mn[0]), "v"(mn[1]), "v"(mn[2]), "v"(mn[3])); }
__device__ __forceinline__ void kk4(float (&kk)[4], float& ss, const float (&k)[4], const f32x4 c) {
    asm("v_mul_f32 %0, %5, %9\n v_mul_f32 %1, %6, %10\n v_mul_f32 %2, %7, %11\n v_mul_f32 %3, %8, %12\n"
        "v_mul_f32 %4, %0, %0\n v_fma_f32 %4, %1, %1, %4\n v_fma_f32 %4, %2, %2, %4\n v_fma_f32 %4, %3, %3, %4"
        : "=&v"(kk[0]), "=&v"(kk[1]), "=&v"(kk[2]), "=&v"(kk[3]), "=&v"(ss) : "v"(k[0]), "v"(k[1]), "v"(k[2]), "v"(k[3]), "v"(c[0]), "v"(c[1]), "v"(c[2]), "v"(c[3])); }
__device__ __forceinline__ void row_update2(float (&s)[4], const f32x4 w, const f32x4 b, const f32x4 k, float v, float vkr, float sa, float yp, float& y) {
    float t0, t1, t2, t3;
    asm("v_mul_f32 %0, %6, %14\n v_mul_f32 %1, %6, %15\n v_mul_f32 %2, %6, %16\n v_mul_f32 %3, %6, %17\n"
        "v_add_f32 %4, %4, %5\n"
        "v_fmac_f32 %0, %7, %10\n v_fmac_f32 %1, %7, %11\n v_fmac_f32 %2, %7, %12\n v_fmac_f32 %3, %7, %13\n"
        "v_fmac_f32 %0, %8, %18\n v_fmac_f32 %1, %9, %19\n v_fmac_f32 %2, %22, %20\n v_fmac_f32 %3, %23, %21"
        : "=&v"(t0), "=&v"(t1), "=&v"(t2), "=&v"(t3), "+v"(yp)
        : "v"(vkr), "v"(v), "v"(sa), "v"(s[0]), "v"(s[1]), "v"(b[0]), "v"(b[1]), "v"(b[2]), "v"(b[3]), "v"(k[0]), "v"(k[1]), "v"(k[2]), "v"(k[3]), "v"(w[0]), "v"(w[1]), "v"(w[2]), "v"(w[3]), "v"(s[2]), "v"(s[3]));
    s[0] = t0; s[1] = t1; s[2] = t2; s[3] = t3; y = yp; }
__device__ __forceinline__ void row_update3(float (&s)[4], const f32x4 w, const f32x4 b, const f32x4 k, float v, float sa) {
    float t0, t1, t2, t3;
    asm("v_mul_f32 %0, %4, %12\n v_mul_f32 %1, %4, %13\n v_mul_f32 %2, %4, %14\n v_mul_f32 %3, %4, %15\n"
        "v_fmac_f32 %0, %5, %8\n v_fmac_f32 %1, %5, %9\n v_fmac_f32 %2, %5, %10\n v_fmac_f32 %3, %5, %11\n"
        "v_fmac_f32 %0, %6, %16\n v_fmac_f32 %1, %7, %17\n v_fmac_f32 %2, %20, %18\n v_fmac_f32 %3, %21, %19"
        : "=&v"(t0), "=&v"(t1), "=&v"(t2), "=&v"(t3)
        : "v"(v), "v"(sa), "v"(s[0]), "v"(s[1]), "v"(b[0]), "v"(b[1]), "v"(b[2]), "v"(b[3]), "v"(k[0]), "v"(k[1]), "v"(k[2]), "v"(k[3]), "v"(w[0]), "v"(w[1]), "v"(w[2]), "v"(w[3]), "v"(s[2]), "v"(s[3]));
    s[0] = t0; s[1] = t1; s[2] = t2; s[3] = t3; }
template <int CTRL> __device__ __forceinline__ float dppf(float x) { return __int_as_float(__builtin_amdgcn_update_dpp(0, __float_as_int(x), CTRL, 0xF, 0xF, true)); }
__device__ __forceinline__ float red4(float x) { x += dppf<0xB1>(x); x += dppf<0x4E>(x); return x; }
__device__ __forceinline__ float red8(float x) { x = red4(x); x += dppf<0x141>(x); return x; }
__device__ __forceinline__ float red16(float x) { x = red8(x); x += dppf<0x140>(x); return x; }
__device__ __forceinline__ int opaque_tid() { int t = threadIdx.x; asm volatile("" : "+v"(t)); return t; }
__device__ __forceinline__ const float* xrow(const Params& p, int t) { return t < TP ? p.x_prompt + (size_t)t * DM : p.x_sample + (size_t)(t - TP) * DM; }
__device__ __forceinline__ void seq_of(int t, int& base, int& len) { if (t < TP) { base = t & ~2047; len = 2048; } else { base = TP + ((t - TP) & ~16383); len = 16384; } }

namespace pg8 {
constexpr int BM = 256, BK = 64, HALF = 128, HTB = HALF * BK * 2, STAGE_BYTES = 8 * HTB, NXCD = 8, WGM = 8;
__device__ __forceinline__ int lds_byte(int r, int c) { const int st = (r >> 4) * 2 + (c >> 5), rr = r & 15, cc = c & 31, ob = rr * 64 + cc * 2; return st * 1024 + (ob ^ (((ob >> 9) & 1) << 5)); }
__device__ __forceinline__ void stage_rc(int b, int& R, int& C) { const int st = b / 1024, sb = b % 1024, swz = sb ^ (((sb >> 9) & 1) << 5); R = (st >> 1) * 16 + swz / 64; C = (st & 1) * 32 + (swz % 64) / 2; }
__device__ __forceinline__ int perm32(int rho) { const int n = rho >> 4, i = rho & 15; return 8 * (i >> 2) + 4 * n + (i & 3); }
struct Unit { int pm, pn; };
struct Gemm { const bf16_t* A; const bf16_t* Bt; int M, N, K, lda, ldb; const bf16_t* A2; int ks; };
struct StaticOrder {
    int nM, nN, nwg, G, c;
    __device__ void init(int M, int N, int G_, int c_) { nM = M / BM; nN = N / BM; nwg = nM * nN; G = G_; c = c_; }
    __device__ bool next(int i, Unit& u) const {
        const long L = (long)i * G + c; if (L >= nwg) return false;
        int wgid = (int)L; { const int q = nwg / NXCD, r = nwg % NXCD, xcd = wgid % NXCD, off = wgid / NXCD; wgid = (xcd < r ? xcd * (q + 1) : r * (q + 1) + (xcd - r) * q) + off; }
        const int nig = WGM * nN, gid = wgid / nig, fm = gid * WGM, gsz = (nM - fm) < WGM ? (nM - fm) : WGM;
        u.pm = fm + ((wgid % nig) % gsz); u.pn = (wgid % nig) / gsz; return true;
    }
};

template <class Epi>
__device__ __forceinline__ void gemm_phase(LAS unsigned char* lds, const Gemm g, const StaticOrder& S, const Epi& E) {
    const int tid = opaque_tid();
    const int wid = __builtin_amdgcn_readfirstlane(tid >> 6), lane = tid & 63, wr = wid >> 2, wc = wid & 3, fr = lane & 15, fq = lane >> 4;
    const int K = g.K, nt = K / BK;
    unsigned voffA[2], voffB[2];
#pragma unroll
    for (int i = 0; i < 2; ++i) { int R, C; stage_rc(tid * 16 + i * 8192, R, C); const int Rb = (R & ~31) + perm32(R & 31);
        voffA[i] = (unsigned)(R * g.lda + C) * 2u; voffB[i] = (unsigned)(Rb * g.ldb + C) * 2u; }
    const size_t kstep = (size_t)(BK * 2);
    const size_t hstepA = (size_t)HALF * g.lda * 2, hstepB = (size_t)HALF * g.ldb * 2;
    const size_t tstepA = 2 * hstepA, tstepB = 2 * hstepB;
    const unsigned ldsw = (unsigned)wid * 1024u;
    const int aoff = lds_byte(wr * 64 + fr, fq * 8), boff = lds_byte(wc * 32 + fr, fq * 8);
#define PG8_SA(b, h) (((b) * 2 + (h)) * HTB)
#define PG8_SB(b, h) ((4 + (b) * 2 + (h)) * HTB)
#define PG8_STAGE(bufoff, gbase, voff) do { _Pragma("unroll") for (int _i = 0; _i < 2; ++_i) \
        __builtin_amdgcn_global_load_lds((const unsigned*)((const char*)(gbase) + (voff)[_i]), (LAS unsigned*)(lds + (bufoff) + ldsw + _i * 8192), 16, 0, 0); } while (0)
#define PG8_LDA(dst, b, h) do { _Pragma("unroll") for (int m = 0; m < 4; ++m) _Pragma("unroll") for (int k = 0; k < 2; ++k) dst[m][k] = *(const LAS bf16x8*)(lds + PG8_SA(b, h) + aoff + m * 2048 + k * 1024); } while (0)
#define PG8_LDB(dst, b, h) do { _Pragma("unroll") for (int n = 0; n < 2; ++n) _Pragma("unroll") for (int k = 0; k < 2; ++k) dst[n][k] = *(const LAS bf16x8*)(lds + PG8_SB(b, h) + boff + n * 2048 + k * 1024); } while (0)
#define PG8_MMA(ai, bj, At, Bt) do { __builtin_amdgcn_s_setprio(1); _Pragma("unroll") for (int m = 0; m < 4; ++m) _Pragma("unroll") for (int n = 0; n < 2; ++n) _Pragma("unroll") for (int k = 0; k < 2; ++k) \
        acc[ai][bj][m][n] = __builtin_amdgcn_mfma_f32_16x16x32_bf16(Bt[n][k], At[m][k], acc[ai][bj][m][n], 0, 0, 0); __builtin_amdgcn_s_setprio(0); } while (0)
#define PG8_WAIT_V(n) asm volatile("s_waitcnt vmcnt(" #n ")" ::: "memory")
#define PG8_WAIT_L(n) asm volatile("s_waitcnt lgkmcnt(" #n ")" ::: "memory")
#define PG8_BAR __builtin_amdgcn_s_barrier()
#define PG8_SCHED __builtin_amdgcn_sched_barrier(0)
    Unit cur, nxt; int ui = 0;
    if (!S.next(0, cur)) return;
    f32x4 acc[2][2][4][2];
#pragma unroll
    for (int a = 0; a < 2; ++a)
#pragma unroll
        for (int b = 0; b < 2; ++b)
#pragma unroll
            for (int m = 0; m < 4; ++m)
#pragma unroll
                for (int n = 0; n < 2; ++n) acc[a][b][m][n] = (f32x4){0.f, 0.f, 0.f, 0.f};
    bf16x8 At[4][2], B0[2][2], B1[2][2];
    const char* cA = (const char*)g.A + (size_t)cur.pm * tstepA; const char* cB = (const char*)g.Bt + (size_t)cur.pn * tstepB;
    const bool two = g.A2 != nullptr; const int ks = two ? g.ks : (1 << 30);
    const char* cA2 = two ? (const char*)g.A2 + (size_t)cur.pm * tstepA : cA;
    PG8_STAGE(PG8_SB(0, 0), cB, voffB); PG8_STAGE(PG8_SA(0, 0), cA, voffA); PG8_STAGE(PG8_SB(0, 1), cB + hstepB, voffB); PG8_STAGE(PG8_SA(0, 1), cA + hstepA, voffA);
    if (wr == 1) PG8_BAR;
    PG8_WAIT_V(4); PG8_BAR;
    PG8_STAGE(PG8_SB(1, 0), cB + kstep, voffB); PG8_STAGE(PG8_SA(1, 0), cA + kstep, voffA); PG8_STAGE(PG8_SB(1, 1), cB + hstepB + kstep, voffB);
    PG8_WAIT_V(6); PG8_BAR;
    for (;;) {
        const bool has_next = S.next(ui + 1, nxt);
        const char* nA = has_next ? (const char*)g.A + (size_t)nxt.pm * tstepA : cA; const char* nB = has_next ? (const char*)g.Bt + (size_t)nxt.pn * tstepB : cB;
        const char* nA2 = (two && has_next) ? (const char*)g.A2 + (size_t)nxt.pm * tstepA : cA2;
#pragma unroll 1
        for (int t = 0; t < nt; t += 2) {
            const bool last = (t == nt - 2);
            const char* a1 = (t + 1 < ks) ? cA + (size_t)(t + 1) * kstep : cA2 + (size_t)(t + 1 - ks) * kstep;
            const char* a2 = last ? nA : ((t + 2 < ks) ? cA + (size_t)(t + 2) * kstep : cA2 + (size_t)(t + 2 - ks) * kstep); const char* b2 = last ? nB : cB + (size_t)(t + 2) * kstep;
            const char* a3 = a2 + kstep; const char* b3 = b2 + kstep;
            PG8_LDB(B0, 0, 0); PG8_SCHED; PG8_LDA(At, 0, 0); PG8_STAGE(PG8_SA(1, 1), a1 + hstepA, voffA);
            PG8_WAIT_L(8); PG8_BAR; PG8_WAIT_L(0); PG8_MMA(0, 0, At, B0); PG8_BAR; PG8_SCHED;
            PG8_LDB(B1, 0, 1); PG8_STAGE(PG8_SB(0, 0), b2, voffB);
            PG8_BAR; PG8_WAIT_L(0); PG8_MMA(0, 1, At, B1); PG8_BAR;
            PG8_LDA(At, 0, 1); PG8_STAGE(PG8_SA(0, 0), a2, voffA);
            PG8_BAR; PG8_WAIT_L(0); PG8_MMA(1, 0, At, B0); PG8_BAR; PG8_SCHED;
            PG8_STAGE(PG8_SB(0, 1), b2 + hstepB, voffB);
            PG8_WAIT_V(6); PG8_BAR; PG8_MMA(1, 1, At, B1); PG8_BAR;
            PG8_LDB(B0, 1, 0); PG8_SCHED; PG8_LDA(At, 1, 0); PG8_STAGE(PG8_SA(0, 1), a2 + hstepA, voffA);
            PG8_WAIT_L(8); PG8_BAR; PG8_WAIT_L(0); PG8_MMA(0, 0, At, B0); PG8_BAR; PG8_SCHED;
            PG8_LDB(B1, 1, 1); PG8_STAGE(PG8_SB(1, 0), b3, voffB);
            PG8_BAR; PG8_WAIT_L(0); PG8_MMA(0, 1, At, B1); PG8_BAR;
            PG8_LDA(At, 1, 1); PG8_STAGE(PG8_SA(1, 0), a3, voffA);
            PG8_BAR; PG8_WAIT_L(0); PG8_MMA(1, 0, At, B0); PG8_BAR; PG8_SCHED;
            PG8_STAGE(PG8_SB(1, 1), b3 + hstepB, voffB);
            PG8_WAIT_V(6); PG8_BAR; PG8_MMA(1, 1, At, B1); PG8_BAR;
        }
        E(acc, cur, wr, wc, fr, fq);
        if (!has_next) break;
#pragma unroll
        for (int a = 0; a < 2; ++a)
#pragma unroll
            for (int b = 0; b < 2; ++b)
#pragma unroll
                for (int m = 0; m < 4; ++m)
#pragma unroll
                    for (int n = 0; n < 2; ++n) acc[a][b][m][n] = (f32x4){0.f, 0.f, 0.f, 0.f};
        cur = nxt; cA = nA; cA2 = nA2; cB = nB; ++ui;
    }
    PG8_WAIT_V(0);
    if (wr == 0) PG8_BAR;
    PG8_BAR;
#undef PG8_SA
#undef PG8_SB
#undef PG8_STAGE
#undef PG8_LDA
#undef PG8_LDB
#undef PG8_MMA
#undef PG8_WAIT_V
#undef PG8_WAIT_L
#undef PG8_BAR
#undef PG8_SCHED
}
}
using pg8::Unit;

#define EPI_LOOP_BEGIN const int row0 = u.pm * 256 + wr * 64 + fr, col0 = u.pn * 256 + wc * 32 + 8 * fq; \
    _Pragma("unroll") for (int ai = 0; ai < 2; ++ai) _Pragma("unroll") for (int m = 0; m < 4; ++m) { const int row = row0 + ai * 128 + m * 16;
#define EPI_BJ _Pragma("unroll") for (int bj = 0; bj < 2; ++bj) { const int col = col0 + bj * 128; const f32x4 v0 = acc[ai][bj][m][0], v1 = acc[ai][bj][m][1];
#define EPI_ACC const f32x4 (&acc)[2][2][4][2], const Unit& u, int wr, int wc, int fr, int fq

__device__ __forceinline__ u32x4 pack8(const f32x4 a, const f32x4 b) { u32x4 w; w.x = pk_bf16(a[0], a[1]); w.y = pk_bf16(a[2], a[3]); w.z = pk_bf16(b[0], b[1]); w.w = pk_bf16(b[2], b[3]); return w; }
__device__ __forceinline__ void unpack8(const u32x4 w, f32x4& a, f32x4& b) { a = (f32x4){bf_lo(w.x), bf_hi(w.x), bf_lo(w.y), bf_hi(w.y)}; b = (f32x4){bf_lo(w.z), bf_hi(w.z), bf_lo(w.w), bf_hi(w.w)}; }

struct EpiStore {
    bf16_t* O; int ldc;
    __device__ __forceinline__ void operator()(EPI_ACC) const { EPI_LOOP_BEGIN EPI_BJ *(u32x4*)(O + (size_t)row * ldc + col) = pack8(v0, v1); } } }
};
struct EpiMulInPlace {
    bf16_t* Y;
    __device__ __forceinline__ void operator()(EPI_ACC) const { EPI_LOOP_BEGIN if ((m & 1) == 0) __builtin_amdgcn_sched_barrier(0);
        EPI_BJ u32x4* ptr = (u32x4*)(Y + (size_t)row * 1024 + col); f32x4 a, b; unpack8(*ptr, a, b); *ptr = pack8(a * v0, b * v1); } } }
};
struct EpiGates {
    bf16_t* G; const float* bias;
    __device__ __forceinline__ void operator()(EPI_ACC) const { EPI_LOOP_BEGIN EPI_BJ
        const f32x4 b0 = *(const f32x4*)(bias + col), b1 = *(const f32x4*)(bias + col + 4); f32x4 a, b;
#pragma unroll
        for (int j = 0; j < 4; ++j) { a[j] = sigmoidf_(v0[j] + b0[j]); b[j] = sigmoidf_(v1[j] + b1[j]); }
        *(u32x4*)(G + (size_t)row * 2048 + col) = pack8(a, b); } } }
};
struct EpiPool {
    bf16_t* P; const bf16_t* G;
    __device__ __forceinline__ void operator()(EPI_ACC) const { EPI_LOOP_BEGIN EPI_BJ f32x4 a, b; unpack8(*(const u32x4*)(G + (size_t)row * 2048 + col), a, b);
        *(u32x4*)(P + (size_t)row * 1024 + col) = pack8(a * v0, b * v1); } } }
};
struct EpiMerge {
    bf16_t* P; const bf16_t* G;
    __device__ __forceinline__ void operator()(EPI_ACC) const { EPI_LOOP_BEGIN EPI_BJ f32x4 a, b, pa, pb; unpack8(*(const u32x4*)(G + (size_t)row * 2048 + 1024 + col), a, b);
        u32x4* ptr = (u32x4*)(P + (size_t)row * 1024 + col); unpack8(*ptr, pa, pb); *ptr = pack8(pa + a * v0, pb + b * v1); } } }
};
struct EpiOut {
    const float* xp; const float* xs; float* X1; bf16_t* X1B; float* rowsq;
    __device__ __forceinline__ void operator()(EPI_ACC) const { EPI_LOOP_BEGIN const float* xr = row < TP ? xp + (size_t)row * DM : xs + (size_t)(row - TP) * DM; float ss = 0.f; EPI_BJ
        f32x4 a = *(const f32x4*)(xr + col) + v0, b = *(const f32x4*)(xr + col + 4) + v1;
        *(f32x4*)(X1 + (size_t)row * 1024 + col) = a; *(f32x4*)(X1 + (size_t)row * 1024 + col + 4) = b; *(u32x4*)(X1B + (size_t)row * 1024 + col) = pack8(a, b);
#pragma unroll
        for (int j = 0; j < 4; ++j) ss += a[j] * a[j] + b[j] * b[j]; }
        ss += __shfl_xor(ss, 16); ss += __shfl_xor(ss, 32); if (fq == 0) atomicAdd(rowsq + row, ss); } }
};
struct EpiFF1 {
    bf16_t* Hlo; bf16_t* Hhi; const float* rowsq;
    __device__ __forceinline__ void operator()(EPI_ACC) const { bf16_t* H = u.pn < 8 ? Hlo : Hhi; const int cshift = u.pn < 8 ? 0 : 2048;
        EPI_LOOP_BEGIN const float rinv = rsqrtf(rowsq[row] * (1.0f / 1024.0f) + 1e-6f); EPI_BJ f32x4 a, b;
#pragma unroll
        for (int j = 0; j < 4; ++j) { float t0 = fmaxf(v0[j] * rinv, 0.f), t1 = fmaxf(v1[j] * rinv, 0.f); a[j] = t0 * t0; b[j] = t1 * t1; }
        *(u32x4*)(H + (size_t)row * 2048 + (col - cshift)) = pack8(a, b); } } }
};
struct EpiAddInPlace {
    float* X;
    __device__ __forceinline__ void operator()(EPI_ACC) const { EPI_LOOP_BEGIN EPI_BJ f32x4* ptr = (f32x4*)(X + (size_t)row * 1024 + col); ptr[0] = ptr[0] + v0; ptr[1] = ptr[1] + v1; } } }
};
struct EpiFinal {
    float* X; float* rowsq;
    __device__ __forceinline__ void operator()(EPI_ACC) const { EPI_LOOP_BEGIN float ss = 0.f; EPI_BJ f32x4* ptr = (f32x4*)(X + (size_t)row * 1024 + col); const f32x4 a = ptr[0] + v0, b = ptr[1] + v1; ptr[0] = a; ptr[1] = b;
#pragma unroll
        for (int j = 0; j < 4; ++j) ss += a[j] * a[j] + b[j] * b[j]; }
        ss += __shfl_xor(ss, 16); ss += __shfl_xor(ss, 32); if (fq == 0) atomicAdd(rowsq + row, ss); } }
};

template <class Epi>
__device__ __forceinline__ void run_gemm(unsigned char* shm, const bf16_t* A, int lda, const bf16_t* Bt, int ldb, int N, int K, const Epi& E, const bf16_t* A2 = nullptr, int ks = 0) {
    pg8::Gemm g; g.A = A; g.Bt = Bt; g.M = T_TOK; g.N = N; g.K = K; g.lda = lda; g.ldb = ldb; g.A2 = A2; g.ks = ks;
    pg8::StaticOrder S; S.init(T_TOK, N, (int)gridDim.x, (int)blockIdx.x);
    pg8::gemm_phase<Epi>((LAS unsigned char*)shm, g, S, E);
}

__device__ __forceinline__ void transpose_tile(float* tile, int tid, const float* src, int N, bf16_t* dst, int ldd, const float* kscale, int t) {
    const int ntn = N / 64, tk = t / ntn, tn = t % ntn;
#pragma unroll
    for (int i = 0; i < 8; ++i) { const int kl = (tid >> 6) + 8 * i, nl = tid & 63; const int k = tk * 64 + kl;
        tile[kl * 65 + nl] = src[(size_t)k * N + tn * 64 + nl] * (kscale ? kscale[k] : 1.0f); }
    __syncthreads();
#pragma unroll
    for (int i = 0; i < 8; ++i) { const int nl = (tid >> 6) + 8 * i, kl = tid & 63;
        const unsigned w = pk_bf16(tile[kl * 65 + nl], 0.f); dst[(size_t)(tn * 64 + nl) * ldd + tk * 64 + kl] = (bf16_t)(w & 0xFFFFu); }
    __syncthreads();
}
__device__ void transpose_cvt(unsigned char* shm, const float* src, int K, int N, bf16_t* dst, int ldd, const float* kscale) {
    float* tile = (float*)shm;
    const int tid = opaque_tid(), ntk = K / 64, ntn = N / 64;
    for (int t = blockIdx.x; t < ntk * ntn; t += gridDim.x) transpose_tile(tile, tid, src, N, dst, ldd, kscale, t);
}
constexpr int DU_RBR = 256, DU_OUT = 512, DU_FF1 = 1536, DU_FF2 = 2560, DU_G = 2592, DU_GZ = 2624, N_DEFER = 2624 + 256;
__device__ void deferred_unit(const Params& p, unsigned char* shm, int tid, int u) {
    unsigned char* ws = p.ws; float* tile = (float*)shm;
    if (u < DU_RBR) transpose_tile(tile, tid, p.w_rwkv_br, 1024, (bf16_t*)(ws + OFF_WRBR), 1024, nullptr, u);
    else if (u < DU_OUT) transpose_tile(tile, tid, p.w_out, 1024, (bf16_t*)(ws + OFF_WOUT), 1024, nullptr, u - DU_RBR);
    else if (u < DU_FF1) transpose_tile(tile, tid, p.w_ff1, 4096, (bf16_t*)(ws + OFF_WFF1), 1024, p.g_ffn, u - DU_OUT);
    else if (u < DU_FF2) transpose_tile(tile, tid, p.w_ff2, 1024, (bf16_t*)(ws + OFF_WFF2), 4096, nullptr, u - DU_FF1);
    else if (u < DU_G) transpose_tile(tile, tid, p.g_up, 1024, (bf16_t*)(ws + OFF_WG), 256, nullptr, u - DU_FF2);
    else if (u < DU_GZ) { bf16_t* wg = (bf16_t*)(ws + OFF_WG);
#pragma unroll
        for (int m = 0; m < 8; ++m) { const int i = (u - DU_G) * 4096 + m * 512 + tid; wg[(size_t)(i >> 7) * 256 + 128 + (i & 127)] = 0; } }
    else {
        bf16_t* we = (bf16_t*)(ws + OFF_WEFF); const int base = (u - DU_GZ) * 2048; float acc[4] = {0.f, 0.f, 0.f, 0.f};
        const int gI = (base >> 10) >> 7;
        for (int d = 0; d < 128; ++d) { const float sc = p.pool_scale[gI * 128 + d];
#pragma unroll
            for (int m = 0; m < 4; ++m) { const int i = base + m * 512 + tid, k = i >> 10, n = i & 1023;
                acc[m] += p.pool_w[(size_t)k * 128 + d] * sc * p.w_pool_br[(size_t)(gI * 128 + d) * 1024 + n]; } }
#pragma unroll
        for (int m = 0; m < 4; ++m) { const int i = base + m * 512 + tid, k = i >> 10, n = i & 1023; we[(size_t)n * 512 + k] = (bf16_t)(pk_bf16(acc[m], 0.f) & 0xFFFFu); } }
}
__device__ void rmsnorm_rows(const Params& p, const float* g, bf16_t* dst) {
    const int tidx = opaque_tid(); const int lane = tidx & 63, wave = (blockIdx.x * 512 + tidx) >> 6, nw = (gridDim.x * 512) >> 6;
    f32x4 gv[4];
#pragma unroll
    for (int i = 0; i < 4; ++i) gv[i] = *(const f32x4*)(g + lane * 4 + 256 * i);
    for (int t0 = wave; t0 < T_TOK; t0 += 2 * nw) {
        const int t1 = t0 + nw; const bool has1 = t1 < T_TOK;
        const float* xr0 = xrow(p, t0); const float* xr1 = xrow(p, has1 ? t1 : t0); f32x4 v0[4], v1[4]; float ss0 = 0.f, ss1 = 0.f;
#pragma unroll
        for (int i = 0; i < 4; ++i) { v0[i] = *(const f32x4*)(xr0 + lane * 4 + 256 * i); v1[i] = *(const f32x4*)(xr1 + lane * 4 + 256 * i); }
#pragma unroll
        for (int i = 0; i < 4; ++i) { ss0 += v0[i][0] * v0[i][0] + v0[i][1] * v0[i][1] + v0[i][2] * v0[i][2] + v0[i][3] * v0[i][3]; ss1 += v1[i][0] * v1[i][0] + v1[i][1] * v1[i][1] + v1[i][2] * v1[i][2] + v1[i][3] * v1[i][3]; }
#pragma unroll
        for (int o = 1; o < 64; o <<= 1) { ss0 += __shfl_xor(ss0, o); ss1 += __shfl_xor(ss1, o); }
        const float r0 = rsqrtf(ss0 * (1.0f / 1024.0f) + 1e-6f), r1 = rsqrtf(ss1 * (1.0f / 1024.0f) + 1e-6f);
#pragma unroll
        for (int i = 0; i < 4; ++i) { u32x2 w; w.x = pk_bf16(v0[i][0] * r0 * gv[i][0], v0[i][1] * r0 * gv[i][1]); w.y = pk_bf16(v0[i][2] * r0 * gv[i][2], v0[i][3] * r0 * gv[i][3]);
            *(u32x2*)(dst + (size_t)t0 * 1024 + lane * 4 + 256 * i) = w; }
        if (has1) {
#pragma unroll
            for (int i = 0; i < 4; ++i) { u32x2 w; w.x = pk_bf16(v1[i][0] * r1 * gv[i][0], v1[i][1] * r1 * gv[i][1]); w.y = pk_bf16(v1[i][2] * r1 * gv[i][2], v1[i][3] * r1 * gv[i][3]);
                *(u32x2*)(dst + (size_t)t1 * 1024 + lane * 4 + 256 * i) = w; } }
    }
}

__device__ void prep_phase(const Params& p, unsigned char* shm) {
    unsigned char* ws = p.ws;
    const int gtid = blockIdx.x * 512 + opaque_tid(), gn = gridDim.x * 512;
    for (int i = gtid; i < T_TOK; i += gn) { ((float*)(ws + OFF_ROWSQ))[i] = 0.f; ((float*)(ws + OFF_ROWSQ2))[i] = 0.f; }
    if (gtid < 64) ((unsigned*)(ws + OFF_QUEUE))[gtid] = 0u;
    transpose_cvt(shm, p.w_in, 1024, 5888, (bf16_t*)(ws + OFF_WIN), 1024, nullptr);
    rmsnorm_rows(p, p.g_mix, (bf16_t*)(ws + OFF_R1));
}

#define LDS_BAR() do { asm volatile("s_waitcnt lgkmcnt(0)" ::: "memory"); __builtin_amdgcn_s_barrier(); asm volatile("" ::: "memory"); } while (0)
constexpr int N_SAMPLE_ITEMS = 128, N_ITEMS = N_SAMPLE_ITEMS + 1024;

template <int LPR, int RPL, int DIR>
__device__ __forceinline__ void scan_item(const Params& p, unsigned char* shm, const int tid, const int tbase, const int L, const int h, const int half) {
    constexpr int dir = DIR;
    constexpr int EC = 64 / LPR, RPW = RPL * (64 / LPR);
    float* sW = (float*)shm; float* sAV = sW + 2048; float* sBV = sW + 4096; float* sKD = sW + 6144; float* sWR = sW + 8192; float* sR = sW + 10240; float* sV = sW + 12288; float* sY = sW + 14336;
    float* sBK = sW + 16384;
    bf16_t* sTW = (bf16_t*)(sW + 16384 + 64);
    bf16_t* sZA = sTW + 32 * 72;
    const int lane = tid & 63, wv = tid >> 6;
    const bf16_t* zall = (const bf16_t*)(p.ws + OFF_Z);
    const int tokA = tid >> 4, q = tid & 15;
    const int rowS = half * 32 + wv * RPW + RPL * (lane / LPR), gS = lane % LPR;
    const int NC = L / 32;
    bf16_t* ybuf = (bf16_t*)p.out + (dir ? (size_t)T_TOK * 1024 : 0);
    float* bonus = (float*)(p.ws + OFF_BONUS) + (dir ? (size_t)T_TOK * 16 : 0);
    const float* w_up = dir ? p.w_up_b : p.w_up_f; const float* a_up = dir ? p.a_up_b : p.a_up_f;
    const float* w0 = dir ? p.w0_b : p.w0_f; const float* a0 = dir ? p.a0_b : p.a0_f;
    const int mat = wv >> 2, cbk = wv & 3, colB = cbk * 16 + (lane & 15), quad = lane >> 4;
    u32x4* sBF = (u32x4*)(shm + 84 * 1024);
    { const float* up = mat ? a_up : w_up;
#pragma unroll
      for (int kb = 0; kb < 2; ++kb) { float f[8];
#pragma unroll
          for (int j = 0; j < 8; ++j) f[j] = up[(size_t)(kb * 32 + quad * 8 + j) * 1024 + h * 64 + colB];
          u32x4 w; w.x = pk_bf16(f[0], f[1]); w.y = pk_bf16(f[2], f[3]); w.z = pk_bf16(f[4], f[5]); w.w = pk_bf16(f[6], f[7]); sBF[kb * 512 + tid] = w; } }
    const float c0B = (mat ? a0 : w0)[h * 64 + colB];
    const float kaB = p.k_a[h * 64 + colB];
    int colz[5];
    float* sV2 = (float*)(shm + 104 * 1024);
    float* sM0 = (float*)(shm + 100 * 1024);
    float* sMU = (float*)(shm + 76 * 1024);
#pragma unroll
    for (int gi = 0; gi < 5; ++gi) colz[gi] = (gi == 0 ? COL_R + h * 64 : gi == 1 ? COL_K + h * 64 : gi == 2 ? COL_V + h * 64 : gi == 3 ? COL_W : COL_A) + 4 * q;
    if (tid < 320) { const int gi = tid >> 6, c = tid & 63; const int col = (gi == 0 ? COL_R + h * 64 : gi == 1 ? COL_K + h * 64 : gi == 2 ? COL_V + h * 64 : gi == 3 ? COL_W : COL_A) + c - COL_R;
        const float mpv_ = p.mu_prev[col], mnv_ = p.mu_next[col]; sMU[gi * 64 + c] = mpv_; sMU[320 + gi * 64 + c] = mnv_; sM0[gi * 64 + c] = 1.0f - mpv_ - mnv_; }
    else if (tid < 384) sMU[640 + (tid - 320)] = p.k_k[h * 64 + (tid - 320)];
    else if (tid < 448) sMU[704 + (tid - 384)] = p.r_k[h * 64 + (tid - 384)];
    __syncthreads();
    float s[RPL][EC];
#pragma unroll
    for (int r = 0; r < RPL; ++r)
#pragma unroll
        for (int j = 0; j < EC; ++j) s[r][j] = 0.f;
    u32x2 zc[5], zp[5], zn[5];
    auto load_chunk = [&](int ci) {
        const int t = tbase + 32 * (dir ? NC - 1 - ci : ci) + tokA; const bool hasPrev = t > tbase, hasNext = t < tbase + L - 1;
        const bf16_t* zr = zall + (size_t)t * ZLD;
#pragma unroll
        for (int gi = 0; gi < 5; ++gi) { zc[gi] = *(const u32x2*)(zr + colz[gi]); zp[gi] = (u32x2){0u, 0u}; zn[gi] = (u32x2){0u, 0u};
            if (hasPrev) zp[gi] = *(const u32x2*)(zr - ZLD + colz[gi]);
            if (hasNext) zn[gi] = *(const u32x2*)(zr + ZLD + colz[gi]); }
    };
    load_chunk(0);
    for (int ci = 0; ci < NC; ++ci) {
        const int t0 = tbase + 32 * (dir ? NC - 1 - ci : ci);
        { float zs[5][4];
          f32x4 MP[5], MN[5], M0[5];
#pragma unroll
          for (int gi = 0; gi < 5; ++gi) { MP[gi] = *(const f32x4*)(sMU + gi * 64 + 4 * q); MN[gi] = *(const f32x4*)(sMU + 320 + gi * 64 + 4 * q); M0[gi] = *(const f32x4*)(sM0 + gi * 64 + 4 * q); }
          const f32x4 kk4c = *(const f32x4*)(sMU + 640 + 4 * q);
#pragma unroll
          for (int gi = 0; gi < 5; ++gi) {
              const float c[4] = {bf_lo(zc[gi].x), bf_hi(zc[gi].x), bf_lo(zc[gi].y), bf_hi(zc[gi].y)}, pv[4] = {bf_lo(zp[gi].x), bf_hi(zp[gi].x), bf_lo(zp[gi].y), bf_hi(zp[gi].y)}, nx[4] = {bf_lo(zn[gi].x), bf_hi(zn[gi].x), bf_lo(zn[gi].y), bf_hi(zn[gi].y)};
              shift4(zs[gi], c, pv, nx, M0[gi], MP[gi], MN[gi]);
          }
          if (ci + 1 < NC) load_chunk(ci + 1);
          *(f32x4*)(sR + tokA * 64 + 4 * q) = (f32x4){zs[0][0], zs[0][1], zs[0][2], zs[0][3]};
          *(f32x4*)(sKD + tokA * 64 + 4 * q) = (f32x4){zs[1][0], zs[1][1], zs[1][2], zs[1][3]};
          *(f32x4*)(sV + tokA * 64 + 4 * q) = (f32x4){zs[2][0], zs[2][1], zs[2][2], zs[2][3]};
          float kk[4], ss;
          kk4(kk, ss, zs[1], kk4c);
          ss = ss + 0.0f * kk[0];
          ss = red16(ss);
          const float inv = -__builtin_amdgcn_rsqf(fmaxf(ss, 1e-24f));
          *(f32x4*)(sAV + tokA * 64 + 4 * q) = (f32x4){kk[0] * inv, kk[1] * inv, kk[2] * inv, kk[3] * inv};
          float tw[4];
#pragma unroll
          for (int j = 0; j < 4; ++j) tw[j] = 1.0f - 2.0f * __builtin_amdgcn_rcpf(1.0f + fexp2_scaled(zs[3][j], 2.8853900818f));
          u32x2 w; w.x = pk_bf16(tw[0], tw[1]); w.y = pk_bf16(tw[2], tw[3]); *(u32x2*)(sTW + tokA * 72 + 4 * q) = w;
          w.x = pk_bf16(zs[4][0], zs[4][1]); w.y = pk_bf16(zs[4][2], zs[4][3]); *(u32x2*)(sZA + tokA * 72 + 4 * q) = w;
        }
        LDS_BAR();
        { const int matu = __builtin_amdgcn_readfirstlane(mat);
          const bf16_t* sX = matu ? sZA : sTW;
          const bf16x8 b0 = __builtin_bit_cast(bf16x8, sBF[tid]), b1 = __builtin_bit_cast(bf16x8, sBF[512 + tid]);
          const bf16_t* ap = sX + (lane & 15) * 72 + quad * 8;
          const bf16x8 a00 = *(const bf16x8*)(ap), a01 = *(const bf16x8*)(ap + 32), a10 = *(const bf16x8*)(ap + 16 * 72), a11 = *(const bf16x8*)(ap + 16 * 72 + 32);
          const int idx0 = (quad * 4) * 64 + colB;
          float o1[8], o2[8];
          if (matu == 0) {
#pragma unroll
              for (int i = 0; i < 8; ++i) o1[i] = sR[idx0 + ((i >> 2) * 16 + (i & 3)) * 64];
          } else {
#pragma unroll
              for (int i = 0; i < 8; ++i) { o1[i] = sKD[idx0 + ((i >> 2) * 16 + (i & 3)) * 64]; o2[i] = sAV[idx0 + ((i >> 2) * 16 + (i & 3)) * 64]; }
          }
          f32x4 acc0 = (f32x4){c0B, c0B, c0B, c0B}, acc1 = acc0;
          acc0 = __builtin_amdgcn_mfma_f32_16x16x32_bf16(a00, b0, acc0, 0, 0, 0); acc1 = __builtin_amdgcn_mfma_f32_16x16x32_bf16(a10, b0, acc1, 0, 0, 0);
          acc0 = __builtin_amdgcn_mfma_f32_16x16x32_bf16(a01, b1, acc0, 0, 0, 0); acc1 = __builtin_amdgcn_mfma_f32_16x16x32_bf16(a11, b1, acc1, 0, 0, 0);
          float sg[8];
#pragma unroll
          for (int i = 0; i < 8; ++i) sg[i] = sigmoidf_(i < 4 ? acc0[i & 3] : acc1[i & 3]);
          if (matu == 0) {
              float wv_[8];
#pragma unroll
              for (int i = 0; i < 8; ++i) wv_[i] = fexp2_scaled(sg[i], -0.6065306597f * 1.4426950409f);
#pragma unroll
              for (int i = 0; i < 8; ++i) { const int idx = idx0 + ((i >> 2) * 16 + (i & 3)) * 64; sW[idx] = wv_[i]; sWR[idx] = wv_[i] * o1[i]; }
          } else {
#pragma unroll
              for (int i = 0; i < 8; ++i) { const int idx = idx0 + ((i >> 2) * 16 + (i & 3)) * 64; sKD[idx] = o1[i] * (1.0f + (sg[i] - 1.0f) * kaB); sBV[idx] = -o2[i] * sg[i]; }
          } }
        LDS_BAR();
        { const f32x4 r4 = *(const f32x4*)(sR + tokA * 64 + 4 * q), b4 = *(const f32x4*)(sBV + tokA * 64 + 4 * q), k4 = *(const f32x4*)(sKD + tokA * 64 + 4 * q);
          float br = 0.f, kr = 0.f, cb = 0.f; const f32x4 rk4 = *(const f32x4*)(sMU + 704 + 4 * q);
#pragma unroll
          for (int j = 0; j < 4; ++j) { br += b4[j] * r4[j]; kr += k4[j] * r4[j]; cb += r4[j] * k4[j] * rk4[j]; }
          br = red16(br); kr = red16(kr); cb = red16(cb);
          { f32x4* qp = (f32x4*)(sWR + tokA * 64 + 4 * q); const f32x4 a4 = *(const f32x4*)(sAV + tokA * 64 + 4 * q); *qp = *qp + a4 * br; }
          { const f32x4 v4 = *(const f32x4*)(sV + tokA * 64 + 4 * q); *(f32x4*)(sV2 + tokA * 64 + 4 * q) = v4 * kr; }
          if (q == 0 && half == 0) bonus[(size_t)(t0 + tokA) * 16 + h] = cb; }
        LDS_BAR();
        {
            constexpr int NV = EC / 4;
            struct Ops { f32x4 w[NV], a[NV], b[NV], k[NV], q[NV]; float v[RPL]; };
            auto ld = [&](Ops& o, int i) { const int tk = DIR ? 31 - i : i; const int off = tk * 64 + 4 * gS;
#pragma unroll
                for (int c = 0; c < NV; ++c) { o.w[c] = *(const f32x4*)(sW + off + 32 * c); o.a[c] = *(const f32x4*)(sAV + off + 32 * c); o.b[c] = *(const f32x4*)(sBV + off + 32 * c);
                    o.k[c] = *(const f32x4*)(sKD + off + 32 * c); o.q[c] = *(const f32x4*)(sWR + off + 32 * c); }
                if constexpr (RPL == 2) { const f32x2 v2 = *(const f32x2*)(sV + tk * 64 + rowS); o.v[0] = v2.x; o.v[1] = v2.y; } else o.v[0] = sV[tk * 64 + rowS]; };
            auto step = [&](const Ops& cur, int i) {
                static_assert(EC == 4, "asm row helpers are written for 4 columns per lane");
                float sa[RPL], yp[RPL], y[RPL];
#pragma unroll
                for (int r = 0; r < RPL; ++r) row_dots(s[r], cur.a[0], cur.q[0], sa[r], yp[r]);
                if constexpr (RPL == 2) red16x4(sa[0], yp[0], sa[1], yp[1]); else red16x2(sa[0], yp[0]);
#pragma unroll
                for (int r = 0; r < RPL; ++r) { row_update3(s[r], cur.w[0], cur.b[0], cur.k[0], cur.v[r], sa[r]); y[r] = yp[r]; }
                if (gS == 0) { if constexpr (RPL == 2) *(f32x2*)(sY + (DIR ? 31 - i : i) * 64 + rowS) = (f32x2){y[0], y[1]}; else sY[(DIR ? 31 - i : i) * 64 + rowS] = y[0]; }
            };
            {
                Ops o0, o1, o2; ld(o0, 0); ld(o1, 1);
#pragma unroll 1
                for (int i = 0; i < 30; i += 3) {
                    ld(o2, i + 2);
                    step(o0, i);
                    ld(o0, i + 3);
                    step(o1, i + 1);
                    ld(o1, min(i + 4, 31));
                    step(o2, i + 2);
                }
                step(o0, 30);
                step(o1, 31);
            }
        }
        LDS_BAR();
        if (RPL == 2 || (q >> 3) == half) { const f32x4 y4 = *(const f32x4*)(sY + tokA * 64 + 4 * q) + *(const f32x4*)(sV2 + tokA * 64 + 4 * q); u32x2 w; w.x = pk_bf16(y4[0], y4[1]); w.y = pk_bf16(y4[2], y4[3]);
          *(u32x2*)(ybuf + (size_t)(t0 + tokA) * 1024 + h * 64 + 4 * q) = w; }
    }
}

__device__ void scan_phase(const Params& p, unsigned char* shm) {
    int* sItem = (int*)(shm + 80 * 1024);
    const int tid = opaque_tid();
    unsigned* queue = (unsigned*)(p.ws + OFF_QUEUE);
    for (;;) {
        if (tid == 0) *sItem = (int)atomicAdd(queue, 1u);
        __syncthreads();
        const int item = *sItem;
        __syncthreads();
        if (item >= N_ITEMS) break;
        int tid2 = tid; asm volatile("" : "+v"(tid2));
        if (item < N_SAMPLE_ITEMS) {
            const int half = item & 1, j = item >> 1;
            if (j & 1) scan_item<16, 1, 1>(p, shm, tid2, TP + (j >> 5) * 16384, 16384, (j >> 1) & 15, half); else scan_item<16, 1, 0>(p, shm, tid2, TP + (j >> 5) * 16384, 16384, (j >> 1) & 15, half);
        } else { const int j = item - N_SAMPLE_ITEMS;
            if (j & 1) scan_item<16, 2, 1>(p, shm, tid2, (j >> 5) * 2048, 2048, (j >> 1) & 15, 0); else scan_item<16, 2, 0>(p, shm, tid2, (j >> 5) * 2048, 2048, (j >> 1) & 15, 0); }
        __syncthreads();
    }
    for (;;) {
        if (tid == 0) *sItem = (int)atomicAdd(queue + 1, 1u);
        __syncthreads();
        const int u = *sItem;
        __syncthreads();
        if (u >= N_DEFER) break;
        deferred_unit(p, shm, tid, u);
    }
}


__device__ void mix_phase(const Params& p) {
    const int tidx = opaque_tid(); const int lane = tidx & 63, wave = (blockIdx.x * 512 + tidx) >> 6, nw = (gridDim.x * 512) >> 6;
    const bf16_t* zall = (const bf16_t*)(p.ws + OFF_Z);
    bf16_t* yf = (bf16_t*)p.out; const bf16_t* yb = (const bf16_t*)p.out + (size_t)T_TOK * 1024;
    const float* bonus_f = (const float*)(p.ws + OFF_BONUS); const float* bonus_b = bonus_f + (size_t)T_TOK * 16;
    bf16_t* pooled = (bf16_t*)(p.ws + OFF_POOLED); bf16_t* sg = (bf16_t*)(p.ws + OFF_SG);
    const int hL = lane >> 2;
    const int tpw = (T_TOK + nw - 1) / nw;
    for (int t = wave * tpw; t < min(T_TOK, (wave + 1) * tpw); ++t) {
        int tbase, L; seq_of(t, tbase, L); const int pos = t - tbase; const bool hasPrev = pos > 0, hasNext = pos < L - 1;
        const bf16_t* zr = zall + (size_t)t * ZLD;
        { const int c0 = lane * 16; float y[16];
          { const u32x4 a0 = *(const u32x4*)(yf + (size_t)t * 1024 + c0), a1 = *(const u32x4*)(yf + (size_t)t * 1024 + c0 + 8);
            const u32x4 b0 = *(const u32x4*)(yb + (size_t)t * 1024 + c0), b1 = *(const u32x4*)(yb + (size_t)t * 1024 + c0 + 8);
            f32x4 fa, fb, ga, gb; unpack8(a0, fa, fb); unpack8(b0, ga, gb);
#pragma unroll
            for (int j = 0; j < 4; ++j) { y[j] = fa[j] + ga[j]; y[4 + j] = fb[j] + gb[j]; }
            unpack8(a1, fa, fb); unpack8(b1, ga, gb);
#pragma unroll
            for (int j = 0; j < 4; ++j) { y[8 + j] = fa[j] + ga[j]; y[12 + j] = fb[j] + gb[j]; } }
          float sm = 0.f;
#pragma unroll
          for (int j = 0; j < 16; ++j) sm += y[j];
          const float mean = red4(sm) * (1.0f / 64.0f); float vs = 0.f;
#pragma unroll
          for (int j = 0; j < 16; ++j) { const float d = y[j] - mean; vs += d * d; }
          const float rstd = rsqrtf(red4(vs) * (1.0f / 64.0f) + 64e-5f);
          const float bon = bonus_f[(size_t)t * 16 + hL] + bonus_b[(size_t)t * 16 + hL];
          float vv[16];
          { const bf16_t* zc = zr + COL_V + c0;
            u32x4 c_[2], p_[2], n_[2];
#pragma unroll
            for (int i = 0; i < 2; ++i) { c_[i] = *(const u32x4*)(zc + 8 * i); p_[i] = hasPrev ? *(const u32x4*)(zc - ZLD + 8 * i) : (u32x4){0u, 0u, 0u, 0u}; n_[i] = hasNext ? *(const u32x4*)(zc + ZLD + 8 * i) : (u32x4){0u, 0u, 0u, 0u}; }
#pragma unroll
            for (int i = 0; i < 2; ++i) { f32x4 ca, cb, pa, pb, na, nb; unpack8(c_[i], ca, cb); unpack8(p_[i], pa, pb); unpack8(n_[i], na, nb);
                const float* mp = p.mu_prev + (COL_V - COL_R) + c0 + 8 * i; const float* mn = p.mu_next + (COL_V - COL_R) + c0 + 8 * i;
                const f32x4 mp0 = *(const f32x4*)mp, mp1 = *(const f32x4*)(mp + 4), mn0 = *(const f32x4*)mn, mn1 = *(const f32x4*)(mn + 4);
#pragma unroll
                for (int j = 0; j < 4; ++j) { vv[8 * i + j] = ca[j] + mp0[j] * (pa[j] - ca[j]) + mn0[j] * (na[j] - ca[j]); vv[8 * i + 4 + j] = cb[j] + mp1[j] * (pb[j] - cb[j]) + mn1[j] * (nb[j] - cb[j]); } } }
          float o[16];
#pragma unroll
          for (int i = 0; i < 4; ++i) { const f32x4 lw = *(const f32x4*)(p.ln_w + c0 + 4 * i), lb = *(const f32x4*)(p.ln_b + c0 + 4 * i);
#pragma unroll
              for (int j = 0; j < 4; ++j) o[4 * i + j] = (y[4 * i + j] - mean) * rstd * lw[j] + lb[j] + bon * vv[4 * i + j]; }
          u32x4 w0, w1; w0.x = pk_bf16(o[0], o[1]); w0.y = pk_bf16(o[2], o[3]); w0.z = pk_bf16(o[4], o[5]); w0.w = pk_bf16(o[6], o[7]);
          w1.x = pk_bf16(o[8], o[9]); w1.y = pk_bf16(o[10], o[11]); w1.z = pk_bf16(o[12], o[13]); w1.w = pk_bf16(o[14], o[15]);
          *(u32x4*)(yf + (size_t)t * 1024 + c0) = w0; *(u32x4*)(yf + (size_t)t * 1024 + c0 + 8) = w1; }
        { const int c = 2 * lane; const bf16_t* zc = zr + COL_G + c; const unsigned wc_ = *(const unsigned*)zc; const unsigned wp = hasPrev ? *(const unsigned*)(zc - ZLD) : 0u, wn = hasNext ? *(const unsigned*)(zc + ZLD) : 0u;
          const float mp0 = p.mu_prev[COL_G - COL_R + c], mp1 = p.mu_prev[COL_G - COL_R + c + 1], mn0 = p.mu_next[COL_G - COL_R + c], mn1 = p.mu_next[COL_G - COL_R + c + 1];
          const float c0v = bf_lo(wc_), c1v = bf_hi(wc_);
          const float z0 = c0v + mp0 * (bf_lo(wp) - c0v) + mn0 * (bf_lo(wn) - c0v), z1 = c1v + mp1 * (bf_hi(wp) - c1v) + mn1 * (bf_hi(wn) - c1v);
          *(unsigned*)(sg + (size_t)t * 256 + c) = pk_bf16(sigmoidf_(z0), sigmoidf_(z1)); *(unsigned*)(sg + (size_t)t * 256 + 128 + c) = 0u; }
        { const int c = lane * 8, gi = lane >> 4, w = 2 << gi; const int lo = max(pos - (w >> 1), 0), hi = min(pos + (w >> 1) - 1, L - 1);
          float sum[8];
#pragma unroll
          for (int j = 0; j < 8; ++j) sum[j] = 0.f;
          u32x4 wr_[16];
#pragma unroll
          for (int d = 0; d < 16; ++d) { const int r = pos - 8 + d; wr_[d] = (u32x4){0u, 0u, 0u, 0u}; if (r >= lo && r <= hi) wr_[d] = *(const u32x4*)(zall + (size_t)(tbase + r) * ZLD + c); }
#pragma unroll
          for (int d = 0; d < 16; ++d) { f32x4 a, b; unpack8(wr_[d], a, b);
#pragma unroll
              for (int j = 0; j < 4; ++j) { sum[j] += a[j]; sum[4 + j] += b[j]; } }
          const float icnt = 1.0f / (float)(hi - lo + 1); f32x4 a, b; unpack8(*(const u32x4*)(zr + c), a, b); f32x4 oa, ob;
#pragma unroll
          for (int j = 0; j < 4; ++j) { oa[j] = sum[j] * icnt - a[j]; ob[j] = sum[4 + j] * icnt - b[j]; }
          *(u32x4*)(pooled + (size_t)t * 512 + c) = pack8(oa, ob); }
    }
}

__device__ void final_phase(const Params& p) {
    const int tidx = opaque_tid(); const int lane = tidx & 63, wave = (blockIdx.x * 512 + tidx) >> 6, nw = (gridDim.x * 512) >> 6;
    const float* x2 = (const float*)(p.ws + OFF_X1); const float* rowsq2 = (const float*)(p.ws + OFF_ROWSQ2);
    f32x4 gv[4];
#pragma unroll
    for (int i = 0; i < 4; ++i) gv[i] = *(const f32x4*)(p.g_final + lane * 4 + 256 * i);
    for (int t0 = wave; t0 < T_TOK; t0 += 2 * nw) {
        const int t1 = t0 + nw < T_TOK ? t0 + nw : t0;
        const float r0 = rsqrtf(rowsq2[t0] * (1.0f / 1024.0f) + 1e-6f), r1 = rsqrtf(rowsq2[t1] * (1.0f / 1024.0f) + 1e-6f);
        f32x4 a[4], b[4];
#pragma unroll
        for (int i = 0; i < 4; ++i) { a[i] = *(const f32x4*)(x2 + (size_t)t0 * 1024 + lane * 4 + 256 * i); b[i] = *(const f32x4*)(x2 + (size_t)t1 * 1024 + lane * 4 + 256 * i); }
#pragma unroll
        for (int i = 0; i < 4; ++i) { *(f32x4*)(p.out + (size_t)t0 * 1024 + lane * 4 + 256 * i) = a[i] * r0 * gv[i]; *(f32x4*)(p.out + (size_t)t1 * 1024 + lane * 4 + 256 * i) = b[i] * r1 * gv[i]; }
    }
}

__global__ void __launch_bounds__(512, 2) fwd_megakernel(Params p) {
    extern __shared__ __attribute__((aligned(16))) unsigned char shm[];
    unsigned char* ws = p.ws;
    prep_phase(p, shm);
    cg::this_grid().sync();
    { EpiStore E; E.O = (bf16_t*)(ws + OFF_Z); E.ldc = ZLD; run_gemm(shm, (const bf16_t*)(ws + OFF_R1), 1024, (const bf16_t*)(ws + OFF_WIN), 1024, 3840, 1024, E); }
    cg::this_grid().sync();
    scan_phase(p, shm);
    cg::this_grid().sync();
    mix_phase(p);
    cg::this_grid().sync();
    rmsnorm_rows(p, p.g_mix, (bf16_t*)(ws + OFF_XN2));
    { EpiMulInPlace E; E.Y = (bf16_t*)p.out; run_gemm(shm, (const bf16_t*)(ws + OFF_SG), 256, (const bf16_t*)(ws + OFF_WG), 256, 1024, 256, E); }
    cg::this_grid().sync();
    { EpiGates E; E.G = (bf16_t*)(ws + OFF_GATES); E.bias = p.b_gate; run_gemm(shm, (const bf16_t*)(ws + OFF_XN2), 1024, (const bf16_t*)(ws + OFF_WIN) + (size_t)3840 * 1024, 1024, 2048, 1024, E); }
    cg::this_grid().sync();
    { EpiPool E; E.P = (bf16_t*)(ws + OFF_MERGED); E.G = (const bf16_t*)(ws + OFF_GATES); run_gemm(shm, (const bf16_t*)(ws + OFF_POOLED), 512, (const bf16_t*)(ws + OFF_WEFF), 512, 1024, 512, E); }
    { EpiMerge E; E.P = (bf16_t*)(ws + OFF_MERGED); E.G = (const bf16_t*)(ws + OFF_GATES); run_gemm(shm, (const bf16_t*)p.out, 1024, (const bf16_t*)(ws + OFF_WRBR), 1024, 1024, 1024, E); }
    cg::this_grid().sync();
    { EpiOut E; E.xp = p.x_prompt; E.xs = p.x_sample; E.X1 = (float*)(ws + OFF_X1); E.X1B = (bf16_t*)(ws + OFF_X1B); E.rowsq = (float*)(ws + OFF_ROWSQ); run_gemm(shm, (const bf16_t*)(ws + OFF_MERGED), 1024, (const bf16_t*)(ws + OFF_WOUT), 1024, 1024, 1024, E); }
    cg::this_grid().sync();
    { EpiFF1 E; E.Hlo = (bf16_t*)(ws + OFF_HLO); E.Hhi = (bf16_t*)p.out; E.rowsq = (const float*)(ws + OFF_ROWSQ); run_gemm(shm, (const bf16_t*)(ws + OFF_X1B), 1024, (const bf16_t*)(ws + OFF_WFF1), 1024, 4096, 1024, E); }
    cg::this_grid().sync();
    { EpiFinal E; E.X = (float*)(ws + OFF_X1); E.rowsq = (float*)(ws + OFF_ROWSQ2);
      run_gemm(shm, (const bf16_t*)(ws + OFF_HLO), 2048, (const bf16_t*)(ws + OFF_WFF2), 4096, 1024, 4096, E, (const bf16_t*)p.out, 32); }
    cg::this_grid().sync();
    final_phase(p);
}

extern "C" void kernel_launch(void* const* d_in, const int* in_sizes, int n_in, void* d_out, int out_size, void* d_ws, size_t ws_size, hipStream_t stream) {
    constexpr size_t kDynLds = 131072;
    static int grid_blocks = 0;
    if (!grid_blocks) {
        hipFuncSetAttribute((const void*)fwd_megakernel, hipFuncAttributeMaxDynamicSharedMemorySize, (int)kDynLds);
        int dev = 0, cus = 0, per_cu = 0;
        hipGetDevice(&dev);
        hipDeviceGetAttribute(&cus, hipDeviceAttributeMultiprocessorCount, dev);
        hipOccupancyMaxActiveBlocksPerMultiprocessor(&per_cu, fwd_megakernel, 512, kDynLds);
        if (per_cu < 1) per_cu = 1;
        grid_blocks = cus;
    }
    Params p{};
    const float** pf = (const float**)&p;
    for (int i = 0; i < 30; ++i) pf[i] = (const float*)d_in[i];
    p.out = (float*)d_out; p.ws = (unsigned char*)d_ws;
    void* args[] = {&p};
    hipError_t e = hipLaunchCooperativeKernel((const void*)fwd_megakernel, dim3(grid_blocks), dim3(512), args, kDynLds, stream);
    if (e != hipSuccess) fprintf(stderr, "cooperative launch failed: %s (grid %d)\n", hipGetErrorString(e), grid_blocks);
}
```

```cpp
#include <hip/hip_runtime.h>
#include <hip/hip_cooperative_groups.h>
#include <cstdio>
namespace cg = cooperative_groups;

#define LAS __attribute__((address_space(3)))
typedef unsigned short bf16_t;
typedef short bf16x8 __attribute__((ext_vector_type(8)));
typedef float f32x4 __attribute__((ext_vector_type(4)));
typedef float f32x2 __attribute__((ext_vector_type(2)));
typedef unsigned u32x4 __attribute__((ext_vector_type(4)));
typedef unsigned u32x2 __attribute__((ext_vector_type(2)));

constexpr int T_TOK = 98304, DM = 1024, TP = 65536;
constexpr int ZLD = 3840;
constexpr int COL_R = 512, COL_K = 1536, COL_V = 2560, COL_W = 3584, COL_A = 3648, COL_G = 3712;
constexpr size_t MiB = 1ull << 20;
constexpr size_t OFF_WIN = 0, OFF_WEFF = 12 * MiB, OFF_WRBR = 13 * MiB, OFF_WOUT = 15 * MiB, OFF_WFF1 = 17 * MiB, OFF_WFF2 = 25 * MiB, OFF_WG = 33 * MiB;
constexpr size_t OFF_ROWSQ = 34 * MiB, OFF_ROWSQ2 = 34 * MiB + 512 * 1024, OFF_QUEUE = 35 * MiB, OFF_BONUS = 36 * MiB;
constexpr size_t OFF_R1 = 48 * MiB, OFF_Z = 240 * MiB;
constexpr size_t OFF_POOLED = OFF_R1, OFF_SG = OFF_R1 + 96 * MiB, OFF_XN2 = OFF_Z, OFF_GATES = OFF_Z + 192 * MiB, OFF_MERGED = OFF_Z + 576 * MiB;
constexpr size_t OFF_X1B = OFF_R1, OFF_X1 = OFF_Z, OFF_HLO = OFF_Z + 384 * MiB;
constexpr size_t U_BYTES = (size_t)T_TOK * 1024 * 2;

struct Params {
    const float *x_prompt, *x_sample, *g_mix, *w_in, *b_gate, *mu_prev, *mu_next, *pool_w, *pool_scale, *w_pool_br, *k_k, *k_a, *r_k,
        *w0_f, *w_up_f, *a0_f, *a_up_f, *w0_b, *w_up_b, *a0_b, *a_up_b, *g_up, *ln_w, *ln_b, *w_rwkv_br, *w_out, *g_ffn, *w_ff1, *w_ff2, *g_final;
    float* out; unsigned char* ws;
};

__device__ __forceinline__ float bf_lo(unsigned w) { return __uint_as_float(w << 16); }
__device__ __forceinline__ float bf_hi(unsigned w) { return __uint_as_float(w & 0xFFFF0000u); }
typedef __bf16 bf16x2_t __attribute__((ext_vector_type(2)));
__device__ __forceinline__ unsigned pk_bf16(float lo, float hi) { f32x2 v = {lo, hi}; bf16x2_t b = __builtin_convertvector(v, bf16x2_t); return __builtin_bit_cast(unsigned, b); }
__device__ __forceinline__ float fexp2_scaled(float x, float scale_log2e) { return __builtin_amdgcn_exp2f(x * scale_log2e); }
__device__ __forceinline__ float sigmoidf_(float x) { return __builtin_amdgcn_rcpf(1.0f + fexp2_scaled(x, -1.4426950409f)); }
__device__ __forceinline__ float fma_s(float a, float b, float c) { float d; asm("v_fma_f32 %0, %1, %2, %3" : "=v"(d) : "v"(a), "v"(b), "v"(c)); return d; }
__device__ __forceinline__ float mul_s(float a, float b) { float d; asm("v_mul_f32 %0, %1, %2" : "=v"(d) : "v"(a), "v"(b)); return d; }
__device__ __forceinline__ float add_s(float a, float b) { float d; asm("v_add_f32 %0, %1, %2" : "=v"(d) : "v"(a), "v"(b)); return d; }
#define DPPA(x, c) "v_add_f32_dpp " x ", " x ", " x " " c " row_mask:0xf bank_mask:0xf bound_ctrl:1\n"
#define DPP4(c) DPPA("%0", c) DPPA("%1", c) DPPA("%2", c) DPPA("%3", c)
#define DPP2(c) DPPA("%0", c) DPPA("%1", c) "s_nop 0\n"
__device__ __forceinline__ void red16x4(float& a, float& b, float& c, float& d) {
    asm("s_nop 1\n" DPP4("quad_perm:[1,0,3,2]") DPP4("quad_perm:[2,3,0,1]") DPP4("row_half_mirror") DPP4("row_mirror") : "+v"(a), "+v"(b), "+v"(c), "+v"(d)); }
__device__ __forceinline__ void red16x2(float& a, float& b) {
    asm("s_nop 1\n" DPP2("quad_perm:[1,0,3,2]") DPP2("quad_perm:[2,3,0,1]") DPP2("row_half_mirror") DPP2("row_mirror") : "+v"(a), "+v"(b)); }
__device__ __forceinline__ void row_dots(const float (&s)[4], const f32x4 a, const f32x4 q, float& sa, float& yp) {
    asm("v_mul_f32 %0, %2, %6\n v_mul_f32 %1, %2, %10\n v_fmac_f32 %0, %3, %7\n v_fmac_f32 %1, %3, %11\n v_fmac_f32 %0, %4, %8\n v_fmac_f32 %1, %4, %12\n v_fmac_f32 %0, %5, %9\n v_fmac_f32 %1, %5, %13"
        : "=&v"(sa), "=&v"(yp) : "v"(s[0]), "v"(s[1]), "v"(s[2]), "v"(s[3]), "v"(a[0]), "v"(a[1]), "v"(a[2]), "v"(a[3]), "v"(q[0]), "v"(q[1]), "v"(q[2]), "v"(q[3])); }
__device__ __forceinline__ void row_update(float (&s)[4], const f32x4 w, const f32x4 b, const f32x4 k, float v, float sa, float yp, float bkx, float bky, float& y) {
    float t0, t1, t2, t3;
    asm("v_mul_f32 %0, %6, %15\n v_mul_f32 %1, %6, %16\n v_mul_f32 %2, %6, %17\n v_mul_f32 %3, %6, %18\n"
        "v_fmac_f32 %4, %7, %5\n"
        "v_fmac_f32 %0, %7, %11\n v_fmac_f32 %1, %7, %12\n v_fmac_f32 %2, %7, %13\n v_fmac_f32 %3, %7, %14\n"
        "v_fmac_f32 %4, %6, %8\n"
        "v_fmac_f32 %0, %9, %19\n v_fmac_f32 %1, %10, %20\n v_fmac_f32 %2, %23, %21\n v_fmac_f32 %3, %24, %22"
        : "=&v"(t0), "=&v"(t1), "=&v"(t2), "=&v"(t3), "+v"(yp)
        : "v"(bkx), "v"(v), "v"(sa), "v"(bky), "v"(s[0]), "v"(s[1]), "v"(b[0]), "v"(b[1]), "v"(b[2]), "v"(b[3]), "v"(k[0]), "v"(k[1]), "v"(k[2]), "v"(k[3]), "v"(w[0]), "v"(w[1]), "v"(w[2]), "v"(w[3]), "v"(s[2]), "v"(s[3]));
    s[0] = t0; s[1] = t1; s[2] = t2; s[3] = t3; y = yp; }
__device__ __forceinline__ void shift4(float (&z)[4], const float (&c)[4], const float (&pv)[4], const float (&nx)[4], const f32x4 m0, const f32x4 mp, const f32x4 mn) {
    asm("v_mul_f32 %0, %4, %16\n v_mul_f32 %1, %5, %17\n v_mul_f32 %2, %6, %18\n v_mul_f32 %3, %7, %19\n"
        "v_fma_f32 %0, %8, %20, %0\n v_fma_f32 %1, %9, %21, %1\n v_fma_f32 %2, %10, %22, %2\n v_fma_f32 %3, %11, %23, %3\n"
        "v_fma_f32 %0, %12, %24, %0\n v_fma_f32 %1, %13, %25, %1\n v_fma_f32 %2, %14, %26, %2\n v_fma_f32 %3, %15, %27, %3"
        : "=&v"(z[0]), "=&v"(z[1]), "=&v"(z[2]), "=&v"(z[3])
        : "v"(c[0]), "v"(c[1]), "v"(c[2]), "v"(c[3]), "v"(pv[0]), "v"(pv[1]), "v"(pv[2]), "v"(pv[3]), "v"(nx[0]), "v"(nx[1]), "v"(nx[2]), "v"(nx[3]),
          "v"(m0[0]), "v"(m0[1]), "v"(m0[2]), "v"(m0[3]), "v"(mp[0]), "v"(mp[1]), "v"(mp[2]), "v"(mp[3]), "v"(mn[0]), "v"(mn[1]), "v"(mn[2]), "v"(mn[3])); }
__device__ __forceinline__ void kk4(float (&kk)[4], float& ss, const float (&k)[4], const f32x4 c) {
    asm("v_mul_f32 %0, %5, %9\n v_mul_f32 %1, %6, %10\n v_mul_f32 %2, %7, %11\n v_mul_f32 %3, %8, %12\n"
        "v_mul_f32 %4, %0, %0\n v_fma_f32 %4, %1, %1, %4\n v_fma_f32 %4, %2, %2, %4\n v_fma_f32 %4, %3, %3, %4"
        : "=&v"(kk[0]), "=&v"(kk[1]), "=&v"(kk[2]), "=&v"(kk[3]), "=&v"(ss) : "v"(k[0]), "v"(k[1]), "v"(k[2]), "v"(k[3]), "v"(c[0]), "v"(c[1]), "v"(c[2]), "v"(c[3])); }
__device__ __forceinline__ void row_update2(float (&s)[4], const f32x4 w, const f32x4 b, const f32x4 k, float v, float vkr, float sa, float yp, float& y) {
    float t0, t1, t2, t3;
    asm("v_mul_f32 %0, %6, %14\n v_mul_f32 %1, %6, %15\n v_mul_f32 %2, %6, %16\n v_mul_f32 %3, %6, %17\n"
        "v_add_f32 %4, %4, %5\n"
        "v_fmac_f32 %0, %7, %10\n v_fmac_f32 %1, %7, %11\n v_fmac_f32 %2, %7, %12\n v_fmac_f32 %3, %7, %13\n"
        "v_fmac_f32 %0, %8, %18\n v_fmac_f32 %1, %9, %19\n v_fmac_f32 %2, %22, %20\n v_fmac_f32 %3, %23, %21"
        : "=&v"(t0), "=&v"(t1), "=&v"(t2), "=&v"(t3), "+v"(yp)
        : "v"(vkr), "v"(v), "v"(sa), "v"(s[0]), "v"(s[1]), "v"(b[0]), "v"(b[1]), "v"(b[2]), "v"(b[3]), "v"(k[0]), "v"(k[1]), "v"(k[2]), "v"(k[3]), "v"(w[0]), "v"(w[1]), "v"(w[2]), "v"(w[3]), "v"(s[2]), "v"(s[3]));
    s[0] = t0; s[1] = t1; s[2] = t2; s[3] = t3; y = yp; }
__device__ __forceinline__ void row_update3(float (&s)[4], const f32x4 w, const f32x4 b, const f32x4 k, float v, float sa) {
    float t0, t1, t2, t3;
    asm("v_mul_f32 %0, %4, %12\n v_mul_f32 %1, %4, %13\n v_mul_f32 %2, %4, %14\n v_mul_f32 %3, %4, %15\n"
        "v_fmac_f32 %0, %5, %8\n v_fmac_f32 %1, %5, %9\n v_fmac_f32 %2, %5, %10\n v_fmac_f32 %3, %5, %11\n"
        "v_fmac_f32 %0, %6, %16\n v_fmac_f32 %1, %7, %17\n v_fmac_f32 %2, %20, %18\n v_fmac_f32 %3, %21, %19"
        : "=&v"(t0), "=&v"(t1), "=&v"(t2), "=&v"(t3)
        : "v"(v), "v"(sa), "v"(s[0]), "v"(s[1]), "v"(b[0]), "v"(b[1]), "v"(b[2]), "v"(b[3]), "v"(k[0]), "v"(k[1]), "v"(k[2]), "v"(k[3]), "v"(w[0]), "v"(w[1]), "v"(w[2]), "v"(w[3]), "v"(s[2]), "v"(s[3]));
    s[0] = t0; s[1] = t1; s[2] = t2; s[3] = t3; }
#define DPP2S(c) DPPA("%0", c) DPPA("%2", c)
__device__ __forceinline__ void red16x4y(float& a, float& b, float& c, float& d) {
    asm("s_nop 1\n" DPP4("quad_perm:[1,0,3,2]") DPP4("quad_perm:[2,3,0,1]") DPP4("row_half_mirror") DPP2S("row_mirror") : "+v"(a), "+v"(b), "+v"(c), "+v"(d)); }
__device__ __forceinline__ void red16x2y(float& a, float& b) {
    asm("s_nop 1\n" DPP2("quad_perm:[1,0,3,2]") DPP2("quad_perm:[2,3,0,1]") DPP2("row_half_mirror") DPPA("%0", "row_mirror") : "+v"(a), "+v"(b)); }
template <int CTRL> __device__ __forceinline__ float dppf(float x) { return __int_as_float(__builtin_amdgcn_update_dpp(0, __float_as_int(x), CTRL, 0xF, 0xF, true)); }
__device__ __forceinline__ float red4(float x) { x += dppf<0xB1>(x); x += dppf<0x4E>(x); return x; }
__device__ __forceinline__ float red8(float x) { x = red4(x); x += dppf<0x141>(x); return x; }
__device__ __forceinline__ float red16(float x) { x = red8(x); x += dppf<0x140>(x); return x; }
__device__ __forceinline__ int opaque_tid() { int t = threadIdx.x; asm volatile("" : "+v"(t)); return t; }
__device__ __forceinline__ const float* xrow(const Params& p, int t) { return t < TP ? p.x_prompt + (size_t)t * DM : p.x_sample + (size_t)(t - TP) * DM; }
__device__ __forceinline__ void seq_of(int t, int& base, int& len) { if (t < TP) { base = t & ~2047; len = 2048; } else { base = TP + ((t - TP) & ~16383); len = 16384; } }

namespace pg8 {
constexpr int BM = 256, BK = 64, HALF = 128, HTB = HALF * BK * 2, STAGE_BYTES = 8 * HTB, NXCD = 8, WGM = 8;
__device__ __forceinline__ int lds_byte(int r, int c) { const int st = (r >> 4) * 2 + (c >> 5), rr = r & 15, cc = c & 31, ob = rr * 64 + cc * 2; return st * 1024 + (ob ^ (((ob >> 9) & 1) << 5)); }
__device__ __forceinline__ void stage_rc(int b, int& R, int& C) { const int st = b / 1024, sb = b % 1024, swz = sb ^ (((sb >> 9) & 1) << 5); R = (st >> 1) * 16 + swz / 64; C = (st & 1) * 32 + (swz % 64) / 2; }
__device__ __forceinline__ int perm32(int rho) { const int n = rho >> 4, i = rho & 15; return 8 * (i >> 2) + 4 * n + (i & 3); }
struct Unit { int pm, pn; };
struct Gemm { const bf16_t* A; const bf16_t* Bt; int M, N, K, lda, ldb; const bf16_t* A2; int ks; };
struct StaticOrder {
    int nM, nN, nwg, G, c;
    __device__ void init(int M, int N, int G_, int c_) { nM = M / BM; nN = N / BM; nwg = nM * nN; G = G_; c = c_; }
    __device__ bool next(int i, Unit& u) const {
        const long L = (long)i * G + c; if (L >= nwg) return false;
        int wgid = (int)L; { const int q = nwg / NXCD, r = nwg % NXCD, xcd = wgid % NXCD, off = wgid / NXCD; wgid = (xcd < r ? xcd * (q + 1) : r * (q + 1) + (xcd - r) * q) + off; }
        const int nig = WGM * nN, gid = wgid / nig, fm = gid * WGM, gsz = (nM - fm) < WGM ? (nM - fm) : WGM;
        u.pm = fm + ((wgid % nig) % gsz); u.pn = (wgid % nig) / gsz; return true;
    }
};

template <class Epi>
__device__ __forceinline__ void gemm_phase(LAS unsigned char* lds, const Gemm g, const StaticOrder& S, const Epi& E) {
    const int tid = opaque_tid();
    const int wid = __builtin_amdgcn_readfirstlane(tid >> 6), lane = tid & 63, wr = wid >> 2, wc = wid & 3, fr = lane & 15, fq = lane >> 4;
    const int K = g.K, nt = K / BK;
    unsigned voffA[2], voffB[2];
#pragma unroll
    for (int i = 0; i < 2; ++i) { int R, C; stage_rc(tid * 16 + i * 8192, R, C); const int Rb = (R & ~31) + perm32(R & 31);
        voffA[i] = (unsigned)(R * g.lda + C) * 2u; voffB[i] = (unsigned)(Rb * g.ldb + C) * 2u; }
    const size_t kstep = (size_t)(BK * 2);
    const size_t hstepA = (size_t)HALF * g.lda * 2, hstepB = (size_t)HALF * g.ldb * 2;
    const size_t tstepA = 2 * hstepA, tstepB = 2 * hstepB;
    const unsigned ldsw = (unsigned)wid * 1024u;
    const int aoff = lds_byte(wr * 64 + fr, fq * 8), boff = lds_byte(wc * 32 + fr, fq * 8);
#define PG8_SA(b, h) (((b) * 2 + (h)) * HTB)
#define PG8_SB(b, h) ((4 + (b) * 2 + (h)) * HTB)
#define PG8_STAGE(bufoff, gbase, voff) do { _Pragma("unroll") for (int _i = 0; _i < 2; ++_i) \
        __builtin_amdgcn_global_load_lds((const unsigned*)((const char*)(gbase) + (voff)[_i]), (LAS unsigned*)(lds + (bufoff) + ldsw + _i * 8192), 16, 0, 0); } while (0)
#define PG8_LDA(dst, b, h) do { _Pragma("unroll") for (int m = 0; m < 4; ++m) _Pragma("unroll") for (int k = 0; k < 2; ++k) dst[m][k] = *(const LAS bf16x8*)(lds + PG8_SA(b, h) + aoff + m * 2048 + k * 1024); } while (0)
#define PG8_LDB(dst, b, h) do { _Pragma("unroll") for (int n = 0; n < 2; ++n) _Pragma("unroll") for (int k = 0; k < 2; ++k) dst[n][k] = *(const LAS bf16x8*)(lds + PG8_SB(b, h) + boff + n * 2048 + k * 1024); } while (0)
#define PG8_MMA(ai, bj, At, Bt) do { __builtin_amdgcn_s_setprio(1); _Pragma("unroll") for (int m = 0; m < 4; ++m) _Pragma("unroll") for (int n = 0; n < 2; ++n) _Pragma("unroll") for (int k = 0; k < 2; ++k) \
        acc[ai][bj][m][n] = __builtin_amdgcn_mfma_f32_16x16x32_bf16(Bt[n][k], At[m][k], acc[ai][bj][m][n], 0, 0, 0); __builtin_amdgcn_s_setprio(0); } while (0)
#define PG8_WAIT_V(n) asm volatile("s_waitcnt vmcnt(" #n ")" ::: "memory")
#define PG8_WAIT_L(n) asm volatile("s_waitcnt lgkmcnt(" #n ")" ::: "memory")
#define PG8_BAR __builtin_amdgcn_s_barrier()
#define PG8_SCHED __builtin_amdgcn_sched_barrier(0)
    Unit cur, nxt; int ui = 0;
    if (!S.next(0, cur)) return;
    f32x4 acc[2][2][4][2];
#pragma unroll
    for (int a = 0; a < 2; ++a)
#pragma unroll
        for (int b = 0; b < 2; ++b)
#pragma unroll
            for (int m = 0; m < 4; ++m)
#pragma unroll
                for (int n = 0; n < 2; ++n) acc[a][b][m][n] = (f32x4){0.f, 0.f, 0.f, 0.f};
    bf16x8 At[4][2], B0[2][2], B1[2][2];
    const char* cA = (const char*)g.A + (size_t)cur.pm * tstepA; const char* cB = (const char*)g.Bt + (size_t)cur.pn * tstepB;
    const bool two = g.A2 != nullptr; const int ks = two ? g.ks : (1 << 30);
    const char* cA2 = two ? (const char*)g.A2 + (size_t)cur.pm * tstepA : cA;
    PG8_STAGE(PG8_SB(0, 0), cB, voffB); PG8_STAGE(PG8_SA(0, 0), cA, voffA); PG8_STAGE(PG8_SB(0, 1), cB + hstepB, voffB); PG8_STAGE(PG8_SA(0, 1), cA + hstepA, voffA);
    if (wr == 1) PG8_BAR;
    PG8_WAIT_V(4); PG8_BAR;
    PG8_STAGE(PG8_SB(1, 0), cB + kstep, voffB); PG8_STAGE(PG8_SA(1, 0), cA + kstep, voffA); PG8_STAGE(PG8_SB(1, 1), cB + hstepB + kstep, voffB);
    PG8_WAIT_V(6); PG8_BAR;
    for (;;) {
        const bool has_next = S.next(ui + 1, nxt);
        const char* nA = has_next ? (const char*)g.A + (size_t)nxt.pm * tstepA : cA; const char* nB = has_next ? (const char*)g.Bt + (size_t)nxt.pn * tstepB : cB;
        const char* nA2 = (two && has_next) ? (const char*)g.A2 + (size_t)nxt.pm * tstepA : cA2;
#pragma unroll 1
        for (int t = 0; t < nt; t += 2) {
            const bool last = (t == nt - 2);
            const char* a1 = (t + 1 < ks) ? cA + (size_t)(t + 1) * kstep : cA2 + (size_t)(t + 1 - ks) * kstep;
            const char* a2 = last ? nA : ((t + 2 < ks) ? cA + (size_t)(t + 2) * kstep : cA2 + (size_t)(t + 2 - ks) * kstep); const char* b2 = last ? nB : cB + (size_t)(t + 2) * kstep;
            const char* a3 = a2 + kstep; const char* b3 = b2 + kstep;
            PG8_LDB(B0, 0, 0); PG8_SCHED; PG8_LDA(At, 0, 0); PG8_STAGE(PG8_SA(1, 1), a1 + hstepA, voffA);
            PG8_WAIT_L(8); PG8_BAR; PG8_WAIT_L(0); PG8_MMA(0, 0, At, B0); PG8_BAR; PG8_SCHED;
            PG8_LDB(B1, 0, 1); PG8_STAGE(PG8_SB(0, 0), b2, voffB);
            PG8_BAR; PG8_WAIT_L(0); PG8_MMA(0, 1, At, B1); PG8_BAR;
            PG8_LDA(At, 0, 1); PG8_STAGE(PG8_SA(0, 0), a2, voffA);
            PG8_BAR; PG8_WAIT_L(0); PG8_MMA(1, 0, At, B0); PG8_BAR; PG8_SCHED;
            PG8_STAGE(PG8_SB(0, 1), b2 + hstepB, voffB);
            PG8_WAIT_V(6); PG8_BAR; PG8_MMA(1, 1, At, B1); PG8_BAR;
            PG8_LDB(B0, 1, 0); PG8_SCHED; PG8_LDA(At, 1, 0); PG8_STAGE(PG8_SA(0, 1), a2 + hstepA, voffA);
            PG8_WAIT_L(8); PG8_BAR; PG8_WAIT_L(0); PG8_MMA(0, 0, At, B0); PG8_BAR; PG8_SCHED;
            PG8_LDB(B1, 1, 1); PG8_STAGE(PG8_SB(1, 0), b3, voffB);
            PG8_BAR; PG8_WAIT_L(0); PG8_MMA(0, 1, At, B1); PG8_BAR;
            PG8_LDA(At, 1, 1); PG8_STAGE(PG8_SA(1, 0), a3, voffA);
            PG8_BAR; PG8_WAIT_L(0); PG8_MMA(1, 0, At, B0); PG8_BAR; PG8_SCHED;
            PG8_STAGE(PG8_SB(1, 1), b3 + hstepB, voffB);
            PG8_WAIT_V(6); PG8_BAR; PG8_MMA(1, 1, At, B1); PG8_BAR;
        }
        E(acc, cur, wr, wc, fr, fq);
        if (!has_next) break;
#pragma unroll
        for (int a = 0; a < 2; ++a)
#pragma unroll
            for (int b = 0; b < 2; ++b)
#pragma unroll
                for (int m = 0; m < 4; ++m)
#pragma unroll
                    for (int n = 0; n < 2; ++n) acc[a][b][m][n] = (f32x4){0.f, 0.f, 0.f, 0.f};
        cur = nxt; cA = nA; cA2 = nA2; cB = nB; ++ui;
    }
    PG8_WAIT_V(0);
    if (wr == 0) PG8_BAR;
    PG8_BAR;
#undef PG8_SA
#undef PG8_SB
#undef PG8_STAGE
#undef PG8_LDA
#undef PG8_LDB
#undef PG8_MMA
#undef PG8_WAIT_V
#undef PG8_WAIT_L
#undef PG8_BAR
#undef PG8_SCHED
}
}
using pg8::Unit;

#define EPI_LOOP_BEGIN const int row0 = u.pm * 256 + wr * 64 + fr, col0 = u.pn * 256 + wc * 32 + 8 * fq; \
    _Pragma("unroll") for (int ai = 0; ai < 2; ++ai) _Pragma("unroll") for (int m = 0; m < 4; ++m) { const int row = row0 + ai * 128 + m * 16;
#define EPI_BJ _Pragma("unroll") for (int bj = 0; bj < 2; ++bj) { const int col = col0 + bj * 128; const f32x4 v0 = acc[ai][bj][m][0], v1 = acc[ai][bj][m][1];
#define EPI_ACC const f32x4 (&acc)[2][2][4][2], const Unit& u, int wr, int wc, int fr, int fq

__device__ __forceinline__ u32x4 pack8(const f32x4 a, const f32x4 b) { u32x4 w; w.x = pk_bf16(a[0], a[1]); w.y = pk_bf16(a[2], a[3]); w.z = pk_bf16(b[0], b[1]); w.w = pk_bf16(b[2], b[3]); return w; }
__device__ __forceinline__ void unpack8(const u32x4 w, f32x4& a, f32x4& b) { a = (f32x4){bf_lo(w.x), bf_hi(w.x), bf_lo(w.y), bf_hi(w.y)}; b = (f32x4){bf_lo(w.z), bf_hi(w.z), bf_lo(w.w), bf_hi(w.w)}; }

struct EpiStore {
    bf16_t* O; int ldc;
    __device__ __forceinline__ void operator()(EPI_ACC) const { EPI_LOOP_BEGIN EPI_BJ *(u32x4*)(O + (size_t)row * ldc + col) = pack8(v0, v1); } } }
};
struct EpiMulInPlace {
    bf16_t* Y;
    __device__ __forceinline__ void operator()(EPI_ACC) const { EPI_LOOP_BEGIN if ((m & 1) == 0) __builtin_amdgcn_sched_barrier(0);
        EPI_BJ u32x4* ptr = (u32x4*)(Y + (size_t)row * 1024 + col); f32x4 a, b; unpack8(*ptr, a, b); *ptr = pack8(a * v0, b * v1); } } }
};
struct EpiGates {
    bf16_t* G; const float* bias;
    __device__ __forceinline__ void operator()(EPI_ACC) const { EPI_LOOP_BEGIN EPI_BJ
        const f32x4 b0 = *(const f32x4*)(bias + col), b1 = *(const f32x4*)(bias + col + 4); f32x4 a, b;
#pragma unroll
        for (int j = 0; j < 4; ++j) { a[j] = sigmoidf_(v0[j] + b0[j]); b[j] = sigmoidf_(v1[j] + b1[j]); }
        *(u32x4*)(G + (size_t)row * 2048 + col) = pack8(a, b); } } }
};
struct EpiPool {
    bf16_t* P; const bf16_t* G;
    __device__ __forceinline__ void operator()(EPI_ACC) const { EPI_LOOP_BEGIN EPI_BJ f32x4 a, b; unpack8(*(const u32x4*)(G + (size_t)row * 2048 + col), a, b);
        *(u32x4*)(P + (size_t)row * 1024 + col) = pack8(a * v0, b * v1); } } }
};
struct EpiMerge {
    bf16_t* P; const bf16_t* G;
    __device__ __forceinline__ void operator()(EPI_ACC) const { EPI_LOOP_BEGIN EPI_BJ f32x4 a, b, pa, pb; unpack8(*(const u32x4*)(G + (size_t)row * 2048 + 1024 + col), a, b);
        u32x4* ptr = (u32x4*)(P + (size_t)row * 1024 + col); unpack8(*ptr, pa, pb); *ptr = pack8(pa + a * v0, pb + b * v1); } } }
};
struct EpiOut {
    const float* xp; const float* xs; float* X1; bf16_t* X1B; float* rowsq;
    __device__ __forceinline__ void operator()(EPI_ACC) const { EPI_LOOP_BEGIN const float* xr = row < TP ? xp + (size_t)row * DM : xs + (size_t)(row - TP) * DM; float ss = 0.f; EPI_BJ
        f32x4 a = *(const f32x4*)(xr + col) + v0, b = *(const f32x4*)(xr + col + 4) + v1;
        *(f32x4*)(X1 + (size_t)row * 1024 + col) = a; *(f32x4*)(X1 + (size_t)row * 1024 + col + 4) = b; *(u32x4*)(X1B + (size_t)row * 1024 + col) = pack8(a, b);
#pragma unroll
        for (int j = 0; j < 4; ++j) ss += a[j] * a[j] + b[j] * b[j]; }
        ss += __shfl_xor(ss, 16); ss += __shfl_xor(ss, 32); if (fq == 0) atomicAdd(rowsq + row, ss); } }
};
struct EpiFF1 {
    bf16_t* Hlo; bf16_t* Hhi; const float* rowsq;
    __device__ __forceinline__ void operator()(EPI_ACC) const { bf16_t* H = u.pn < 8 ? Hlo : Hhi; const int cshift = u.pn < 8 ? 0 : 2048;
        EPI_LOOP_BEGIN const float rinv = rsqrtf(rowsq[row] * (1.0f / 1024.0f) + 1e-6f); EPI_BJ f32x4 a, b;
#pragma unroll
        for (int j = 0; j < 4; ++j) { float t0 = fmaxf(v0[j] * rinv, 0.f), t1 = fmaxf(v1[j] * rinv, 0.f); a[j] = t0 * t0; b[j] = t1 * t1; }
        *(u32x4*)(H + (size_t)row * 2048 + (col - cshift)) = pack8(a, b); } } }
};
struct EpiAddInPlace {
    float* X;
    __device__ __forceinline__ void operator()(EPI_ACC) const { EPI_LOOP_BEGIN EPI_BJ f32x4* ptr = (f32x4*)(X + (size_t)row * 1024 + col); ptr[0] = ptr[0] + v0; ptr[1] = ptr[1] + v1; } } }
};
struct EpiFinal {
    float* X; float* rowsq;
    __device__ __forceinline__ void operator()(EPI_ACC) const { EPI_LOOP_BEGIN float ss = 0.f; EPI_BJ f32x4* ptr = (f32x4*)(X + (size_t)row * 1024 + col); const f32x4 a = ptr[0] + v0, b = ptr[1] + v1; ptr[0] = a; ptr[1] = b;
#pragma unroll
        for (int j = 0; j < 4; ++j) ss += a[j] * a[j] + b[j] * b[j]; }
        ss += __shfl_xor(ss, 16); ss += __shfl_xor(ss, 32); if (fq == 0) atomicAdd(rowsq + row, ss); } }
};

template <class Epi>
__device__ __forceinline__ void run_gemm(unsigned char* shm, const bf16_t* A, int lda, const bf16_t* Bt, int ldb, int N, int K, const Epi& E, const bf16_t* A2 = nullptr, int ks = 0) {
    pg8::Gemm g; g.A = A; g.Bt = Bt; g.M = T_TOK; g.N = N; g.K = K; g.lda = lda; g.ldb = ldb; g.A2 = A2; g.ks = ks;
    pg8::StaticOrder S; S.init(T_TOK, N, (int)gridDim.x, (int)blockIdx.x);
    pg8::gemm_phase<Epi>((LAS unsigned char*)shm, g, S, E);
}

__device__ __forceinline__ void transpose_tile(float* tile, int tid, const float* src, int N, bf16_t* dst, int ldd, const float* kscale, int t) {
    const int ntn = N / 64, tk = t / ntn, tn = t % ntn;
#pragma unroll
    for (int i = 0; i < 8; ++i) { const int kl = (tid >> 6) + 8 * i, nl = tid & 63; const int k = tk * 64 + kl;
        tile[kl * 65 + nl] = src[(size_t)k * N + tn * 64 + nl] * (kscale ? kscale[k] : 1.0f); }
    __syncthreads();
#pragma unroll
    for (int i = 0; i < 8; ++i) { const int nl = (tid >> 6) + 8 * i, kl = tid & 63;
        const unsigned w = pk_bf16(tile[kl * 65 + nl], 0.f); dst[(size_t)(tn * 64 + nl) * ldd + tk * 64 + kl] = (bf16_t)(w & 0xFFFFu); }
    __syncthreads();
}
__device__ void transpose_cvt(unsigned char* shm, const float* src, int K, int N, bf16_t* dst, int ldd, const float* kscale) {
    float* tile = (float*)shm;
    const int tid = opaque_tid(), ntk = K / 64, ntn = N / 64;
    for (int t = blockIdx.x; t < ntk * ntn; t += gridDim.x) transpose_tile(tile, tid, src, N, dst, ldd, kscale, t);
}
constexpr int DU_RBR = 256, DU_OUT = 512, DU_FF1 = 1536, DU_FF2 = 2560, DU_G = 2592, DU_GZ = 2624, N_DEFER = 2624 + 256;
__device__ void deferred_unit(const Params& p, unsigned char* shm, int tid, int u) {
    unsigned char* ws = p.ws; float* tile = (float*)shm;
    if (u < DU_RBR) transpose_tile(tile, tid, p.w_rwkv_br, 1024, (bf16_t*)(ws + OFF_WRBR), 1024, nullptr, u);
    else if (u < DU_OUT) transpose_tile(tile, tid, p.w_out, 1024, (bf16_t*)(ws + OFF_WOUT), 1024, nullptr, u - DU_RBR);
    else if (u < DU_FF1) transpose_tile(tile, tid, p.w_ff1, 4096, (bf16_t*)(ws + OFF_WFF1), 1024, p.g_ffn, u - DU_OUT);
    else if (u < DU_FF2) transpose_tile(tile, tid, p.w_ff2, 1024, (bf16_t*)(ws + OFF_WFF2), 4096, nullptr, u - DU_FF1);
    else if (u < DU_G) transpose_tile(tile, tid, p.g_up, 1024, (bf16_t*)(ws + OFF_WG), 256, nullptr, u - DU_FF2);
    else if (u < DU_GZ) { bf16_t* wg = (bf16_t*)(ws + OFF_WG);
#pragma unroll
        for (int m = 0; m < 8; ++m) { const int i = (u - DU_G) * 4096 + m * 512 + tid; wg[(size_t)(i >> 7) * 256 + 128 + (i & 127)] = 0; } }
    else {
        bf16_t* we = (bf16_t*)(ws + OFF_WEFF); const int base = (u - DU_GZ) * 2048; float acc[4] = {0.f, 0.f, 0.f, 0.f};
        const int gI = (base >> 10) >> 7;
        for (int d = 0; d < 128; ++d) { const float sc = p.pool_scale[gI * 128 + d];
#pragma unroll
            for (int m = 0; m < 4; ++m) { const int i = base + m * 512 + tid, k = i >> 10, n = i & 1023;
                acc[m] += p.pool_w[(size_t)k * 128 + d] * sc * p.w_pool_br[(size_t)(gI * 128 + d) * 1024 + n]; } }
#pragma unroll
        for (int m = 0; m < 4; ++m) { const int i = base + m * 512 + tid, k = i >> 10, n = i & 1023; we[(size_t)n * 512 + k] = (bf16_t)(pk_bf16(acc[m], 0.f) & 0xFFFFu); } }
}
__device__ void rmsnorm_rows(const Params& p, const float* g, bf16_t* dst) {
    const int tidx = opaque_tid(); const int lane = tidx & 63, wave = (blockIdx.x * 512 + tidx) >> 6, nw = (gridDim.x * 512) >> 6;
    f32x4 gv[4];
#pragma unroll
    for (int i = 0; i < 4; ++i) gv[i] = *(const f32x4*)(g + lane * 4 + 256 * i);
    for (int t0 = wave; t0 < T_TOK; t0 += 2 * nw) {
        const int t1 = t0 + nw; const bool has1 = t1 < T_TOK;
        const float* xr0 = xrow(p, t0); const float* xr1 = xrow(p, has1 ? t1 : t0); f32x4 v0[4], v1[4]; float ss0 = 0.f, ss1 = 0.f;
#pragma unroll
        for (int i = 0; i < 4; ++i) { v0[i] = *(const f32x4*)(xr0 + lane * 4 + 256 * i); v1[i] = *(const f32x4*)(xr1 + lane * 4 + 256 * i); }
#pragma unroll
        for (int i = 0; i < 4; ++i) { ss0 += v0[i][0] * v0[i][0] + v0[i][1] * v0[i][1] + v0[i][2] * v0[i][2] + v0[i][3] * v0[i][3]; ss1 += v1[i][0] * v1[i][0] + v1[i][1] * v1[i][1] + v1[i][2] * v1[i][2] + v1[i][3] * v1[i][3]; }
#pragma unroll
        for (int o = 1; o < 64; o <<= 1) { ss0 += __shfl_xor(ss0, o); ss1 += __shfl_xor(ss1, o); }
        const float r0 = rsqrtf(ss0 * (1.0f / 1024.0f) + 1e-6f), r1 = rsqrtf(ss1 * (1.0f / 1024.0f) + 1e-6f);
#pragma unroll
        for (int i = 0; i < 4; ++i) { u32x2 w; w.x = pk_bf16(v0[i][0] * r0 * gv[i][0], v0[i][1] * r0 * gv[i][1]); w.y = pk_bf16(v0[i][2] * r0 * gv[i][2], v0[i][3] * r0 * gv[i][3]);
            *(u32x2*)(dst + (size_t)t0 * 1024 + lane * 4 + 256 * i) = w; }
        if (has1) {
#pragma unroll
            for (int i = 0; i < 4; ++i) { u32x2 w; w.x = pk_bf16(v1[i][0] * r1 * gv[i][0], v1[i][1] * r1 * gv[i][1]); w.y = pk_bf16(v1[i][2] * r1 * gv[i][2], v1[i][3] * r1 * gv[i][3]);
                *(u32x2*)(dst + (size_t)t1 * 1024 + lane * 4 + 256 * i) = w; } }
    }
}

__device__ void prep_phase(const Params& p, unsigned char* shm) {
    unsigned char* ws = p.ws;
    const int gtid = blockIdx.x * 512 + opaque_tid(), gn = gridDim.x * 512;
    for (int i = gtid; i < T_TOK; i += gn) { ((float*)(ws + OFF_ROWSQ))[i] = 0.f; ((float*)(ws + OFF_ROWSQ2))[i] = 0.f; }
    if (gtid < 64) ((unsigned*)(ws + OFF_QUEUE))[gtid] = 0u;
    transpose_cvt(shm, p.w_in, 1024, 5888, (bf16_t*)(ws + OFF_WIN), 1024, nullptr);
    rmsnorm_rows(p, p.g_mix, (bf16_t*)(ws + OFF_R1));
}

#define LDS_BAR() do { asm volatile("s_waitcnt lgkmcnt(0)" ::: "memory"); __builtin_amdgcn_s_barrier(); asm volatile("" ::: "memory"); } while (0)
constexpr int N_SAMPLE_ITEMS = 128, N_ITEMS = N_SAMPLE_ITEMS + 1024;

template <int LPR, int RPL, int DIR>
__device__ __forceinline__ void scan_item(const Params& p, unsigned char* shm, const int tid, const int tbase, const int L, const int h, const int half) {
    constexpr int dir = DIR;
    constexpr int EC = 64 / LPR, RPW = RPL * (64 / LPR);
    float* sW = (float*)shm; float* sAV = sW + 2048; float* sBV = sW + 4096; float* sKD = sW + 6144; float* sWR = sW + 8192; float* sR = sW + 10240; float* sV = sW + 12288; float* sY = sW + 14336;
    float* sBK = sW + 16384;
    bf16_t* sTW = (bf16_t*)(sW + 16384 + 64);
    bf16_t* sZA = sTW + 32 * 72;
    const int lane = tid & 63, wv = tid >> 6;
    const bf16_t* zall = (const bf16_t*)(p.ws + OFF_Z);
    const int tokA = tid >> 4, q = tid & 15;
    const int rowS = half * 32 + wv * RPW + RPL * (lane / LPR), gS = lane % LPR;
    const int NC = L / 32;
    bf16_t* ybuf = (bf16_t*)p.out + (dir ? (size_t)T_TOK * 1024 : 0);
    float* bonus = (float*)(p.ws + OFF_BONUS) + (dir ? (size_t)T_TOK * 16 : 0);
    const float* w_up = dir ? p.w_up_b : p.w_up_f; const float* a_up = dir ? p.a_up_b : p.a_up_f;
    const float* w0 = dir ? p.w0_b : p.w0_f; const float* a0 = dir ? p.a0_b : p.a0_f;
    const int mat = wv >> 2, cbk = wv & 3, colB = cbk * 16 + (lane & 15), quad = lane >> 4;
    u32x4* sBF = (u32x4*)(shm + 84 * 1024);
    { const float* up = mat ? a_up : w_up;
#pragma unroll
      for (int kb = 0; kb < 2; ++kb) { float f[8];
#pragma unroll
          for (int j = 0; j < 8; ++j) f[j] = up[(size_t)(kb * 32 + quad * 8 + j) * 1024 + h * 64 + colB];
          u32x4 w; w.x = pk_bf16(f[0], f[1]); w.y = pk_bf16(f[2], f[3]); w.z = pk_bf16(f[4], f[5]); w.w = pk_bf16(f[6], f[7]); sBF[kb * 512 + tid] = w; } }
    const float c0B = (mat ? a0 : w0)[h * 64 + colB];
    const float kaB = p.k_a[h * 64 + colB];
    int colz[5];
    float* sV2 = (float*)(shm + 104 * 1024);
    float* sYP = (float*)(shm + 112 * 1024);
    float* sM0 = (float*)(shm + 100 * 1024);
    float* sMU = (float*)(shm + 76 * 1024);
#pragma unroll
    for (int gi = 0; gi < 5; ++gi) colz[gi] = (gi == 0 ? COL_R + h * 64 : gi == 1 ? COL_K + h * 64 : gi == 2 ? COL_V + h * 64 : gi == 3 ? COL_W : COL_A) + 4 * q;
    if (tid < 320) { const int gi = tid >> 6, c = tid & 63; const int col = (gi == 0 ? COL_R + h * 64 : gi == 1 ? COL_K + h * 64 : gi == 2 ? COL_V + h * 64 : gi == 3 ? COL_W : COL_A) + c - COL_R;
        const float mpv_ = p.mu_prev[col], mnv_ = p.mu_next[col]; sMU[gi * 64 + c] = mpv_; sMU[320 + gi * 64 + c] = mnv_; sM0[gi * 64 + c] = 1.0f - mpv_ - mnv_; }
    else if (tid < 384) sMU[640 + (tid - 320)] = p.k_k[h * 64 + (tid - 320)];
    else if (tid < 448) sMU[704 + (tid - 384)] = p.r_k[h * 64 + (tid - 384)];
    __syncthreads();
    float s[RPL][EC];
#pragma unroll
    for (int r = 0; r < RPL; ++r)
#pragma unroll
        for (int j = 0; j < EC; ++j) s[r][j] = 0.f;
    u32x2 zc[5], zp[5], zn[5];
    auto load_chunk = [&](int ci) {
        const int t = tbase + 32 * (dir ? NC - 1 - ci : ci) + tokA; const bool hasPrev = t > tbase, hasNext = t < tbase + L - 1;
        const bf16_t* zr = zall + (size_t)t * ZLD;
#pragma unroll
        for (int gi = 0; gi < 5; ++gi) { zc[gi] = *(const u32x2*)(zr + colz[gi]); zp[gi] = (u32x2){0u, 0u}; zn[gi] = (u32x2){0u, 0u};
            if (hasPrev) zp[gi] = *(const u32x2*)(zr - ZLD + colz[gi]);
            if (hasNext) zn[gi] = *(const u32x2*)(zr + ZLD + colz[gi]); }
    };
    load_chunk(0);
    for (int ci = 0; ci < NC; ++ci) {
        const int t0 = tbase + 32 * (dir ? NC - 1 - ci : ci);
        { float zs[5][4];
          f32x4 MP[5], MN[5], M0[5];
#pragma unroll
          for (int gi = 0; gi < 5; ++gi) { MP[gi] = *(const f32x4*)(sMU + gi * 64 + 4 * q); MN[gi] = *(const f32x4*)(sMU + 320 + gi * 64 + 4 * q); M0[gi] = *(const f32x4*)(sM0 + gi * 64 + 4 * q); }
          const f32x4 kk4c = *(const f32x4*)(sMU + 640 + 4 * q);
#pragma unroll
          for (int gi = 0; gi < 5; ++gi) {
              const float c[4] = {bf_lo(zc[gi].x), bf_hi(zc[gi].x), bf_lo(zc[gi].y), bf_hi(zc[gi].y)}, pv[4] = {bf_lo(zp[gi].x), bf_hi(zp[gi].x), bf_lo(zp[gi].y), bf_hi(zp[gi].y)}, nx[4] = {bf_lo(zn[gi].x), bf_hi(zn[gi].x), bf_lo(zn[gi].y), bf_hi(zn[gi].y)};
              shift4(zs[gi], c, pv, nx, M0[gi], MP[gi], MN[gi]);
          }
          if (ci + 1 < NC) load_chunk(ci + 1);
          *(f32x4*)(sR + tokA * 64 + 4 * q) = (f32x4){zs[0][0], zs[0][1], zs[0][2], zs[0][3]};
          *(f32x4*)(sKD + tokA * 64 + 4 * q) = (f32x4){zs[1][0], zs[1][1], zs[1][2], zs[1][3]};
          *(f32x4*)(sV + tokA * 64 + 4 * q) = (f32x4){zs[2][0], zs[2][1], zs[2][2], zs[2][3]};
          float kk[4], ss;
          kk4(kk, ss, zs[1], kk4c);
          ss = ss + 0.0f * kk[0];
          ss = red16(ss);
          const float inv = -__builtin_amdgcn_rsqf(fmaxf(ss, 1e-24f));
          *(f32x4*)(sAV + tokA * 64 + 4 * q) = (f32x4){kk[0] * inv, kk[1] * inv, kk[2] * inv, kk[3] * inv};
          float tw[4];
#pragma unroll
          for (int j = 0; j < 4; ++j) tw[j] = 1.0f - 2.0f * __builtin_amdgcn_rcpf(1.0f + fexp2_scaled(zs[3][j], 2.8853900818f));
          u32x2 w; w.x = pk_bf16(tw[0], tw[1]); w.y = pk_bf16(tw[2], tw[3]); *(u32x2*)(sTW + tokA * 72 + 4 * q) = w;
          w.x = pk_bf16(zs[4][0], zs[4][1]); w.y = pk_bf16(zs[4][2], zs[4][3]); *(u32x2*)(sZA + tokA * 72 + 4 * q) = w;
        }
        LDS_BAR();
        { const int matu = __builtin_amdgcn_readfirstlane(mat);
          const bf16_t* sX = matu ? sZA : sTW;
          const bf16x8 b0 = __builtin_bit_cast(bf16x8, sBF[tid]), b1 = __builtin_bit_cast(bf16x8, sBF[512 + tid]);
          const bf16_t* ap = sX + (lane & 15) * 72 + quad * 8;
          const bf16x8 a00 = *(const bf16x8*)(ap), a01 = *(const bf16x8*)(ap + 32), a10 = *(const bf16x8*)(ap + 16 * 72), a11 = *(const bf16x8*)(ap + 16 * 72 + 32);
          const int idx0 = (quad * 4) * 64 + colB;
          float o1[8], o2[8];
          if (matu == 0) {
#pragma unroll
              for (int i = 0; i < 8; ++i) o1[i] = sR[idx0 + ((i >> 2) * 16 + (i & 3)) * 64];
          } else {
#pragma unroll
              for (int i = 0; i < 8; ++i) { o1[i] = sKD[idx0 + ((i >> 2) * 16 + (i & 3)) * 64]; o2[i] = sAV[idx0 + ((i >> 2) * 16 + (i & 3)) * 64]; }
          }
          f32x4 acc0 = (f32x4){c0B, c0B, c0B, c0B}, acc1 = acc0;
          acc0 = __builtin_amdgcn_mfma_f32_16x16x32_bf16(a00, b0, acc0, 0, 0, 0); acc1 = __builtin_amdgcn_mfma_f32_16x16x32_bf16(a10, b0, acc1, 0, 0, 0);
          acc0 = __builtin_amdgcn_mfma_f32_16x16x32_bf16(a01, b1, acc0, 0, 0, 0); acc1 = __builtin_amdgcn_mfma_f32_16x16x32_bf16(a11, b1, acc1, 0, 0, 0);
          float sg[8];
#pragma unroll
          for (int i = 0; i < 8; ++i) sg[i] = sigmoidf_(i < 4 ? acc0[i & 3] : acc1[i & 3]);
          if (matu == 0) {
              float wv_[8];
#pragma unroll
              for (int i = 0; i < 8; ++i) wv_[i] = fexp2_scaled(sg[i], -0.6065306597f * 1.4426950409f);
#pragma unroll
              for (int i = 0; i < 8; ++i) { const int idx = idx0 + ((i >> 2) * 16 + (i & 3)) * 64; sW[idx] = wv_[i]; sWR[idx] = wv_[i] * o1[i]; }
          } else {
#pragma unroll
              for (int i = 0; i < 8; ++i) { const int idx = idx0 + ((i >> 2) * 16 + (i & 3)) * 64; sKD[idx] = o1[i] * (1.0f + (sg[i] - 1.0f) * kaB); sBV[idx] = -o2[i] * sg[i]; }
          } }
        LDS_BAR();
        { const f32x4 r4 = *(const f32x4*)(sR + tokA * 64 + 4 * q), b4 = *(const f32x4*)(sBV + tokA * 64 + 4 * q), k4 = *(const f32x4*)(sKD + tokA * 64 + 4 * q);
          float br = 0.f, kr = 0.f, cb = 0.f; const f32x4 rk4 = *(const f32x4*)(sMU + 704 + 4 * q);
#pragma unroll
          for (int j = 0; j < 4; ++j) { br += b4[j] * r4[j]; kr += k4[j] * r4[j]; cb += r4[j] * k4[j] * rk4[j]; }
          br = red16(br); kr = red16(kr); cb = red16(cb);
          { f32x4* qp = (f32x4*)(sWR + tokA * 64 + 4 * q); const f32x4 a4 = *(const f32x4*)(sAV + tokA * 64 + 4 * q); *qp = *qp + a4 * br; }
          { const f32x4 v4 = *(const f32x4*)(sV + tokA * 64 + 4 * q); *(f32x4*)(sV2 + tokA * 64 + 4 * q) = v4 * kr; }
          if (q == 0 && half == 0) bonus[(size_t)(t0 + tokA) * 16 + h] = cb; }
        LDS_BAR();
        {
            constexpr int NV = EC / 4;
            struct Ops { f32x4 w[NV], a[NV], b[NV], k[NV], q[NV]; float v[RPL]; };
            auto ld = [&](Ops& o, int i) { const int tk = DIR ? 31 - i : i; const int off = tk * 64 + 4 * gS;
#pragma unroll
                for (int c = 0; c < NV; ++c) { o.w[c] = *(const f32x4*)(sW + off + 32 * c); o.a[c] = *(const f32x4*)(sAV + off + 32 * c); o.b[c] = *(const f32x4*)(sBV + off + 32 * c);
                    o.k[c] = *(const f32x4*)(sKD + off + 32 * c); o.q[c] = *(const f32x4*)(sWR + off + 32 * c); }
                if constexpr (RPL == 2) { const f32x2 v2 = *(const f32x2*)(sV + tk * 64 + rowS); o.v[0] = v2.x; o.v[1] = v2.y; } else o.v[0] = sV[tk * 64 + rowS]; };
            auto step = [&](const Ops& cur, int i) {
                static_assert(EC == 4, "asm row helpers are written for 4 columns per lane");
                float sa[RPL], yp[RPL], y[RPL];
#pragma unroll
                for (int r = 0; r < RPL; ++r) row_dots(s[r], cur.a[0], cur.q[0], sa[r], yp[r]);
                if constexpr (RPL == 2) red16x4y(sa[0], yp[0], sa[1], yp[1]); else red16x2y(sa[0], yp[0]);
#pragma unroll
                for (int r = 0; r < RPL; ++r) { row_update3(s[r], cur.w[0], cur.b[0], cur.k[0], cur.v[r], sa[r]); y[r] = yp[r]; }
                if ((gS & 7) == 0) { float* yd = sYP + ((DIR ? 31 - i : i) * 2 + (gS >> 3)) * 64 + rowS; if constexpr (RPL == 2) *(f32x2*)yd = (f32x2){y[0], y[1]}; else *yd = y[0]; }
            };
            {
                Ops o0, o1, o2; ld(o0, 0); ld(o1, 1);
#pragma unroll 1
                for (int i = 0; i < 30; i += 3) {
                    ld(o2, i + 2);
                    step(o0, i);
                    ld(o0, i + 3);
                    step(o1, i + 1);
                    ld(o1, min(i + 4, 31));
                    step(o2, i + 2);
                }
                step(o0, 30);
                step(o1, 31);
            }
        }
        LDS_BAR();
        if (RPL == 2 || (q >> 3) == half) { const f32x4 y4 = *(const f32x4*)(sYP + (tokA * 2) * 64 + 4 * q) + *(const f32x4*)(sYP + (tokA * 2 + 1) * 64 + 4 * q) + *(const f32x4*)(sV2 + tokA * 64 + 4 * q); u32x2 w; w.x = pk_bf16(y4[0], y4[1]); w.y = pk_bf16(y4[2], y4[3]);
          *(u32x2*)(ybuf + (size_t)(t0 + tokA) * 1024 + h * 64 + 4 * q) = w; }
    }
}

__device__ void scan_phase(const Params& p, unsigned char* shm) {
    int* sItem = (int*)(shm + 80 * 1024);
    const int tid = opaque_tid();
    unsigned* queue = (unsigned*)(p.ws + OFF_QUEUE);
    for (;;) {
        if (tid == 0) *sItem = (int)atomicAdd(queue, 1u);
        __syncthreads();
        const int item = *sItem;
        __syncthreads();
        if (item >= N_ITEMS) break;
        int tid2 = tid; asm volatile("" : "+v"(tid2));
        if (item < N_SAMPLE_ITEMS) {
            const int half = item & 1, j = item >> 1;
            if (j & 1) scan_item<16, 1, 1>(p, shm, tid2, TP + (j >> 5) * 16384, 16384, (j >> 1) & 15, half); else scan_item<16, 1, 0>(p, shm, tid2, TP + (j >> 5) * 16384, 16384, (j >> 1) & 15, half);
        } else { const int j = item - N_SAMPLE_ITEMS;
            if (j & 1) scan_item<16, 2, 1>(p, shm, tid2, (j >> 5) * 2048, 2048, (j >> 1) & 15, 0); else scan_item<16, 2, 0>(p, shm, tid2, (j >> 5) * 2048, 2048, (j >> 1) & 15, 0); }
        __syncthreads();
    }
    for (;;) {
        if (tid == 0) *sItem = (int)atomicAdd(queue + 1, 1u);
        __syncthreads();
        const int u = *sItem;
        __syncthreads();
        if (u >= N_DEFER) break;
        deferred_unit(p, shm, tid, u);
    }
}


__device__ void mix_phase(const Params& p) {
    const int tidx = opaque_tid(); const int lane = tidx & 63, wave = (blockIdx.x * 512 + tidx) >> 6, nw = (gridDim.x * 512) >> 6;
    const bf16_t* zall = (const bf16_t*)(p.ws + OFF_Z);
    bf16_t* yf = (bf16_t*)p.out; const bf16_t* yb = (const bf16_t*)p.out + (size_t)T_TOK * 1024;
    const float* bonus_f = (const float*)(p.ws + OFF_BONUS); const float* bonus_b = bonus_f + (size_t)T_TOK * 16;
    bf16_t* pooled = (bf16_t*)(p.ws + OFF_POOLED); bf16_t* sg = (bf16_t*)(p.ws + OFF_SG);
    const int hL = lane >> 2;
    const int tpw = (T_TOK + nw - 1) / nw;
    for (int t = wave * tpw; t < min(T_TOK, (wave + 1) * tpw); ++t) {
        int tbase, L; seq_of(t, tbase, L); const int pos = t - tbase; const bool hasPrev = pos > 0, hasNext = pos < L - 1;
        const bf16_t* zr = zall + (size_t)t * ZLD;
        { const int c0 = lane * 16; float y[16];
          { const u32x4 a0 = *(const u32x4*)(yf + (size_t)t * 1024 + c0), a1 = *(const u32x4*)(yf + (size_t)t * 1024 + c0 + 8);
            const u32x4 b0 = *(const u32x4*)(yb + (size_t)t * 1024 + c0), b1 = *(const u32x4*)(yb + (size_t)t * 1024 + c0 + 8);
            f32x4 fa, fb, ga, gb; unpack8(a0, fa, fb); unpack8(b0, ga, gb);
#pragma unroll
            for (int j = 0; j < 4; ++j) { y[j] = fa[j] + ga[j]; y[4 + j] = fb[j] + gb[j]; }
            unpack8(a1, fa, fb); unpack8(b1, ga, gb);
#pragma unroll
            for (int j = 0; j < 4; ++j) { y[8 + j] = fa[j] + ga[j]; y[12 + j] = fb[j] + gb[j]; } }
          float sm = 0.f;
#pragma unroll
          for (int j = 0; j < 16; ++j) sm += y[j];
          const float mean = red4(sm) * (1.0f / 64.0f); float vs = 0.f;
#pragma unroll
          for (int j = 0; j < 16; ++j) { const float d = y[j] - mean; vs += d * d; }
          const float rstd = rsqrtf(red4(vs) * (1.0f / 64.0f) + 64e-5f);
          const float bon = bonus_f[(size_t)t * 16 + hL] + bonus_b[(size_t)t * 16 + hL];
          float vv[16];
          { const bf16_t* zc = zr + COL_V + c0;
            u32x4 c_[2], p_[2], n_[2];
#pragma unroll
            for (int i = 0; i < 2; ++i) { c_[i] = *(const u32x4*)(zc + 8 * i); p_[i] = hasPrev ? *(const u32x4*)(zc - ZLD + 8 * i) : (u32x4){0u, 0u, 0u, 0u}; n_[i] = hasNext ? *(const u32x4*)(zc + ZLD + 8 * i) : (u32x4){0u, 0u, 0u, 0u}; }
#pragma unroll
            for (int i = 0; i < 2; ++i) { f32x4 ca, cb, pa, pb, na, nb; unpack8(c_[i], ca, cb); unpack8(p_[i], pa, pb); unpack8(n_[i], na, nb);
                const float* mp = p.mu_prev + (COL_V - COL_R) + c0 + 8 * i; const float* mn = p.mu_next + (COL_V - COL_R) + c0 + 8 * i;
                const f32x4 mp0 = *(const f32x4*)mp, mp1 = *(const f32x4*)(mp + 4), mn0 = *(const f32x4*)mn, mn1 = *(const f32x4*)(mn + 4);
#pragma unroll
                for (int j = 0; j < 4; ++j) { vv[8 * i + j] = ca[j] + mp0[j] * (pa[j] - ca[j]) + mn0[j] * (na[j] - ca[j]); vv[8 * i + 4 + j] = cb[j] + mp1[j] * (pb[j] - cb[j]) + mn1[j] * (nb[j] - cb[j]); } } }
          float o[16];
#pragma unroll
          for (int i = 0; i < 4; ++i) { const f32x4 lw = *(const f32x4*)(p.ln_w + c0 + 4 * i), lb = *(const f32x4*)(p.ln_b + c0 + 4 * i);
#pragma unroll
              for (int j = 0; j < 4; ++j) o[4 * i + j] = (y[4 * i + j] - mean) * rstd * lw[j] + lb[j] + bon * vv[4 * i + j]; }
          u32x4 w0, w1; w0.x = pk_bf16(o[0], o[1]); w0.y = pk_bf16(o[2], o[3]); w0.z = pk_bf16(o[4], o[5]); w0.w = pk_bf16(o[6], o[7]);
          w1.x = pk_bf16(o[8], o[9]); w1.y = pk_bf16(o[10], o[11]); w1.z = pk_bf16(o[12], o[13]); w1.w = pk_bf16(o[14], o[15]);
          *(u32x4*)(yf + (size_t)t * 1024 + c0) = w0; *(u32x4*)(yf + (size_t)t * 1024 + c0 + 8) = w1; }
        { const int c = 2 * lane; const bf16_t* zc = zr + COL_G + c; const unsigned wc_ = *(const unsigned*)zc; const unsigned wp = hasPrev ? *(const unsigned*)(zc - ZLD) : 0u, wn = hasNext ? *(const unsigned*)(zc + ZLD) : 0u;
          const float mp0 = p.mu_prev[COL_G - COL_R + c], mp1 = p.mu_prev[COL_G - COL_R + c + 1], mn0 = p.mu_next[COL_G - COL_R + c], mn1 = p.mu_next[COL_G - COL_R + c + 1];
          const float c0v = bf_lo(wc_), c1v = bf_hi(wc_);
          const float z0 = c0v + mp0 * (bf_lo(wp) - c0v) + mn0 * (bf_lo(wn) - c0v), z1 = c1v + mp1 * (bf_hi(wp) - c1v) + mn1 * (bf_hi(wn) - c1v);
          *(unsigned*)(sg + (size_t)t * 256 + c) = pk_bf16(sigmoidf_(z0), sigmoidf_(z1)); *(unsigned*)(sg + (size_t)t * 256 + 128 + c) = 0u; }
        { const int c = lane * 8, gi = lane >> 4, w = 2 << gi; const int lo = max(pos - (w >> 1), 0), hi = min(pos + (w >> 1) - 1, L - 1);
          float sum[8];
#pragma unroll
          for (int j = 0; j < 8; ++j) sum[j] = 0.f;
          u32x4 wr_[16];
#pragma unroll
          for (int d = 0; d < 16; ++d) { const int r = pos - 8 + d; wr_[d] = (u32x4){0u, 0u, 0u, 0u}; if (r >= lo && r <= hi) wr_[d] = *(const u32x4*)(zall + (size_t)(tbase + r) * ZLD + c); }
#pragma unroll
          for (int d = 0; d < 16; ++d) { f32x4 a, b; unpack8(wr_[d], a, b);
#pragma unroll
              for (int j = 0; j < 4; ++j) { sum[j] += a[j]; sum[4 + j] += b[j]; } }
          const float icnt = 1.0f / (float)(hi - lo + 1); f32x4 a, b; unpack8(*(const u32x4*)(zr + c), a, b); f32x4 oa, ob;
#pragma unroll
          for (int j = 0; j < 4; ++j) { oa[j] = sum[j] * icnt - a[j]; ob[j] = sum[4 + j] * icnt - b[j]; }
          *(u32x4*)(pooled + (size_t)t * 512 + c) = pack8(oa, ob); }
    }
}

__device__ void final_phase(const Params& p) {
    const int tidx = opaque_tid(); const int lane = tidx & 63, wave = (blockIdx.x * 512 + tidx) >> 6, nw = (gridDim.x * 512) >> 6;
    const float* x2 = (const float*)(p.ws + OFF_X1); const float* rowsq2 = (const float*)(p.ws + OFF_ROWSQ2);
    f32x4 gv[4];
#pragma unroll
    for (int i = 0; i < 4; ++i) gv[i] = *(const f32x4*)(p.g_final + lane * 4 + 256 * i);
    for (int t0 = wave; t0 < T_TOK; t0 += 2 * nw) {
        const int t1 = t0 + nw < T_TOK ? t0 + nw : t0;
        const float r0 = rsqrtf(rowsq2[t0] * (1.0f / 1024.0f) + 1e-6f), r1 = rsqrtf(rowsq2[t1] * (1.0f / 1024.0f) + 1e-6f);
        f32x4 a[4], b[4];
#pragma unroll
        for (int i = 0; i < 4; ++i) { a[i] = *(const f32x4*)(x2 + (size_t)t0 * 1024 + lane * 4 + 256 * i); b[i] = *(const f32x4*)(x2 + (size_t)t1 * 1024 + lane * 4 + 256 * i); }
#pragma unroll
        for (int i = 0; i < 4; ++i) { *(f32x4*)(p.out + (size_t)t0 * 1024 + lane * 4 + 256 * i) = a[i] * r0 * gv[i]; *(f32x4*)(p.out + (size_t)t1 * 1024 + lane * 4 + 256 * i) = b[i] * r1 * gv[i]; }
    }
}

__global__ void __launch_bounds__(512, 2) fwd_megakernel(Params p) {
    extern __shared__ __attribute__((aligned(16))) unsigned char shm[];
    unsigned char* ws = p.ws;
    prep_phase(p, shm);
    cg::this_grid().sync();
    { EpiStore E; E.O = (bf16_t*)(ws + OFF_Z); E.ldc = ZLD; run_gemm(shm, (const bf16_t*)(ws + OFF_R1), 1024, (const bf16_t*)(ws + OFF_WIN), 1024, 3840, 1024, E); }
    cg::this_grid().sync();
    scan_phase(p, shm);
    cg::this_grid().sync();
    mix_phase(p);
    cg::this_grid().sync();
    rmsnorm_rows(p, p.g_mix, (bf16_t*)(ws + OFF_XN2));
    { EpiMulInPlace E; E.Y = (bf16_t*)p.out; run_gemm(shm, (const bf16_t*)(ws + OFF_SG), 256, (const bf16_t*)(ws + OFF_WG), 256, 1024, 256, E); }
    cg::this_grid().sync();
    { EpiGates E; E.G = (bf16_t*)(ws + OFF_GATES); E.bias = p.b_gate; run_gemm(shm, (const bf16_t*)(ws + OFF_XN2), 1024, (const bf16_t*)(ws + OFF_WIN) + (size_t)3840 * 1024, 1024, 2048, 1024, E); }
    cg::this_grid().sync();
    { EpiPool E; E.P = (bf16_t*)(ws + OFF_MERGED); E.G = (const bf16_t*)(ws + OFF_GATES); run_gemm(shm, (const bf16_t*)(ws + OFF_POOLED), 512, (const bf16_t*)(ws + OFF_WEFF), 512, 1024, 512, E); }
    { EpiMerge E; E.P = (bf16_t*)(ws + OFF_MERGED); E.G = (const bf16_t*)(ws + OFF_GATES); run_gemm(shm, (const bf16_t*)p.out, 1024, (const bf16_t*)(ws + OFF_WRBR), 1024, 1024, 1024, E); }
    cg::this_grid().sync();
    { EpiOut E; E.xp = p.x_prompt; E.xs = p.x_sample; E.X1 = (float*)(ws + OFF_X1); E.X1B = (bf16_t*)(ws + OFF_X1B); E.rowsq = (float*)(ws + OFF_ROWSQ); run_gemm(shm, (const bf16_t*)(ws + OFF_MERGED), 1024, (const bf16_t*)(ws + OFF_WOUT), 1024, 1024, 1024, E); }
    cg::this_grid().sync();
    { EpiFF1 E; E.Hlo = (bf16_t*)(ws + OFF_HLO); E.Hhi = (bf16_t*)p.out; E.rowsq = (const float*)(ws + OFF_ROWSQ); run_gemm(shm, (const bf16_t*)(ws + OFF_X1B), 1024, (const bf16_t*)(ws + OFF_WFF1), 1024, 4096, 1024, E); }
    cg::this_grid().sync();
    { EpiFinal E; E.X = (float*)(ws + OFF_X1); E.rowsq = (float*)(ws + OFF_ROWSQ2);
      run_gemm(shm, (const bf16_t*)(ws + OFF_HLO), 2048, (const bf16_t*)(ws + OFF_WFF2), 4096, 1024, 4096, E, (const bf16_t*)p.out, 32); }
    cg::this_grid().sync();
    final_phase(p);
}

extern "C" void kernel_launch(void* const* d_in, const int* in_sizes, int n_in, void* d_out, int out_size, void* d_ws, size_t ws_size, hipStream_t stream) {
    constexpr size_t kDynLds = 131072;
    static int grid_blocks = 0;
    if (!grid_blocks) {
        hipFuncSetAttribute((const void*)fwd_megakernel, hipFuncAttributeMaxDynamicSharedMemorySize, (int)kDynLds);
        int dev = 0, cus = 0, per_cu = 0;
        hipGetDevice(&dev);
        hipDeviceGetAttribute(&cus, hipDeviceAttributeMultiprocessorCount, dev);
        hipOccupancyMaxActiveBlocksPerMultiprocessor(&per_cu, fwd_megakernel, 512, kDynLds);
        if (per_cu < 1) per_cu = 1;
        grid_blocks = cus;
    }
    Params p{};
    const float** pf = (const float**)&p;
    for (int i = 0; i < 30; ++i) pf[i] = (const float*)d_in[i];
    p.out = (float*)d_out; p.ws = (unsigned char*)d_ws;
    void* args[] = {&p};
    hipError_t e = hipLaunchCooperativeKernel((const void*)fwd_megakernel, dim3(grid_blocks), dim3(512), args, kDynLds, stream);
    if (e != hipSuccess) fprintf(stderr, "cooperative launch failed: %s (grid %d)\n", hipGetErrorString(e), grid_blocks);
}
```

```cpp
#include <hip/hip_runtime.h>
#include <hip/hip_cooperative_groups.h>
#include <cstdio>
namespace cg = cooperative_groups;

#define LAS __attribute__((address_space(3)))
typedef unsigned short bf16_t;
typedef short bf16x8 __attribute__((ext_vector_type(8)));
typedef float f32x4 __attribute__((ext_vector_type(4)));
typedef float f32x2 __attribute__((ext_vector_type(2)));
typedef unsigned u32x4 __attribute__((ext_vector_type(4)));
typedef unsigned u32x2 __attribute__((ext_vector_type(2)));

constexpr int T_TOK = 98304, DM = 1024, TP = 65536;
constexpr int ZLD = 3840;
constexpr int COL_R = 512, COL_K = 1536, COL_V = 2560, COL_W = 3584, COL_A = 3648, COL_G = 3712;
constexpr size_t MiB = 1ull << 20;
constexpr size_t OFF_WIN = 0, OFF_WEFF = 12 * MiB, OFF_WRBR = 13 * MiB, OFF_WOUT = 15 * MiB, OFF_WFF1 = 17 * MiB, OFF_WFF2 = 25 * MiB, OFF_WG = 33 * MiB;
constexpr size_t OFF_ROWSQ = 34 * MiB, OFF_ROWSQ2 = 34 * MiB + 512 * 1024, OFF_QUEUE = 35 * MiB, OFF_BONUS = 36 * MiB;
constexpr size_t OFF_R1 = 48 * MiB, OFF_Z = 240 * MiB;
constexpr size_t OFF_POOLED = OFF_R1, OFF_SG = OFF_R1 + 96 * MiB, OFF_XN2 = OFF_Z, OFF_GATES = OFF_Z + 192 * MiB, OFF_MERGED = OFF_Z + 576 * MiB;
constexpr size_t OFF_X1B = OFF_R1, OFF_X1 = OFF_Z, OFF_HLO = OFF_Z + 384 * MiB;
constexpr size_t U_BYTES = (size_t)T_TOK * 1024 * 2;

struct Params {
    const float *x_prompt, *x_sample, *g_mix, *w_in, *b_gate, *mu_prev, *mu_next, *pool_w, *pool_scale, *w_pool_br, *k_k, *k_a, *r_k,
        *w0_f, *w_up_f, *a0_f, *a_up_f, *w0_b, *w_up_b, *a0_b, *a_up_b, *g_up, *ln_w, *ln_b, *w_rwkv_br, *w_out, *g_ffn, *w_ff1, *w_ff2, *g_final;
    float* out; unsigned char* ws;
};

__device__ __forceinline__ float bf_lo(unsigned w) { return __uint_as_float(w << 16); }
__device__ __forceinline__ float bf_hi(unsigned w) { return __uint_as_float(w & 0xFFFF0000u); }
typedef __bf16 bf16x2_t __attribute__((ext_vector_type(2)));
__device__ __forceinline__ unsigned pk_bf16(float lo, float hi) { f32x2 v = {lo, hi}; bf16x2_t b = __builtin_convertvector(v, bf16x2_t); return __builtin_bit_cast(unsigned, b); }
__device__ __forceinline__ float fexp2_scaled(float x, float scale_log2e) { return __builtin_amdgcn_exp2f(x * scale_log2e); }
__device__ __forceinline__ float sigmoidf_(float x) { return __builtin_amdgcn_rcpf(1.0f + fexp2_scaled(x, -1.4426950409f)); }
__device__ __forceinline__ float fma_s(float a, float b, float c) { float d; asm("v_fma_f32 %0, %1, %2, %3" : "=v"(d) : "v"(a), "v"(b), "v"(c)); return d; }
__device__ __forceinline__ float mul_s(float a, float b) { float d; asm("v_mul_f32 %0, %1, %2" : "=v"(d) : "v"(a), "v"(b)); return d; }
__device__ __forceinline__ float add_s(float a, float b) { float d; asm("v_add_f32 %0, %1, %2" : "=v"(d) : "v"(a), "v"(b)); return d; }
#define DPPA(x, c) "v_add_f32_dpp " x ", " x ", " x " " c " row_mask:0xf bank_mask:0xf bound_ctrl:1\n"
#define DPP4(c) DPPA("%0", c) DPPA("%1", c) DPPA("%2", c) DPPA("%3", c)
#define DPP2(c) DPPA("%0", c) DPPA("%1", c) "s_nop 0\n"
__device__ __forceinline__ void red16x4(float& a, float& b, float& c, float& d) {
    asm("s_nop 1\n" DPP4("quad_perm:[1,0,3,2]") DPP4("quad_perm:[2,3,0,1]") DPP4("row_half_mirror") DPP4("row_mirror") : "+v"(a), "+v"(b), "+v"(c), "+v"(d)); }
__device__ __forceinline__ void red16x2(float& a, float& b) {
    asm("s_nop 1\n" DPP2("quad_perm:[1,0,3,2]") DPP2("quad_perm:[2,3,0,1]") DPP2("row_half_mirror") DPP2("row_mirror") : "+v"(a), "+v"(b)); }
__device__ __forceinline__ void row_dots(const float (&s)[4], const f32x4 a, const f32x4 q, float& sa, float& yp) {
    asm("v_mul_f32 %0, %2, %6\n v_mul_f32 %1, %2, %10\n v_fmac_f32 %0, %3, %7\n v_fmac_f32 %1, %3, %11\n v_fmac_f32 %0, %4, %8\n v_fmac_f32 %1, %4, %12\n v_fmac_f32 %0, %5, %9\n v_fmac_f32 %1, %5, %13"
        : "=&v"(sa), "=&v"(yp) : "v"(s[0]), "v"(s[1]), "v"(s[2]), "v"(s[3]), "v"(a[0]), "v"(a[1]), "v"(a[2]), "v"(a[3]), "v"(q[0]), "v"(q[1]), "v"(q[2]), "v"(q[3])); }
__device__ __forceinline__ void row_update(float (&s)[4], const f32x4 w, const f32x4 b, const f32x4 k, float v, float sa, float yp, float bkx, float bky, float& y) {
    float t0, t1, t2, t3;
    asm("v_mul_f32 %0, %6, %15\n v_mul_f32 %1, %6, %16\n v_mul_f32 %2, %6, %17\n v_mul_f32 %3, %6, %18\n"
        "v_fmac_f32 %4, %7, %5\n"
        "v_fmac_f32 %0, %7, %11\n v_fmac_f32 %1, %7, %12\n v_fmac_f32 %2, %7, %13\n v_fmac_f32 %3, %7, %14\n"
        "v_fmac_f32 %4, %6, %8\n"
        "v_fmac_f32 %0, %9, %19\n v_fmac_f32 %1, %10, %20\n v_fmac_f32 %2, %23, %21\n v_fmac_f32 %3, %24, %22"
        : "=&v"(t0), "=&v"(t1), "=&v"(t2), "=&v"(t3), "+v"(yp)
        : "v"(bkx), "v"(v), "v"(sa), "v"(bky), "v"(s[0]), "v"(s[1]), "v"(b[0]), "v"(b[1]), "v"(b[2]), "v"(b[3]), "v"(k[0]), "v"(k[1]), "v"(k[2]), "v"(k[3]), "v"(w[0]), "v"(w[1]), "v"(w[2]), "v"(w[3]), "v"(s[2]), "v"(s[3]));
    s[0] = t0; s[1] = t1; s[2] = t2; s[3] = t3; y = yp; }
__device__ __forceinline__ void shift4(float (&z)[4], const float (&c)[4], const float (&pv)[4], const float (&nx)[4], const f32x4 m0, const f32x4 mp, const f32x4 mn) {
    asm("v_mul_f32 %0, %4, %16\n v_mul_f32 %1, %5, %17\n v_mul_f32 %2, %6, %18\n v_mul_f32 %3, %7, %19\n"
        "v_fma_f32 %0, %8, %20, %0\n v_fma_f32 %1, %9, %21, %1\n v_fma_f32 %2, %10, %22, %2\n v_fma_f32 %3, %11, %23, %3\n"
        "v_fma_f32 %0, %12, %24, %0\n v_fma_f32 %1, %13, %25, %1\n v_fma_f32 %2, %14, %26, %2\n v_fma_f32 %3, %15, %27, %3"
        : "=&v"(z[0]), "=&v"(z[1]), "=&v"(z[2]), "=&v"(z[3])
        : "v"(c[0]), "v"(c[1]), "v"(c[2]), "v"(c[3]), "v"(pv[0]), "v"(pv[1]), "v"(pv[2]), "v"(pv[3]), "v"(nx[0]), "v"(nx[1]), "v"(nx[2]), "v"(nx[3]),
          "v"(m0[0]), "v"(m0[1]), "v"(m0[2]), "v"(m0[3]), "v"(mp[0]), "v"(mp[1]), "v"(mp[2]), "v"(mp[3]), "v"(mn[0]), "v"(mn[1]), "v"(mn[2]), "v"(mn[3])); }
__device__ __forceinline__ void kk4(float (&kk)[4], float& ss, const float (&k)[4], const f32x4 c) {
    asm("v_mul_f32 %0, %5, %9\n v_mul_f32 %1, %6, %10\n v_mul_f32 %2, %7, %11\n v_mul_f32 %3, %8, %12\n"
        "v_mul_f32 %4, %0, %0\n v_fma_f32 %4, %1, %1, %4\n v_fma_f32 %4, %2, %2, %4\n v_fma_f32 %4, %3, %3, %4"
        : "=&v"(kk[0]), "=&v"(kk[1]), "=&v"(kk[2]), "=&v"(kk[3]), "=&v"(ss) : "v"(k[0]), "v"(k[1]), "v"(k[2]), "v"(k[3]), "v"(c[0]), "v"(c[1]), "v"(c[2]), "v"(c[3])); }
__device__ __forceinline__ void row_update2(float (&s)[4], const f32x4 w, const f32x4 b, const f32x4 k, float v, float vkr, float sa, float yp, float& y) {
    float t0, t1, t2, t3;
    asm("v_mul_f32 %0, %6, %14\n v_mul_f32 %1, %6, %15\n v_mul_f32 %2, %6, %16\n v_mul_f32 %3, %6, %17\n"
        "v_add_f32 %4, %4, %5\n"
        "v_fmac_f32 %0, %7, %10\n v_fmac_f32 %1, %7, %11\n v_fmac_f32 %2, %7, %12\n v_fmac_f32 %3, %7, %13\n"
        "v_fmac_f32 %0, %8, %18\n v_fmac_f32 %1, %9, %19\n v_fmac_f32 %2, %22, %20\n v_fmac_f32 %3, %23, %21"
        : "=&v"(t0), "=&v"(t1), "=&v"(t2), "=&v"(t3), "+v"(yp)
        : "v"(vkr), "v"(v), "v"(sa), "v"(s[0]), "v"(s[1]), "v"(b[0]), "v"(b[1]), "v"(b[2]), "v"(b[3]), "v"(k[0]), "v"(k[1]), "v"(k[2]), "v"(k[3]), "v"(w[0]), "v"(w[1]), "v"(w[2]), "v"(w[3]), "v"(s[2]), "v"(s[3]));
    s[0] = t0; s[1] = t1; s[2] = t2; s[3] = t3; y = yp; }
__device__ __forceinline__ void row_update3(float (&s)[4], const f32x4 w, const f32x4 b, const f32x4 k, float v, float sa) {
    float t0, t1, t2, t3;
    asm("v_mul_f32 %0, %4, %12\n v_mul_f32 %1, %4, %13\n v_mul_f32 %2, %4, %14\n v_mul_f32 %3, %4, %15\n"
        "v_fmac_f32 %0, %5, %8\n v_fmac_f32 %1, %5, %9\n v_fmac_f32 %2, %5, %10\n v_fmac_f32 %3, %5, %11\n"
        "v_fmac_f32 %0, %6, %16\n v_fmac_f32 %1, %7, %17\n v_fmac_f32 %2, %20, %18\n v_fmac_f32 %3, %21, %19"
        : "=&v"(t0), "=&v"(t1), "=&v"(t2), "=&v"(t3)
        : "v"(v), "v"(sa), "v"(s[0]), "v"(s[1]), "v"(b[0]), "v"(b[1]), "v"(b[2]), "v"(b[3]), "v"(k[0]), "v"(k[1]), "v"(k[2]), "v"(k[3]), "v"(w[0]), "v"(w[1]), "v"(w[2]), "v"(w[3]), "v"(s[2]), "v"(s[3]));
    s[0] = t0; s[1] = t1; s[2] = t2; s[3] = t3; }
#define DPP2S(c) DPPA("%0", c) DPPA("%2", c)
__device__ __forceinline__ void red16x4y(float& a, float& b, float& c, float& d) {
    asm(DPP4("quad_perm:[1,0,3,2]") DPP4("quad_perm:[2,3,0,1]") DPP4("row_half_mirror") DPP2S("row_mirror") : "+v"(a), "+v"(b), "+v"(c), "+v"(d)); }
__device__ __forceinline__ void red16x2y(float& a, float& b) {
    asm("s_nop 0\n" DPP2("quad_perm:[1,0,3,2]") DPP2("quad_perm:[2,3,0,1]") DPP2("row_half_mirror") DPPA("%0", "row_mirror") : "+v"(a), "+v"(b)); }
template <int CTRL> __device__ __forceinline__ float dppf(float x) { return __int_as_float(__builtin_amdgcn_update_dpp(0, __float_as_int(x), CTRL, 0xF, 0xF, true)); }
__device__ __forceinline__ float red4(float x) { x += dppf<0xB1>(x); x += dppf<0x4E>(x); return x; }
__device__ __forceinline__ float red8(float x) { x = red4(x); x += dppf<0x141>(x); return x; }
__device__ __forceinline__ float red16(float x) { x = red8(x); x += dppf<0x140>(x); return x; }
__device__ __forceinline__ int opaque_tid() { int t = threadIdx.x; asm volatile("" : "+v"(t)); return t; }
__device__ __forceinline__ const float* xrow(const Params& p, int t) { return t < TP ? p.x_prompt + (size_t)t * DM : p.x_sample + (size_t)(t - TP) * DM; }
__device__ __forceinline__ void seq_of(int t, int& base, int& len) { if (t < TP) { base = t & ~2047; len = 2048; } else { base = TP + ((t - TP) & ~16383); len = 16384; } }

namespace pg8 {
constexpr int BM = 256, BK = 64, HALF = 128, HTB = HALF * BK * 2, STAGE_BYTES = 8 * HTB, NXCD = 8, WGM = 8;
__device__ __forceinline__ int lds_byte(int r, int c) { const int st = (r >> 4) * 2 + (c >> 5), rr = r & 15, cc = c & 31, ob = rr * 64 + cc * 2; return st * 1024 + (ob ^ (((ob >> 9) & 1) << 5)); }
__device__ __forceinline__ void stage_rc(int b, int& R, int& C) { const int st = b / 1024, sb = b % 1024, swz = sb ^ (((sb >> 9) & 1) << 5); R = (st >> 1) * 16 + swz / 64; C = (st & 1) * 32 + (swz % 64) / 2; }
__device__ __forceinline__ int perm32(int rho) { const int n = rho >> 4, i = rho & 15; return 8 * (i >> 2) + 4 * n + (i & 3); }
struct Unit { int pm, pn; };
struct Gemm { const bf16_t* A; const bf16_t* Bt; int M, N, K, lda, ldb; const bf16_t* A2; int ks; };
struct StaticOrder {
    int nM, nN, nwg, G, c;
    __device__ void init(int M, int N, int G_, int c_) { nM = M / BM; nN = N / BM; nwg = nM * nN; G = G_; c = c_; }
    __device__ bool next(int i, Unit& u) const {
        const long L = (long)i * G + c; if (L >= nwg) return false;
        int wgid = (int)L; { const int q = nwg / NXCD, r = nwg % NXCD, xcd = wgid % NXCD, off = wgid / NXCD; wgid = (xcd < r ? xcd * (q + 1) : r * (q + 1) + (xcd - r) * q) + off; }
        const int nig = WGM * nN, gid = wgid / nig, fm = gid * WGM, gsz = (nM - fm) < WGM ? (nM - fm) : WGM;
        u.pm = fm + ((wgid % nig) % gsz); u.pn = (wgid % nig) / gsz; return true;
    }
};

template <class Epi>
__device__ __forceinline__ void gemm_phase(LAS unsigned char* lds, const Gemm g, const StaticOrder& S, const Epi& E) {
    const int tid = opaque_tid();
    const int wid = __builtin_amdgcn_readfirstlane(tid >> 6), lane = tid & 63, wr = wid >> 2, wc = wid & 3, fr = lane & 15, fq = lane >> 4;
    const int K = g.K, nt = K / BK;
    unsigned voffA[2], voffB[2];
#pragma unroll
    for (int i = 0; i < 2; ++i) { int R, C; stage_rc(tid * 16 + i * 8192, R, C); const int Rb = (R & ~31) + perm32(R & 31);
        voffA[i] = (unsigned)(R * g.lda + C) * 2u; voffB[i] = (unsigned)(Rb * g.ldb + C) * 2u; }
    const size_t kstep = (size_t)(BK * 2);
    const size_t hstepA = (size_t)HALF * g.lda * 2, hstepB = (size_t)HALF * g.ldb * 2;
    const size_t tstepA = 2 * hstepA, tstepB = 2 * hstepB;
    const unsigned ldsw = (unsigned)wid * 1024u;
    const int aoff = lds_byte(wr * 64 + fr, fq * 8), boff = lds_byte(wc * 32 + fr, fq * 8);
#define PG8_SA(b, h) (((b) * 2 + (h)) * HTB)
#define PG8_SB(b, h) ((4 + (b) * 2 + (h)) * HTB)
#define PG8_STAGE(bufoff, gbase, voff) do { _Pragma("unroll") for (int _i = 0; _i < 2; ++_i) \
        __builtin_amdgcn_global_load_lds((const unsigned*)((const char*)(gbase) + (voff)[_i]), (LAS unsigned*)(lds + (bufoff) + ldsw + _i * 8192), 16, 0, 0); } while (0)
#define PG8_LDA(dst, b, h) do { _Pragma("unroll") for (int m = 0; m < 4; ++m) _Pragma("unroll") for (int k = 0; k < 2; ++k) dst[m][k] = *(const LAS bf16x8*)(lds + PG8_SA(b, h) + aoff + m * 2048 + k * 1024); } while (0)
#define PG8_LDB(dst, b, h) do { _Pragma("unroll") for (int n = 0; n < 2; ++n) _Pragma("unroll") for (int k = 0; k < 2; ++k) dst[n][k] = *(const LAS bf16x8*)(lds + PG8_SB(b, h) + boff + n * 2048 + k * 1024); } while (0)
#define PG8_MMA(ai, bj, At, Bt) do { __builtin_amdgcn_s_setprio(1); _Pragma("unroll") for (int m = 0; m < 4; ++m) _Pragma("unroll") for (int n = 0; n < 2; ++n) _Pragma("unroll") for (int k = 0; k < 2; ++k) \
        acc[ai][bj][m][n] = __builtin_amdgcn_mfma_f32_16x16x32_bf16(Bt[n][k], At[m][k], acc[ai][bj][m][n], 0, 0, 0); __builtin_amdgcn_s_setprio(0); } while (0)
#define PG8_WAIT_V(n) asm volatile("s_waitcnt vmcnt(" #n ")" ::: "memory")
#define PG8_WAIT_L(n) asm volatile("s_waitcnt lgkmcnt(" #n ")" ::: "memory")
#define PG8_BAR __builtin_amdgcn_s_barrier()
#define PG8_SCHED __builtin_amdgcn_sched_barrier(0)
    Unit cur, nxt; int ui = 0;
    if (!S.next(0, cur)) return;
    f32x4 acc[2][2][4][2];
#pragma unroll
    for (int a = 0; a < 2; ++a)
#pragma unroll
        for (int b = 0; b < 2; ++b)
#pragma unroll
            for (int m = 0; m < 4; ++m)
#pragma unroll
                for (int n = 0; n < 2; ++n) acc[a][b][m][n] = (f32x4){0.f, 0.f, 0.f, 0.f};
    bf16x8 At[4][2], B0[2][2], B1[2][2];
    const char* cA = (const char*)g.A + (size_t)cur.pm * tstepA; const char* cB = (const char*)g.Bt + (size_t)cur.pn * tstepB;
    const bool two = g.A2 != nullptr; const int ks = two ? g.ks : (1 << 30);
    const char* cA2 = two ? (const char*)g.A2 + (size_t)cur.pm * tstepA : cA;
    PG8_STAGE(PG8_SB(0, 0), cB, voffB); PG8_STAGE(PG8_SA(0, 0), cA, voffA); PG8_STAGE(PG8_SB(0, 1), cB + hstepB, voffB); PG8_STAGE(PG8_SA(0, 1), cA + hstepA, voffA);
    if (wr == 1) PG8_BAR;
    PG8_WAIT_V(4); PG8_BAR;
    PG8_STAGE(PG8_SB(1, 0), cB + kstep, voffB); PG8_STAGE(PG8_SA(1, 0), cA + kstep, voffA); PG8_STAGE(PG8_SB(1, 1), cB + hstepB + kstep, voffB);
    PG8_WAIT_V(6); PG8_BAR;
    for (;;) {
        const bool has_next = S.next(ui + 1, nxt);
        const char* nA = has_next ? (const char*)g.A + (size_t)nxt.pm * tstepA : cA; const char* nB = has_next ? (const char*)g.Bt + (size_t)nxt.pn * tstepB : cB;
        const char* nA2 = (two && has_next) ? (const char*)g.A2 + (size_t)nxt.pm * tstepA : cA2;
#pragma unroll 1
        for (int t = 0; t < nt; t += 2) {
            const bool last = (t == nt - 2);
            const char* a1 = (t + 1 < ks) ? cA + (size_t)(t + 1) * kstep : cA2 + (size_t)(t + 1 - ks) * kstep;
            const char* a2 = last ? nA : ((t + 2 < ks) ? cA + (size_t)(t + 2) * kstep : cA2 + (size_t)(t + 2 - ks) * kstep); const char* b2 = last ? nB : cB + (size_t)(t + 2) * kstep;
            const char* a3 = a2 + kstep; const char* b3 = b2 + kstep;
            PG8_LDB(B0, 0, 0); PG8_SCHED; PG8_LDA(At, 0, 0); PG8_STAGE(PG8_SA(1, 1), a1 + hstepA, voffA);
            PG8_WAIT_L(8); PG8_BAR; PG8_WAIT_L(0); PG8_MMA(0, 0, At, B0); PG8_BAR; PG8_SCHED;
            PG8_LDB(B1, 0, 1); PG8_STAGE(PG8_SB(0, 0), b2, voffB);
            PG8_BAR; PG8_WAIT_L(0); PG8_MMA(0, 1, At, B1); PG8_BAR;
            PG8_LDA(At, 0, 1); PG8_STAGE(PG8_SA(0, 0), a2, voffA);
            PG8_BAR; PG8_WAIT_L(0); PG8_MMA(1, 0, At, B0); PG8_BAR; PG8_SCHED;
            PG8_STAGE(PG8_SB(0, 1), b2 + hstepB, voffB);
            PG8_WAIT_V(6); PG8_BAR; PG8_MMA(1, 1, At, B1); PG8_BAR;
            PG8_LDB(B0, 1, 0); PG8_SCHED; PG8_LDA(At, 1, 0); PG8_STAGE(PG8_SA(0, 1), a2 + hstepA, voffA);
            PG8_WAIT_L(8); PG8_BAR; PG8_WAIT_L(0); PG8_MMA(0, 0, At, B0); PG8_BAR; PG8_SCHED;
            PG8_LDB(B1, 1, 1); PG8_STAGE(PG8_SB(1, 0), b3, voffB);
            PG8_BAR; PG8_WAIT_L(0); PG8_MMA(0, 1, At, B1); PG8_BAR;
            PG8_LDA(At, 1, 1); PG8_STAGE(PG8_SA(1, 0), a3, voffA);
            PG8_BAR; PG8_WAIT_L(0); PG8_MMA(1, 0, At, B0); PG8_BAR; PG8_SCHED;
            PG8_STAGE(PG8_SB(1, 1), b3 + hstepB, voffB);
            PG8_WAIT_V(6); PG8_BAR; PG8_MMA(1, 1, At, B1); PG8_BAR;
        }
        E(acc, cur, wr, wc, fr, fq);
        if (!has_next) break;
#pragma unroll
        for (int a = 0; a < 2; ++a)
#pragma unroll
            for (int b = 0; b < 2; ++b)
#pragma unroll
                for (int m = 0; m < 4; ++m)
#pragma unroll
                    for (int n = 0; n < 2; ++n) acc[a][b][m][n] = (f32x4){0.f, 0.f, 0.f, 0.f};
        cur = nxt; cA = nA; cA2 = nA2; cB = nB; ++ui;
    }
    PG8_WAIT_V(0);
    if (wr == 0) PG8_BAR;
    PG8_BAR;
#undef PG8_SA
#undef PG8_SB
#undef PG8_STAGE
#undef PG8_LDA
#undef PG8_LDB
#undef PG8_MMA
#undef PG8_WAIT_V
#undef PG8_WAIT_L
#undef PG8_BAR
#undef PG8_SCHED
}
}
using pg8::Unit;

#define EPI_LOOP_BEGIN const int row0 = u.pm * 256 + wr * 64 + fr, col0 = u.pn * 256 + wc * 32 + 8 * fq; \
    _Pragma("unroll") for (int ai = 0; ai < 2; ++ai) _Pragma("unroll") for (int m = 0; m < 4; ++m) { const int row = row0 + ai * 128 + m * 16;
#define EPI_BJ _Pragma("unroll") for (int bj = 0; bj < 2; ++bj) { const int col = col0 + bj * 128; const f32x4 v0 = acc[ai][bj][m][0], v1 = acc[ai][bj][m][1];
#define EPI_ACC const f32x4 (&acc)[2][2][4][2], const Unit& u, int wr, int wc, int fr, int fq

__device__ __forceinline__ u32x4 pack8(const f32x4 a, const f32x4 b) { u32x4 w; w.x = pk_bf16(a[0], a[1]); w.y = pk_bf16(a[2], a[3]); w.z = pk_bf16(b[0], b[1]); w.w = pk_bf16(b[2], b[3]); return w; }
__device__ __forceinline__ void unpack8(const u32x4 w, f32x4& a, f32x4& b) { a = (f32x4){bf_lo(w.x), bf_hi(w.x), bf_lo(w.y), bf_hi(w.y)}; b = (f32x4){bf_lo(w.z), bf_hi(w.z), bf_lo(w.w), bf_hi(w.w)}; }

struct EpiStore {
    bf16_t* O; int ldc;
    __device__ __forceinline__ void operator()(EPI_ACC) const { EPI_LOOP_BEGIN EPI_BJ *(u32x4*)(O + (size_t)row * ldc + col) = pack8(v0, v1); } } }
};
struct EpiMulInPlace {
    bf16_t* Y;
    __device__ __forceinline__ void operator()(EPI_ACC) const { EPI_LOOP_BEGIN if ((m & 1) == 0) __builtin_amdgcn_sched_barrier(0);
        EPI_BJ u32x4* ptr = (u32x4*)(Y + (size_t)row * 1024 + col); f32x4 a, b; unpack8(*ptr, a, b); *ptr = pack8(a * v0, b * v1); } } }
};
struct EpiGates {
    bf16_t* G; const float* bias;
    __device__ __forceinline__ void operator()(EPI_ACC) const { EPI_LOOP_BEGIN EPI_BJ
        const f32x4 b0 = *(const f32x4*)(bias + col), b1 = *(const f32x4*)(bias + col + 4); f32x4 a, b;
#pragma unroll
        for (int j = 0; j < 4; ++j) { a[j] = sigmoidf_(v0[j] + b0[j]); b[j] = sigmoidf_(v1[j] + b1[j]); }
        *(u32x4*)(G + (size_t)row * 2048 + col) = pack8(a, b); } } }
};
struct EpiPool {
    bf16_t* P; const bf16_t* G;
    __device__ __forceinline__ void operator()(EPI_ACC) const { EPI_LOOP_BEGIN EPI_BJ f32x4 a, b; unpack8(*(const u32x4*)(G + (size_t)row * 2048 + col), a, b);
        *(u32x4*)(P + (size_t)row * 1024 + col) = pack8(a * v0, b * v1); } } }
};
struct EpiMerge {
    bf16_t* P; const bf16_t* G;
    __device__ __forceinline__ void operator()(EPI_ACC) const { EPI_LOOP_BEGIN EPI_BJ f32x4 a, b, pa, pb; unpack8(*(const u32x4*)(G + (size_t)row * 2048 + 1024 + col), a, b);
        u32x4* ptr = (u32x4*)(P + (size_t)row * 1024 + col); unpack8(*ptr, pa, pb); *ptr = pack8(pa + a * v0, pb + b * v1); } } }
};
struct EpiOut {
    const float* xp; const float* xs; float* X1; bf16_t* X1B; float* rowsq;
    __device__ __forceinline__ void operator()(EPI_ACC) const { EPI_LOOP_BEGIN const float* xr = row < TP ? xp + (size_t)row * DM : xs + (size_t)(row - TP) * DM; float ss = 0.f; EPI_BJ
        f32x4 a = *(const f32x4*)(xr + col) + v0, b = *(const f32x4*)(xr + col + 4) + v1;
        *(f32x4*)(X1 + (size_t)row * 1024 + col) = a; *(f32x4*)(X1 + (size_t)row * 1024 + col + 4) = b; *(u32x4*)(X1B + (size_t)row * 1024 + col) = pack8(a, b);
#pragma unroll
        for (int j = 0; j < 4; ++j) ss += a[j] * a[j] + b[j] * b[j]; }
        ss += __shfl_xor(ss, 16); ss += __shfl_xor(ss, 32); if (fq == 0) atomicAdd(rowsq + row, ss); } }
};
struct EpiFF1 {
    bf16_t* Hlo; bf16_t* Hhi; const float* rowsq;
    __device__ __forceinline__ void operator()(EPI_ACC) const { bf16_t* H = u.pn < 8 ? Hlo : Hhi; const int cshift = u.pn < 8 ? 0 : 2048;
        EPI_LOOP_BEGIN const float rinv = rsqrtf(rowsq[row] * (1.0f / 1024.0f) + 1e-6f); EPI_BJ f32x4 a, b;
#pragma unroll
        for (int j = 0; j < 4; ++j) { float t0 = fmaxf(v0[j] * rinv, 0.f), t1 = fmaxf(v1[j] * rinv, 0.f); a[j] = t0 * t0; b[j] = t1 * t1; }
        *(u32x4*)(H + (size_t)row * 2048 + (col - cshift)) = pack8(a, b); } } }
};
struct EpiAddInPlace {
    float* X;
    __device__ __forceinline__ void operator()(EPI_ACC) const { EPI_LOOP_BEGIN EPI_BJ f32x4* ptr = (f32x4*)(X + (size_t)row * 1024 + col); ptr[0] = ptr[0] + v0; ptr[1] = ptr[1] + v1; } } }
};
struct EpiFinal {
    float* X; float* rowsq;
    __device__ __forceinline__ void operator()(EPI_ACC) const { EPI_LOOP_BEGIN float ss = 0.f; EPI_BJ f32x4* ptr = (f32x4*)(X + (size_t)row * 1024 + col); const f32x4 a = ptr[0] + v0, b = ptr[1] + v1; ptr[0] = a; ptr[1] = b;
#pragma unroll
        for (int j = 0; j < 4; ++j) ss += a[j] * a[j] + b[j] * b[j]; }
        ss += __shfl_xor(ss, 16); ss += __shfl_xor(ss, 32); if (fq == 0) atomicAdd(rowsq + row, ss); } }
};

template <class Epi>
__device__ __forceinline__ void run_gemm(unsigned char* shm, const bf16_t* A, int lda, const bf16_t* Bt, int ldb, int N, int K, const Epi& E, const bf16_t* A2 = nullptr, int ks = 0) {
    pg8::Gemm g; g.A = A; g.Bt = Bt; g.M = T_TOK; g.N = N; g.K = K; g.lda = lda; g.ldb = ldb; g.A2 = A2; g.ks = ks;
    pg8::StaticOrder S; S.init(T_TOK, N, (int)gridDim.x, (int)blockIdx.x);
    pg8::gemm_phase<Epi>((LAS unsigned char*)shm, g, S, E);
}

__device__ __forceinline__ void transpose_tile(float* tile, int tid, const float* src, int N, bf16_t* dst, int ldd, const float* kscale, int t) {
    const int ntn = N / 64, tk = t / ntn, tn = t % ntn;
#pragma unroll
    for (int i = 0; i < 8; ++i) { const int kl = (tid >> 6) + 8 * i, nl = tid & 63; const int k = tk * 64 + kl;
        tile[kl * 65 + nl] = src[(size_t)k * N + tn * 64 + nl] * (kscale ? kscale[k] : 1.0f); }
    __syncthreads();
#pragma unroll
    for (int i = 0; i < 8; ++i) { const int nl = (tid >> 6) + 8 * i, kl = tid & 63;
        const unsigned w = pk_bf16(tile[kl * 65 + nl], 0.f); dst[(size_t)(tn * 64 + nl) * ldd + tk * 64 + kl] = (bf16_t)(w & 0xFFFFu); }
    __syncthreads();
}
__device__ void transpose_cvt(unsigned char* shm, const float* src, int K, int N, bf16_t* dst, int ldd, const float* kscale) {
    float* tile = (float*)shm;
    const int tid = opaque_tid(), ntk = K / 64, ntn = N / 64;
    for (int t = blockIdx.x; t < ntk * ntn; t += gridDim.x) transpose_tile(tile, tid, src, N, dst, ldd, kscale, t);
}
constexpr int DU_RBR = 256, DU_OUT = 512, DU_FF1 = 1536, DU_FF2 = 2560, DU_G = 2592, DU_GZ = 2624, N_DEFER = 2624 + 256;
__device__ void deferred_unit(const Params& p, unsigned char* shm, int tid, int u) {
    unsigned char* ws = p.ws; float* tile = (float*)shm;
    if (u < DU_RBR) transpose_tile(tile, tid, p.w_rwkv_br, 1024, (bf16_t*)(ws + OFF_WRBR), 1024, nullptr, u);
    else if (u < DU_OUT) transpose_tile(tile, tid, p.w_out, 1024, (bf16_t*)(ws + OFF_WOUT), 1024, nullptr, u - DU_RBR);
    else if (u < DU_FF1) transpose_tile(tile, tid, p.w_ff1, 4096, (bf16_t*)(ws + OFF_WFF1), 1024, p.g_ffn, u - DU_OUT);
    else if (u < DU_FF2) transpose_tile(tile, tid, p.w_ff2, 1024, (bf16_t*)(ws + OFF_WFF2), 4096, nullptr, u - DU_FF1);
    else if (u < DU_G) transpose_tile(tile, tid, p.g_up, 1024, (bf16_t*)(ws + OFF_WG), 256, nullptr, u - DU_FF2);
    else if (u < DU_GZ) { bf16_t* wg = (bf16_t*)(ws + OFF_WG);
#pragma unroll
        for (int m = 0; m < 8; ++m) { const int i = (u - DU_G) * 4096 + m * 512 + tid; wg[(size_t)(i >> 7) * 256 + 128 + (i & 127)] = 0; } }
    else {
        bf16_t* we = (bf16_t*)(ws + OFF_WEFF); const int base = (u - DU_GZ) * 2048; float acc[4] = {0.f, 0.f, 0.f, 0.f};
        const int gI = (base >> 10) >> 7;
        for (int d = 0; d < 128; ++d) { const float sc = p.pool_scale[gI * 128 + d];
#pragma unroll
            for (int m = 0; m < 4; ++m) { const int i = base + m * 512 + tid, k = i >> 10, n = i & 1023;
                acc[m] += p.pool_w[(size_t)k * 128 + d] * sc * p.w_pool_br[(size_t)(gI * 128 + d) * 1024 + n]; } }
#pragma unroll
        for (int m = 0; m < 4; ++m) { const int i = base + m * 512 + tid, k = i >> 10, n = i & 1023; we[(size_t)n * 512 + k] = (bf16_t)(pk_bf16(acc[m], 0.f) & 0xFFFFu); } }
}
__device__ void rmsnorm_rows(const Params& p, const float* g, bf16_t* dst) {
    const int tidx = opaque_tid(); const int lane = tidx & 63, wave = (blockIdx.x * 512 + tidx) >> 6, nw = (gridDim.x * 512) >> 6;
    f32x4 gv[4];
#pragma unroll
    for (int i = 0; i < 4; ++i) gv[i] = *(const f32x4*)(g + lane * 4 + 256 * i);
    for (int t0 = wave; t0 < T_TOK; t0 += 2 * nw) {
        const int t1 = t0 + nw; const bool has1 = t1 < T_TOK;
        const float* xr0 = xrow(p, t0); const float* xr1 = xrow(p, has1 ? t1 : t0); f32x4 v0[4], v1[4]; float ss0 = 0.f, ss1 = 0.f;
#pragma unroll
        for (int i = 0; i < 4; ++i) { v0[i] = *(const f32x4*)(xr0 + lane * 4 + 256 * i); v1[i] = *(const f32x4*)(xr1 + lane * 4 + 256 * i); }
#pragma unroll
        for (int i = 0; i < 4; ++i) { ss0 += v0[i][0] * v0[i][0] + v0[i][1] * v0[i][1] + v0[i][2] * v0[i][2] + v0[i][3] * v0[i][3]; ss1 += v1[i][0] * v1[i][0] + v1[i][1] * v1[i][1] + v1[i][2] * v1[i][2] + v1[i][3] * v1[i][3]; }
#pragma unroll
        for (int o = 1; o < 64; o <<= 1) { ss0 += __shfl_xor(ss0, o); ss1 += __shfl_xor(ss1, o); }
        const float r0 = rsqrtf(ss0 * (1.0f / 1024.0f) + 1e-6f), r1 = rsqrtf(ss1 * (1.0f / 1024.0f) + 1e-6f);
#pragma unroll
        for (int i = 0; i < 4; ++i) { u32x2 w; w.x = pk_bf16(v0[i][0] * r0 * gv[i][0], v0[i][1] * r0 * gv[i][1]); w.y = pk_bf16(v0[i][2] * r0 * gv[i][2], v0[i][3] * r0 * gv[i][3]);
            *(u32x2*)(dst + (size_t)t0 * 1024 + lane * 4 + 256 * i) = w; }
        if (has1) {
#pragma unroll
            for (int i = 0; i < 4; ++i) { u32x2 w; w.x = pk_bf16(v1[i][0] * r1 * gv[i][0], v1[i][1] * r1 * gv[i][1]); w.y = pk_bf16(v1[i][2] * r1 * gv[i][2], v1[i][3] * r1 * gv[i][3]);
                *(u32x2*)(dst + (size_t)t1 * 1024 + lane * 4 + 256 * i) = w; } }
    }
}

__device__ void prep_phase(const Params& p, unsigned char* shm) {
    unsigned char* ws = p.ws;
    const int gtid = blockIdx.x * 512 + opaque_tid(), gn = gridDim.x * 512;
    for (int i = gtid; i < T_TOK; i += gn) { ((float*)(ws + OFF_ROWSQ))[i] = 0.f; ((float*)(ws + OFF_ROWSQ2))[i] = 0.f; }
    if (gtid < 64) ((unsigned*)(ws + OFF_QUEUE))[gtid] = 0u;
    transpose_cvt(shm, p.w_in, 1024, 5888, (bf16_t*)(ws + OFF_WIN), 1024, nullptr);
    rmsnorm_rows(p, p.g_mix, (bf16_t*)(ws + OFF_R1));
}

#define LDS_BAR() do { asm volatile("s_waitcnt lgkmcnt(0)" ::: "memory"); __builtin_amdgcn_s_barrier(); asm volatile("" ::: "memory"); } while (0)
constexpr int N_SAMPLE_ITEMS = 128, N_ITEMS = N_SAMPLE_ITEMS + 1024;

template <int LPR, int RPL, int DIR>
__device__ __forceinline__ void scan_item(const Params& p, unsigned char* shm, const int tid, const int tbase, const int L, const int h, const int half) {
    constexpr int dir = DIR;
    constexpr int EC = 64 / LPR, RPW = RPL * (64 / LPR);
    float* sW = (float*)shm; float* sAV = sW + 2048; float* sBV = sW + 4096; float* sKD = sW + 6144; float* sWR = sW + 8192; float* sR = sW + 10240; float* sV = sW + 12288; float* sY = sW + 14336;
    float* sBK = sW + 16384;
    bf16_t* sTW = (bf16_t*)(sW + 16384 + 64);
    bf16_t* sZA = sTW + 32 * 72;
    const int lane = tid & 63, wv = tid >> 6;
    const bf16_t* zall = (const bf16_t*)(p.ws + OFF_Z);
    const int tokA = tid >> 4, q = tid & 15;
    const int rowS = half * 32 + wv * RPW + RPL * (lane / LPR), gS = lane % LPR;
    const int NC = L / 32;
    bf16_t* ybuf = (bf16_t*)p.out + (dir ? (size_t)T_TOK * 1024 : 0);
    float* bonus = (float*)(p.ws + OFF_BONUS) + (dir ? (size_t)T_TOK * 16 : 0);
    const float* w_up = dir ? p.w_up_b : p.w_up_f; const float* a_up = dir ? p.a_up_b : p.a_up_f;
    const float* w0 = dir ? p.w0_b : p.w0_f; const float* a0 = dir ? p.a0_b : p.a0_f;
    const int mat = wv >> 2, cbk = wv & 3, colB = cbk * 16 + (lane & 15), quad = lane >> 4;
    u32x4* sBF = (u32x4*)(shm + 84 * 1024);
    { const float* up = mat ? a_up : w_up;
#pragma unroll
      for (int kb = 0; kb < 2; ++kb) { float f[8];
#pragma unroll
          for (int j = 0; j < 8; ++j) f[j] = up[(size_t)(kb * 32 + quad * 8 + j) * 1024 + h * 64 + colB];
          u32x4 w; w.x = pk_bf16(f[0], f[1]); w.y = pk_bf16(f[2], f[3]); w.z = pk_bf16(f[4], f[5]); w.w = pk_bf16(f[6], f[7]); sBF[kb * 512 + tid] = w; } }
    const float c0B = (mat ? a0 : w0)[h * 64 + colB];
    const float kaB = p.k_a[h * 64 + colB];
    int colz[5];
    float* sV2 = (float*)(shm + 104 * 1024);
    float* sYP = (float*)(shm + 112 * 1024);
    float* sM0 = (float*)(shm + 100 * 1024);
    float* sMU = (float*)(shm + 76 * 1024);
#pragma unroll
    for (int gi = 0; gi < 5; ++gi) colz[gi] = (gi == 0 ? COL_R + h * 64 : gi == 1 ? COL_K + h * 64 : gi == 2 ? COL_V + h * 64 : gi == 3 ? COL_W : COL_A) + 4 * q;
    if (tid < 320) { const int gi = tid >> 6, c = tid & 63; const int col = (gi == 0 ? COL_R + h * 64 : gi == 1 ? COL_K + h * 64 : gi == 2 ? COL_V + h * 64 : gi == 3 ? COL_W : COL_A) + c - COL_R;
        const float mpv_ = p.mu_prev[col], mnv_ = p.mu_next[col]; sMU[gi * 64 + c] = mpv_; sMU[320 + gi * 64 + c] = mnv_; sM0[gi * 64 + c] = 1.0f - mpv_ - mnv_; }
    else if (tid < 384) sMU[640 + (tid - 320)] = p.k_k[h * 64 + (tid - 320)];
    else if (tid < 448) sMU[704 + (tid - 384)] = p.r_k[h * 64 + (tid - 384)];
    __syncthreads();
    float s[RPL][EC];
#pragma unroll
    for (int r = 0; r < RPL; ++r)
#pragma unroll
        for (int j = 0; j < EC; ++j) s[r][j] = 0.f;
    u32x2 zc[5], zp[5], zn[5];
    auto load_chunk = [&](int ci) {
        const int t = tbase + 32 * (dir ? NC - 1 - ci : ci) + tokA; const bool hasPrev = t > tbase, hasNext = t < tbase + L - 1;
        const bf16_t* zr = zall + (size_t)t * ZLD;
#pragma unroll
        for (int gi = 0; gi < 5; ++gi) { zc[gi] = *(const u32x2*)(zr + colz[gi]); zp[gi] = (u32x2){0u, 0u}; zn[gi] = (u32x2){0u, 0u};
            if (hasPrev) zp[gi] = *(const u32x2*)(zr - ZLD + colz[gi]);
            if (hasNext) zn[gi] = *(const u32x2*)(zr + ZLD + colz[gi]); }
    };
    load_chunk(0);
    for (int ci = 0; ci < NC; ++ci) {
        const int t0 = tbase + 32 * (dir ? NC - 1 - ci : ci);
        { float zs[5][4];
          f32x4 MP[5], MN[5], M0[5];
#pragma unroll
          for (int gi = 0; gi < 5; ++gi) { MP[gi] = *(const f32x4*)(sMU + gi * 64 + 4 * q); MN[gi] = *(const f32x4*)(sMU + 320 + gi * 64 + 4 * q); M0[gi] = *(const f32x4*)(sM0 + gi * 64 + 4 * q); }
          const f32x4 kk4c = *(const f32x4*)(sMU + 640 + 4 * q);
#pragma unroll
          for (int gi = 0; gi < 5; ++gi) {
              const float c[4] = {bf_lo(zc[gi].x), bf_hi(zc[gi].x), bf_lo(zc[gi].y), bf_hi(zc[gi].y)}, pv[4] = {bf_lo(zp[gi].x), bf_hi(zp[gi].x), bf_lo(zp[gi].y), bf_hi(zp[gi].y)}, nx[4] = {bf_lo(zn[gi].x), bf_hi(zn[gi].x), bf_lo(zn[gi].y), bf_hi(zn[gi].y)};
              shift4(zs[gi], c, pv, nx, M0[gi], MP[gi], MN[gi]);
          }
          if (ci + 1 < NC) load_chunk(ci + 1);
          *(f32x4*)(sR + tokA * 64 + 4 * q) = (f32x4){zs[0][0], zs[0][1], zs[0][2], zs[0][3]};
          *(f32x4*)(sKD + tokA * 64 + 4 * q) = (f32x4){zs[1][0], zs[1][1], zs[1][2], zs[1][3]};
          *(f32x4*)(sV + tokA * 64 + 4 * q) = (f32x4){zs[2][0], zs[2][1], zs[2][2], zs[2][3]};
          float kk[4], ss;
          kk4(kk, ss, zs[1], kk4c);
          ss = ss + 0.0f * kk[0];
          ss = red16(ss);
          const float inv = -__builtin_amdgcn_rsqf(fmaxf(ss, 1e-24f));
          *(f32x4*)(sAV + tokA * 64 + 4 * q) = (f32x4){kk[0] * inv, kk[1] * inv, kk[2] * inv, kk[3] * inv};
          float tw[4];
#pragma unroll
          for (int j = 0; j < 4; ++j) tw[j] = 1.0f - 2.0f * __builtin_amdgcn_rcpf(1.0f + fexp2_scaled(zs[3][j], 2.8853900818f));
          u32x2 w; w.x = pk_bf16(tw[0], tw[1]); w.y = pk_bf16(tw[2], tw[3]); *(u32x2*)(sTW + tokA * 72 + 4 * q) = w;
          w.x = pk_bf16(zs[4][0], zs[4][1]); w.y = pk_bf16(zs[4][2], zs[4][3]); *(u32x2*)(sZA + tokA * 72 + 4 * q) = w;
        }
        LDS_BAR();
        { const int matu = __builtin_amdgcn_readfirstlane(mat);
          const bf16_t* sX = matu ? sZA : sTW;
          const bf16x8 b0 = __builtin_bit_cast(bf16x8, sBF[tid]), b1 = __builtin_bit_cast(bf16x8, sBF[512 + tid]);
          const bf16_t* ap = sX + (lane & 15) * 72 + quad * 8;
          const bf16x8 a00 = *(const bf16x8*)(ap), a01 = *(const bf16x8*)(ap + 32), a10 = *(const bf16x8*)(ap + 16 * 72), a11 = *(const bf16x8*)(ap + 16 * 72 + 32);
          const int idx0 = (quad * 4) * 64 + colB;
          float o1[8], o2[8];
          if (matu == 0) {
#pragma unroll
              for (int i = 0; i < 8; ++i) o1[i] = sR[idx0 + ((i >> 2) * 16 + (i & 3)) * 64];
          } else {
#pragma unroll
              for (int i = 0; i < 8; ++i) { o1[i] = sKD[idx0 + ((i >> 2) * 16 + (i & 3)) * 64]; o2[i] = sAV[idx0 + ((i >> 2) * 16 + (i & 3)) * 64]; }
          }
          f32x4 acc0 = (f32x4){c0B, c0B, c0B, c0B}, acc1 = acc0;
          acc0 = __builtin_amdgcn_mfma_f32_16x16x32_bf16(a00, b0, acc0, 0, 0, 0); acc1 = __builtin_amdgcn_mfma_f32_16x16x32_bf16(a10, b0, acc1, 0, 0, 0);
          acc0 = __builtin_amdgcn_mfma_f32_16x16x32_bf16(a01, b1, acc0, 0, 0, 0); acc1 = __builtin_amdgcn_mfma_f32_16x16x32_bf16(a11, b1, acc1, 0, 0, 0);
          float sg[8];
#pragma unroll
          for (int i = 0; i < 8; ++i) sg[i] = sigmoidf_(i < 4 ? acc0[i & 3] : acc1[i & 3]);
          if (matu == 0) {
              float wv_[8];
#pragma unroll
              for (int i = 0; i < 8; ++i) wv_[i] = fexp2_scaled(sg[i], -0.6065306597f * 1.4426950409f);
#pragma unroll
              for (int i = 0; i < 8; ++i) { const int idx = idx0 + ((i >> 2) * 16 + (i & 3)) * 64; sW[idx] = wv_[i]; sWR[idx] = wv_[i] * o1[i]; }
          } else {
#pragma unroll
              for (int i = 0; i < 8; ++i) { const int idx = idx0 + ((i >> 2) * 16 + (i & 3)) * 64; sKD[idx] = o1[i] * (1.0f + (sg[i] - 1.0f) * kaB); sBV[idx] = -o2[i] * sg[i]; }
          } }
        LDS_BAR();
        { const f32x4 r4 = *(const f32x4*)(sR + tokA * 64 + 4 * q), b4 = *(const f32x4*)(sBV + tokA * 64 + 4 * q), k4 = *(const f32x4*)(sKD + tokA * 64 + 4 * q);
          float br = 0.f, kr = 0.f, cb = 0.f; const f32x4 rk4 = *(const f32x4*)(sMU + 704 + 4 * q);
#pragma unroll
          for (int j = 0; j < 4; ++j) { br += b4[j] * r4[j]; kr += k4[j] * r4[j]; cb += r4[j] * k4[j] * rk4[j]; }
          br = red16(br); kr = red16(kr); cb = red16(cb);
          { f32x4* qp = (f32x4*)(sWR + tokA * 64 + 4 * q); const f32x4 a4 = *(const f32x4*)(sAV + tokA * 64 + 4 * q); *qp = *qp + a4 * br; }
          { const f32x4 v4 = *(const f32x4*)(sV + tokA * 64 + 4 * q); *(f32x4*)(sV2 + tokA * 64 + 4 * q) = v4 * kr; }
          if (q == 0 && half == 0) bonus[(size_t)(t0 + tokA) * 16 + h] = cb; }
        LDS_BAR();
        {
            constexpr int NV = EC / 4;
            struct Ops { f32x4 w[NV], a[NV], b[NV], k[NV], q[NV]; float v[RPL]; };
            auto ld = [&](Ops& o, int i) { const int tk = DIR ? 31 - i : i; const int off = tk * 64 + 4 * gS;
#pragma unroll
                for (int c = 0; c < NV; ++c) { o.w[c] = *(const f32x4*)(sW + off + 32 * c); o.a[c] = *(const f32x4*)(sAV + off + 32 * c); o.b[c] = *(const f32x4*)(sBV + off + 32 * c);
                    o.k[c] = *(const f32x4*)(sKD + off + 32 * c); o.q[c] = *(const f32x4*)(sWR + off + 32 * c); }
                if constexpr (RPL == 2) { const f32x2 v2 = *(const f32x2*)(sV + tk * 64 + rowS); o.v[0] = v2.x; o.v[1] = v2.y; } else o.v[0] = sV[tk * 64 + rowS]; };
            auto step = [&](const Ops& cur, int i) {
                static_assert(EC == 4, "asm row helpers are written for 4 columns per lane");
                float sa[RPL], yp[RPL], y[RPL];
#pragma unroll
                for (int r = 0; r < RPL; ++r) row_dots(s[r], cur.a[0], cur.q[0], sa[r], yp[r]);
                if constexpr (RPL == 2) red16x4y(sa[0], yp[0], sa[1], yp[1]); else red16x2y(sa[0], yp[0]);
#pragma unroll
                for (int r = 0; r < RPL; ++r) { row_update3(s[r], cur.w[0], cur.b[0], cur.k[0], cur.v[r], sa[r]); y[r] = yp[r]; }
                if ((gS & 7) == 0) { float* yd = sYP + ((DIR ? 31 - i : i) * 2 + (gS >> 3)) * 64 + rowS; if constexpr (RPL == 2) *(f32x2*)yd = (f32x2){y[0], y[1]}; else *yd = y[0]; }
            };
            {
                Ops o0, o1, o2; ld(o0, 0); ld(o1, 1);
#pragma unroll 1
                for (int i = 0; i < 30; i += 3) {
                    ld(o2, i + 2);
                    step(o0, i);
                    ld(o0, i + 3);
                    step(o1, i + 1);
                    ld(o1, min(i + 4, 31));
                    step(o2, i + 2);
                }
                step(o0, 30);
                step(o1, 31);
            }
        }
        LDS_BAR();
        if (RPL == 2 || (q >> 3) == half) { const f32x4 y4 = *(const f32x4*)(sYP + (tokA * 2) * 64 + 4 * q) + *(const f32x4*)(sYP + (tokA * 2 + 1) * 64 + 4 * q) + *(const f32x4*)(sV2 + tokA * 64 + 4 * q); u32x2 w; w.x = pk_bf16(y4[0], y4[1]); w.y = pk_bf16(y4[2], y4[3]);
          *(u32x2*)(ybuf + (size_t)(t0 + tokA) * 1024 + h * 64 + 4 * q) = w; }
    }
}

__device__ void scan_phase(const Params& p, unsigned char* shm) {
    int* sItem = (int*)(shm + 80 * 1024);
    const int tid = opaque_tid();
    unsigned* queue = (unsigned*)(p.ws + OFF_QUEUE);
    for (;;) {
        if (tid == 0) *sItem = (int)atomicAdd(queue, 1u);
        __syncthreads();
        const int item = *sItem;
        __syncthreads();
        if (item >= N_ITEMS) break;
        int tid2 = tid; asm volatile("" : "+v"(tid2));
        if (item < N_SAMPLE_ITEMS) {
            const int half = item & 1, j = item >> 1;
            if (j & 1) scan_item<16, 1, 1>(p, shm, tid2, TP + (j >> 5) * 16384, 16384, (j >> 1) & 15, half); else scan_item<16, 1, 0>(p, shm, tid2, TP + (j >> 5) * 16384, 16384, (j >> 1) & 15, half);
        } else { const int j = item - N_SAMPLE_ITEMS;
            if (j & 1) scan_item<16, 2, 1>(p, shm, tid2, (j >> 5) * 2048, 2048, (j >> 1) & 15, 0); else scan_item<16, 2, 0>(p, shm, tid2, (j >> 5) * 2048, 2048, (j >> 1) & 15, 0); }
        __syncthreads();
    }
    for (;;) {
        if (tid == 0) *sItem = (int)atomicAdd(queue + 1, 1u);
        __syncthreads();
        const int u = *sItem;
        __syncthreads();
        if (u >= N_DEFER) break;
        deferred_unit(p, shm, tid, u);
    }
}


__device__ void mix_phase(const Params& p) {
    const int tidx = opaque_tid(); const int lane = tidx & 63, wave = (blockIdx.x * 512 + tidx) >> 6, nw = (gridDim.x * 512) >> 6;
    const bf16_t* zall = (const bf16_t*)(p.ws + OFF_Z);
    bf16_t* yf = (bf16_t*)p.out; const bf16_t* yb = (const bf16_t*)p.out + (size_t)T_TOK * 1024;
    const float* bonus_f = (const float*)(p.ws + OFF_BONUS); const float* bonus_b = bonus_f + (size_t)T_TOK * 16;
    bf16_t* pooled = (bf16_t*)(p.ws + OFF_POOLED); bf16_t* sg = (bf16_t*)(p.ws + OFF_SG);
    const int hL = lane >> 2;
    const int tpw = (T_TOK + nw - 1) / nw;
    for (int t = wave * tpw; t < min(T_TOK, (wave + 1) * tpw); ++t) {
        int tbase, L; seq_of(t, tbase, L); const int pos = t - tbase; const bool hasPrev = pos > 0, hasNext = pos < L - 1;
        const bf16_t* zr = zall + (size_t)t * ZLD;
        { const int c0 = lane * 16; float y[16];
          { const u32x4 a0 = *(const u32x4*)(yf + (size_t)t * 1024 + c0), a1 = *(const u32x4*)(yf + (size_t)t * 1024 + c0 + 8);
            const u32x4 b0 = *(const u32x4*)(yb + (size_t)t * 1024 + c0), b1 = *(const u32x4*)(yb + (size_t)t * 1024 + c0 + 8);
            f32x4 fa, fb, ga, gb; unpack8(a0, fa, fb); unpack8(b0, ga, gb);
#pragma unroll
            for (int j = 0; j < 4; ++j) { y[j] = fa[j] + ga[j]; y[4 + j] = fb[j] + gb[j]; }
            unpack8(a1, fa, fb); unpack8(b1, ga, gb);
#pragma unroll
            for (int j = 0; j < 4; ++j) { y[8 + j] = fa[j] + ga[j]; y[12 + j] = fb[j] + gb[j]; } }
          float sm = 0.f;
#pragma unroll
          for (int j = 0; j < 16; ++j) sm += y[j];
          const float mean = red4(sm) * (1.0f / 64.0f); float vs = 0.f;
#pragma unroll
          for (int j = 0; j < 16; ++j) { const float d = y[j] - mean; vs += d * d; }
          const float rstd = rsqrtf(red4(vs) * (1.0f / 64.0f) + 64e-5f);
          const float bon = bonus_f[(size_t)t * 16 + hL] + bonus_b[(size_t)t * 16 + hL];
          float vv[16];
          { const bf16_t* zc = zr + COL_V + c0;
            u32x4 c_[2], p_[2], n_[2];
#pragma unroll
            for (int i = 0; i < 2; ++i) { c_[i] = *(const u32x4*)(zc + 8 * i); p_[i] = hasPrev ? *(const u32x4*)(zc - ZLD + 8 * i) : (u32x4){0u, 0u, 0u, 0u}; n_[i] = hasNext ? *(const u32x4*)(zc + ZLD + 8 * i) : (u32x4){0u, 0u, 0u, 0u}; }
#pragma unroll
            for (int i = 0; i < 2; ++i) { f32x4 ca, cb, pa, pb, na, nb; unpack8(c_[i], ca, cb); unpack8(p_[i], pa, pb); unpack8(n_[i], na, nb);
                const float* mp = p.mu_prev + (COL_V - COL_R) + c0 + 8 * i; const float* mn = p.mu_next + (COL_V - COL_R) + c0 + 8 * i;
                const f32x4 mp0 = *(const f32x4*)mp, mp1 = *(const f32x4*)(mp + 4), mn0 = *(const f32x4*)mn, mn1 = *(const f32x4*)(mn + 4);
#pragma unroll
                for (int j = 0; j < 4; ++j) { vv[8 * i + j] = ca[j] + mp0[j] * (pa[j] - ca[j]) + mn0[j] * (na[j] - ca[j]); vv[8 * i + 4 + j] = cb[j] + mp1[j] * (pb[j] - cb[j]) + mn1[j] * (nb[j] - cb[j]); } } }
          float o[16];
#pragma unroll
          for (int i = 0; i < 4; ++i) { const f32x4 lw = *(const f32x4*)(p.ln_w + c0 + 4 * i), lb = *(const f32x4*)(p.ln_b + c0 + 4 * i);
#pragma unroll
              for (int j = 0; j < 4; ++j) o[4 * i + j] = (y[4 * i + j] - mean) * rstd * lw[j] + lb[j] + bon * vv[4 * i + j]; }
          u32x4 w0, w1; w0.x = pk_bf16(o[0], o[1]); w0.y = pk_bf16(o[2], o[3]); w0.z = pk_bf16(o[4], o[5]); w0.w = pk_bf16(o[6], o[7]);
          w1.x = pk_bf16(o[8], o[9]); w1.y = pk_bf16(o[10], o[11]); w1.z = pk_bf16(o[12], o[13]); w1.w = pk_bf16(o[14], o[15]);
          *(u32x4*)(yf + (size_t)t * 1024 + c0) = w0; *(u32x4*)(yf + (size_t)t * 1024 + c0 + 8) = w1; }
        { const int c = 2 * lane; const bf16_t* zc = zr + COL_G + c; const unsigned wc_ = *(const unsigned*)zc; const unsigned wp = hasPrev ? *(const unsigned*)(zc - ZLD) : 0u, wn = hasNext ? *(const unsigned*)(zc + ZLD) : 0u;
          const float mp0 = p.mu_prev[COL_G - COL_R + c], mp1 = p.mu_prev[COL_G - COL_R + c + 1], mn0 = p.mu_next[COL_G - COL_R + c], mn1 = p.mu_next[COL_G - COL_R + c + 1];
          const float c0v = bf_lo(wc_), c1v = bf_hi(wc_);
          const float z0 = c0v + mp0 * (bf_lo(wp) - c0v) + mn0 * (bf_lo(wn) - c0v), z1 = c1v + mp1 * (bf_hi(wp) - c1v) + mn1 * (bf_hi(wn) - c1v);
          *(unsigned*)(sg + (size_t)t * 256 + c) = pk_bf16(sigmoidf_(z0), sigmoidf_(z1)); *(unsigned*)(sg + (size_t)t * 256 + 128 + c) = 0u; }
        { const int c = lane * 8, gi = lane >> 4, w = 2 << gi; const int lo = max(pos - (w >> 1), 0), hi = min(pos + (w >> 1) - 1, L - 1);
          float sum[8];
#pragma unroll
          for (int j = 0; j < 8; ++j) sum[j] = 0.f;
          u32x4 wr_[16];
#pragma unroll
          for (int d = 0; d < 16; ++d) { const int r = pos - 8 + d; wr_[d] = (u32x4){0u, 0u, 0u, 0u}; if (r >= lo && r <= hi) wr_[d] = *(const u32x4*)(zall + (size_t)(tbase + r) * ZLD + c); }
#pragma unroll
          for (int d = 0; d < 16; ++d) { f32x4 a, b; unpack8(wr_[d], a, b);
#pragma unroll
              for (int j = 0; j < 4; ++j) { sum[j] += a[j]; sum[4 + j] += b[j]; } }
          const float icnt = 1.0f / (float)(hi - lo + 1); f32x4 a, b; unpack8(*(const u32x4*)(zr + c), a, b); f32x4 oa, ob;
#pragma unroll
          for (int j = 0; j < 4; ++j) { oa[j] = sum[j] * icnt - a[j]; ob[j] = sum[4 + j] * icnt - b[j]; }
          *(u32x4*)(pooled + (size_t)t * 512 + c) = pack8(oa, ob); }
    }
}

__device__ void final_phase(const Params& p) {
    const int tidx = opaque_tid(); const int lane = tidx & 63, wave = (blockIdx.x * 512 + tidx) >> 6, nw = (gridDim.x * 512) >> 6;
    const float* x2 = (const float*)(p.ws + OFF_X1); const float* rowsq2 = (const float*)(p.ws + OFF_ROWSQ2);
    f32x4 gv[4];
#pragma unroll
    for (int i = 0; i < 4; ++i) gv[i] = *(const f32x4*)(p.g_final + lane * 4 + 256 * i);
    for (int t0 = wave; t0 < T_TOK; t0 += 2 * nw) {
        const int t1 = t0 + nw < T_TOK ? t0 + nw : t0;
        const float r0 = rsqrtf(rowsq2[t0] * (1.0f / 1024.0f) + 1e-6f), r1 = rsqrtf(rowsq2[t1] * (1.0f / 1024.0f) + 1e-6f);
        f32x4 a[4], b[4];
#pragma unroll
        for (int i = 0; i < 4; ++i) { a[i] = *(const f32x4*)(x2 + (size_t)t0 * 1024 + lane * 4 + 256 * i); b[i] = *(const f32x4*)(x2 + (size_t)t1 * 1024 + lane * 4 + 256 * i); }
#pragma unroll
        for (int i = 0; i < 4; ++i) { *(f32x4*)(p.out + (size_t)t0 * 1024 + lane * 4 + 256 * i) = a[i] * r0 * gv[i]; *(f32x4*)(p.out + (size_t)t1 * 1024 + lane * 4 + 256 * i) = b[i] * r1 * gv[i]; }
    }
}

__global__ void __launch_bounds__(512, 2) fwd_megakernel(Params p) {
    extern __shared__ __attribute__((aligned(16))) unsigned char shm[];
    unsigned char* ws = p.ws;
    prep_phase(p, shm);
    cg::this_grid().sync();
    { EpiStore E; E.O = (bf16_t*)(ws + OFF_Z); E.ldc = ZLD; run_gemm(shm, (const bf16_t*)(ws + OFF_R1), 1024, (const bf16_t*)(ws + OFF_WIN), 1024, 3840, 1024, E); }
    cg::this_grid().sync();
    scan_phase(p, shm);
    cg::this_grid().sync();
    mix_phase(p);
    cg::this_grid().sync();
    rmsnorm_rows(p, p.g_mix, (bf16_t*)(ws + OFF_XN2));
    { EpiMulInPlace E; E.Y = (bf16_t*)p.out; run_gemm(shm, (const bf16_t*)(ws + OFF_SG), 256, (const bf16_t*)(ws + OFF_WG), 256, 1024, 256, E); }
    cg::this_grid().sync();
    { EpiGates E; E.G = (bf16_t*)(ws + OFF_GATES); E.bias = p.b_gate; run_gemm(shm, (const bf16_t*)(ws + OFF_XN2), 1024, (const bf16_t*)(ws + OFF_WIN) + (size_t)3840 * 1024, 1024, 2048, 1024, E); }
    cg::this_grid().sync();
    { EpiPool E; E.P = (bf16_t*)(ws + OFF_MERGED); E.G = (const bf16_t*)(ws + OFF_GATES); run_gemm(shm, (const bf16_t*)(ws + OFF_POOLED), 512, (const bf16_t*)(ws + OFF_WEFF), 512, 1024, 512, E); }
    { EpiMerge E; E.P = (bf16_t*)(ws + OFF_MERGED); E.G = (const bf16_t*)(ws + OFF_GATES); run_gemm(shm, (const bf16_t*)p.out, 1024, (const bf16_t*)(ws + OFF_WRBR), 1024, 1024, 1024, E); }
    cg::this_grid().sync();
    { EpiOut E; E.xp = p.x_prompt; E.xs = p.x_sample; E.X1 = (float*)(ws + OFF_X1); E.X1B = (bf16_t*)(ws + OFF_X1B); E.rowsq = (float*)(ws + OFF_ROWSQ); run_gemm(shm, (const bf16_t*)(ws + OFF_MERGED), 1024, (const bf16_t*)(ws + OFF_WOUT), 1024, 1024, 1024, E); }
    cg::this_grid().sync();
    { EpiFF1 E; E.Hlo = (bf16_t*)(ws + OFF_HLO); E.Hhi = (bf16_t*)p.out; E.rowsq = (const float*)(ws + OFF_ROWSQ); run_gemm(shm, (const bf16_t*)(ws + OFF_X1B), 1024, (const bf16_t*)(ws + OFF_WFF1), 1024, 4096, 1024, E); }
    cg::this_grid().sync();
    { EpiFinal E; E.X = (float*)(ws + OFF_X1); E.rowsq = (float*)(ws + OFF_ROWSQ2);
      run_gemm(shm, (const bf16_t*)(ws + OFF_HLO), 2048, (const bf16_t*)(ws + OFF_WFF2), 4096, 1024, 4096, E, (const bf16_t*)p.out, 32); }
    cg::this_grid().sync();
    final_phase(p);
}

extern "C" void kernel_launch(void* const* d_in, const int* in_sizes, int n_in, void* d_out, int out_size, void* d_ws, size_t ws_size, hipStream_t stream) {
    constexpr size_t kDynLds = 131072;
    static int grid_blocks = 0;
    if (!grid_blocks) {
        hipFuncSetAttribute((const void*)fwd_megakernel, hipFuncAttributeMaxDynamicSharedMemorySize, (int)kDynLds);
        int dev = 0, cus = 0, per_cu = 0;
        hipGetDevice(&dev);
        hipDeviceGetAttribute(&cus, hipDeviceAttributeMultiprocessorCount, dev);
        hipOccupancyMaxActiveBlocksPerMultiprocessor(&per_cu, fwd_megakernel, 512, kDynLds);
        if (per_cu < 1) per_cu = 1;
        grid_blocks = cus;
    }
    Params p{};
    const float** pf = (const float**)&p;
    for (int i = 0; i < 30; ++i) pf[i] = (const float*)d_in[i];
    p.out = (float*)d_out; p.ws = (unsigned char*)d_ws;
    void* args[] = {&p};
    hipError_t e = hipLaunchCooperativeKernel((const void*)fwd_megakernel, dim3(grid_blocks), dim3(512), args, kDynLds, stream);
    if (e != hipSuccess) fprintf(stderr, "cooperative launch failed: %s (grid %d)\n", hipGetErrorString(e), grid_blocks);
}
```

```cpp
#include <hip/hip_runtime.h>
#include <hip/hip_cooperative_groups.h>
#include <cstdio>
namespace cg = cooperative_groups;

#define LAS __attribute__((address_space(3)))
typedef unsigned short bf16_t;
typedef short bf16x8 __attribute__((ext_vector_type(8)));
typedef float f32x4 __attribute__((ext_vector_type(4)));
typedef float f32x2 __attribute__((ext_vector_type(2)));
typedef unsigned u32x4 __attribute__((ext_vector_type(4)));
typedef unsigned u32x2 __attribute__((ext_vector_type(2)));

constexpr int T_TOK = 98304, DM = 1024, TP = 65536;
constexpr int ZLD = 3840;
constexpr int COL_R = 512, COL_K = 1536, COL_V = 2560, COL_W = 3584, COL_A = 3648, COL_G = 3712;
constexpr size_t MiB = 1ull << 20;
constexpr size_t OFF_WIN = 0, OFF_WEFF = 12 * MiB, OFF_WRBR = 13 * MiB, OFF_WOUT = 15 * MiB, OFF_WFF1 = 17 * MiB, OFF_WFF2 = 25 * MiB, OFF_WG = 33 * MiB;
constexpr size_t OFF_ROWSQ = 34 * MiB, OFF_ROWSQ2 = 34 * MiB + 512 * 1024, OFF_QUEUE = 35 * MiB, OFF_BONUS = 36 * MiB;
constexpr size_t OFF_R1 = 48 * MiB, OFF_Z = 240 * MiB;
constexpr size_t OFF_POOLED = OFF_R1, OFF_SG = OFF_R1 + 96 * MiB, OFF_XN2 = OFF_Z, OFF_GATES = OFF_Z + 192 * MiB, OFF_MERGED = OFF_Z + 576 * MiB;
constexpr size_t OFF_X1B = OFF_R1, OFF_X1 = OFF_Z, OFF_HLO = OFF_Z + 384 * MiB;
constexpr size_t U_BYTES = (size_t)T_TOK * 1024 * 2;

struct Params {
    const float *x_prompt, *x_sample, *g_mix, *w_in, *b_gate, *mu_prev, *mu_next, *pool_w, *pool_scale, *w_pool_br, *k_k, *k_a, *r_k,
        *w0_f, *w_up_f, *a0_f, *a_up_f, *w0_b, *w_up_b, *a0_b, *a_up_b, *g_up, *ln_w, *ln_b, *w_rwkv_br, *w_out, *g_ffn, *w_ff1, *w_ff2, *g_final;
    float* out; unsigned char* ws;
};

__device__ __forceinline__ float bf_lo(unsigned w) { return __uint_as_float(w << 16); }
__device__ __forceinline__ float bf_hi(unsigned w) { return __uint_as_float(w & 0xFFFF0000u); }
typedef __bf16 bf16x2_t __attribute__((ext_vector_type(2)));
__device__ __forceinline__ unsigned pk_bf16(float lo, float hi) { f32x2 v = {lo, hi}; bf16x2_t b = __builtin_convertvector(v, bf16x2_t); return __builtin_bit_cast(unsigned, b); }
__device__ __forceinline__ float fexp2_scaled(float x, float scale_log2e) { return __builtin_amdgcn_exp2f(x * scale_log2e); }
__device__ __forceinline__ float sigmoidf_(float x) { return __builtin_amdgcn_rcpf(1.0f + fexp2_scaled(x, -1.4426950409f)); }
__device__ __forceinline__ float fma_s(float a, float b, float c) { float d; asm("v_fma_f32 %0, %1, %2, %3" : "=v"(d) : "v"(a), "v"(b), "v"(c)); return d; }
__device__ __forceinline__ float mul_s(float a, float b) { float d; asm("v_mul_f32 %0, %1, %2" : "=v"(d) : "v"(a), "v"(b)); return d; }
__device__ __forceinline__ float add_s(float a, float b) { float d; asm("v_add_f32 %0, %1, %2" : "=v"(d) : "v"(a), "v"(b)); return d; }
#define DPPA(x, c) "v_add_f32_dpp " x ", " x ", " x " " c " row_mask:0xf bank_mask:0xf bound_ctrl:1\n"
#define DPP4(c) DPPA("%0", c) DPPA("%1", c) DPPA("%2", c) DPPA("%3", c)
#define DPP2(c) DPPA("%0", c) DPPA("%1", c) "s_nop 0\n"
__device__ __forceinline__ void red16x4(float& a, float& b, float& c, float& d) {
    asm("s_nop 1\n" DPP4("quad_perm:[1,0,3,2]") DPP4("quad_perm:[2,3,0,1]") DPP4("row_half_mirror") DPP4("row_mirror") : "+v"(a), "+v"(b), "+v"(c), "+v"(d)); }
__device__ __forceinline__ void red16x2(float& a, float& b) {
    asm("s_nop 1\n" DPP2("quad_perm:[1,0,3,2]") DPP2("quad_perm:[2,3,0,1]") DPP2("row_half_mirror") DPP2("row_mirror") : "+v"(a), "+v"(b)); }
__device__ __forceinline__ void row_dots(const float (&s)[4], const f32x4 a, const f32x4 q, float& sa, float& yp) {
    asm("v_mul_f32 %0, %2, %6\n v_mul_f32 %1, %2, %10\n v_fmac_f32 %0, %3, %7\n v_fmac_f32 %1, %3, %11\n v_fmac_f32 %0, %4, %8\n v_fmac_f32 %1, %4, %12\n v_fmac_f32 %0, %5, %9\n v_fmac_f32 %1, %5, %13"
        : "=&v"(sa), "=&v"(yp) : "v"(s[0]), "v"(s[1]), "v"(s[2]), "v"(s[3]), "v"(a[0]), "v"(a[1]), "v"(a[2]), "v"(a[3]), "v"(q[0]), "v"(q[1]), "v"(q[2]), "v"(q[3])); }
__device__ __forceinline__ void row_update(float (&s)[4], const f32x4 w, const f32x4 b, const f32x4 k, float v, float sa, float yp, float bkx, float bky, float& y) {
    float t0, t1, t2, t3;
    asm("v_mul_f32 %0, %6, %15\n v_mul_f32 %1, %6, %16\n v_mul_f32 %2, %6, %17\n v_mul_f32 %3, %6, %18\n"
        "v_fmac_f32 %4, %7, %5\n"
        "v_fmac_f32 %0, %7, %11\n v_fmac_f32 %1, %7, %12\n v_fmac_f32 %2, %7, %13\n v_fmac_f32 %3, %7, %14\n"
        "v_fmac_f32 %4, %6, %8\n"
        "v_fmac_f32 %0, %9, %19\n v_fmac_f32 %1, %10, %20\n v_fmac_f32 %2, %23, %21\n v_fmac_f32 %3, %24, %22"
        : "=&v"(t0), "=&v"(t1), "=&v"(t2), "=&v"(t3), "+v"(yp)
        : "v"(bkx), "v"(v), "v"(sa), "v"(bky), "v"(s[0]), "v"(s[1]), "v"(b[0]), "v"(b[1]), "v"(b[2]), "v"(b[3]), "v"(k[0]), "v"(k[1]), "v"(k[2]), "v"(k[3]), "v"(w[0]), "v"(w[1]), "v"(w[2]), "v"(w[3]), "v"(s[2]), "v"(s[3]));
    s[0] = t0; s[1] = t1; s[2] = t2; s[3] = t3; y = yp; }
__device__ __forceinline__ void shift4(float (&z)[4], const float (&c)[4], const float (&pv)[4], const float (&nx)[4], const f32x4 m0, const f32x4 mp, const f32x4 mn) {
    asm("v_mul_f32 %0, %4, %16\n v_mul_f32 %1, %5, %17\n v_mul_f32 %2, %6, %18\n v_mul_f32 %3, %7, %19\n"
        "v_fma_f32 %0, %8, %20, %0\n v_fma_f32 %1, %9, %21, %1\n v_fma_f32 %2, %10, %22, %2\n v_fma_f32 %3, %11, %23, %3\n"
        "v_fma_f32 %0, %12, %24, %0\n v_fma_f32 %1, %13, %25, %1\n v_fma_f32 %2, %14, %26, %2\n v_fma_f32 %3, %15, %27, %3"
        : "=&v"(z[0]), "=&v"(z[1]), "=&v"(z[2]), "=&v"(z[3])
        : "v"(c[0]), "v"(c[1]), "v"(c[2]), "v"(c[3]), "v"(pv[0]), "v"(pv[1]), "v"(pv[2]), "v"(pv[3]), "v"(nx[0]), "v"(nx[1]), "v"(nx[2]), "v"(nx[3]),
          "v"(m0[0]), "v"(m0[1]), "v"(m0[2]), "v"(m0[3]), "v"(mp[0]), "v"(mp[1]), "v"(mp[2]), "v"(mp[3]), "v"(mn[0]), "v"(mn[1]), "v"(mn[2]), "v"(mn[3])); }
__device__ __forceinline__ void kk4(float (&kk)[4], float& ss, const float (&k)[4], const f32x4 c) {
    asm("v_mul_f32 %0, %5, %9\n v_mul_f32 %1, %6, %10\n v_mul_f32 %2, %7, %11\n v_mul_f32 %3, %8, %12\n"
        "v_mul_f32 %4, %0, %0\n v_fma_f32 %4, %1, %1, %4\n v_fma_f32 %4, %2, %2, %4\n v_fma_f32 %4, %3, %3, %4"
        : "=&v"(kk[0]), "=&v"(kk[1]), "=&v"(kk[2]), "=&v"(kk[3]), "=&v"(ss) : "v"(k[0]), "v"(k[1]), "v"(k[2]), "v"(k[3]), "v"(c[0]), "v"(c[1]), "v"(c[2]), "v"(c[3])); }
__device__ __forceinline__ void row_update2(float (&s)[4], const f32x4 w, const f32x4 b, const f32x4 k, float v, float vkr, float sa, float yp, float& y) {
    float t0, t1, t2, t3;
    asm("v_mul_f32 %0, %6, %14\n v_mul_f32 %1, %6, %15\n v_mul_f32 %2, %6, %16\n v_mul_f32 %3, %6, %17\n"
        "v_add_f32 %4, %4, %5\n"
        "v_fmac_f32 %0, %7, %10\n v_fmac_f32 %1, %7, %11\n v_fmac_f32 %2, %7, %12\n v_fmac_f32 %3, %7, %13\n"
        "v_fmac_f32 %0, %8, %18\n v_fmac_f32 %1, %9, %19\n v_fmac_f32 %2, %22, %20\n v_fmac_f32 %3, %23, %21"
        : "=&v"(t0), "=&v"(t1), "=&v"(t2), "=&v"(t3), "+v"(yp)
        : "v"(vkr), "v"(v), "v"(sa), "v"(s[0]), "v"(s[1]), "v"(b[0]), "v"(b[1]), "v"(b[2]), "v"(b[3]), "v"(k[0]), "v"(k[1]), "v"(k[2]), "v"(k[3]), "v"(w[0]), "v"(w[1]), "v"(w[2]), "v"(w[3]), "v"(s[2]), "v"(s[3]));
    s[0] = t0; s[1] = t1; s[2] = t2; s[3] = t3; y = yp; }
__device__ __forceinline__ void row_update3(float (&s)[4], const f32x4 w, const f32x4 b, const f32x4 k, float v, float sa) {
    float t0, t1, t2, t3;
    asm("v_mul_f32 %0, %4, %12\n v_mul_f32 %1, %4, %13\n v_mul_f32 %2, %4, %14\n v_mul_f32 %3, %4, %15\n"
        "v_fmac_f32 %0, %5, %8\n v_fmac_f32 %1, %5, %9\n v_fmac_f32 %2, %5, %10\n v_fmac_f32 %3, %5, %11\n"
        "v_fmac_f32 %0, %6, %16\n v_fmac_f32 %1, %7, %17\n v_fmac_f32 %2, %20, %18\n v_fmac_f32 %3, %21, %19"
        : "=&v"(t0), "=&v"(t1), "=&v"(t2), "=&v"(t3)
        : "v"(v), "v"(sa), "v"(s[0]), "v"(s[1]), "v"(b[0]), "v"(b[1]), "v"(b[2]), "v"(b[3]), "v"(k[0]), "v"(k[1]), "v"(k[2]), "v"(k[3]), "v"(w[0]), "v"(w[1]), "v"(w[2]), "v"(w[3]), "v"(s[2]), "v"(s[3]));
    s[0] = t0; s[1] = t1; s[2] = t2; s[3] = t3; }
#define DPP2S(c) DPPA("%0", c) DPPA("%2", c)
__device__ __forceinline__ void red16x4y(float& a, float& b, float& c, float& d) {
    asm("s_nop 1\n" DPP4("quad_perm:[1,0,3,2]") DPP4("quad_perm:[2,3,0,1]") DPP4("row_half_mirror") DPP2S("row_mirror") : "+v"(a), "+v"(b), "+v"(c), "+v"(d)); }
__device__ __forceinline__ void red16x2y(float& a, float& b) {
    asm("s_nop 1\n" DPP2("quad_perm:[1,0,3,2]") DPP2("quad_perm:[2,3,0,1]") DPP2("row_half_mirror") DPPA("%0", "row_mirror") : "+v"(a), "+v"(b)); }
template <int CTRL> __device__ __forceinline__ float dppf(float x) { return __int_as_float(__builtin_amdgcn_update_dpp(0, __float_as_int(x), CTRL, 0xF, 0xF, true)); }
__device__ __forceinline__ float red4(float x) { x += dppf<0xB1>(x); x += dppf<0x4E>(x); return x; }
__device__ __forceinline__ float red8(float x) { x = red4(x); x += dppf<0x141>(x); return x; }
__device__ __forceinline__ float red16(float x) { x = red8(x); x += dppf<0x140>(x); return x; }
__device__ __forceinline__ int opaque_tid() { int t = threadIdx.x; asm volatile("" : "+v"(t)); return t; }
__device__ __forceinline__ const float* xrow(const Params& p, int t) { return t < TP ? p.x_prompt + (size_t)t * DM : p.x_sample + (size_t)(t - TP) * DM; }
__device__ __forceinline__ void seq_of(int t, int& base, int& len) { if (t < TP) { base = t & ~2047; len = 2048; } else { base = TP + ((t - TP) & ~16383); len = 16384; } }

namespace pg8 {
constexpr int BM = 256, BK = 64, HALF = 128, HTB = HALF * BK * 2, STAGE_BYTES = 8 * HTB, NXCD = 8, WGM = 8;
__device__ __forceinline__ int lds_byte(int r, int c) { const int st = (r >> 4) * 2 + (c >> 5), rr = r & 15, cc = c & 31, ob = rr * 64 + cc * 2; return st * 1024 + (ob ^ (((ob >> 9) & 1) << 5)); }
__device__ __forceinline__ void stage_rc(int b, int& R, int& C) { const int st = b / 1024, sb = b % 1024, swz = sb ^ (((sb >> 9) & 1) << 5); R = (st >> 1) * 16 + swz / 64; C = (st & 1) * 32 + (swz % 64) / 2; }
__device__ __forceinline__ int perm32(int rho) { const int n = rho >> 4, i = rho & 15; return 8 * (i >> 2) + 4 * n + (i & 3); }
struct Unit { int pm, pn; };
struct Gemm { const bf16_t* A; const bf16_t* Bt; int M, N, K, lda, ldb; const bf16_t* A2; int ks; };
struct StaticOrder {
    int nM, nN, nwg, G, c;
    __device__ void init(int M, int N, int G_, int c_) { nM = M / BM; nN = N / BM; nwg = nM * nN; G = G_; c = c_; }
    __device__ bool next(int i, Unit& u) const {
        const long L = (long)i * G + c; if (L >= nwg) return false;
        int wgid = (int)L; { const int q = nwg / NXCD, r = nwg % NXCD, xcd = wgid % NXCD, off = wgid / NXCD; wgid = (xcd < r ? xcd * (q + 1) : r * (q + 1) + (xcd - r) * q) + off; }
        const int nig = WGM * nN, gid = wgid / nig, fm = gid * WGM, gsz = (nM - fm) < WGM ? (nM - fm) : WGM;
        u.pm = fm + ((wgid % nig) % gsz); u.pn = (wgid % nig) / gsz; return true;
    }
};

template <class Epi>
__device__ __forceinline__ void gemm_phase(LAS unsigned char* lds, const Gemm g, const StaticOrder& S, const Epi& E) {
    const int tid = opaque_tid();
    const int wid = __builtin_amdgcn_readfirstlane(tid >> 6), lane = tid & 63, wr = wid >> 2, wc = wid & 3, fr = lane & 15, fq = lane >> 4;
    const int K = g.K, nt = K / BK;
    unsigned voffA[2], voffB[2];
#pragma unroll
    for (int i = 0; i < 2; ++i) { int R, C; stage_rc(tid * 16 + i * 8192, R, C); const int Rb = (R & ~31) + perm32(R & 31);
        voffA[i] = (unsigned)(R * g.lda + C) * 2u; voffB[i] = (unsigned)(Rb * g.ldb + C) * 2u; }
    const size_t kstep = (size_t)(BK * 2);
    const size_t hstepA = (size_t)HALF * g.lda * 2, hstepB = (size_t)HALF * g.ldb * 2;
    const size_t tstepA = 2 * hstepA, tstepB = 2 * hstepB;
    const unsigned ldsw = (unsigned)wid * 1024u;
    const int aoff = lds_byte(wr * 64 + fr, fq * 8), boff = lds_byte(wc * 32 + fr, fq * 8);
#define PG8_SA(b, h) (((b) * 2 + (h)) * HTB)
#define PG8_SB(b, h) ((4 + (b) * 2 + (h)) * HTB)
#define PG8_STAGE(bufoff, gbase, voff) do { _Pragma("unroll") for (int _i = 0; _i < 2; ++_i) \
        __builtin_amdgcn_global_load_lds((const unsigned*)((const char*)(gbase) + (voff)[_i]), (LAS unsigned*)(lds + (bufoff) + ldsw + _i * 8192), 16, 0, 0); } while (0)
#define PG8_LDA(dst, b, h) do { _Pragma("unroll") for (int m = 0; m < 4; ++m) _Pragma("unroll") for (int k = 0; k < 2; ++k) dst[m][k] = *(const LAS bf16x8*)(lds + PG8_SA(b, h) + aoff + m * 2048 + k * 1024); } while (0)
#define PG8_LDB(dst, b, h) do { _Pragma("unroll") for (int n = 0; n < 2; ++n) _Pragma("unroll") for (int k = 0; k < 2; ++k) dst[n][k] = *(const LAS bf16x8*)(lds + PG8_SB(b, h) + boff + n * 2048 + k * 1024); } while (0)
#define PG8_MMA(ai, bj, At, Bt) do { __builtin_amdgcn_s_setprio(1); _Pragma("unroll") for (int m = 0; m < 4; ++m) _Pragma("unroll") for (int n = 0; n < 2; ++n) _Pragma("unroll") for (int k = 0; k < 2; ++k) \
        acc[ai][bj][m][n] = __builtin_amdgcn_mfma_f32_16x16x32_bf16(Bt[n][k], At[m][k], acc[ai][bj][m][n], 0, 0, 0); __builtin_amdgcn_s_setprio(0); } while (0)
#define PG8_WAIT_V(n) asm volatile("s_waitcnt vmcnt(" #n ")" ::: "memory")
#define PG8_WAIT_L(n) asm volatile("s_waitcnt lgkmcnt(" #n ")" ::: "memory")
#define PG8_BAR __builtin_amdgcn_s_barrier()
#define PG8_SCHED __builtin_amdgcn_sched_barrier(0)
    Unit cur, nxt; int ui = 0;
    if (!S.next(0, cur)) return;
    f32x4 acc[2][2][4][2];
#pragma unroll
    for (int a = 0; a < 2; ++a)
#pragma unroll
        for (int b = 0; b < 2; ++b)
#pragma unroll
            for (int m = 0; m < 4; ++m)
#pragma unroll
                for (int n = 0; n < 2; ++n) acc[a][b][m][n] = (f32x4){0.f, 0.f, 0.f, 0.f};
    bf16x8 At[4][2], B0[2][2], B1[2][2];
    const char* cA = (const char*)g.A + (size_t)cur.pm * tstepA; const char* cB = (const char*)g.Bt + (size_t)cur.pn * tstepB;
    const bool two = g.A2 != nullptr; const int ks = two ? g.ks : (1 << 30);
    const char* cA2 = two ? (const char*)g.A2 + (size_t)cur.pm * tstepA : cA;
    PG8_STAGE(PG8_SB(0, 0), cB, voffB); PG8_STAGE(PG8_SA(0, 0), cA, voffA); PG8_STAGE(PG8_SB(0, 1), cB + hstepB, voffB); PG8_STAGE(PG8_SA(0, 1), cA + hstepA, voffA);
    if (wr == 1) PG8_BAR;
    PG8_WAIT_V(4); PG8_BAR;
    PG8_STAGE(PG8_SB(1, 0), cB + kstep, voffB); PG8_STAGE(PG8_SA(1, 0), cA + kstep, voffA); PG8_STAGE(PG8_SB(1, 1), cB + hstepB + kstep, voffB);
    PG8_WAIT_V(6); PG8_BAR;
    for (;;) {
        const bool has_next = S.next(ui + 1, nxt);
        const char* nA = has_next ? (const char*)g.A + (size_t)nxt.pm * tstepA : cA; const char* nB = has_next ? (const char*)g.Bt + (size_t)nxt.pn * tstepB : cB;
        const char* nA2 = (two && has_next) ? (const char*)g.A2 + (size_t)nxt.pm * tstepA : cA2;
#pragma unroll 1
        for (int t = 0; t < nt; t += 2) {
            const bool last = (t == nt - 2);
            const char* a1 = (t + 1 < ks) ? cA + (size_t)(t + 1) * kstep : cA2 + (size_t)(t + 1 - ks) * kstep;
            const char* a2 = last ? nA : ((t + 2 < ks) ? cA + (size_t)(t + 2) * kstep : cA2 + (size_t)(t + 2 - ks) * kstep); const char* b2 = last ? nB : cB + (size_t)(t + 2) * kstep;
            const char* a3 = a2 + kstep; const char* b3 = b2 + kstep;
            PG8_LDB(B0, 0, 0); PG8_SCHED; PG8_LDA(At, 0, 0); PG8_STAGE(PG8_SA(1, 1), a1 + hstepA, voffA);
            PG8_WAIT_L(8); PG8_BAR; PG8_WAIT_L(0); PG8_MMA(0, 0, At, B0); PG8_BAR; PG8_SCHED;
            PG8_LDB(B1, 0, 1); PG8_STAGE(PG8_SB(0, 0), b2, voffB);
            PG8_BAR; PG8_WAIT_L(0); PG8_MMA(0, 1, At, B1); PG8_BAR;
            PG8_LDA(At, 0, 1); PG8_STAGE(PG8_SA(0, 0), a2, voffA);
            PG8_BAR; PG8_WAIT_L(0); PG8_MMA(1, 0, At, B0); PG8_BAR; PG8_SCHED;
            PG8_STAGE(PG8_SB(0, 1), b2 + hstepB, voffB);
            PG8_WAIT_V(6); PG8_BAR; PG8_MMA(1, 1, At, B1); PG8_BAR;
            PG8_LDB(B0, 1, 0); PG8_SCHED; PG8_LDA(At, 1, 0); PG8_STAGE(PG8_SA(0, 1), a2 + hstepA, voffA);
            PG8_WAIT_L(8); PG8_BAR; PG8_WAIT_L(0); PG8_MMA(0, 0, At, B0); PG8_BAR; PG8_SCHED;
            PG8_LDB(B1, 1, 1); PG8_STAGE(PG8_SB(1, 0), b3, voffB);
            PG8_BAR; PG8_WAIT_L(0); PG8_MMA(0, 1, At, B1); PG8_BAR;
            PG8_LDA(At, 1, 1); PG8_STAGE(PG8_SA(1, 0), a3, voffA);
            PG8_BAR; PG8_WAIT_L(0); PG8_MMA(1, 0, At, B0); PG8_BAR; PG8_SCHED;
            PG8_STAGE(PG8_SB(1, 1), b3 + hstepB, voffB);
            PG8_WAIT_V(6); PG8_BAR; PG8_MMA(1, 1, At, B1); PG8_BAR;
        }
        E(acc, cur, wr, wc, fr, fq);
        if (!has_next) break;
#pragma unroll
        for (int a = 0; a < 2; ++a)
#pragma unroll
            for (int b = 0; b < 2; ++b)
#pragma unroll
                for (int m = 0; m < 4; ++m)
#pragma unroll
                    for (int n = 0; n < 2; ++n) acc[a][b][m][n] = (f32x4){0.f, 0.f, 0.f, 0.f};
        cur = nxt; cA = nA; cA2 = nA2; cB = nB; ++ui;
    }
    PG8_WAIT_V(0);
    if (wr == 0) PG8_BAR;
    PG8_BAR;
#undef PG8_SA
#undef PG8_SB
#undef PG8_STAGE
#undef PG8_LDA
#undef PG8_LDB
#undef PG8_MMA
#undef PG8_WAIT_V
#undef PG8_WAIT_L
#undef PG8_BAR
#undef PG8_SCHED
}
}
using pg8::Unit;

#define EPI_LOOP_BEGIN const int row0 = u.pm * 256 + wr * 64 + fr, col0 = u.pn * 256 + wc * 32 + 8 * fq; \
    _Pragma("unroll") for (int ai = 0; ai < 2; ++ai) _Pragma("unroll") for (int m = 0; m < 4; ++m) { const int row = row0 + ai * 128 + m * 16;
#define EPI_BJ _Pragma("unroll") for (int bj = 0; bj < 2; ++bj) { const int col = col0 + bj * 128; const f32x4 v0 = acc[ai][bj][m][0], v1 = acc[ai][bj][m][1];
#define EPI_ACC const f32x4 (&acc)[2][2][4][2], const Unit& u, int wr, int wc, int fr, int fq

__device__ __forceinline__ u32x4 pack8(const f32x4 a, const f32x4 b) { u32x4 w; w.x = pk_bf16(a[0], a[1]); w.y = pk_bf16(a[2], a[3]); w.z = pk_bf16(b[0], b[1]); w.w = pk_bf16(b[2], b[3]); return w; }
__device__ __forceinline__ void unpack8(const u32x4 w, f32x4& a, f32x4& b) { a = (f32x4){bf_lo(w.x), bf_hi(w.x), bf_lo(w.y), bf_hi(w.y)}; b = (f32x4){bf_lo(w.z), bf_hi(w.z), bf_lo(w.w), bf_hi(w.w)}; }

struct EpiStore {
    bf16_t* O; int ldc;
    __device__ __forceinline__ void operator()(EPI_ACC) const { EPI_LOOP_BEGIN EPI_BJ *(u32x4*)(O + (size_t)row * ldc + col) = pack8(v0, v1); } } }
};
struct EpiMulInPlace {
    bf16_t* Y;
    __device__ __forceinline__ void operator()(EPI_ACC) const { EPI_LOOP_BEGIN if ((m & 1) == 0) __builtin_amdgcn_sched_barrier(0);
        EPI_BJ u32x4* ptr = (u32x4*)(Y + (size_t)row * 1024 + col); f32x4 a, b; unpack8(*ptr, a, b); *ptr = pack8(a * v0, b * v1); } } }
};
struct EpiGates {
    bf16_t* G; const float* bias;
    __device__ __forceinline__ void operator()(EPI_ACC) const { EPI_LOOP_BEGIN EPI_BJ
        const f32x4 b0 = *(const f32x4*)(bias + col), b1 = *(const f32x4*)(bias + col + 4); f32x4 a, b;
#pragma unroll
        for (int j = 0; j < 4; ++j) { a[j] = sigmoidf_(v0[j] + b0[j]); b[j] = sigmoidf_(v1[j] + b1[j]); }
        *(u32x4*)(G + (size_t)row * 2048 + col) = pack8(a, b); } } }
};
struct EpiPool {
    bf16_t* P; const bf16_t* G;
    __device__ __forceinline__ void operator()(EPI_ACC) const { EPI_LOOP_BEGIN EPI_BJ f32x4 a, b; unpack8(*(const u32x4*)(G + (size_t)row * 2048 + col), a, b);
        *(u32x4*)(P + (size_t)row * 1024 + col) = pack8(a * v0, b * v1); } } }
};
struct EpiMerge {
    bf16_t* P; const bf16_t* G;
    __device__ __forceinline__ void operator()(EPI_ACC) const { EPI_LOOP_BEGIN EPI_BJ f32x4 a, b, pa, pb; unpack8(*(const u32x4*)(G + (size_t)row * 2048 + 1024 + col), a, b);
        u32x4* ptr = (u32x4*)(P + (size_t)row * 1024 + col); unpack8(*ptr, pa, pb); *ptr = pack8(pa + a * v0, pb + b * v1); } } }
};
struct EpiOut {
    const float* xp; const float* xs; float* X1; bf16_t* X1B; float* rowsq;
    __device__ __forceinline__ void operator()(EPI_ACC) const { EPI_LOOP_BEGIN const float* xr = row < TP ? xp + (size_t)row * DM : xs + (size_t)(row - TP) * DM; float ss = 0.f; EPI_BJ
        f32x4 a = *(const f32x4*)(xr + col) + v0, b = *(const f32x4*)(xr + col + 4) + v1;
        *(f32x4*)(X1 + (size_t)row * 1024 + col) = a; *(f32x4*)(X1 + (size_t)row * 1024 + col + 4) = b; *(u32x4*)(X1B + (size_t)row * 1024 + col) = pack8(a, b);
#pragma unroll
        for (int j = 0; j < 4; ++j) ss += a[j] * a[j] + b[j] * b[j]; }
        ss += __shfl_xor(ss, 16); ss += __shfl_xor(ss, 32); if (fq == 0) atomicAdd(rowsq + row, ss); } }
};
struct EpiFF1 {
    bf16_t* Hlo; bf16_t* Hhi; const float* rowsq;
    __device__ __forceinline__ void operator()(EPI_ACC) const { bf16_t* H = u.pn < 8 ? Hlo : Hhi; const int cshift = u.pn < 8 ? 0 : 2048;
        EPI_LOOP_BEGIN const float rinv = rsqrtf(rowsq[row] * (1.0f / 1024.0f) + 1e-6f); EPI_BJ f32x4 a, b;
#pragma unroll
        for (int j = 0; j < 4; ++j) { float t0 = fmaxf(v0[j] * rinv, 0.f), t1 = fmaxf(v1[j] * rinv, 0.f); a[j] = t0 * t0; b[j] = t1 * t1; }
        *(u32x4*)(H + (size_t)row * 2048 + (col - cshift)) = pack8(a, b); } } }
};
struct EpiAddInPlace {
    float* X;
    __device__ __forceinline__ void operator()(EPI_ACC) const { EPI_LOOP_BEGIN EPI_BJ f32x4* ptr = (f32x4*)(X + (size_t)row * 1024 + col); ptr[0] = ptr[0] + v0; ptr[1] = ptr[1] + v1; } } }
};
struct EpiFinal {
    float* X; float* rowsq;
    __device__ __forceinline__ void operator()(EPI_ACC) const { EPI_LOOP_BEGIN float ss = 0.f; EPI_BJ f32x4* ptr = (f32x4*)(X + (size_t)row * 1024 + col); const f32x4 a = ptr[0] + v0, b = ptr[1] + v1; ptr[0] = a; ptr[1] = b;
#pragma unroll
        for (int j = 0; j < 4; ++j) ss += a[j] * a[j] + b[j] * b[j]; }
        ss += __shfl_xor(ss, 16); ss += __shfl_xor(ss, 32); if (fq == 0) atomicAdd(rowsq + row, ss); } }
};

template <class Epi>
__device__ __forceinline__ void run_gemm(unsigned char* shm, const bf16_t* A, int lda, const bf16_t* Bt, int ldb, int N, int K, const Epi& E, const bf16_t* A2 = nullptr, int ks = 0) {
    pg8::Gemm g; g.A = A; g.Bt = Bt; g.M = T_TOK; g.N = N; g.K = K; g.lda = lda; g.ldb = ldb; g.A2 = A2; g.ks = ks;
    pg8::StaticOrder S; S.init(T_TOK, N, (int)gridDim.x, (int)blockIdx.x);
    pg8::gemm_phase<Epi>((LAS unsigned char*)shm, g, S, E);
}

__device__ __forceinline__ void transpose_tile(float* tile, int tid, const float* src, int N, bf16_t* dst, int ldd, const float* kscale, int t) {
    const int ntn = N / 64, tk = t / ntn, tn = t % ntn;
#pragma unroll
    for (int i = 0; i < 8; ++i) { const int kl = (tid >> 6) + 8 * i, nl = tid & 63; const int k = tk * 64 + kl;
        tile[kl * 65 + nl] = src[(size_t)k * N + tn * 64 + nl] * (kscale ? kscale[k] : 1.0f); }
    __syncthreads();
#pragma unroll
    for (int i = 0; i < 8; ++i) { const int nl = (tid >> 6) + 8 * i, kl = tid & 63;
        const unsigned w = pk_bf16(tile[kl * 65 + nl], 0.f); dst[(size_t)(tn * 64 + nl) * ldd + tk * 64 + kl] = (bf16_t)(w & 0xFFFFu); }
    __syncthreads();
}
__device__ void transpose_cvt(unsigned char* shm, const float* src, int K, int N, bf16_t* dst, int ldd, const float* kscale) {
    float* tile = (float*)shm;
    const int tid = opaque_tid(), ntk = K / 64, ntn = N / 64;
    for (int t = blockIdx.x; t < ntk * ntn; t += gridDim.x) transpose_tile(tile, tid, src, N, dst, ldd, kscale, t);
}
constexpr int DU_RBR = 256, DU_OUT = 512, DU_FF1 = 1536, DU_FF2 = 2560, DU_G = 2592, DU_GZ = 2624, N_DEFER = 2624 + 256;
__device__ void deferred_unit(const Params& p, unsigned char* shm, int tid, int u) {
    unsigned char* ws = p.ws; float* tile = (float*)shm;
    if (u < DU_RBR) transpose_tile(tile, tid, p.w_rwkv_br, 1024, (bf16_t*)(ws + OFF_WRBR), 1024, nullptr, u);
    else if (u < DU_OUT) transpose_tile(tile, tid, p.w_out, 1024, (bf16_t*)(ws + OFF_WOUT), 1024, nullptr, u - DU_RBR);
    else if (u < DU_FF1) transpose_tile(tile, tid, p.w_ff1, 4096, (bf16_t*)(ws + OFF_WFF1), 1024, p.g_ffn, u - DU_OUT);
    else if (u < DU_FF2) transpose_tile(tile, tid, p.w_ff2, 1024, (bf16_t*)(ws + OFF_WFF2), 4096, nullptr, u - DU_FF1);
    else if (u < DU_G) transpose_tile(tile, tid, p.g_up, 1024, (bf16_t*)(ws + OFF_WG), 256, nullptr, u - DU_FF2);
    else if (u < DU_GZ) { bf16_t* wg = (bf16_t*)(ws + OFF_WG);
#pragma unroll
        for (int m = 0; m < 8; ++m) { const int i = (u - DU_G) * 4096 + m * 512 + tid; wg[(size_t)(i >> 7) * 256 + 128 + (i & 127)] = 0; } }
    else {
        bf16_t* we = (bf16_t*)(ws + OFF_WEFF); const int base = (u - DU_GZ) * 2048; float acc[4] = {0.f, 0.f, 0.f, 0.f};
        const int gI = (base >> 10) >> 7;
        for (int d = 0; d < 128; ++d) { const float sc = p.pool_scale[gI * 128 + d];
#pragma unroll
            for (int m = 0; m < 4; ++m) { const int i = base + m * 512 + tid, k = i >> 10, n = i & 1023;
                acc[m] += p.pool_w[(size_t)k * 128 + d] * sc * p.w_pool_br[(size_t)(gI * 128 + d) * 1024 + n]; } }
#pragma unroll
        for (int m = 0; m < 4; ++m) { const int i = base + m * 512 + tid, k = i >> 10, n = i & 1023; we[(size_t)n * 512 + k] = (bf16_t)(pk_bf16(acc[m], 0.f) & 0xFFFFu); } }
}
__device__ void rmsnorm_rows(const Params& p, const float* g, bf16_t* dst) {
    const int tidx = opaque_tid(); const int lane = tidx & 63, wave = (blockIdx.x * 512 + tidx) >> 6, nw = (gridDim.x * 512) >> 6;
    f32x4 gv[4];
#pragma unroll
    for (int i = 0; i < 4; ++i) gv[i] = *(const f32x4*)(g + lane * 4 + 256 * i);
    for (int t0 = wave; t0 < T_TOK; t0 += 2 * nw) {
        const int t1 = t0 + nw; const bool has1 = t1 < T_TOK;
        const float* xr0 = xrow(p, t0); const float* xr1 = xrow(p, has1 ? t1 : t0); f32x4 v0[4], v1[4]; float ss0 = 0.f, ss1 = 0.f;
#pragma unroll
        for (int i = 0; i < 4; ++i) { v0[i] = *(const f32x4*)(xr0 + lane * 4 + 256 * i); v1[i] = *(const f32x4*)(xr1 + lane * 4 + 256 * i); }
#pragma unroll
        for (int i = 0; i < 4; ++i) { ss0 += v0[i][0] * v0[i][0] + v0[i][1] * v0[i][1] + v0[i][2] * v0[i][2] + v0[i][3] * v0[i][3]; ss1 += v1[i][0] * v1[i][0] + v1[i][1] * v1[i][1] + v1[i][2] * v1[i][2] + v1[i][3] * v1[i][3]; }
#pragma unroll
        for (int o = 1; o < 64; o <<= 1) { ss0 += __shfl_xor(ss0, o); ss1 += __shfl_xor(ss1, o); }
        const float r0 = rsqrtf(ss0 * (1.0f / 1024.0f) + 1e-6f), r1 = rsqrtf(ss1 * (1.0f / 1024.0f) + 1e-6f);
#pragma unroll
        for (int i = 0; i < 4; ++i) { u32x2 w; w.x = pk_bf16(v0[i][0] * r0 * gv[i][0], v0[i][1] * r0 * gv[i][1]); w.y = pk_bf16(v0[i][2] * r0 * gv[i][2], v0[i][3] * r0 * gv[i][3]);
            *(u32x2*)(dst + (size_t)t0 * 1024 + lane * 4 + 256 * i) = w; }
        if (has1) {
#pragma unroll
            for (int i = 0; i < 4; ++i) { u32x2 w; w.x = pk_bf16(v1[i][0] * r1 * gv[i][0], v1[i][1] * r1 * gv[i][1]); w.y = pk_bf16(v1[i][2] * r1 * gv[i][2], v1[i][3] * r1 * gv[i][3]);
                *(u32x2*)(dst + (size_t)t1 * 1024 + lane * 4 + 256 * i) = w; } }
    }
}

__device__ void prep_phase(const Params& p, unsigned char* shm) {
    unsigned char* ws = p.ws;
    const int gtid = blockIdx.x * 512 + opaque_tid(), gn = gridDim.x * 512;
    for (int i = gtid; i < T_TOK; i += gn) { ((float*)(ws + OFF_ROWSQ))[i] = 0.f; ((float*)(ws + OFF_ROWSQ2))[i] = 0.f; }
    if (gtid < 64) ((unsigned*)(ws + OFF_QUEUE))[gtid] = 0u;
    transpose_cvt(shm, p.w_in, 1024, 5888, (bf16_t*)(ws + OFF_WIN), 1024, nullptr);
    rmsnorm_rows(p, p.g_mix, (bf16_t*)(ws + OFF_R1));
}

#define LDS_BAR() do { asm volatile("s_waitcnt lgkmcnt(0)" ::: "memory"); __builtin_amdgcn_s_barrier(); asm volatile("" ::: "memory"); } while (0)
constexpr int N_SAMPLE_ITEMS = 128, N_ITEMS = N_SAMPLE_ITEMS + 1024;

template <int LPR, int RPL, int DIR>
__device__ __forceinline__ void scan_item(const Params& p, unsigned char* shm, const int tid, const int tbase, const int L, const int h, const int half) {
    constexpr int dir = DIR;
    constexpr int EC = 64 / LPR, RPW = RPL * (64 / LPR);
    float* sW = (float*)shm; float* sAV = sW + 2048; float* sBV = sW + 4096; float* sKD = sW + 6144; float* sWR = sW + 8192; float* sR = sW + 10240; float* sV = sW + 12288; float* sY = sW + 14336;
    float* sBK = sW + 16384;
    bf16_t* sTW = (bf16_t*)(sW + 16384 + 64);
    bf16_t* sZA = sTW + 32 * 72;
    const int lane = tid & 63, wv = tid >> 6;
    const bf16_t* zall = (const bf16_t*)(p.ws + OFF_Z);
    const int tokA = tid >> 4, q = tid & 15;
    const int rowS = half * 32 + wv * RPW + RPL * (lane / LPR), gS = lane % LPR;
    const int NC = L / 32;
    bf16_t* ybuf = (bf16_t*)p.out + (dir ? (size_t)T_TOK * 1024 : 0);
    float* bonus = (float*)(p.ws + OFF_BONUS) + (dir ? (size_t)T_TOK * 16 : 0);
    const float* w_up = dir ? p.w_up_b : p.w_up_f; const float* a_up = dir ? p.a_up_b : p.a_up_f;
    const float* w0 = dir ? p.w0_b : p.w0_f; const float* a0 = dir ? p.a0_b : p.a0_f;
    const int mat = wv >> 2, cbk = wv & 3, colB = cbk * 16 + (lane & 15), quad = lane >> 4;
    u32x4* sBF = (u32x4*)(shm + 84 * 1024);
    { const float* up = mat ? a_up : w_up;
#pragma unroll
      for (int kb = 0; kb < 2; ++kb) { float f[8];
#pragma unroll
          for (int j = 0; j < 8; ++j) f[j] = up[(size_t)(kb * 32 + quad * 8 + j) * 1024 + h * 64 + colB];
          u32x4 w; w.x = pk_bf16(f[0], f[1]); w.y = pk_bf16(f[2], f[3]); w.z = pk_bf16(f[4], f[5]); w.w = pk_bf16(f[6], f[7]); sBF[kb * 512 + tid] = w; } }
    const float c0B = (mat ? a0 : w0)[h * 64 + colB];
    const float kaB = p.k_a[h * 64 + colB];
    int colz[5];
    float* sV2 = (float*)(shm + 104 * 1024);
    float* sYP = (float*)(shm + 112 * 1024);
    float* sM0 = (float*)(shm + 100 * 1024);
    float* sMU = (float*)(shm + 76 * 1024);
#pragma unroll
    for (int gi = 0; gi < 5; ++gi) colz[gi] = (gi == 0 ? COL_R + h * 64 : gi == 1 ? COL_K + h * 64 : gi == 2 ? COL_V + h * 64 : gi == 3 ? COL_W : COL_A) + 4 * q;
    if (tid < 320) { const int gi = tid >> 6, c = tid & 63; const int col = (gi == 0 ? COL_R + h * 64 : gi == 1 ? COL_K + h * 64 : gi == 2 ? COL_V + h * 64 : gi == 3 ? COL_W : COL_A) + c - COL_R;
        const float mpv_ = p.mu_prev[col], mnv_ = p.mu_next[col]; sMU[gi * 64 + c] = mpv_; sMU[320 + gi * 64 + c] = mnv_; sM0[gi * 64 + c] = 1.0f - mpv_ - mnv_; }
    else if (tid < 384) sMU[640 + (tid - 320)] = p.k_k[h * 64 + (tid - 320)];
    else if (tid < 448) sMU[704 + (tid - 384)] = p.r_k[h * 64 + (tid - 384)];
    __syncthreads();
    float s[RPL][EC];
#pragma unroll
    for (int r = 0; r < RPL; ++r)
#pragma unroll
        for (int j = 0; j < EC; ++j) s[r][j] = 0.f;
    u32x2 zc[5], zp[5], zn[5];
    auto load_chunk = [&](int ci) {
        const int t = tbase + 32 * (dir ? NC - 1 - ci : ci) + tokA; const bool hasPrev = t > tbase, hasNext = t < tbase + L - 1;
        const bf16_t* zr = zall + (size_t)t * ZLD;
#pragma unroll
        for (int gi = 0; gi < 5; ++gi) { zc[gi] = *(const u32x2*)(zr + colz[gi]); zp[gi] = (u32x2){0u, 0u}; zn[gi] = (u32x2){0u, 0u};
            if (hasPrev) zp[gi] = *(const u32x2*)(zr - ZLD + colz[gi]);
            if (hasNext) zn[gi] = *(const u32x2*)(zr + ZLD + colz[gi]); }
    };
    load_chunk(0);
    for (int ci = 0; ci < NC; ++ci) {
        const int t0 = tbase + 32 * (dir ? NC - 1 - ci : ci);
        { float zs[5][4];
          f32x4 MP[5], MN[5], M0[5];
#pragma unroll
          for (int gi = 0; gi < 5; ++gi) { MP[gi] = *(const f32x4*)(sMU + gi * 64 + 4 * q); MN[gi] = *(const f32x4*)(sMU + 320 + gi * 64 + 4 * q); M0[gi] = *(const f32x4*)(sM0 + gi * 64 + 4 * q); }
          const f32x4 kk4c = *(const f32x4*)(sMU + 640 + 4 * q);
#pragma unroll
          for (int gi = 0; gi < 5; ++gi) {
              const float c[4] = {bf_lo(zc[gi].x), bf_hi(zc[gi].x), bf_lo(zc[gi].y), bf_hi(zc[gi].y)}, pv[4] = {bf_lo(zp[gi].x), bf_hi(zp[gi].x), bf_lo(zp[gi].y), bf_hi(zp[gi].y)}, nx[4] = {bf_lo(zn[gi].x), bf_hi(zn[gi].x), bf_lo(zn[gi].y), bf_hi(zn[gi].y)};
              shift4(zs[gi], c, pv, nx, M0[gi], MP[gi], MN[gi]);
          }
          if (ci + 1 < NC) load_chunk(ci + 1);
          *(f32x4*)(sR + tokA * 64 + 4 * q) = (f32x4){zs[0][0], zs[0][1], zs[0][2], zs[0][3]};
          *(f32x4*)(sKD + tokA * 64 + 4 * q) = (f32x4){zs[1][0], zs[1][1], zs[1][2], zs[1][3]};
          *(f32x4*)(sV + tokA * 64 + 4 * q) = (f32x4){zs[2][0], zs[2][1], zs[2][2], zs[2][3]};
          float kk[4], ss;
          kk4(kk, ss, zs[1], kk4c);
          ss = ss + 0.0f * kk[0];
          ss = red16(ss);
          const float inv = -__builtin_amdgcn_rsqf(fmaxf(ss, 1e-24f));
          *(f32x4*)(sAV + tokA * 64 + 4 * q) = (f32x4){kk[0] * inv, kk[1] * inv, kk[2] * inv, kk[3] * inv};
          float tw[4];
#pragma unroll
          for (int j = 0; j < 4; ++j) tw[j] = 1.0f - 2.0f * __builtin_amdgcn_rcpf(1.0f + fexp2_scaled(zs[3][j], 2.8853900818f));
          u32x2 w; w.x = pk_bf16(tw[0], tw[1]); w.y = pk_bf16(tw[2], tw[3]); *(u32x2*)(sTW + tokA * 72 + 4 * q) = w;
          w.x = pk_bf16(zs[4][0], zs[4][1]); w.y = pk_bf16(zs[4][2], zs[4][3]); *(u32x2*)(sZA + tokA * 72 + 4 * q) = w;
        }
        LDS_BAR();
        { const int matu = __builtin_amdgcn_readfirstlane(mat);
          const bf16_t* sX = matu ? sZA : sTW;
          const bf16x8 b0 = __builtin_bit_cast(bf16x8, sBF[tid]), b1 = __builtin_bit_cast(bf16x8, sBF[512 + tid]);
          const bf16_t* ap = sX + (lane & 15) * 72 + quad * 8;
          const bf16x8 a00 = *(const bf16x8*)(ap), a01 = *(const bf16x8*)(ap + 32), a10 = *(const bf16x8*)(ap + 16 * 72), a11 = *(const bf16x8*)(ap + 16 * 72 + 32);
          const int idx0 = (quad * 4) * 64 + colB;
          float o1[8], o2[8];
          if (matu == 0) {
#pragma unroll
              for (int i = 0; i < 8; ++i) o1[i] = sR[idx0 + ((i >> 2) * 16 + (i & 3)) * 64];
          } else {
#pragma unroll
              for (int i = 0; i < 8; ++i) { o1[i] = sKD[idx0 + ((i >> 2) * 16 + (i & 3)) * 64]; o2[i] = sAV[idx0 + ((i >> 2) * 16 + (i & 3)) * 64]; }
          }
          f32x4 acc0 = (f32x4){c0B, c0B, c0B, c0B}, acc1 = acc0;
          acc0 = __builtin_amdgcn_mfma_f32_16x16x32_bf16(a00, b0, acc0, 0, 0, 0); acc1 = __builtin_amdgcn_mfma_f32_16x16x32_bf16(a10, b0, acc1, 0, 0, 0);
          acc0 = __builtin_amdgcn_mfma_f32_16x16x32_bf16(a01, b1, acc0, 0, 0, 0); acc1 = __builtin_amdgcn_mfma_f32_16x16x32_bf16(a11, b1, acc1, 0, 0, 0);
          float sg[8];
#pragma unroll
          for (int i = 0; i < 8; ++i) sg[i] = sigmoidf_(i < 4 ? acc0[i & 3] : acc1[i & 3]);
          if (matu == 0) {
              float wv_[8];
#pragma unroll
              for (int i = 0; i < 8; ++i) wv_[i] = fexp2_scaled(sg[i], -0.6065306597f * 1.4426950409f);
#pragma unroll
              for (int i = 0; i < 8; ++i) { const int idx = idx0 + ((i >> 2) * 16 + (i & 3)) * 64; sW[idx] = wv_[i]; sWR[idx] = wv_[i] * o1[i]; }
          } else {
#pragma unroll
              for (int i = 0; i < 8; ++i) { const int idx = idx0 + ((i >> 2) * 16 + (i & 3)) * 64; sKD[idx] = o1[i] * (1.0f + (sg[i] - 1.0f) * kaB); sBV[idx] = -o2[i] * sg[i]; }
          } }
        LDS_BAR();
        { const int o4 = tokA * 64 + 4 * q;
          const f32x4 r4 = *(const f32x4*)(sR + o4), b4 = *(const f32x4*)(sBV + o4), k4 = *(const f32x4*)(sKD + o4), rk4 = *(const f32x4*)(sMU + 704 + 4 * q);
          const f32x4 a4 = *(const f32x4*)(sAV + o4), q4 = *(const f32x4*)(sWR + o4), v4 = *(const f32x4*)(sV + o4);
          float br = 0.f, kr = 0.f, cb = 0.f;
#pragma unroll
          for (int j = 0; j < 4; ++j) { br += b4[j] * r4[j]; kr += k4[j] * r4[j]; cb += r4[j] * k4[j] * rk4[j]; }
          br = red16(br); kr = red16(kr); cb = red16(cb);
          *(f32x4*)(sWR + o4) = q4 + a4 * br;
          *(f32x4*)(sV2 + o4) = v4 * kr;
          if (q == 0 && half == 0) bonus[(size_t)(t0 + tokA) * 16 + h] = cb; }
        LDS_BAR();
        {
            constexpr int NV = EC / 4;
            struct Ops { f32x4 w[NV], a[NV], b[NV], k[NV], q[NV]; float v[RPL]; };
            auto ld = [&](Ops& o, int i) { const int tk = DIR ? 31 - i : i; const int off = tk * 64 + 4 * gS;
#pragma unroll
                for (int c = 0; c < NV; ++c) { o.w[c] = *(const f32x4*)(sW + off + 32 * c); o.a[c] = *(const f32x4*)(sAV + off + 32 * c); o.b[c] = *(const f32x4*)(sBV + off + 32 * c);
                    o.k[c] = *(const f32x4*)(sKD + off + 32 * c); o.q[c] = *(const f32x4*)(sWR + off + 32 * c); }
                if constexpr (RPL == 2) { const f32x2 v2 = *(const f32x2*)(sV + tk * 64 + rowS); o.v[0] = v2.x; o.v[1] = v2.y; } else o.v[0] = sV[tk * 64 + rowS]; };
            auto step = [&](const Ops& cur, int i) {
                static_assert(EC == 4, "asm row helpers are written for 4 columns per lane");
                float sa[RPL], yp[RPL], y[RPL];
#pragma unroll
                for (int r = 0; r < RPL; ++r) row_dots(s[r], cur.a[0], cur.q[0], sa[r], yp[r]);
                if constexpr (RPL == 2) red16x4y(sa[0], yp[0], sa[1], yp[1]); else red16x2y(sa[0], yp[0]);
#pragma unroll
                for (int r = 0; r < RPL; ++r) { row_update3(s[r], cur.w[0], cur.b[0], cur.k[0], cur.v[r], sa[r]); y[r] = yp[r]; }
                if ((gS & 7) == 0) { float* yd = sYP + ((DIR ? 31 - i : i) * 2 + (gS >> 3)) * 64 + rowS; if constexpr (RPL == 2) *(f32x2*)yd = (f32x2){y[0], y[1]}; else *yd = y[0]; }
            };
            {
                Ops o0, o1, o2; ld(o0, 0); ld(o1, 1);
#pragma unroll 1
                for (int i = 0; i < 30; i += 3) {
                    ld(o2, i + 2);
                    step(o0, i);
                    ld(o0, i + 3);
                    step(o1, i + 1);
                    ld(o1, min(i + 4, 31));
                    step(o2, i + 2);
                }
                step(o0, 30);
                step(o1, 31);
            }
        }
        LDS_BAR();
        if (RPL == 2 || (q >> 3) == half) { const f32x4 y4 = *(const f32x4*)(sYP + (tokA * 2) * 64 + 4 * q) + *(const f32x4*)(sYP + (tokA * 2 + 1) * 64 + 4 * q) + *(const f32x4*)(sV2 + tokA * 64 + 4 * q); u32x2 w; w.x = pk_bf16(y4[0], y4[1]); w.y = pk_bf16(y4[2], y4[3]);
          *(u32x2*)(ybuf + (size_t)(t0 + tokA) * 1024 + h * 64 + 4 * q) = w; }
    }
}

__device__ void scan_phase(const Params& p, unsigned char* shm) {
    int* sItem = (int*)(shm + 80 * 1024);
    const int tid = opaque_tid();
    unsigned* queue = (unsigned*)(p.ws + OFF_QUEUE);
    for (;;) {
        if (tid == 0) *sItem = (int)atomicAdd(queue, 1u);
        __syncthreads();
        const int item = *sItem;
        __syncthreads();
        if (item >= N_ITEMS) break;
        int tid2 = tid; asm volatile("" : "+v"(tid2));
        if (item < N_SAMPLE_ITEMS) {
            const int half = item & 1, j = item >> 1;
            if (j & 1) scan_item<16, 1, 1>(p, shm, tid2, TP + (j >> 5) * 16384, 16384, (j >> 1) & 15, half); else scan_item<16, 1, 0>(p, shm, tid2, TP + (j >> 5) * 16384, 16384, (j >> 1) & 15, half);
        } else { const int j = item - N_SAMPLE_ITEMS;
            if (j & 1) scan_item<16, 2, 1>(p, shm, tid2, (j >> 5) * 2048, 2048, (j >> 1) & 15, 0); else scan_item<16, 2, 0>(p, shm, tid2, (j >> 5) * 2048, 2048, (j >> 1) & 15, 0); }
        __syncthreads();
    }
    for (;;) {
        if (tid == 0) *sItem = (int)atomicAdd(queue + 1, 1u);
        __syncthreads();
        const int u = *sItem;
        __syncthreads();
        if (u >= N_DEFER) break;
        deferred_unit(p, shm, tid, u);
    }
}


__device__ void mix_phase(const Params& p) {
    const int tidx = opaque_tid(); const int lane = tidx & 63, wave = (blockIdx.x * 512 + tidx) >> 6, nw = (gridDim.x * 512) >> 6;
    const bf16_t* zall = (const bf16_t*)(p.ws + OFF_Z);
    bf16_t* yf = (bf16_t*)p.out; const bf16_t* yb = (const bf16_t*)p.out + (size_t)T_TOK * 1024;
    const float* bonus_f = (const float*)(p.ws + OFF_BONUS); const float* bonus_b = bonus_f + (size_t)T_TOK * 16;
    bf16_t* pooled = (bf16_t*)(p.ws + OFF_POOLED); bf16_t* sg = (bf16_t*)(p.ws + OFF_SG);
    const int hL = lane >> 2;
    const int tpw = (T_TOK + nw - 1) / nw;
    for (int t = wave * tpw; t < min(T_TOK, (wave + 1) * tpw); ++t) {
        int tbase, L; seq_of(t, tbase, L); const int pos = t - tbase; const bool hasPrev = pos > 0, hasNext = pos < L - 1;
        const bf16_t* zr = zall + (size_t)t * ZLD;
        { const int c0 = lane * 16; float y[16];
          { const u32x4 a0 = *(const u32x4*)(yf + (size_t)t * 1024 + c0), a1 = *(const u32x4*)(yf + (size_t)t * 1024 + c0 + 8);
            const u32x4 b0 = *(const u32x4*)(yb + (size_t)t * 1024 + c0), b1 = *(const u32x4*)(yb + (size_t)t * 1024 + c0 + 8);
            f32x4 fa, fb, ga, gb; unpack8(a0, fa, fb); unpack8(b0, ga, gb);
#pragma unroll
            for (int j = 0; j < 4; ++j) { y[j] = fa[j] + ga[j]; y[4 + j] = fb[j] + gb[j]; }
            unpack8(a1, fa, fb); unpack8(b1, ga, gb);
#pragma unroll
            for (int j = 0; j < 4; ++j) { y[8 + j] = fa[j] + ga[j]; y[12 + j] = fb[j] + gb[j]; } }
          float sm = 0.f;
#pragma unroll
          for (int j = 0; j < 16; ++j) sm += y[j];
          const float mean = red4(sm) * (1.0f / 64.0f); float vs = 0.f;
#pragma unroll
          for (int j = 0; j < 16; ++j) { const float d = y[j] - mean; vs += d * d; }
          const float rstd = rsqrtf(red4(vs) * (1.0f / 64.0f) + 64e-5f);
          const float bon = bonus_f[(size_t)t * 16 + hL] + bonus_b[(size_t)t * 16 + hL];
          float vv[16];
          { const bf16_t* zc = zr + COL_V + c0;
            u32x4 c_[2], p_[2], n_[2];
#pragma unroll
            for (int i = 0; i < 2; ++i) { c_[i] = *(const u32x4*)(zc + 8 * i); p_[i] = hasPrev ? *(const u32x4*)(zc - ZLD + 8 * i) : (u32x4){0u, 0u, 0u, 0u}; n_[i] = hasNext ? *(const u32x4*)(zc + ZLD + 8 * i) : (u32x4){0u, 0u, 0u, 0u}; }
#pragma unroll
            for (int i = 0; i < 2; ++i) { f32x4 ca, cb, pa, pb, na, nb; unpack8(c_[i], ca, cb); unpack8(p_[i], pa, pb); unpack8(n_[i], na, nb);
                const float* mp = p.mu_prev + (COL_V - COL_R) + c0 + 8 * i; const float* mn = p.mu_next + (COL_V - COL_R) + c0 + 8 * i;
                const f32x4 mp0 = *(const f32x4*)mp, mp1 = *(const f32x4*)(mp + 4), mn0 = *(const f32x4*)mn, mn1 = *(const f32x4*)(mn + 4);
#pragma unroll
                for (int j = 0; j < 4; ++j) { vv[8 * i + j] = ca[j] + mp0[j] * (pa[j] - ca[j]) + mn0[j] * (na[j] - ca[j]); vv[8 * i + 4 + j] = cb[j] + mp1[j] * (pb[j] - cb[j]) + mn1[j] * (nb[j] - cb[j]); } } }
          float o[16];
#pragma unroll
          for (int i = 0; i < 4; ++i) { const f32x4 lw = *(const f32x4*)(p.ln_w + c0 + 4 * i), lb = *(const f32x4*)(p.ln_b + c0 + 4 * i);
#pragma unroll
              for (int j = 0; j < 4; ++j) o[4 * i + j] = (y[4 * i + j] - mean) * rstd * lw[j] + lb[j] + bon * vv[4 * i + j]; }
          u32x4 w0, w1; w0.x = pk_bf16(o[0], o[1]); w0.y = pk_bf16(o[2], o[3]); w0.z = pk_bf16(o[4], o[5]); w0.w = pk_bf16(o[6], o[7]);
          w1.x = pk_bf16(o[8], o[9]); w1.y = pk_bf16(o[10], o[11]); w1.z = pk_bf16(o[12], o[13]); w1.w = pk_bf16(o[14], o[15]);
          *(u32x4*)(yf + (size_t)t * 1024 + c0) = w0; *(u32x4*)(yf + (size_t)t * 1024 + c0 + 8) = w1; }
        { const int c = 2 * lane; const bf16_t* zc = zr + COL_G + c; const unsigned wc_ = *(const unsigned*)zc; const unsigned wp = hasPrev ? *(const unsigned*)(zc - ZLD) : 0u, wn = hasNext ? *(const unsigned*)(zc + ZLD) : 0u;
          const float mp0 = p.mu_prev[COL_G - COL_R + c], mp1 = p.mu_prev[COL_G - COL_R + c + 1], mn0 = p.mu_next[COL_G - COL_R + c], mn1 = p.mu_next[COL_G - COL_R + c + 1];
          const float c0v = bf_lo(wc_), c1v = bf_hi(wc_);
          const float z0 = c0v + mp0 * (bf_lo(wp) - c0v) + mn0 * (bf_lo(wn) - c0v), z1 = c1v + mp1 * (bf_hi(wp) - c1v) + mn1 * (bf_hi(wn) - c1v);
          *(unsigned*)(sg + (size_t)t * 256 + c) = pk_bf16(sigmoidf_(z0), sigmoidf_(z1)); *(unsigned*)(sg + (size_t)t * 256 + 128 + c) = 0u; }
        { const int c = lane * 8, gi = lane >> 4, w = 2 << gi; const int lo = max(pos - (w >> 1), 0), hi = min(pos + (w >> 1) - 1, L - 1);
          float sum[8];
#pragma unroll
          for (int j = 0; j < 8; ++j) sum[j] = 0.f;
          u32x4 wr_[16];
#pragma unroll
          for (int d = 0; d < 16; ++d) { const int r = pos - 8 + d; wr_[d] = (u32x4){0u, 0u, 0u, 0u}; if (r >= lo && r <= hi) wr_[d] = *(const u32x4*)(zall + (size_t)(tbase + r) * ZLD + c); }
#pragma unroll
          for (int d = 0; d < 16; ++d) { f32x4 a, b; unpack8(wr_[d], a, b);
#pragma unroll
              for (int j = 0; j < 4; ++j) { sum[j] += a[j]; sum[4 + j] += b[j]; } }
          const float icnt = 1.0f / (float)(hi - lo + 1); f32x4 a, b; unpack8(*(const u32x4*)(zr + c), a, b); f32x4 oa, ob;
#pragma unroll
          for (int j = 0; j < 4; ++j) { oa[j] = sum[j] * icnt - a[j]; ob[j] = sum[4 + j] * icnt - b[j]; }
          *(u32x4*)(pooled + (size_t)t * 512 + c) = pack8(oa, ob); }
    }
}

__device__ void final_phase(const Params& p) {
    const int tidx = opaque_tid(); const int lane = tidx & 63, wave = (blockIdx.x * 512 + tidx) >> 6, nw = (gridDim.x * 512) >> 6;
    const float* x2 = (const float*)(p.ws + OFF_X1); const float* rowsq2 = (const float*)(p.ws + OFF_ROWSQ2);
    f32x4 gv[4];
#pragma unroll
    for (int i = 0; i < 4; ++i) gv[i] = *(const f32x4*)(p.g_final + lane * 4 + 256 * i);
    for (int t0 = wave; t0 < T_TOK; t0 += 2 * nw) {
        const int t1 = t0 + nw < T_TOK ? t0 + nw : t0;
        const float r0 = rsqrtf(rowsq2[t0] * (1.0f / 1024.0f) + 1e-6f), r1 = rsqrtf(rowsq2[t1] * (1.0f / 1024.0f) + 1e-6f);
        f32x4 a[4], b[4];
#pragma unroll
        for (int i = 0; i < 4; ++i) { a[i] = *(const f32x4*)(x2 + (size_t)t0 * 1024 + lane * 4 + 256 * i); b[i] = *(const f32x4*)(x2 + (size_t)t1 * 1024 + lane * 4 + 256 * i); }
#pragma unroll
        for (int i = 0; i < 4; ++i) { *(f32x4*)(p.out + (size_t)t0 * 1024 + lane * 4 + 256 * i) = a[i] * r0 * gv[i]; *(f32x4*)(p.out + (size_t)t1 * 1024 + lane * 4 + 256 * i) = b[i] * r1 * gv[i]; }
    }
}

__global__ void __launch_bounds__(512, 2) fwd_megakernel(Params p) {
    extern __shared__ __attribute__((aligned(16))) unsigned char shm[];
    unsigned char* ws = p.ws;
    prep_phase(p, shm);
    cg::this_grid().sync();
    { EpiStore E; E.O = (bf16_t*)(ws + OFF_Z); E.ldc = ZLD; run_gemm(shm, (const bf16_t*)(ws + OFF_R1), 1024, (const bf16_t*)(ws + OFF_WIN), 1024, 3840, 1024, E); }
    cg::this_grid().sync();
    scan_phase(p, shm);
    cg::this_grid().sync();
    mix_phase(p);
    cg::this_grid().sync();
    rmsnorm_rows(p, p.g_mix, (bf16_t*)(ws + OFF_XN2));
    { EpiMulInPlace E; E.Y = (bf16_t*)p.out; run_gemm(shm, (const bf16_t*)(ws + OFF_SG), 256, (const bf16_t*)(ws + OFF_WG), 256, 1024, 256, E); }
    cg::this_grid().sync();
    { EpiGates E; E.G = (bf16_t*)(ws + OFF_GATES); E.bias = p.b_gate; run_gemm(shm, (const bf16_t*)(ws + OFF_XN2), 1024, (const bf16_t*)(ws + OFF_WIN) + (size_t)3840 * 1024, 1024, 2048, 1024, E); }
    cg::this_grid().sync();
    { EpiPool E; E.P = (bf16_t*)(ws + OFF_MERGED); E.G = (const bf16_t*)(ws + OFF_GATES); run_gemm(shm, (const bf16_t*)(ws + OFF_POOLED), 512, (const bf16_t*)(ws + OFF_WEFF), 512, 1024, 512, E); }
    { EpiMerge E; E.P = (bf16_t*)(ws + OFF_MERGED); E.G = (const bf16_t*)(ws + OFF_GATES); run_gemm(shm, (const bf16_t*)p.out, 1024, (const bf16_t*)(ws + OFF_WRBR), 1024, 1024, 1024, E); }
    cg::this_grid().sync();
    { EpiOut E; E.xp = p.x_prompt; E.xs = p.x_sample; E.X1 = (float*)(ws + OFF_X1); E.X1B = (bf16_t*)(ws + OFF_X1B); E.rowsq = (float*)(ws + OFF_ROWSQ); run_gemm(shm, (const bf16_t*)(ws + OFF_MERGED), 1024, (const bf16_t*)(ws + OFF_WOUT), 1024, 1024, 1024, E); }
    cg::this_grid().sync();
    { EpiFF1 E; E.Hlo = (bf16_t*)(ws + OFF_HLO); E.Hhi = (bf16_t*)p.out; E.rowsq = (const float*)(ws + OFF_ROWSQ); run_gemm(shm, (const bf16_t*)(ws + OFF_X1B), 1024, (const bf16_t*)(ws + OFF_WFF1), 1024, 4096, 1024, E); }
    cg::this_grid().sync();
    { EpiFinal E; E.X = (float*)(ws + OFF_X1); E.rowsq = (float*)(ws + OFF_ROWSQ2);
      run_gemm(shm, (const bf16_t*)(ws + OFF_HLO), 2048, (const bf16_t*)(ws + OFF_WFF2), 4096, 1024, 4096, E, (const bf16_t*)p.out, 32); }
    cg::this_grid().sync();
    final_phase(p);
}

extern "C" void kernel_launch(void* const* d_in, const int* in_sizes, int n_in, void* d_out, int out_size, void* d_ws, size_t ws_size, hipStream_t stream) {
    constexpr size_t kDynLds = 131072;
    static int grid_blocks = 0;
    if (!grid_blocks) {
        hipFuncSetAttribute((const void*)fwd_megakernel, hipFuncAttributeMaxDynamicSharedMemorySize, (int)kDynLds);
        int dev = 0, cus = 0, per_cu = 0;
        hipGetDevice(&dev);
        hipDeviceGetAttribute(&cus, hipDeviceAttributeMultiprocessorCount, dev);
        hipOccupancyMaxActiveBlocksPerMultiprocessor(&per_cu, fwd_megakernel, 512, kDynLds);
        if (per_cu < 1) per_cu = 1;
        grid_blocks = cus;
    }
    Params p{};
    const float** pf = (const float**)&p;
    for (int i = 0; i < 30; ++i) pf[i] = (const float*)d_in[i];
    p.out = (float*)d_out; p.ws = (unsigned char*)d_ws;
    void* args[] = {&p};
    hipError_t e = hipLaunchCooperativeKernel((const void*)fwd_megakernel, dim3(grid_blocks), dim3(512), args, kDynLds, stream);
    if (e != hipSuccess) fprintf(stderr, "cooperative launch failed: %s (grid %d)\n", hipGetErrorString(e), grid_blocks);
}
```
